# Optimizing an MI355X kernel written in HIP

```python
import math
import jax, jax.numpy as jnp
from jax import lax
import numpy as np


D_MODEL = 2048
BATCH = 8
SEQ = 4096
DEPTH = 1

SSM_WIDTH = D_MODEL // 2
SSM_GROUP = 16
SSM_N_GROUPS = SSM_WIDTH // SSM_GROUP
SSM_STATE = 64
ATTN_HEAD_DIM = 64
ATTN_Q_HEADS = (D_MODEL - SSM_WIDTH) // ATTN_HEAD_DIM
ATTN_KV_HEADS = 4
ATTN_REP = ATTN_Q_HEADS // ATTN_KV_HEADS
ATTN_Q_WIDTH = ATTN_Q_HEADS * ATTN_HEAD_DIM
ATTN_KV_WIDTH = ATTN_KV_HEADS * ATTN_HEAD_DIM
WINDOW = 128
MIX_WIDTH = SSM_WIDTH + ATTN_Q_WIDTH
IN_PROJ_WIDTH = SSM_WIDTH + ATTN_Q_WIDTH + 2 * ATTN_KV_WIDTH
REL_BUCKETS = 32
REL_MAX_DIST = 128
MEM_LEN = 256
MEM_HEADS = 4
MEM_HEAD_DIM = 128
MEM_WIDTH = MEM_HEADS * MEM_HEAD_DIM
PEER_HEADS = 8
PEER_N_KEYS = 128
PEER_N_EXPERTS = PEER_N_KEYS * PEER_N_KEYS
PEER_TOPK = 16
PEER_KEY_DIM = 256
PEER_HALF = PEER_KEY_DIM // 2
PEER_TOKEN_BLOCK = 128
NORM_EPS = 1e-6
DT_MIN = 1e-3
DT_MAX = 1e-1

kernel_name = 'hybrid_s5_swa_sink_peer_block'

F32 = jnp.float32


def rmsnorm(x, g):
    x32 = x.astype(F32)
    y = x32 * lax.rsqrt(jnp.mean(x32 * x32, axis=-1, keepdims=True) + NORM_EPS)
    return (y * g.astype(F32)).astype(x.dtype)


def s5_mixer(u, lam_re, lam_im, b_re, b_im, c_re, c_im, d, log_dt, w_glu, b_glu):
    bsz, L, _ = u.shape
    lam = lax.complex(lam_re.astype(F32), lam_im.astype(F32))
    dt = jnp.exp(log_dt.astype(F32))[:, None]
    lam_bar = jnp.exp(lam * dt)
    b = lax.complex(b_re.astype(F32), b_im.astype(F32))
    b_bar = ((lam_bar - 1.0) / lam)[..., None] * b
    c = lax.complex(c_re.astype(F32), c_im.astype(F32))
    ug = u.astype(F32).reshape(bsz, L, SSM_N_GROUPS, SSM_GROUP)

    def combine(left, right):
        a_l, s_l = left
        a_r, s_r = right
        return a_r * a_l, a_r * s_l + s_r

    def scan_one(u_seq):
        bu = jnp.einsum('gph,lgh->lgp', b_bar, u_seq.astype(jnp.complex64))
        a = jnp.broadcast_to(lam_bar, bu.shape)
        _, states = lax.associative_scan(combine, (a, bu), axis=0)
        return jnp.einsum('ghp,lgp->lgh', c, states).real

    y = lax.map(scan_one, ug) + d.astype(F32)[None, None] * ug
    y = jax.nn.gelu(y.reshape(bsz, L, SSM_WIDTH))
    return y * jax.nn.sigmoid(y @ w_glu.astype(F32) + b_glu.astype(F32))


def t5_bucket(dist):
    max_exact = REL_BUCKETS // 2
    d_f = jnp.maximum(dist, 1).astype(F32)
    large = max_exact + (jnp.log(d_f / max_exact) / math.log(REL_MAX_DIST / max_exact)
                         * (REL_BUCKETS - max_exact)).astype(jnp.int32)
    large = jnp.minimum(large, REL_BUCKETS - 1)
    return jnp.where(dist < max_exact, dist, large)


def sliding_window_gqa_sinks(q, k, v, sinks, rel_bias):
    bsz, L = q.shape[0], q.shape[1]
    nb = L // WINDOW
    qb = q.reshape(bsz, nb, WINDOW, ATTN_KV_HEADS, ATTN_REP, ATTN_HEAD_DIM)

    def windows(t):
        tp = jnp.pad(t, ((0, 0), (WINDOW, 0), (0, 0), (0, 0)))
        tp = tp.reshape(bsz, nb + 1, WINDOW, ATTN_KV_HEADS, ATTN_HEAD_DIM)
        return jnp.concatenate([tp[:, :-1], tp[:, 1:]], axis=2)

    kw = windows(k)
    vw = windows(v)
    scores = jnp.einsum('bnqgrd,bnkgd->bngrqk', qb, kw).astype(F32) * (ATTN_HEAD_DIM ** -0.5)
    qi = jnp.arange(WINDOW)[:, None]
    kj = jnp.arange(2 * WINDOW)[None, :]
    dist = qi + WINDOW - kj
    in_window = (dist >= 0) & (dist < WINDOW)
    key_pos = jnp.arange(nb)[:, None, None] * WINDOW + kj[None] - WINDOW
    valid = in_window[None] & (key_pos >= 0)
    bias = rel_bias.astype(F32)[t5_bucket(jnp.clip(dist, 0, WINDOW - 1))]
    bias = bias.transpose(2, 0, 1).reshape(ATTN_KV_HEADS, ATTN_REP, WINDOW, 2 * WINDOW)
    scores = jnp.where(valid[None, :, None, None], scores + bias[None, None], -jnp.inf)
    sink = jnp.broadcast_to(
        sinks.astype(F32).reshape(ATTN_KV_HEADS, ATTN_REP)[None, None, :, :, None, None],
        scores.shape[:-1] + (1,))
    p = jax.nn.softmax(jnp.concatenate([scores, sink], axis=-1), axis=-1)[..., :-1]
    out = jnp.einsum('bngrqk,bnkgd->bnqgrd', p.astype(vw.dtype), vw)
    return out.reshape(bsz, L, ATTN_Q_WIDTH)


def memory_cross_attention(hn, mem_n, w_cq, w_ckv, w_co):
    bsz, L, _ = hn.shape
    q = (hn @ w_cq).reshape(bsz, L, MEM_HEADS, MEM_HEAD_DIM)
    kv = (mem_n @ w_ckv).reshape(bsz, mem_n.shape[1], 2, MEM_HEADS, MEM_HEAD_DIM)
    k = kv[:, :, 0]
    v = kv[:, :, 1]
    s = jnp.einsum('blhd,bmhd->bhlm', q, k).astype(F32) * (MEM_HEAD_DIM ** -0.5)
    p = jax.nn.softmax(s, axis=-1)
    o = jnp.einsum('bhlm,bmhd->blhd', p.astype(v.dtype), v).reshape(bsz, L, MEM_WIDTH)
    return o @ w_co


def peer_ffn(hn, w_q, sub_keys, u_tab, v_tab):
    bsz, L, D = hn.shape
    tokens = hn.reshape(-1, PEER_TOKEN_BLOCK, D)

    def block(xb):
        T = xb.shape[0]
        q = (xb @ w_q).reshape(T, PEER_HEADS, 2, PEER_HALF)
        s = jnp.einsum('thcd,hckd->thck', q, sub_keys).astype(F32)
        s_top, i_top = lax.top_k(s, PEER_TOPK)
        cand = s_top[:, :, 0, :, None] + s_top[:, :, 1, None, :]
        cand_idx = i_top[:, :, 0, :, None] * PEER_N_KEYS + i_top[:, :, 1, None, :]
        best, pos = lax.top_k(cand.reshape(T, PEER_HEADS, PEER_TOPK * PEER_TOPK), PEER_TOPK)
        idx = jnp.take_along_axis(cand_idx.reshape(T, PEER_HEADS, PEER_TOPK * PEER_TOPK), pos, axis=-1)
        g = jax.nn.softmax(best, axis=-1)
        act = jax.nn.gelu(jnp.einsum('td,thkd->thk', xb, u_tab[idx]).astype(F32))
        coef = (g * act).astype(xb.dtype)
        return jnp.einsum('thk,thkd->td', coef, v_tab[idx])

    return lax.map(block, tokens).reshape(bsz, L, D)


def setup_inputs(seed: int = 0) -> dict:
    key = jax.random.key(seed)
    ks = jax.random.split(key, 32)
    nrm = lambda k, shape, s: jax.random.normal(k, shape, F32) * s
    G, P, H = SSM_N_GROUPS, SSM_STATE, SSM_GROUP
    x = jax.random.normal(ks[0], (BATCH, SEQ, D_MODEL), F32)
    mem = jax.random.normal(ks[1], (BATCH, MEM_LEN, D_MODEL), F32)
    rel_bias = nrm(ks[2], (REL_BUCKETS, ATTN_Q_HEADS), 0.5)
    norm_mix = 1.0 + nrm(ks[3], (DEPTH, D_MODEL), 0.02)
    w_in = nrm(ks[4], (DEPTH, D_MODEL, IN_PROJ_WIDTH), D_MODEL ** -0.5)
    n_idx = jnp.arange(P, dtype=F32)
    ssm_lambda_re = -0.5 + nrm(ks[5], (DEPTH, G, P), 0.01)
    ssm_lambda_im = math.pi * n_idx[None, None] + nrm(ks[6], (DEPTH, G, P), 0.01)
    ssm_b_re = nrm(ks[7], (DEPTH, G, P, H), (2 * H) ** -0.5)
    ssm_b_im = nrm(ks[8], (DEPTH, G, P, H), (2 * H) ** -0.5)
    ssm_c_re = nrm(ks[9], (DEPTH, G, H, P), (2 * P) ** -0.5)
    ssm_c_im = nrm(ks[10], (DEPTH, G, H, P), (2 * P) ** -0.5)
    ssm_d = nrm(ks[11], (DEPTH, G, H), 1.0)
    ssm_log_dt = jax.random.uniform(ks[12], (DEPTH, G), F32, math.log(DT_MIN), math.log(DT_MAX))
    ssm_w_glu = nrm(ks[13], (DEPTH, SSM_WIDTH, SSM_WIDTH), SSM_WIDTH ** -0.5)
    ssm_b_glu = nrm(ks[14], (DEPTH, SSM_WIDTH), 0.01)
    attn_sinks = nrm(ks[15], (DEPTH, ATTN_Q_HEADS), 1.0)
    w_out = nrm(ks[16], (DEPTH, MIX_WIDTH, D_MODEL), MIX_WIDTH ** -0.5)
    norm_cross = 1.0 + nrm(ks[17], (DEPTH, D_MODEL), 0.02)
    norm_mem = 1.0 + nrm(ks[18], (DEPTH, D_MODEL), 0.02)
    w_cq = nrm(ks[19], (DEPTH, D_MODEL, MEM_WIDTH), D_MODEL ** -0.5)
    w_ckv = nrm(ks[20], (DEPTH, D_MODEL, 2 * MEM_WIDTH), D_MODEL ** -0.5)
    w_co = nrm(ks[21], (DEPTH, MEM_WIDTH, D_MODEL), MEM_WIDTH ** -0.5)
    norm_ffn = 1.0 + nrm(ks[22], (DEPTH, D_MODEL), 0.02)
    peer_w_q = nrm(ks[23], (DEPTH, D_MODEL, PEER_HEADS * PEER_KEY_DIM), D_MODEL ** -0.5)
    peer_sub_keys = nrm(ks[24], (DEPTH, PEER_HEADS, 2, PEER_N_KEYS, PEER_HALF), PEER_HALF ** -0.5)
    peer_u = nrm(ks[25], (DEPTH, PEER_N_EXPERTS, D_MODEL), D_MODEL ** -0.5)
    peer_v = nrm(ks[26], (DEPTH, PEER_N_EXPERTS, D_MODEL), 0.1)
    norm_final = 1.0 + nrm(ks[27], (D_MODEL,), 0.02)
    return {'x': x, 'mem': mem, 'rel_bias': rel_bias, 'norm_mix': norm_mix, 'w_in': w_in,
            'ssm_lambda_re': ssm_lambda_re, 'ssm_lambda_im': ssm_lambda_im,
            'ssm_b_re': ssm_b_re, 'ssm_b_im': ssm_b_im, 'ssm_c_re': ssm_c_re, 'ssm_c_im': ssm_c_im,
            'ssm_d': ssm_d, 'ssm_log_dt': ssm_log_dt, 'ssm_w_glu': ssm_w_glu, 'ssm_b_glu': ssm_b_glu,
            'attn_sinks': attn_sinks, 'w_out': w_out, 'norm_cross': norm_cross, 'norm_mem': norm_mem,
            'w_cq': w_cq, 'w_ckv': w_ckv, 'w_co': w_co, 'norm_ffn': norm_ffn,
            'peer_w_q': peer_w_q, 'peer_sub_keys': peer_sub_keys, 'peer_u': peer_u, 'peer_v': peer_v,
            'norm_final': norm_final}


def reference(x, mem, rel_bias, norm_mix, w_in, ssm_lambda_re, ssm_lambda_im, ssm_b_re, ssm_b_im,
              ssm_c_re, ssm_c_im, ssm_d, ssm_log_dt, ssm_w_glu, ssm_b_glu, attn_sinks, w_out,
              norm_cross, norm_mem, w_cq, w_ckv, w_co, norm_ffn, peer_w_q, peer_sub_keys,
              peer_u, peer_v, norm_final):
    bsz, L, _ = x.shape
    h = x
    for l in range(DEPTH):
        proj = rmsnorm(h, norm_mix[l]) @ w_in[l]
        u_ssm = proj[..., :SSM_WIDTH]
        o = SSM_WIDTH
        q = proj[..., o:o + ATTN_Q_WIDTH].reshape(bsz, L, ATTN_Q_HEADS, ATTN_HEAD_DIM)
        o += ATTN_Q_WIDTH
        k = proj[..., o:o + ATTN_KV_WIDTH].reshape(bsz, L, ATTN_KV_HEADS, ATTN_HEAD_DIM)
        o += ATTN_KV_WIDTH
        v = proj[..., o:o + ATTN_KV_WIDTH].reshape(bsz, L, ATTN_KV_HEADS, ATTN_HEAD_DIM)
        y_ssm = s5_mixer(u_ssm, ssm_lambda_re[l], ssm_lambda_im[l], ssm_b_re[l], ssm_b_im[l],
                         ssm_c_re[l], ssm_c_im[l], ssm_d[l], ssm_log_dt[l], ssm_w_glu[l], ssm_b_glu[l])
        y_attn = sliding_window_gqa_sinks(q, k, v, attn_sinks[l], rel_bias)
        y_mix = jnp.concatenate([y_ssm.astype(h.dtype), y_attn.astype(h.dtype)], axis=-1)
        h = h + y_mix @ w_out[l]
        h = h + memory_cross_attention(rmsnorm(h, norm_cross[l]), rmsnorm(mem, norm_mem[l]),
                                       w_cq[l], w_ckv[l], w_co[l])
        h = h + peer_ffn(rmsnorm(h, norm_ffn[l]), peer_w_q[l], peer_sub_keys[l], peer_u[l], peer_v[l])
    return rmsnorm(h, norm_final)
```

```cpp
#include <hip/hip_runtime.h>
#include <hip/hip_cooperative_groups.h>
#include <cstdio>
#include <cstdint>
#ifndef ONE_LAUNCH
#define ONE_LAUNCH 0
#endif
#define PROBE_QC_AS_OC 0
#define SN_HD __host__ __device__ __forceinline__
#ifndef SN_HD
#define SN_HD __host__ __device__ __forceinline__
#endif
typedef unsigned int u32;
SN_HD u32 sn_max(u32 a, u32 b) { return a > b ? a : b; }
SN_HD u32 sn_min(u32 a, u32 b) { return a < b ? a : b; }
SN_HD u32 f2key(float f) { u32 u = __builtin_bit_cast(u32, f); return (u & 0x80000000u) ? ~u : (u | 0x80000000u); }
SN_HD float key2f(u32 k) { u32 u = (k & 0x80000000u) ? (k & 0x7fffffffu) : ~k; return __builtin_bit_cast(float, u); }
template <int BASE> SN_HD void bitonic_merge16_desc(u32 (&v)[64]) {
#pragma unroll
    for (int j = 8; j > 0; j >>= 1) {
#pragma unroll
        for (int i = 0; i < 16; ++i) { const int l = i ^ j; if (l > i) { const u32 a = v[BASE + i], b = v[BASE + l]; v[BASE + i] = sn_max(a, b); v[BASE + l] = sn_min(a, b); } }
    }
}
template <int BASE> SN_HD void bitonic_sort16_desc(u32 (&v)[64]) {
#pragma unroll
    for (int k = 2; k <= 16; k <<= 1) {
#pragma unroll
        for (int j = k >> 1; j > 0; j >>= 1) {
#pragma unroll
            for (int i = 0; i < 16; ++i) { const int l = i ^ j; if (l > i) { const u32 a = v[BASE + i], b = v[BASE + l]; const bool desc = ((i & k) == 0);
                v[BASE + i] = desc ? sn_max(a, b) : sn_min(a, b); v[BASE + l] = desc ? sn_min(a, b) : sn_max(a, b); } }
        }
    }
}
template <int A, int B> SN_HD void merge_top16(u32 (&v)[64]) {
#pragma unroll
    for (int i = 0; i < 16; ++i) v[A + i] = sn_max(v[A + i], v[B + 15 - i]);
    bitonic_merge16_desc<A>(v);
}
SN_HD void top16_of_64(u32 (&v)[64]) {
    bitonic_sort16_desc<0>(v); bitonic_sort16_desc<16>(v); bitonic_sort16_desc<32>(v); bitonic_sort16_desc<48>(v);
    merge_top16<0, 16>(v); merge_top16<32, 48>(v); merge_top16<0, 32>(v);
}
namespace pg8 {
#define PG8_LAS __attribute__((address_space(3)))
typedef unsigned short bf16_t;
typedef short bf16x8 __attribute__((ext_vector_type(8)));
typedef float f32x4 __attribute__((ext_vector_type(4)));
typedef unsigned u32x4 __attribute__((ext_vector_type(4)));
constexpr int BM = 256, BK = 64, HALF = 128, HTB = HALF * BK * 2  , STAGE_BYTES = 8 * HTB, NXCD = 8, WGM = 8;

__host__ __device__ __forceinline__ int lds_byte(int r, int c) { const int st = (r >> 4) * 2 + (c >> 5), rr = r & 15, cc = c & 31, ob = rr * 64 + cc * 2; return st * 1024 + (ob ^ (((ob >> 9) & 1) << 5)); }
__host__ __device__ __forceinline__ void stage_rc(int b, int& R, int& C) { const int st = b / 1024, sb = b % 1024, swz = sb ^ (((sb >> 9) & 1) << 5); R = (st >> 1) * 16 + swz / 64; C = (st & 1) * 32 + (swz % 64) / 2; }
__host__ __device__ __forceinline__ int perm32(int rho) { const int n = rho >> 4, i = rho & 15; return 8 * (i >> 2) + 4 * n + (i & 3); }

struct Unit { int pm, pn; };
struct Gemm { const bf16_t* A; const bf16_t* Bt; int M, N, K; };

struct StaticOrder {
    int nM, nN, nwg, G, c;
    __host__ __device__ void init(int M, int N, int G_, int c_) { nM = M / BM; nN = N / BM; nwg = nM * nN; G = G_; c = c_; }
    __host__ __device__ bool next(int i, Unit& u) const {
        const long L = (long)i * G + c; if (L >= nwg) return false;
        int wgid = (int)L; { const int q = nwg / NXCD, r = nwg % NXCD, xcd = wgid % NXCD, off = wgid / NXCD; wgid = (xcd < r ? xcd * (q + 1) : r * (q + 1) + (xcd - r) * q) + off; }
        const int nig = WGM * nN, gid = wgid / nig, fm = gid * WGM, gsz = (nM - fm) < WGM ? (nM - fm) : WGM;
        u.pm = fm + ((wgid % nig) % gsz); u.pn = (wgid % nig) / gsz; return true;
    }
    __device__ __forceinline__ void a_ready(const Unit&) const {}
    __device__ __forceinline__ void done(const Unit&) const {}
};

typedef float f32x2_t __attribute__((ext_vector_type(2)));
typedef __bf16 bf16x2_t __attribute__((ext_vector_type(2)));
__device__ __forceinline__ unsigned cvt_pk_bf16(float lo, float hi) { const f32x2_t f = {lo, hi}; const bf16x2_t b = __builtin_convertvector(f, bf16x2_t); return __builtin_bit_cast(unsigned, b); }


template <class Epi, class Sched>
__device__ __forceinline__ void gemm_phase(PG8_LAS unsigned char* lds, const Gemm g, const Sched& S, const Epi& E) {
    const int tid = threadIdx.x, wid = __builtin_amdgcn_readfirstlane(tid >> 6), lane = tid & 63, wr = wid >> 2, wc = wid & 3, fr = lane & 15, fq = lane >> 4;
    const int K = g.K, nt = K / BK;
    unsigned voffA[2], voffB[2];
#pragma unroll
    for (int i = 0; i < 2; ++i) { int R, C; stage_rc(tid * 16 + i * 8192, R, C); const int Rb = Epi::PERM ? ((R & ~31) + perm32(R & 31)) : R;
        voffA[i] = (unsigned)(R * K + C) * 2u; voffB[i] = (unsigned)(Rb * K + C) * 2u; }
    const size_t kstep = (size_t)(BK * 2);
    const size_t hstep = (size_t)HALF * K * 2;
    const size_t tstep = 2 * hstep;
    const unsigned ldsw = (unsigned)wid * 1024u;
    const int aoff = lds_byte(wr * 64 + fr, fq * 8), boff = lds_byte(wc * 32 + fr, fq * 8);
#define PG8_SA(b, h) (((b) * 2 + (h)) * HTB)
#define PG8_SB(b, h) ((4 + (b) * 2 + (h)) * HTB)
#define PG8_STAGE(bufoff, gbase, voff) do { _Pragma("unroll") for (int _i = 0; _i < 2; ++_i) \
        __builtin_amdgcn_global_load_lds((const unsigned*)((const char*)(gbase) + (voff)[_i]), (PG8_LAS unsigned*)(lds + (bufoff) + ldsw + _i * 8192), 16, 0, 0); } while (0)
#define PG8_LDA(dst, b, h) do { _Pragma("unroll") for (int m = 0; m < 4; ++m) _Pragma("unroll") for (int k = 0; k < 2; ++k) dst[m][k] = *(const PG8_LAS bf16x8*)(lds + PG8_SA(b, h) + aoff + m * 2048 + k * 1024); } while (0)
#define PG8_LDB(dst, b, h) do { _Pragma("unroll") for (int n = 0; n < 2; ++n) _Pragma("unroll") for (int k = 0; k < 2; ++k) dst[n][k] = *(const PG8_LAS bf16x8*)(lds + PG8_SB(b, h) + boff + n * 2048 + k * 1024); } while (0)
#define PG8_MMA(ai, bj, At, Bt) do { __builtin_amdgcn_s_setprio(1); _Pragma("unroll") for (int m = 0; m < 4; ++m) _Pragma("unroll") for (int n = 0; n < 2; ++n) _Pragma("unroll") for (int k = 0; k < 2; ++k) \
        acc[ai][bj][m][n] = __builtin_amdgcn_mfma_f32_16x16x32_bf16(Bt[n][k], At[m][k], acc[ai][bj][m][n], 0, 0, 0); __builtin_amdgcn_s_setprio(0); } while (0)
#define PG8_WAIT_V(n) asm volatile("s_waitcnt vmcnt(" #n ")" ::: "memory")
#define PG8_WAIT_L(n) asm volatile("s_waitcnt lgkmcnt(" #n ")" ::: "memory")
#define PG8_BAR __builtin_amdgcn_s_barrier()
#define PG8_SCHED __builtin_amdgcn_sched_barrier(0)
    Unit cur, nxt; int ui = 0;
    if (!S.next(0, cur)) return;
    f32x4 acc[2][2][4][2];
#pragma unroll
    for (int a = 0; a < 2; ++a)
#pragma unroll
        for (int b = 0; b < 2; ++b)
#pragma unroll
            for (int m = 0; m < 4; ++m)
#pragma unroll
                for (int n = 0; n < 2; ++n) acc[a][b][m][n] = (f32x4){0.f, 0.f, 0.f, 0.f};
    bf16x8 At[4][2], B0[2][2], B1[2][2];
    const char* cA = (const char*)g.A + (size_t)cur.pm * tstep; const char* cB = (const char*)g.Bt + (size_t)cur.pn * tstep;
    S.a_ready(cur);
    PG8_STAGE(PG8_SB(0, 0), cB, voffB); PG8_STAGE(PG8_SA(0, 0), cA, voffA); PG8_STAGE(PG8_SB(0, 1), cB + hstep, voffB); PG8_STAGE(PG8_SA(0, 1), cA + hstep, voffA);
    if (wr == 1) PG8_BAR;
    PG8_WAIT_V(4); PG8_BAR;
    PG8_STAGE(PG8_SB(1, 0), cB + kstep, voffB); PG8_STAGE(PG8_SA(1, 0), cA + kstep, voffA); PG8_STAGE(PG8_SB(1, 1), cB + hstep + kstep, voffB);
    PG8_WAIT_V(6); PG8_BAR;
    for (;;) {
        const bool has_next = S.next(ui + 1, nxt);
        const char* nA = has_next ? (const char*)g.A + (size_t)nxt.pm * tstep : cA; const char* nB = has_next ? (const char*)g.Bt + (size_t)nxt.pn * tstep : cB;
        for (int t = 0; t < nt; t += 2) {
            const bool last = (t == nt - 2);
            const char* a1 = cA + (size_t)(t + 1) * kstep;
            const char* a2 = last ? nA : cA + (size_t)(t + 2) * kstep; const char* b2 = last ? nB : cB + (size_t)(t + 2) * kstep;
            const char* a3 = a2 + kstep; const char* b3 = b2 + kstep;
            if (last && has_next) S.a_ready(nxt);
            PG8_LDB(B0, 0, 0); PG8_SCHED; PG8_LDA(At, 0, 0); PG8_STAGE(PG8_SA(1, 1), a1 + hstep, voffA);
            PG8_WAIT_L(8); PG8_BAR; PG8_WAIT_L(0); PG8_MMA(0, 0, At, B0); PG8_BAR; PG8_SCHED;
            PG8_LDB(B1, 0, 1); PG8_STAGE(PG8_SB(0, 0), b2, voffB);
            PG8_BAR; PG8_WAIT_L(0); PG8_MMA(0, 1, At, B1); PG8_BAR;
            PG8_LDA(At, 0, 1); PG8_STAGE(PG8_SA(0, 0), a2, voffA);
            PG8_BAR; PG8_WAIT_L(0); PG8_MMA(1, 0, At, B0); PG8_BAR; PG8_SCHED;
            PG8_STAGE(PG8_SB(0, 1), b2 + hstep, voffB);
            PG8_WAIT_V(6); PG8_BAR; PG8_MMA(1, 1, At, B1); PG8_BAR;
            PG8_LDB(B0, 1, 0); PG8_SCHED; PG8_LDA(At, 1, 0); PG8_STAGE(PG8_SA(0, 1), a2 + hstep, voffA);
            PG8_WAIT_L(8); PG8_BAR; PG8_WAIT_L(0); PG8_MMA(0, 0, At, B0); PG8_BAR; PG8_SCHED;
            PG8_LDB(B1, 1, 1); PG8_STAGE(PG8_SB(1, 0), b3, voffB);
            PG8_BAR; PG8_WAIT_L(0); PG8_MMA(0, 1, At, B1); PG8_BAR;
            PG8_LDA(At, 1, 1); PG8_STAGE(PG8_SA(1, 0), a3, voffA);
            PG8_BAR; PG8_WAIT_L(0); PG8_MMA(1, 0, At, B0); PG8_BAR; PG8_SCHED;
            PG8_STAGE(PG8_SB(1, 1), b3 + hstep, voffB);
            PG8_WAIT_V(6); PG8_BAR; PG8_MMA(1, 1, At, B1); PG8_BAR;
        }
        E(acc, cur, wr, wc, fr, fq); S.done(cur);
        if (!has_next) break;
#pragma unroll
        for (int a = 0; a < 2; ++a)
#pragma unroll
            for (int b = 0; b < 2; ++b)
#pragma unroll
                for (int m = 0; m < 4; ++m)
#pragma unroll
                    for (int n = 0; n < 2; ++n) acc[a][b][m][n] = (f32x4){0.f, 0.f, 0.f, 0.f};
        cur = nxt; cA = nA; cB = nB; ++ui;
    }
    PG8_WAIT_V(0);
    if (wr == 0) PG8_BAR;
    PG8_BAR;
#undef PG8_SA
#undef PG8_SB
#undef PG8_STAGE
#undef PG8_LDA
#undef PG8_LDB
#undef PG8_MMA
#undef PG8_WAIT_V
#undef PG8_WAIT_L
#undef PG8_BAR
#undef PG8_SCHED
}

struct EpiInProj {
    static constexpr bool PERM = true;
    bf16_t *U, *Q, *Kb, *Vb;
    __device__ __forceinline__ void operator()(const f32x4 (&acc)[2][2][4][2], const Unit& u, int wr, int wc, int fr, int fq) const {
        bf16_t* base; int ldc, colt;
        if (u.pn < 4) { base = U; ldc = 1024; colt = u.pn * BM; } else if (u.pn < 8) { base = Q; ldc = 1024; colt = (u.pn - 4) * BM; } else if (u.pn == 8) { base = Kb; ldc = 256; colt = 0; } else { base = Vb; ldc = 256; colt = 0; }
        const int row0 = u.pm * BM + wr * 64 + fr, col0 = colt + wc * 32 + 8 * fq;
#pragma unroll
        for (int ai = 0; ai < 2; ++ai)
#pragma unroll
            for (int m = 0; m < 4; ++m) { bf16_t* rowp = base + (size_t)(row0 + ai * HALF + m * 16) * ldc + col0;
#pragma unroll
                for (int bj = 0; bj < 2; ++bj) { const f32x4 v0 = acc[ai][bj][m][0], v1 = acc[ai][bj][m][1];
                    u32x4 w; w.x = cvt_pk_bf16(v0[0], v0[1]); w.y = cvt_pk_bf16(v0[2], v0[3]); w.z = cvt_pk_bf16(v1[0], v1[1]); w.w = cvt_pk_bf16(v1[2], v1[3]);
                    *(u32x4*)(rowp + bj * HALF) = w; } }
    }
};
struct EpiBf16Plain {
    static constexpr bool PERM = true;
    bf16_t* O; int ldc;
    __device__ __forceinline__ void operator()(const f32x4 (&acc)[2][2][4][2], const Unit& u, int wr, int wc, int fr, int fq) const {
        const int row0 = u.pm * BM + wr * 64 + fr, col0 = u.pn * BM + wc * 32 + 8 * fq;
#pragma unroll
        for (int ai = 0; ai < 2; ++ai)
#pragma unroll
            for (int m = 0; m < 4; ++m) { bf16_t* rowp = O + (size_t)(row0 + ai * HALF + m * 16) * ldc + col0;
#pragma unroll
                for (int bj = 0; bj < 2; ++bj) { const f32x4 v0 = acc[ai][bj][m][0], v1 = acc[ai][bj][m][1];
                    u32x4 w; w.x = cvt_pk_bf16(v0[0], v0[1]); w.y = cvt_pk_bf16(v0[2], v0[3]); w.z = cvt_pk_bf16(v1[0], v1[1]); w.w = cvt_pk_bf16(v1[2], v1[3]);
                    *(u32x4*)(rowp + bj * HALF) = w; } }
    }
};
struct EpiGlu {
    static constexpr bool PERM = true;
    bf16_t* O; int ldo; const bf16_t* Y; int ldy; const float* bias;
    __device__ __forceinline__ void operator()(const f32x4 (&acc)[2][2][4][2], const Unit& u, int wr, int wc, int fr, int fq) const {
        const int row0 = u.pm * BM + wr * 64 + fr, col0 = u.pn * BM + wc * 32 + 8 * fq;
        f32x4 bv[2][2];
#pragma unroll
        for (int bj = 0; bj < 2; ++bj)
#pragma unroll
            for (int n = 0; n < 2; ++n) bv[bj][n] = *(const f32x4*)(bias + col0 + bj * HALF + 4 * n);
#pragma unroll
        for (int ai = 0; ai < 2; ++ai)
#pragma unroll
            for (int m = 0; m < 4; ++m) { const size_t row = (size_t)(row0 + ai * HALF + m * 16);
#pragma unroll
                for (int bj = 0; bj < 2; ++bj) {
                    const u32x4 yw = *(const u32x4*)(Y + row * ldy + col0 + bj * HALF);
                    float o[8];
#pragma unroll
                    for (int e = 0; e < 8; ++e) { const float a = acc[ai][bj][m][e >> 2][e & 3] + bv[bj][e >> 2][e & 3];
                        const unsigned yy = yw[e >> 1]; const float y = __uint_as_float((e & 1) ? (yy & 0xffff0000u) : (yy << 16));
                        o[e] = y / (1.0f + __expf(-a)); }
                    u32x4 w; w.x = cvt_pk_bf16(o[0], o[1]); w.y = cvt_pk_bf16(o[2], o[3]); w.z = cvt_pk_bf16(o[4], o[5]); w.w = cvt_pk_bf16(o[6], o[7]);
                    *(u32x4*)(O + row * ldo + col0 + bj * HALF) = w; } }
    }
};
struct EpiResF32 {
    static constexpr bool PERM = false;
    float* C; const float* R; int ldc;
    __device__ __forceinline__ void operator()(const f32x4 (&acc)[2][2][4][2], const Unit& u, int wr, int wc, int fr, int fq) const {
        const int row0 = u.pm * BM + wr * 64 + fr, col0 = u.pn * BM + wc * 32 + 4 * fq;
#pragma unroll
        for (int ai = 0; ai < 2; ++ai)
#pragma unroll
            for (int m = 0; m < 4; ++m) { const size_t off = (size_t)(row0 + ai * HALF + m * 16) * ldc + col0;
#pragma unroll
                for (int bj = 0; bj < 2; ++bj)
#pragma unroll
                    for (int n = 0; n < 2; ++n) { f32x4 v = acc[ai][bj][m][n]; if (R) v = v + *(const f32x4*)(R + off + bj * HALF + n * 16); *(f32x4*)(C + off + bj * HALF + n * 16) = v; } }
    }
};
}
constexpr int NTOK = 32768, DM = 2048, SEQ = 4096, NB = 8;
constexpr int NWAVES = 8, NTHREADS = 512;
constexpr int LDS_BYTES = 147456;
constexpr float NORM_EPS = 1e-6f;

#define LAS __attribute__((address_space(3)))
typedef unsigned short bf16;
typedef unsigned u32;
typedef short bf16x8 __attribute__((ext_vector_type(8)));
typedef short s16x4 __attribute__((ext_vector_type(4)));
typedef float f32x4 __attribute__((ext_vector_type(4)));
typedef float f32x16 __attribute__((ext_vector_type(16)));
typedef unsigned u32x4 __attribute__((ext_vector_type(4)));
typedef unsigned u32x2 __attribute__((ext_vector_type(2)));

constexpr size_t MiB = 1u << 20;
constexpr size_t WS_CTL = 0, CTL_ZERO_BYTES = 64 * 1024;
constexpr size_t WS_W_IN_T = 1 * MiB, WS_W_GLU_T = 11 * MiB, WS_W_OUT_T = 13 * MiB, WS_W_CQ_T = 21 * MiB, WS_W_CKV_T = 23 * MiB, WS_W_CO_T = 27 * MiB, WS_W_S_T = 29 * MiB;
constexpr size_t WS_S5_WIN = 37 * MiB, WS_S5_WOUT = 41 * MiB, WS_S5_K = 45 * MiB, WS_S5_LAM = 46 * MiB, WS_BIAS_TAB = 46 * MiB + 512 * 1024;
constexpr size_t WS_MEM_N = 47 * MiB, WS_KV_C = 55 * MiB;
constexpr size_t WS_PEER_U = 64 * MiB, WS_PEER_V = 128 * MiB;
constexpr size_t WS_HN = 192 * MiB;
constexpr size_t WS_U = 320 * MiB, WS_Q = 384 * MiB, WS_K = 448 * MiB, WS_V = 464 * MiB, WS_YPRE = 480 * MiB, WS_YMIX = 544 * MiB;
constexpr size_t WS_SCORES = 320 * MiB;
constexpr size_t WS_QC = 672 * MiB, WS_OC = 704 * MiB, WS_TK_IDX = 736 * MiB, WS_TK_G = 752 * MiB, WS_END = 768 * MiB;

__device__ __forceinline__ unsigned f2bf(float f) { unsigned u = __float_as_uint(f); return (u + 0x7fffu + ((u >> 16) & 1u)) >> 16; }
__device__ __forceinline__ unsigned pk2(float lo, float hi) { return pg8::cvt_pk_bf16(lo, hi); }
__device__ __forceinline__ unsigned cvtpk(float lo, float hi) { return pg8::cvt_pk_bf16(lo, hi); }
__device__ __forceinline__ float bflo(unsigned w) { return __uint_as_float(w << 16); }
__device__ __forceinline__ float bfhi(unsigned w) { return __uint_as_float(w & 0xffff0000u); }
__device__ __forceinline__ float wave_sum(float v) {
#pragma unroll
    for (int o = 1; o < 64; o <<= 1) v += __shfl_xor(v, o);
    return v;
}
__device__ __forceinline__ float gelu_tanh(float x) { const float z = 0.7978845608028654f * (x + 0.044715f * x * x * x); return x / (1.0f + __expf(-2.0f * z)); }
#define LDS_WAIT() asm volatile("s_waitcnt lgkmcnt(0)" ::: "memory")
#define MFMA16(a, b, c) __builtin_amdgcn_mfma_f32_16x16x32_bf16((a), (b), (c), 0, 0, 0)
#define MFMA32(a, b, c) __builtin_amdgcn_mfma_f32_32x32x16_bf16((a), (b), (c), 0, 0, 0)

__device__ __forceinline__ void p0_transpose_item(const float* W, int K, int N, bf16* WT, LAS float* scr, int item, int lane) {
    const int nblk = N / 32, kb = item / nblk, nb = item % nblk, k0 = 64 * kb, n0 = 32 * nb;
#pragma unroll 8
    for (int i = 0; i < 32; ++i) { const int kk = 2 * i + (lane >> 5); scr[kk * 33 + (lane & 31)] = W[(size_t)(k0 + kk) * N + n0 + (lane & 31)]; }
    LDS_WAIT(); asm volatile("" ::: "memory");
    const int c = lane & 7;
#pragma unroll
    for (int j = 0; j < 4; ++j) { const int n = (lane >> 3) + 8 * j; const LAS float* s = scr + (8 * c) * 33 + n;
        u32x4 o; o.x = pk2(s[0 * 33], s[1 * 33]); o.y = pk2(s[2 * 33], s[3 * 33]); o.z = pk2(s[4 * 33], s[5 * 33]); o.w = pk2(s[6 * 33], s[7 * 33]);
        *(u32x4*)(WT + (size_t)(n0 + n) * K + k0 + 8 * c) = o; }
    LDS_WAIT(); asm volatile("" ::: "memory");
}
__device__ __forceinline__ void rms_row_to_bf16(const float* xrow, const float* gain, bf16* orow, int lane) {
    const f32x4* xr = (const f32x4*)xrow + lane; const f32x4* gr = (const f32x4*)gain + lane;
    f32x4 v[8]; float s = 0.f;
#pragma unroll
    for (int j = 0; j < 8; ++j) { v[j] = xr[64 * j]; s += (v[j].x * v[j].x + v[j].y * v[j].y) + (v[j].z * v[j].z + v[j].w * v[j].w); }
    const float r = rsqrtf(wave_sum(s) * (1.f / DM) + NORM_EPS);
    u32x2* o8 = (u32x2*)orow + lane;
#pragma unroll
    for (int j = 0; j < 8; ++j) { const f32x4 g = gr[64 * j]; u32x2 w; w.x = pk2(v[j].x * r * g.x, v[j].y * r * g.y); w.y = pk2(v[j].z * r * g.z, v[j].w * r * g.w); o8[64 * j] = w; }
}

struct Ptrs {
    const float* in[28]; float* out; unsigned char* ws;
};

__device__ __forceinline__ void phase_prologue(const Ptrs& P, LAS unsigned char* lds, int G) {
    const int tid = threadIdx.x, lane = tid & 63, wave = __builtin_amdgcn_readfirstlane(tid >> 6);
    unsigned char* ws = P.ws;
    {
        const float* wq = P.in[23]; const float* sk = P.in[24]; bf16* WsT = (bf16*)(ws + WS_W_S_T);
        LAS float* wq_l = (LAS float*)lds;
        for (int it = blockIdx.x; it < 512; it += G) {
            const int hc = it >> 5, d0 = (it & 31) * 64;
            __syncthreads();
#pragma unroll
            for (int i = 0; i < 16; ++i) { const int e = tid + 512 * i, dl = e >> 7, j = e & 127; wq_l[dl * 129 + j] = wq[(size_t)(d0 + dl) * 2048 + hc * 128 + j]; }
            __syncthreads();
            const float* skp = sk + ((size_t)hc * 128 + wave * 16) * 128;
            float acc[16];
#pragma unroll
            for (int i = 0; i < 16; ++i) acc[i] = 0.f;
            for (int j = 0; j < 128; ++j) { const float w = wq_l[lane * 129 + j];
#pragma unroll
                for (int i = 0; i < 16; ++i) acc[i] += skp[i * 128 + j] * w; }
#pragma unroll
            for (int i = 0; i < 16; ++i) WsT[(size_t)(hc * 128 + wave * 16 + i) * 2048 + d0 + lane] = (bf16)f2bf(acc[i]);
        }
        __syncthreads();
    }
    {
        const float *lam_re = P.in[5], *lam_im = P.in[6], *b_re = P.in[7], *b_im = P.in[8], *c_re = P.in[9], *c_im = P.in[10], *dd = P.in[11], *log_dt = P.in[12];
        LAS float* pwr = (LAS float*)lds;
        LAS float* bbar = pwr + 17 * 64 * 2;
        LAS float* cc = bbar + 64 * 16 * 2;
        for (int g = blockIdx.x; g < 64; g += G) {
            __syncthreads();
            if (tid < 64) {
                const int p = tid; const float lre = lam_re[g * 64 + p], lim = lam_im[g * 64 + p], dt = expf(log_dt[g]);
                const float er = expf(lre * dt); float sn, cs; sincosf(lim * dt, &sn, &cs);
                const float lbr = er * cs, lbi = er * sn;
                const float nr = lbr - 1.0f, ni = lbi, den = lre * lre + lim * lim;
                const float fr = (nr * lre + ni * lim) / den, fi = (ni * lre - nr * lim) / den;
#pragma unroll
                for (int h = 0; h < 16; ++h) { const float br = b_re[(g * 64 + p) * 16 + h], bi = b_im[(g * 64 + p) * 16 + h];
                    bbar[(p * 16 + h) * 2] = fr * br - fi * bi; bbar[(p * 16 + h) * 2 + 1] = fr * bi + fi * br; }
                float pr = 1.f, pi = 0.f;
                for (int j = 0; j <= 16; ++j) { pwr[(j * 64 + p) * 2] = pr; pwr[(j * 64 + p) * 2 + 1] = pi; const float t = pr * lbr - pi * lbi; pi = pr * lbi + pi * lbr; pr = t; }
            }
            for (int e = tid; e < 1024; e += NTHREADS) { cc[e * 2] = c_re[g * 1024 + e]; cc[e * 2 + 1] = c_im[g * 1024 + e]; }
            __syncthreads();
            bf16* Win = (bf16*)(ws + WS_S5_WIN) + (size_t)g * 32768; bf16* Wout = (bf16*)(ws + WS_S5_WOUT) + (size_t)g * 32768; bf16* Kt = (bf16*)(ws + WS_S5_K) + (size_t)g * 4096;
            for (int e = tid; e < 32768; e += NTHREADS) {
                const int m = e >> 8, kk = e & 255, p = m & 63, ri = m >> 6, sg = kk >> 4, hp = kk & 15;
                const float ar = pwr[((15 - sg) * 64 + p) * 2], ai = pwr[((15 - sg) * 64 + p) * 2 + 1], xr = bbar[(p * 16 + hp) * 2], xi = bbar[(p * 16 + hp) * 2 + 1];
                Win[e] = (bf16)f2bf(ri ? (ar * xi + ai * xr) : (ar * xr - ai * xi));
            }
            for (int e = tid; e < 32768; e += NTHREADS) {
                const int mm = e >> 7, m = e & 127, tau = mm >> 4, h = mm & 15, p = m & 63, ri = m >> 6;
                const float ar = pwr[((tau + 1) * 64 + p) * 2], ai = pwr[((tau + 1) * 64 + p) * 2 + 1], cr = cc[(h * 64 + p) * 2], ci = cc[(h * 64 + p) * 2 + 1];
                Wout[e] = (bf16)f2bf(ri ? -(cr * ai + ci * ar) : (cr * ar - ci * ai));
            }
            for (int e = tid; e < 4096; e += NTHREADS) {
                const int j = e >> 8, h = (e >> 4) & 15, hp = e & 15; float s = 0.f;
                for (int p = 0; p < 64; ++p) { const float ar = pwr[(j * 64 + p) * 2], ai = pwr[(j * 64 + p) * 2 + 1], cr = cc[(h * 64 + p) * 2], ci = cc[(h * 64 + p) * 2 + 1];
                    const float wr = cr * ar - ci * ai, wi = cr * ai + ci * ar; s += wr * bbar[(p * 16 + hp) * 2] - wi * bbar[(p * 16 + hp) * 2 + 1]; }
                if (j == 0 && h == hp) s += dd[g * 16 + h];
                Kt[e] = (bf16)f2bf(s);
            }
            if (tid < 64) { float* lamq = (float*)(ws + WS_S5_LAM) + g * 128; lamq[2 * tid] = pwr[(16 * 64 + tid) * 2]; lamq[2 * tid + 1] = pwr[(16 * 64 + tid) * 2 + 1]; }
        }
        __syncthreads();
    }
    {
        const float* rel_bias = P.in[2]; float* bt = (float*)(ws + WS_BIAS_TAB);
        for (int e = blockIdx.x * NTHREADS + tid; e < 2048; e += G * NTHREADS) {
            const int hq = e >> 7, dist = e & 127; int bucket = dist;
            if (dist >= 16) { int lg = 16 + (int)(logf((float)dist / 16.0f) / logf(8.0f) * 16.0f); bucket = lg < 31 ? lg : 31; }
            bt[e] = rel_bias[bucket * 16 + hq];
        }
    }
    {
        LAS float* scr = (LAS float*)(lds + wave * 16384);
        const int gw = blockIdx.x * NWAVES + wave, NGW = G * NWAVES;
        constexpr int I0 = 32 * 80, I1 = 16 * 32, I2 = 32 * 64, I3 = 32 * 16, I4 = 32 * 32, I5 = 8 * 64;
        for (int it = gw; it < I0 + I1 + I2 + I3 + I4 + I5; it += NGW) {
            int r = it;
            if (r < I0) { p0_transpose_item(P.in[4], 2048, 2560, (bf16*)(ws + WS_W_IN_T), scr, r, lane); continue; } r -= I0;
            if (r < I1) { p0_transpose_item(P.in[13], 1024, 1024, (bf16*)(ws + WS_W_GLU_T), scr, r, lane); continue; } r -= I1;
            if (r < I2) { p0_transpose_item(P.in[16], 2048, 2048, (bf16*)(ws + WS_W_OUT_T), scr, r, lane); continue; } r -= I2;
            if (r < I3) { p0_transpose_item(P.in[19], 2048, 512, (bf16*)(ws + WS_W_CQ_T), scr, r, lane); continue; } r -= I3;
            if (r < I4) { p0_transpose_item(P.in[20], 2048, 1024, (bf16*)(ws + WS_W_CKV_T), scr, r, lane); continue; } r -= I4;
            p0_transpose_item(P.in[21], 512, 2048, (bf16*)(ws + WS_W_CO_T), scr, r, lane);
        }
        for (int m = gw; m < NTOK; m += NGW) rms_row_to_bf16(P.in[0] + (size_t)m * DM, P.in[3], (bf16*)(ws + WS_HN) + (size_t)m * DM, lane);
        for (int m = gw; m < 2048; m += NGW) rms_row_to_bf16(P.in[1] + (size_t)m * DM, P.in[18], (bf16*)(ws + WS_MEM_N) + (size_t)m * DM, lane);
    }
    {
        const size_t n8 = (size_t)16384 * 2048 / 8;
        for (int t = 0; t < 2; ++t) {
            const f32x4* src = (const f32x4*)P.in[25 + t]; u32x4* dst = (u32x4*)(ws + (t ? WS_PEER_V : WS_PEER_U));
            for (size_t i = (size_t)blockIdx.x * NTHREADS + tid; i < n8; i += (size_t)G * NTHREADS) {
                const f32x4 a = src[2 * i], b = src[2 * i + 1];
                u32x4 w; w.x = pk2(a.x, a.y); w.y = pk2(a.z, a.w); w.z = pk2(b.x, b.y); w.w = pk2(b.z, b.w); dst[i] = w;
            }
        }
    }
}

__device__ __forceinline__ void phase_norm(const float* h, const float* gain, bf16* hn, int G) {
    const int lane = threadIdx.x & 63, wave = __builtin_amdgcn_readfirstlane(threadIdx.x >> 6);
    for (int m = blockIdx.x * NWAVES + wave; m < NTOK; m += G * NWAVES) rms_row_to_bf16(h + (size_t)m * DM, gain, hn + (size_t)m * DM, lane);
}

__device__ __forceinline__ void phase_s5(const Ptrs& P, LAS unsigned char* lds, int G) {
    const int tid = threadIdx.x, l = tid & 63, w = __builtin_amdgcn_readfirstlane(tid >> 6);
    unsigned char* ws = P.ws;
    const bf16* U = (const bf16*)(ws + WS_U); bf16* Y = (bf16*)(ws + WS_YPRE);
    LAS float* S_l = (LAS float*)lds;
    LAS bf16* Xs_l = (LAS bf16*)(lds + 66048);
    LAS float* Eseg = (LAS float*)(lds + 66048 + 34816);
    LAS float* Gcar = (LAS float*)(lds + 66048 + 34816 + 4096);
    const int l15 = l & 15, l4 = l >> 4;
    for (int it = blockIdx.x; it < 512; it += G) {
        const int b = it >> 6, g = it & 63;
        const bf16* Win = (const bf16*)(ws + WS_S5_WIN) + (size_t)g * 32768; const bf16* Wout = (const bf16*)(ws + WS_S5_WOUT) + (size_t)g * 32768; const bf16* Kt = (const bf16*)(ws + WS_S5_K) + (size_t)g * 4096;
        const float* lamq = (const float*)(ws + WS_S5_LAM) + g * 128;
        const int p = tid & 63, seg = tid >> 6;
        const float lqr = lamq[2 * p], lqi = lamq[2 * p + 1];
        float l16r = lqr, l16i = lqi;
#pragma unroll
        for (int i = 0; i < 4; ++i) { const float t = l16r * l16r - l16i * l16i; l16i = 2.f * l16r * l16i; l16r = t; }
        __syncthreads();
        if (tid < 64) { Gcar[2 * tid] = 0.f; Gcar[2 * tid + 1] = 0.f; }
#pragma unroll 1
        for (int hp = 0; hp < 2; ++hp) {
            bf16x8 Aw[8];
#pragma unroll
            for (int ks = 0; ks < 8; ++ks) Aw[ks] = *(const bf16x8*)(Win + (16 * w + l15) * 256 + 32 * ks + 8 * l4);
#pragma unroll 1
            for (int cb = 0; cb < 8; ++cb) {
                f32x4 acc = (f32x4){0.f, 0.f, 0.f, 0.f};
                const size_t tokb = (size_t)b * SEQ + 16 * (hp * 128 + cb * 16 + l15);
#pragma unroll
                for (int ks = 0; ks < 8; ++ks) { const bf16x8 Bf = *(const bf16x8*)(U + (tokb + 2 * ks + (l >> 5)) * 1024 + 16 * g + 8 * (l4 & 1)); acc = MFMA16(Aw[ks], Bf, acc); }
#pragma unroll
                for (int r = 0; r < 4; ++r) S_l[(16 * w + 4 * l4 + r) * 129 + cb * 16 + l15] = acc[r];
            }
            __syncthreads();
            {
                float er = 0.f, ei = 0.f; const int c0 = seg * 16;
                for (int i = 0; i < 16; ++i) { const int c = c0 + i; const float sr = S_l[p * 129 + c], si = S_l[(64 + p) * 129 + c];
                    const float t = lqr * er - lqi * ei + sr; ei = lqr * ei + lqi * er + si; er = t; S_l[p * 129 + c] = er; S_l[(64 + p) * 129 + c] = ei; }
                Eseg[(seg * 64 + p) * 2] = er; Eseg[(seg * 64 + p) * 2 + 1] = ei;
                __syncthreads();
                float gr = Gcar[((hp & 1) * 64 + p) * 2], gi = Gcar[((hp & 1) * 64 + p) * 2 + 1];
                for (int s = 0; s < seg; ++s) { const float t = l16r * gr - l16i * gi + Eseg[(s * 64 + p) * 2]; gi = l16r * gi + l16i * gr + Eseg[(s * 64 + p) * 2 + 1]; gr = t; }
                if (seg == 7) { Gcar[(((hp + 1) & 1) * 64 + p) * 2] = l16r * gr - l16i * gi + er; Gcar[(((hp + 1) & 1) * 64 + p) * 2 + 1] = l16r * gi + l16i * gr + ei; }
                float pr = 1.f, pi = 0.f;
                for (int i = 0; i < 16; ++i) { const int c = c0 + i;
                    float xr = pr * gr - pi * gi, xi = pr * gi + pi * gr;
                    if (i > 0) { xr += S_l[p * 129 + c - 1]; xi += S_l[(64 + p) * 129 + c - 1]; }
                    Xs_l[c * 136 + p] = (bf16)f2bf(xr); Xs_l[c * 136 + 64 + p] = (bf16)f2bf(xi);
                    const float t = pr * lqr - pi * lqi; pi = pr * lqi + pi * lqr; pr = t; }
            }
            __syncthreads();
#pragma unroll 1
            for (int tt = 0; tt < 2; ++tt) {
                const int tau = tt ? 15 - w : w;
                bf16x8 Tf[8], Wo[4];
#pragma unroll
                for (int ks = 0; ks < 8; ++ks) { const int lag = tau - (2 * ks + (l >> 5));
                    bf16x8 z = (bf16x8){0, 0, 0, 0, 0, 0, 0, 0};
                    if (lag >= 0) z = *(const bf16x8*)(Kt + (lag * 16 + l15) * 16 + 8 * (l4 & 1));
                    Tf[ks] = z; }
#pragma unroll
                for (int k2 = 0; k2 < 4; ++k2) Wo[k2] = *(const bf16x8*)(Wout + (tau * 16 + l15) * 128 + 32 * k2 + 8 * l4);
#pragma unroll 1
                for (int cb = 0; cb < 8; ++cb) {
                    f32x4 acc = (f32x4){0.f, 0.f, 0.f, 0.f};
                    const size_t tokb = (size_t)b * SEQ + 16 * (hp * 128 + cb * 16 + l15);
#pragma unroll
                    for (int ks = 0; ks < 8; ++ks) if (2 * ks <= tau) { const bf16x8 Bf = *(const bf16x8*)(U + (tokb + 2 * ks + (l >> 5)) * 1024 + 16 * g + 8 * (l4 & 1)); acc = MFMA16(Tf[ks], Bf, acc); }
#pragma unroll
                    for (int k2 = 0; k2 < 4; ++k2) { const bf16x8 Bx = *(const LAS bf16x8*)(Xs_l + (cb * 16 + l15) * 136 + 32 * k2 + 8 * l4); acc = MFMA16(Wo[k2], Bx, acc); }
                    u32x2 o; o.x = pk2(gelu_tanh(acc[0]), gelu_tanh(acc[1])); o.y = pk2(gelu_tanh(acc[2]), gelu_tanh(acc[3]));
                    *(u32x2*)(Y + (tokb + tau) * 1024 + 16 * g + 4 * l4) = o;
                }
            }
            __syncthreads();
        }
    }
}

template <int D, int NKB, bool SWA>
__device__ __forceinline__ void attn_task(const bf16* qrow, const LAS unsigned char* Kl, int kstrideB, const LAS unsigned char* Vl, int vstrideB, int kb0,
                                          const LAS float* biasr, int qloc, bool first_blk, float sink, float scale, bf16* orow, int l) {
    const int r32 = l & 31, h = l >> 5;
    bf16x8 qf[D / 16];
#pragma unroll
    for (int s = 0; s < D / 16; ++s) qf[s] = *(const bf16x8*)(qrow + 16 * s + 8 * h);
    f32x16 x[NKB];
#pragma unroll
    for (int kbi = 0; kbi < NKB; ++kbi) {
#pragma unroll
        for (int i = 0; i < 16; ++i) x[kbi][i] = 0.f;
#pragma unroll
        for (int s = 0; s < D / 16; ++s) { const bf16x8 a = *(const LAS bf16x8*)(Kl + ((kb0 + kbi) * 32 + r32) * kstrideB + (16 * s + 8 * h) * 2); x[kbi] = MFMA32(a, qf[s], x[kbi]); }
    }
    float m = -INFINITY;
#pragma unroll
    for (int kbi = 0; kbi < NKB; ++kbi)
#pragma unroll
        for (int i = 0; i < 16; ++i) {
            float s = x[kbi][i] * scale;
            if (SWA) { const int kloc = (kb0 + kbi) * 32 + (i & 3) + 8 * (i >> 2) + 4 * h, dist = qloc - kloc;
                const bool valid = (dist >= 0) && (dist < 128) && (!first_blk || kloc >= 128);
                const int dcl = dist < 0 ? 0 : (dist > 127 ? 127 : dist);
                s = valid ? s + biasr[dcl] : -INFINITY; }
            x[kbi][i] = s; m = fmaxf(m, s);
        }
    m = fmaxf(m, __shfl_xor(m, 32)); if (SWA) m = fmaxf(m, sink);
    float sum = 0.f;
    u32 pk[NKB][8];
#pragma unroll
    for (int kbi = 0; kbi < NKB; ++kbi)
#pragma unroll
        for (int i = 0; i < 16; i += 2) { const float e0 = __expf(x[kbi][i] - m), e1 = __expf(x[kbi][i + 1] - m); sum += e0 + e1; pk[kbi][i >> 1] = cvtpk(e0, e1); }
    sum += __shfl_xor(sum, 32); if (SWA) sum += __expf(sink - m);
    const float inv = 1.0f / sum;
    f32x16 o[D / 32];
#pragma unroll
    for (int db = 0; db < D / 32; ++db)
#pragma unroll
        for (int i = 0; i < 16; ++i) o[db][i] = 0.f;
#pragma unroll
    for (int kbi = 0; kbi < NKB; ++kbi)
#pragma unroll
        for (int s2 = 0; s2 < 2; ++s2) {
            u32x4 pw; pw.x = pk[kbi][4 * s2]; pw.y = pk[kbi][4 * s2 + 1]; pw.z = pk[kbi][4 * s2 + 2]; pw.w = pk[kbi][4 * s2 + 3];
            const bf16x8 pb = __builtin_bit_cast(bf16x8, pw);
#pragma unroll
            for (int db = 0; db < D / 32; ++db) {
                const LAS unsigned char* vp = Vl + (db * 32 + r32) * vstrideB + ((kb0 + kbi) * 32 + 16 * s2 + 4 * h) * 2;
                const s16x4 lo = *(const LAS s16x4*)vp, hi = *(const LAS s16x4*)(vp + 16);
                const bf16x8 a = __builtin_shufflevector(lo, hi, 0, 1, 2, 3, 4, 5, 6, 7);
                o[db] = MFMA32(a, pb, o[db]);
            }
        }
#pragma unroll
    for (int db = 0; db < D / 32; ++db)
#pragma unroll
        for (int g4 = 0; g4 < 4; ++g4) { u32x2 wv; wv.x = cvtpk(o[db][4 * g4] * inv, o[db][4 * g4 + 1] * inv); wv.y = cvtpk(o[db][4 * g4 + 2] * inv, o[db][4 * g4 + 3] * inv);
            *(u32x2*)(orow + db * 32 + 8 * g4 + 4 * h) = wv; }
}

__device__ __forceinline__ void phase_swa(const Ptrs& P, LAS unsigned char* lds, int G) {
    const int tid = threadIdx.x, l = tid & 63, w = __builtin_amdgcn_readfirstlane(tid >> 6);
    unsigned char* ws = P.ws;
    const bf16* Qb = (const bf16*)(ws + WS_Q); const bf16* Kb = (const bf16*)(ws + WS_K); const bf16* Vb = (const bf16*)(ws + WS_V); bf16* Ym = (bf16*)(ws + WS_YMIX);
    const float* bt = (const float*)(ws + WS_BIAS_TAB); const float* sinks = P.in[15];
    LAS unsigned char* Kl = lds;
    LAS unsigned char* Vl = lds + 36864;
    LAS float* bias_l = (LAS float*)(lds + 36864 + 33280);
    for (int it = blockIdx.x; it < 1024; it += G) {
        const int g = it & 3, n = (it >> 2) & 31, b = it >> 7;
        __syncthreads();
#pragma unroll
        for (int i = 0; i < 4; ++i) { const int e = tid + 512 * i, key = e >> 3, part = e & 7; const int kpos = n * 128 - 128 + key;
            u32x4 v = (u32x4){0u, 0u, 0u, 0u};
            if (kpos >= 0) v = *(const u32x4*)(Kb + ((size_t)b * SEQ + kpos) * 256 + g * 64 + part * 8);
            *(LAS u32x4*)(Kl + key * 144 + part * 16) = v; }
#pragma unroll
        for (int i = 0; i < 4; ++i) { const int e = tid + 512 * i, key = e & 255, part = e >> 8; const int kpos = n * 128 - 128 + key;
            u32x4 v = (u32x4){0u, 0u, 0u, 0u};
            if (kpos >= 0) v = *(const u32x4*)(Vb + ((size_t)b * SEQ + kpos) * 256 + g * 64 + part * 8);
#pragma unroll
            for (int jj = 0; jj < 8; ++jj) { const unsigned wv = v[jj >> 1]; *(LAS bf16*)(Vl + (part * 8 + jj) * 520 + key * 2) = (bf16)((jj & 1) ? (wv >> 16) : (wv & 0xffffu)); } }
        bias_l[tid] = bt[(4 * g + (tid >> 7)) * 128 + (tid & 127)];
        __syncthreads();
        const int r = w >> 1, hq = 4 * g + r; const float sink = sinks[hq];
#pragma unroll 1
        for (int t = 0; t < 2; ++t) {
            const int qq = 2 * (w & 1) + t, r32 = l & 31;
            const size_t qtok = (size_t)b * SEQ + n * 128 + 32 * qq + r32;
            attn_task<64, 5, true>(Qb + qtok * 1024 + hq * 64, Kl, 144, Vl, 520, qq, bias_l + r * 128, 128 + 32 * qq + r32, n == 0, sink, 0.125f,
                                   Ym + qtok * 2048 + 1024 + hq * 64, l);
        }
    }
}

__device__ __forceinline__ void phase_cross(const Ptrs& P, LAS unsigned char* lds, int G) {
    const int tid = threadIdx.x, l = tid & 63, w = __builtin_amdgcn_readfirstlane(tid >> 6);
    unsigned char* ws = P.ws;
    const bf16* Qc = (const bf16*)(ws + WS_QC); const bf16* KV = (const bf16*)(ws + WS_KV_C); bf16* Oc = (bf16*)(ws + WS_OC);
    LAS unsigned char* Kl = lds;
    LAS unsigned char* Vl = lds + 69632;
    int prev = -1;
    for (int it = blockIdx.x; it < 512; it += G) {
        const int qb = it & 15, hd = (it >> 4) & 3, b = it >> 6;
        if ((it >> 4) != prev) {
            prev = it >> 4;
            __syncthreads();
#pragma unroll
            for (int i = 0; i < 8; ++i) { const int e = tid + 512 * i, key = e >> 4, part = e & 15;
                *(LAS u32x4*)(Kl + key * 272 + part * 16) = *(const u32x4*)(KV + ((size_t)b * 256 + key) * 1024 + hd * 128 + part * 8); }
#pragma unroll
            for (int i = 0; i < 8; ++i) { const int e = tid + 512 * i, key = e & 255, part = e >> 8;
                const u32x4 v = *(const u32x4*)(KV + ((size_t)b * 256 + key) * 1024 + 512 + hd * 128 + part * 8);
#pragma unroll
                for (int jj = 0; jj < 8; ++jj) { const unsigned wv = v[jj >> 1]; *(LAS bf16*)(Vl + (part * 8 + jj) * 520 + key * 2) = (bf16)((jj & 1) ? (wv >> 16) : (wv & 0xffffu)); } }
            __syncthreads();
        }
        const size_t qtok = (size_t)b * SEQ + qb * 256 + 32 * w + (l & 31);
        attn_task<128, 8, false>(Qc + qtok * 512 + hd * 128, Kl, 272, Vl, 520, 0, (const LAS float*)lds, 0, false, 0.f, 0.08838834764831845f, Oc + qtok * 512 + hd * 128, l);
    }
}
__device__ __forceinline__ void phase_topk(const Ptrs& P, LAS unsigned char* lds, int G) {
    const int tid = threadIdx.x, l = tid & 63, w = __builtin_amdgcn_readfirstlane(tid >> 6);
    unsigned char* ws = P.ws;
    const float* SC = (const float*)(ws + WS_SCORES); int* TI = (int*)(ws + WS_TK_IDX); float* TG = (float*)(ws + WS_TK_G);
    LAS unsigned char* wb = lds + w * 16384;
    const int j = l >> 1, half = l & 1, sw = 2 * (j & 7);
    for (int tp = blockIdx.x * NWAVES + w; tp < NTOK / 2; tp += G * NWAVES) {
        const float* src = SC + (size_t)tp * 4096;
        asm volatile("" ::: "memory");
#pragma unroll
        for (int inst = 0; inst < 16; ++inst) { const int cg = inst * 64 + l, jj = cg >> 5, ci = cg & 31, phys = ci ^ (2 * (jj & 7));
            const f32x4 v = *(const f32x4*)(src + cg * 4); *(LAS f32x4*)(wb + jj * 512 + phys * 16) = v; }
        LDS_WAIT(); asm volatile("" ::: "memory");
        u32 v[64];
#pragma unroll
        for (int i = 0; i < 16; ++i) { const int ci = 2 * i + half, phys = ci ^ sw; const f32x4 f = *(const LAS f32x4*)(wb + j * 512 + phys * 16);
#pragma unroll
            for (int e = 0; e < 4; ++e) v[4 * i + e] = (f2key(f[e]) & ~0x7Fu) | (u32)(127 - (8 * i + 4 * half + e)); }
        LDS_WAIT(); asm volatile("" ::: "memory");
        top16_of_64(v);
        {
            u32 o[16];
#pragma unroll
            for (int i = 0; i < 16; ++i) o[i] = (u32)__shfl_xor((int)v[i], 1);
#pragma unroll
            for (int i = 0; i < 16; ++i) v[i] = sn_max(v[i], o[15 - i]);
            bitonic_merge16_desc<0>(v);
        }
        LAS u32* lut = (LAS u32*)wb;
#pragma unroll
        for (int i = 0; i < 16; ++i) lut[l * 16 + i] = v[i];
        float va[16], vb[16];
        {
            const bool c1 = (l >> 1) & 1;
#pragma unroll
            for (int i = 0; i < 16; ++i) { const u32 o = (u32)__shfl_xor((int)v[i], 2); const u32 a = c1 ? o : v[i], b = c1 ? v[i] : o; va[i] = key2f(a & ~0x7Fu); vb[i] = key2f(b & ~0x7Fu); }
        }
        u32 cnd[64];
        {
            int n = 0;
#pragma unroll
            for (int i = 0; i < 16; ++i)
#pragma unroll
                for (int q = 0; q < 16; ++q) if ((i + 1) * (q + 1) <= 16) { cnd[n] = (f2key(va[i] + vb[q]) & ~0xFFu) | (u32)(255 - (16 * i + q)); ++n; }
#pragma unroll
            for (int i = 50; i < 64; ++i) cnd[i] = 0u;
        }
        top16_of_64(cnd);
        LDS_WAIT(); asm volatile("" ::: "memory");
        float best[16]; int eidx[16];
        const int la = (l & ~2) * 16, lb = (l | 2) * 16;
#pragma unroll
        for (int r = 0; r < 16; ++r) { const u32 key = cnd[r]; const int pos = 255 - (int)(key & 0xFFu); best[r] = key2f(key & ~0xFFu);
            const int k0 = 127 - (int)(lut[la + (pos >> 4)] & 0x7Fu), k1 = 127 - (int)(lut[lb + (pos & 15)] & 0x7Fu); eidx[r] = k0 * 128 + k1; }
        float s = 0.f;
#pragma unroll
        for (int r = 0; r < 16; ++r) { best[r] = __expf(best[r] - key2f(cnd[0] & ~0xFFu)); s += best[r]; }
        const float inv = 1.0f / s;
        if ((l & 3) == 0) {
            const int tok = 2 * tp + (j >> 4), h = (j & 15) >> 1; const size_t o = ((size_t)tok * 8 + h) * 16;
#pragma unroll
            for (int r4 = 0; r4 < 4; ++r4) { *(int4*)(TI + o + 4 * r4) = make_int4(eidx[4 * r4], eidx[4 * r4 + 1], eidx[4 * r4 + 2], eidx[4 * r4 + 3]);
                *(f32x4*)(TG + o + 4 * r4) = (f32x4){best[4 * r4] * inv, best[4 * r4 + 1] * inv, best[4 * r4 + 2] * inv, best[4 * r4 + 3] * inv}; }
        }
        LDS_WAIT(); asm volatile("" ::: "memory");
    }
}

__device__ __forceinline__ void phase_peer(const Ptrs& P, int G) {
    const int tid = threadIdx.x, l = tid & 63, w = __builtin_amdgcn_readfirstlane(tid >> 6);
    unsigned char* ws = P.ws;
    const bf16* HN = (const bf16*)(ws + WS_HN); const bf16* UT = (const bf16*)(ws + WS_PEER_U); const bf16* VT = (const bf16*)(ws + WS_PEER_V);
    const int* TI = (const int*)(ws + WS_TK_IDX); const float* TG = (const float*)(ws + WS_TK_G); float* out = P.out; const float* gfin = P.in[27];
    for (int tok = blockIdx.x * NWAVES + w; tok < NTOK; tok += G * NWAVES) {
        float xr[32], acc[32];
#pragma unroll
        for (int i = 0; i < 4; ++i) { const u32x4 wv = *(const u32x4*)(HN + (size_t)tok * DM + 512 * i + 8 * l);
#pragma unroll
            for (int q = 0; q < 4; ++q) { xr[8 * i + 2 * q] = bflo(wv[q]); xr[8 * i + 2 * q + 1] = bfhi(wv[q]); } }
#pragma unroll
        for (int i = 0; i < 32; ++i) acc[i] = 0.f;
        const int iv0 = TI[(size_t)tok * 128 + l], iv1 = TI[(size_t)tok * 128 + 64 + l];
        const float gv0 = TG[(size_t)tok * 128 + l], gv1 = TG[(size_t)tok * 128 + 64 + l];
        for (int k = 0; k < 128; k += 2) {
            const int e0 = __builtin_amdgcn_readlane(k < 64 ? iv0 : iv1, k & 63), e1 = __builtin_amdgcn_readlane(k < 64 ? iv0 : iv1, (k + 1) & 63);
            const float g0 = __uint_as_float(__builtin_amdgcn_readlane(__float_as_uint(k < 64 ? gv0 : gv1), k & 63)), g1 = __uint_as_float(__builtin_amdgcn_readlane(__float_as_uint(k < 64 ? gv0 : gv1), (k + 1) & 63));
            u32x4 u0[4], u1[4], v0[4], v1[4];
#pragma unroll
            for (int i = 0; i < 4; ++i) { u0[i] = *(const u32x4*)(UT + (size_t)e0 * DM + 512 * i + 8 * l); u1[i] = *(const u32x4*)(UT + (size_t)e1 * DM + 512 * i + 8 * l); }
#pragma unroll
            for (int i = 0; i < 4; ++i) { v0[i] = *(const u32x4*)(VT + (size_t)e0 * DM + 512 * i + 8 * l); v1[i] = *(const u32x4*)(VT + (size_t)e1 * DM + 512 * i + 8 * l); }
            float d0 = 0.f, d1 = 0.f;
#pragma unroll
            for (int i = 0; i < 4; ++i)
#pragma unroll
                for (int q = 0; q < 4; ++q) { d0 += xr[8 * i + 2 * q] * bflo(u0[i][q]) + xr[8 * i + 2 * q + 1] * bfhi(u0[i][q]); d1 += xr[8 * i + 2 * q] * bflo(u1[i][q]) + xr[8 * i + 2 * q + 1] * bfhi(u1[i][q]); }
#pragma unroll
            for (int o = 1; o < 64; o <<= 1) { d0 += __shfl_xor(d0, o); d1 += __shfl_xor(d1, o); }
            const float c0 = g0 * gelu_tanh(d0), c1 = g1 * gelu_tanh(d1);
#pragma unroll
            for (int i = 0; i < 4; ++i)
#pragma unroll
                for (int q = 0; q < 4; ++q) { acc[8 * i + 2 * q] += c0 * bflo(v0[i][q]) + c1 * bflo(v1[i][q]); acc[8 * i + 2 * q + 1] += c0 * bfhi(v0[i][q]) + c1 * bfhi(v1[i][q]); }
        }
        float ss = 0.f;
#pragma unroll
        for (int i = 0; i < 4; ++i) { const f32x4* hp = (const f32x4*)(out + (size_t)tok * DM + 512 * i + 8 * l); const f32x4 a = hp[0], b = hp[1];
            acc[8 * i + 0] += a.x; acc[8 * i + 1] += a.y; acc[8 * i + 2] += a.z; acc[8 * i + 3] += a.w; acc[8 * i + 4] += b.x; acc[8 * i + 5] += b.y; acc[8 * i + 6] += b.z; acc[8 * i + 7] += b.w;
#pragma unroll
            for (int q = 0; q < 8; ++q) ss += acc[8 * i + q] * acc[8 * i + q]; }
        const float r = rsqrtf(wave_sum(ss) * (1.f / DM) + NORM_EPS);
#pragma unroll
        for (int i = 0; i < 4; ++i) { const f32x4* gp = (const f32x4*)(gfin + 512 * i + 8 * l); const f32x4 ga = gp[0], gb = gp[1]; f32x4* op = (f32x4*)(out + (size_t)tok * DM + 512 * i + 8 * l);
            op[0] = (f32x4){acc[8 * i + 0] * r * ga.x, acc[8 * i + 1] * r * ga.y, acc[8 * i + 2] * r * ga.z, acc[8 * i + 3] * r * ga.w};
            op[1] = (f32x4){acc[8 * i + 4] * r * gb.x, acc[8 * i + 5] * r * gb.y, acc[8 * i + 6] * r * gb.z, acc[8 * i + 7] * r * gb.w}; }
    }
}
struct Params { const float* in[28]; float* out; unsigned char* ws; int ph_lo, ph_hi; };
constexpr int N_PHASES = 13;
#ifndef STOP_AFTER
#define STOP_AFTER 12
#endif

__global__ void __launch_bounds__(NTHREADS, 2) mega(Params prm) {
    extern __shared__ __attribute__((aligned(16))) unsigned char lds_raw[];
    LAS unsigned char* lds = (LAS unsigned char*)lds_raw;
    const int G = gridDim.x;
    Ptrs P;
#pragma unroll
    for (int i = 0; i < 28; ++i) P.in[i] = prm.in[i];
    P.out = prm.out; P.ws = prm.ws;
    unsigned char* ws = prm.ws;
    const int lo = prm.ph_lo, hi = prm.ph_hi;
#ifndef PHMASK
#define PHMASK 0x1fff
#endif
#define IN(k) (((PHMASK >> (k)) & 1) && lo <= (k) && (k) < hi)
#if ONE_LAUNCH
    cooperative_groups::grid_group grid = cooperative_groups::this_grid();
#define SEAM(k) do { if (IN(k) && IN((k) + 1)) grid.sync(); } while (0)
#else
#define SEAM(k) do { } while (0)
#endif
    bf16* HN = (bf16*)(ws + WS_HN);
    if (IN(0)) { phase_prologue(P, lds, G); }
    SEAM(0);
    if (IN(1)) {
        __syncthreads();
        { pg8::Gemm g{HN, (const bf16*)(ws + WS_W_IN_T), NTOK, 2560, 2048}; pg8::StaticOrder S; S.init(NTOK, 2560, G, (int)blockIdx.x);
          pg8::EpiInProj E{(bf16*)(ws + WS_U), (bf16*)(ws + WS_Q), (bf16*)(ws + WS_K), (bf16*)(ws + WS_V)};
          pg8::gemm_phase<pg8::EpiInProj, pg8::StaticOrder>(lds, g, S, E); }
    }
    SEAM(1);
    if (IN(2)) {
#ifndef NO_S5
        __syncthreads(); phase_s5(P, lds, G);
#endif
#ifndef NO_SWA
        __syncthreads(); phase_swa(P, lds, G);
#endif
    }
    SEAM(2);
    if (IN(3)) {
        __syncthreads();
        pg8::Gemm g{(const bf16*)(ws + WS_YPRE), (const bf16*)(ws + WS_W_GLU_T), NTOK, 1024, 1024}; pg8::StaticOrder S; S.init(NTOK, 1024, G, (int)blockIdx.x);
        pg8::EpiGlu E{(bf16*)(ws + WS_YMIX), 2048, (const bf16*)(ws + WS_YPRE), 1024, P.in[14]};
        pg8::gemm_phase<pg8::EpiGlu, pg8::StaticOrder>(lds, g, S, E);
    }
    SEAM(3);
    if (IN(4)) {
        __syncthreads();
        pg8::Gemm g{(const bf16*)(ws + WS_YMIX), (const bf16*)(ws + WS_W_OUT_T), NTOK, 2048, 2048}; pg8::StaticOrder S; S.init(NTOK, 2048, G, (int)blockIdx.x);
        pg8::EpiResF32 E{P.out, P.in[0], 2048};
        pg8::gemm_phase<pg8::EpiResF32, pg8::StaticOrder>(lds, g, S, E);
    }
    SEAM(4);
    if (IN(5)) { phase_norm(P.out, P.in[17], HN, G);
        __syncthreads();
        { pg8::Gemm g{(const bf16*)(ws + WS_MEM_N), (const bf16*)(ws + WS_W_CKV_T), 2048, 1024, 2048}; pg8::StaticOrder S; S.init(2048, 1024, G, (int)blockIdx.x);
          pg8::EpiBf16Plain E{(bf16*)(ws + WS_KV_C), 1024};
          pg8::gemm_phase<pg8::EpiBf16Plain, pg8::StaticOrder>(lds, g, S, E); }
    }
    SEAM(5);
    if (IN(6)) {
        __syncthreads();
        pg8::Gemm g{HN, (const bf16*)(ws + WS_W_CQ_T), NTOK, 512, 2048}; pg8::StaticOrder S; S.init(NTOK, 512, G, (int)blockIdx.x);
        pg8::EpiBf16Plain E{(bf16*)(ws + WS_QC), 512};
        pg8::gemm_phase<pg8::EpiBf16Plain, pg8::StaticOrder>(lds, g, S, E);
    }
    SEAM(6);
    if (IN(7)) { __syncthreads(); phase_cross(P, lds, G); }
    SEAM(7);
    if (IN(8)) {
        __syncthreads();
        pg8::Gemm g{(const bf16*)(ws + (PROBE_QC_AS_OC ? WS_QC : WS_OC)), (const bf16*)(ws + WS_W_CO_T), NTOK, 2048, 512}; pg8::StaticOrder S; S.init(NTOK, 2048, G, (int)blockIdx.x);
        pg8::EpiResF32 E{P.out, P.out, 2048};
        pg8::gemm_phase<pg8::EpiResF32, pg8::StaticOrder>(lds, g, S, E);
    }
    SEAM(8);
    if (IN(9)) { phase_norm(P.out, P.in[22], HN, G); }
    SEAM(9);
    if (IN(10)) {
        __syncthreads();
        pg8::Gemm g{HN, (const bf16*)(ws + WS_W_S_T), NTOK, 2048, 2048}; pg8::StaticOrder S; S.init(NTOK, 2048, G, (int)blockIdx.x);
        pg8::EpiResF32 E{(float*)(ws + WS_SCORES), nullptr, 2048};
        pg8::gemm_phase<pg8::EpiResF32, pg8::StaticOrder>(lds, g, S, E);
    }
    SEAM(10);
    if (IN(11)) { __syncthreads(); phase_topk(P, lds, G); }
    SEAM(11);
    if (IN(12)) { phase_peer(P, G); }
    if (lo <= 13 && 13 < hi) {
        const int lane = threadIdx.x & 63, wave = threadIdx.x >> 6;
        for (int m = blockIdx.x * NWAVES + wave; m < NTOK; m += G * NWAVES) {
            f32x4* xr = (f32x4*)(P.out + (size_t)m * DM) + lane; const f32x4* gr = (const f32x4*)P.in[27] + lane;
            f32x4 v[8]; float ss = 0.f;
#pragma unroll
            for (int j = 0; j < 8; ++j) { v[j] = xr[64 * j]; ss += (v[j].x * v[j].x + v[j].y * v[j].y) + (v[j].z * v[j].z + v[j].w * v[j].w); }
            const float r = rsqrtf(wave_sum(ss) * (1.f / DM) + NORM_EPS);
#pragma unroll
            for (int j = 0; j < 8; ++j) { const f32x4 g = gr[64 * j]; xr[64 * j] = (f32x4){v[j].x * r * g.x, v[j].y * r * g.y, v[j].z * r * g.z, v[j].w * r * g.w}; }
        }
    }
}

extern "C" void kernel_launch(void* const* d_in, const int* in_sizes, int n_in, void* d_out, int out_size, void* d_ws, size_t ws_size, hipStream_t stream) {
    static int grid = 0;
    if (!grid) {
        int dev = 0, cus = 0, per_cu = 0;
        if (hipGetDevice(&dev) != hipSuccess || hipDeviceGetAttribute(&cus, hipDeviceAttributeMultiprocessorCount, dev) != hipSuccess) { fprintf(stderr, "kernel_launch: device query failed\n"); return; }
        if (hipFuncSetAttribute((const void*)mega, hipFuncAttributeMaxDynamicSharedMemorySize, LDS_BYTES) != hipSuccess) { fprintf(stderr, "kernel_launch: hipFuncSetAttribute failed\n"); return; }
        if (hipOccupancyMaxActiveBlocksPerMultiprocessor(&per_cu, (const void*)mega, NTHREADS, LDS_BYTES) != hipSuccess || per_cu < 1) { fprintf(stderr, "kernel_launch: occupancy query says %d\n", per_cu); per_cu = 1; }
        grid = cus * 1;
        if (ws_size < WS_END || n_in != 28) fprintf(stderr, "kernel_launch: unexpected ws_size %zu / n_in %d\n", ws_size, n_in);
    }
    Params p{};
    for (int i = 0; i < 28; ++i) p.in[i] = (const float*)d_in[i];
    p.out = (float*)d_out; p.ws = (unsigned char*)d_ws;
#if ONE_LAUNCH
    p.ph_lo = 0; p.ph_hi = N_PHASES;
    void* args[] = {&p};
    hipError_t e = hipLaunchCooperativeKernel((const void*)mega, dim3(grid), dim3(NTHREADS), args, LDS_BYTES, stream);
    if (e != hipSuccess) fprintf(stderr, "cooperative launch failed: %s (grid %d)\n", hipGetErrorString(e), grid);
#else
    for (int ph = 0; ph <= STOP_AFTER; ++ph) { p.ph_lo = ph; p.ph_hi = ph + 1; hipLaunchKernelGGL(mega, dim3(grid), dim3(NTHREADS), LDS_BYTES, stream, p); }
    if (STOP_AFTER < 12) { p.ph_lo = 13; p.ph_hi = 14; hipLaunchKernelGGL(mega, dim3(grid), dim3(NTHREADS), LDS_BYTES, stream, p); }
#endif
}
```

```cpp
#include <hip/hip_runtime.h>
#include <cstdio>
#include <cstdint>
#ifndef ONE_LAUNCH
#define ONE_LAUNCH 1
#endif
#define SN_HD __host__ __device__ __forceinline__
#ifndef SN_HD
#define SN_HD __host__ __device__ __forceinline__
#endif
typedef unsigned int u32;
SN_HD u32 sn_max(u32 a, u32 b) { return a > b ? a : b; }
SN_HD u32 sn_min(u32 a, u32 b) { return a < b ? a : b; }
SN_HD u32 f2key(float f) { u32 u = __builtin_bit_cast(u32, f); return (u & 0x80000000u) ? ~u : (u | 0x80000000u); }
SN_HD float key2f(u32 k) { u32 u = (k & 0x80000000u) ? (k & 0x7fffffffu) : ~k; return __builtin_bit_cast(float, u); }
template <int BASE> SN_HD void bitonic_merge16_desc(u32 (&v)[64]) {
#pragma unroll
    for (int j = 8; j > 0; j >>= 1) {
#pragma unroll
        for (int i = 0; i < 16; ++i) { const int l = i ^ j; if (l > i) { const u32 a = v[BASE + i], b = v[BASE + l]; v[BASE + i] = sn_max(a, b); v[BASE + l] = sn_min(a, b); } }
    }
}
template <int BASE> SN_HD void bitonic_sort16_desc(u32 (&v)[64]) {
#pragma unroll
    for (int k = 2; k <= 16; k <<= 1) {
#pragma unroll
        for (int j = k >> 1; j > 0; j >>= 1) {
#pragma unroll
            for (int i = 0; i < 16; ++i) { const int l = i ^ j; if (l > i) { const u32 a = v[BASE + i], b = v[BASE + l]; const bool desc = ((i & k) == 0);
                v[BASE + i] = desc ? sn_max(a, b) : sn_min(a, b); v[BASE + l] = desc ? sn_min(a, b) : sn_max(a, b); } }
        }
    }
}
template <int A, int B> SN_HD void merge_top16(u32 (&v)[64]) {
#pragma unroll
    for (int i = 0; i < 16; ++i) v[A + i] = sn_max(v[A + i], v[B + 15 - i]);
    bitonic_merge16_desc<A>(v);
}
SN_HD void top16_of_64(u32 (&v)[64]) {
    bitonic_sort16_desc<0>(v); bitonic_sort16_desc<16>(v); bitonic_sort16_desc<32>(v); bitonic_sort16_desc<48>(v);
    merge_top16<0, 16>(v); merge_top16<32, 48>(v); merge_top16<0, 32>(v);
}

SN_HD void merge_sorted16_desc(u32 (&a)[16]) {
#pragma unroll
    for (int j = 8; j > 0; j >>= 1) {
#pragma unroll
        for (int i = 0; i < 16; ++i) { const int l = i ^ j; if (l > i) { const u32 x = a[i], y = a[l]; a[i] = sn_max(x, y); a[l] = sn_min(x, y); } }
    }
}
SN_HD void sort16_desc(u32 (&a)[16]) {
#pragma unroll
    for (int k = 2; k <= 16; k <<= 1) {
#pragma unroll
        for (int j = k >> 1; j > 0; j >>= 1) {
#pragma unroll
            for (int i = 0; i < 16; ++i) { const int l = i ^ j; if (l > i) { const u32 x = a[i], y = a[l]; const bool desc = ((i & k) == 0);
                a[i] = desc ? sn_max(x, y) : sn_min(x, y); a[l] = desc ? sn_min(x, y) : sn_max(x, y); } }
        }
    }
}
SN_HD void merge_top16_desc(u32 (&a)[16], const u32 (&b)[16]) {
#pragma unroll
    for (int i = 0; i < 16; ++i) a[i] = sn_max(a[i], b[15 - i]);
    merge_sorted16_desc(a);
}
SN_HD void insert_top16_desc(u32 (&a)[16], u32 x) {
#pragma unroll
    for (int k = 15; k > 0; --k) a[k] = sn_max(a[k], sn_min(a[k - 1], x));
    a[0] = sn_max(a[0], x);
}
namespace pg8 {
#define PG8_LAS __attribute__((address_space(3)))
typedef unsigned short bf16_t;
typedef short bf16x8 __attribute__((ext_vector_type(8)));
typedef float f32x4 __attribute__((ext_vector_type(4)));
typedef unsigned u32x4 __attribute__((ext_vector_type(4)));
constexpr int BM = 256, BK = 64, HALF = 128, HTB = HALF * BK * 2  , STAGE_BYTES = 8 * HTB, NXCD = 8, WGM = 4;

__host__ __device__ __forceinline__ int lds_byte(int r, int c) { const int st = (r >> 4) * 2 + (c >> 5), rr = r & 15, cc = c & 31, ob = rr * 64 + cc * 2; return st * 1024 + (ob ^ (((ob >> 9) & 1) << 5)); }
__host__ __device__ __forceinline__ void stage_rc(int b, int& R, int& C) { const int st = b / 1024, sb = b % 1024, swz = sb ^ (((sb >> 9) & 1) << 5); R = (st >> 1) * 16 + swz / 64; C = (st & 1) * 32 + (swz % 64) / 2; }
__host__ __device__ __forceinline__ int perm32(int rho) { const int n = rho >> 4, i = rho & 15; return 8 * (i >> 2) + 4 * n + (i & 3); }

struct Unit { int pm, pn; };
struct Gemm { const bf16_t* A; const bf16_t* Bt; int M, N, K; };

struct StaticOrder {
    int nM, nN, nwg, G, c;
    __host__ __device__ void init(int M, int N, int G_, int c_) { nM = M / BM; nN = N / BM; nwg = nM * nN; G = G_; c = c_; }
    __host__ __device__ bool next(int i, Unit& u) const {
        const long L = (long)i * G + c; if (L >= nwg) return false;
        int wgid = (int)L; { const int q = nwg / NXCD, r = nwg % NXCD, xcd = wgid % NXCD, off = wgid / NXCD; wgid = (xcd < r ? xcd * (q + 1) : r * (q + 1) + (xcd - r) * q) + off; }
        const int nig = WGM * nN, gid = wgid / nig, fm = gid * WGM, gsz = (nM - fm) < WGM ? (nM - fm) : WGM;
        u.pm = fm + ((wgid % nig) % gsz); u.pn = (wgid % nig) / gsz; return true;
    }
    __device__ __forceinline__ void a_ready(const Unit&) const {}
    __device__ __forceinline__ void done(const Unit&) const {}
};

typedef float f32x2_t __attribute__((ext_vector_type(2)));
typedef __bf16 bf16x2_t __attribute__((ext_vector_type(2)));
struct OneUnit { Unit u;
    __device__ __forceinline__ bool next(int i, Unit& o) const { if (i) return false; o = u; return true; }
    __device__ __forceinline__ void a_ready(const Unit&) const {}
    __device__ __forceinline__ void done(const Unit&) const {} };

__device__ __forceinline__ unsigned cvt_pk_bf16(float lo, float hi) { const f32x2_t f = {lo, hi}; const bf16x2_t b = __builtin_convertvector(f, bf16x2_t); return __builtin_bit_cast(unsigned, b); }


template <class Epi, class Sched, bool ALIGN_EPI = false, bool SP2 = false>
__device__ __forceinline__ void gemm_phase(PG8_LAS unsigned char* lds, const Gemm g, const Sched& S, const Epi& E) {
    const int tid = threadIdx.x, wid = __builtin_amdgcn_readfirstlane(tid >> 6), lane = tid & 63, wr = wid >> 2, wc = wid & 3, fr = lane & 15, fq = lane >> 4;
    const int K = g.K, nt = K / BK;
    unsigned voffA[2], voffB[2];
#pragma unroll
    for (int i = 0; i < 2; ++i) { int R, C; stage_rc(tid * 16 + i * 8192, R, C); const int Rb = Epi::PERM ? ((R & ~31) + perm32(R & 31)) : R;
        voffA[i] = (unsigned)(R * K + C) * 2u; voffB[i] = (unsigned)(Rb * K + C) * 2u; }
    const size_t kstep = (size_t)(BK * 2);
    const size_t hstep = (size_t)HALF * K * 2;
    const size_t tstep = 2 * hstep;
    const unsigned ldsw = (unsigned)wid * 1024u;
    const int aoff = lds_byte(wr * 64 + fr, fq * 8), boff = lds_byte(wc * 32 + fr, fq * 8);
#define PG8_SA(b, h) (((b) * 2 + (h)) * HTB)
#define PG8_SB(b, h) ((4 + (b) * 2 + (h)) * HTB)
#define PG8_STAGE(bufoff, gbase, voff) do { _Pragma("unroll") for (int _i = 0; _i < 2; ++_i) \
        __builtin_amdgcn_global_load_lds((const unsigned*)((const char*)(gbase) + (voff)[_i]), (PG8_LAS unsigned*)(lds + (bufoff) + ldsw + _i * 8192), 16, 0, 0); } while (0)
#define PG8_LDA(dst, b, h) do { _Pragma("unroll") for (int m = 0; m < 4; ++m) _Pragma("unroll") for (int k = 0; k < 2; ++k) dst[m][k] = *(const PG8_LAS bf16x8*)(lds + PG8_SA(b, h) + aoff + m * 2048 + k * 1024); } while (0)
#define PG8_LDB(dst, b, h) do { _Pragma("unroll") for (int n = 0; n < 2; ++n) _Pragma("unroll") for (int k = 0; k < 2; ++k) dst[n][k] = *(const PG8_LAS bf16x8*)(lds + PG8_SB(b, h) + boff + n * 2048 + k * 1024); } while (0)
#define PG8_MMA(ai, bj, At, Bt) do { __builtin_amdgcn_s_setprio(1); _Pragma("unroll") for (int m = 0; m < 4; ++m) _Pragma("unroll") for (int n = 0; n < 2; ++n) _Pragma("unroll") for (int k = 0; k < 2; ++k) \
        acc[ai][bj][m][n] = __builtin_amdgcn_mfma_f32_16x16x32_bf16(Bt[n][k], At[m][k], acc[ai][bj][m][n], 0, 0, 0); __builtin_amdgcn_s_setprio(0); } while (0)
#define PG8_WAIT_V(n) asm volatile("s_waitcnt vmcnt(" #n ")" ::: "memory")
#define PG8_WAIT_L(n) asm volatile("s_waitcnt lgkmcnt(" #n ")" ::: "memory")
#define PG8_BAR __builtin_amdgcn_s_barrier()
#define PG8_SCHED __builtin_amdgcn_sched_barrier(0)
    Unit cur, nxt; int ui = 0;
    if (!S.next(0, cur)) return;
    f32x4 acc[2][2][4][2];
#pragma unroll
    for (int a = 0; a < 2; ++a)
#pragma unroll
        for (int b = 0; b < 2; ++b)
#pragma unroll
            for (int m = 0; m < 4; ++m)
#pragma unroll
                for (int n = 0; n < 2; ++n) acc[a][b][m][n] = (f32x4){0.f, 0.f, 0.f, 0.f};
    bf16x8 At[4][2], B0[2][2], B1[2][2];
    const char* cA = (const char*)g.A + (size_t)cur.pm * tstep; const char* cB = (const char*)g.Bt + (size_t)cur.pn * tstep;
    S.a_ready(cur);
    if constexpr (SP2) {
        PG8_STAGE(PG8_SB(0, 0), cB, voffB); PG8_STAGE(PG8_SB(0, 1), cB + hstep, voffB); PG8_STAGE(PG8_SA(0, 0), cA, voffA); PG8_STAGE(PG8_SA(0, 1), cA + hstep, voffA);
        if (wr == 1) PG8_BAR;
        PG8_WAIT_V(2); PG8_BAR;
        PG8_STAGE(PG8_SB(1, 0), cB + kstep, voffB); PG8_STAGE(PG8_SA(1, 0), cA + kstep, voffA); PG8_STAGE(PG8_SB(1, 1), cB + hstep + kstep, voffB);
        PG8_WAIT_V(6); PG8_BAR;
    } else {
        PG8_STAGE(PG8_SB(0, 0), cB, voffB); PG8_STAGE(PG8_SA(0, 0), cA, voffA); PG8_STAGE(PG8_SB(0, 1), cB + hstep, voffB); PG8_STAGE(PG8_SA(0, 1), cA + hstep, voffA);
        if (wr == 1) PG8_BAR;
        PG8_WAIT_V(4); PG8_BAR;
        PG8_STAGE(PG8_SB(1, 0), cB + kstep, voffB); PG8_STAGE(PG8_SA(1, 0), cA + kstep, voffA); PG8_STAGE(PG8_SB(1, 1), cB + hstep + kstep, voffB);
        PG8_WAIT_V(6); PG8_BAR;
    }
    for (;;) {
        const bool has_next = S.next(ui + 1, nxt);
        const char* nA = has_next ? (const char*)g.A + (size_t)nxt.pm * tstep : cA; const char* nB = has_next ? (const char*)g.Bt + (size_t)nxt.pn * tstep : cB;
        for (int t = 0; t < nt; t += 2) {
            const bool last = (t == nt - 2);
            const char* a1 = cA + (size_t)(t + 1) * kstep;
            const char* a2 = last ? nA : cA + (size_t)(t + 2) * kstep; const char* b2 = last ? nB : cB + (size_t)(t + 2) * kstep;
            const char* a3 = a2 + kstep; const char* b3 = b2 + kstep;
            if (last && has_next) S.a_ready(nxt);
            if constexpr (SP2) {
            PG8_LDB(B0, 0, 0); PG8_LDB(B1, 0, 1); PG8_SCHED; PG8_LDA(At, 0, 0); PG8_STAGE(PG8_SA(1, 1), a1 + hstep, voffA);
            PG8_WAIT_V(8); PG8_WAIT_L(0); PG8_BAR; PG8_MMA(0, 0, At, B0); PG8_MMA(0, 1, At, B1); PG8_BAR; PG8_SCHED;
            PG8_LDA(At, 0, 1); PG8_STAGE(PG8_SB(0, 0), b2, voffB); PG8_STAGE(PG8_SB(0, 1), b2 + hstep, voffB); PG8_STAGE(PG8_SA(0, 0), a2, voffA);
            PG8_WAIT_V(8); PG8_WAIT_L(0); PG8_BAR; PG8_MMA(1, 0, At, B0); PG8_MMA(1, 1, At, B1); PG8_BAR; PG8_SCHED;
            PG8_LDB(B0, 1, 0); PG8_LDB(B1, 1, 1); PG8_SCHED; PG8_LDA(At, 1, 0); PG8_STAGE(PG8_SA(0, 1), a2 + hstep, voffA);
            PG8_WAIT_V(8); PG8_WAIT_L(0); PG8_BAR; PG8_MMA(0, 0, At, B0); PG8_MMA(0, 1, At, B1); PG8_BAR; PG8_SCHED;
            PG8_LDA(At, 1, 1); PG8_STAGE(PG8_SB(1, 0), b3, voffB); PG8_STAGE(PG8_SB(1, 1), b3 + hstep, voffB); PG8_STAGE(PG8_SA(1, 0), a3, voffA);
            PG8_WAIT_V(8); PG8_WAIT_L(0); PG8_BAR; PG8_MMA(1, 0, At, B0); PG8_MMA(1, 1, At, B1); PG8_BAR; PG8_SCHED;
            } else {
            PG8_LDB(B0, 0, 0); PG8_SCHED; PG8_LDA(At, 0, 0); PG8_STAGE(PG8_SA(1, 1), a1 + hstep, voffA);
            PG8_WAIT_L(8); PG8_BAR; PG8_WAIT_L(0); PG8_MMA(0, 0, At, B0); PG8_BAR; PG8_SCHED;
            PG8_LDB(B1, 0, 1); PG8_STAGE(PG8_SB(0, 0), b2, voffB);
            PG8_BAR; PG8_WAIT_L(0); PG8_MMA(0, 1, At, B1); PG8_BAR;
            PG8_LDA(At, 0, 1); PG8_STAGE(PG8_SA(0, 0), a2, voffA);
            PG8_BAR; PG8_WAIT_L(0); PG8_MMA(1, 0, At, B0); PG8_BAR; PG8_SCHED;
            PG8_STAGE(PG8_SB(0, 1), b2 + hstep, voffB);
            PG8_WAIT_V(6); PG8_BAR; PG8_MMA(1, 1, At, B1); PG8_BAR;
            PG8_LDB(B0, 1, 0); PG8_SCHED; PG8_LDA(At, 1, 0); PG8_STAGE(PG8_SA(0, 1), a2 + hstep, voffA);
            PG8_WAIT_L(8); PG8_BAR; PG8_WAIT_L(0); PG8_MMA(0, 0, At, B0); PG8_BAR; PG8_SCHED;
            PG8_LDB(B1, 1, 1); PG8_STAGE(PG8_SB(1, 0), b3, voffB);
            PG8_BAR; PG8_WAIT_L(0); PG8_MMA(0, 1, At, B1); PG8_BAR;
            PG8_LDA(At, 1, 1); PG8_STAGE(PG8_SA(1, 0), a3, voffA);
            PG8_BAR; PG8_WAIT_L(0); PG8_MMA(1, 0, At, B0); PG8_BAR; PG8_SCHED;
            PG8_STAGE(PG8_SB(1, 1), b3 + hstep, voffB);
            PG8_WAIT_V(6); PG8_BAR; PG8_MMA(1, 1, At, B1); PG8_BAR;
            }
        }
        if constexpr (ALIGN_EPI) { if (wr == 0) PG8_BAR; }
        if constexpr (!Epi::AFTER_DRAIN) { E(acc, cur, wr, wc, fr, fq); S.done(cur); }
        if (!has_next) break;
#pragma unroll
        for (int a = 0; a < 2; ++a)
#pragma unroll
            for (int b = 0; b < 2; ++b)
#pragma unroll
                for (int m = 0; m < 4; ++m)
#pragma unroll
                    for (int n = 0; n < 2; ++n) acc[a][b][m][n] = (f32x4){0.f, 0.f, 0.f, 0.f};
        cur = nxt; cA = nA; cB = nB; ++ui;
        if constexpr (ALIGN_EPI) { if (wr == 1) PG8_BAR; }
    }
    PG8_WAIT_V(0);
    if constexpr (!ALIGN_EPI) { if (wr == 0) PG8_BAR; }
    PG8_BAR;
    if constexpr (Epi::AFTER_DRAIN) { E.fused(acc, cur, wr, wc, fr, fq, lds, wid, lane); S.done(cur); }
#undef PG8_SA
#undef PG8_SB
#undef PG8_STAGE
#undef PG8_LDA
#undef PG8_LDB
#undef PG8_MMA
#undef PG8_WAIT_V
#undef PG8_WAIT_L
#undef PG8_BAR
#undef PG8_SCHED
}

struct EpiInProj {
    static constexpr bool PERM = true, AFTER_DRAIN = false;
    bf16_t *U, *Q, *Kb, *Vb;
    __device__ __forceinline__ void operator()(const f32x4 (&acc)[2][2][4][2], const Unit& u, int wr, int wc, int fr, int fq) const {
        const int row0 = u.pm * BM + wr * 64 + fr;
        if (u.pn < 4) {
            const int col0 = u.pn * BM + wc * 32 + 8 * fq;
#pragma unroll
            for (int ai = 0; ai < 2; ++ai)
#pragma unroll
                for (int m = 0; m < 4; ++m) { const int row = row0 + ai * HALF + m * 16, b = row >> 12, t = row & 4095;
#pragma unroll
                    for (int bj = 0; bj < 2; ++bj) { const int col = col0 + bj * HALF; const f32x4 v0 = acc[ai][bj][m][0], v1 = acc[ai][bj][m][1];
                        u32x4 w; w.x = cvt_pk_bf16(v0[0], v0[1]); w.y = cvt_pk_bf16(v0[2], v0[3]); w.z = cvt_pk_bf16(v1[0], v1[1]); w.w = cvt_pk_bf16(v1[2], v1[3]);
                        *(u32x4*)(U + (((size_t)(b * 64 + (col >> 4)) * 4096 + t) * 16 + (col & 8))) = w; } }
            return;
        }
        bf16_t* base; int ldc, colt;
        if (u.pn < 8) { base = Q; ldc = 1024; colt = (u.pn - 4) * BM; } else if (u.pn == 8) { base = Kb; ldc = 256; colt = 0; } else { base = Vb; ldc = 256; colt = 0; }
        const int col0 = colt + wc * 32 + 8 * fq;
#pragma unroll
        for (int ai = 0; ai < 2; ++ai)
#pragma unroll
            for (int m = 0; m < 4; ++m) { bf16_t* rowp = base + (size_t)(row0 + ai * HALF + m * 16) * ldc + col0;
#pragma unroll
                for (int bj = 0; bj < 2; ++bj) { const f32x4 v0 = acc[ai][bj][m][0], v1 = acc[ai][bj][m][1];
                    u32x4 w; w.x = cvt_pk_bf16(v0[0], v0[1]); w.y = cvt_pk_bf16(v0[2], v0[3]); w.z = cvt_pk_bf16(v1[0], v1[1]); w.w = cvt_pk_bf16(v1[2], v1[3]);
                    *(u32x4*)(rowp + bj * HALF) = w; } }
    }
};
struct EpiBf16Plain {
    static constexpr bool PERM = true, AFTER_DRAIN = false;
    bf16_t* O; int ldc;
    __device__ __forceinline__ void operator()(const f32x4 (&acc)[2][2][4][2], const Unit& u, int wr, int wc, int fr, int fq) const {
        const int row0 = u.pm * BM + wr * 64 + fr, col0 = u.pn * BM + wc * 32 + 8 * fq;
#pragma unroll
        for (int ai = 0; ai < 2; ++ai)
#pragma unroll
            for (int m = 0; m < 4; ++m) { bf16_t* rowp = O + (size_t)(row0 + ai * HALF + m * 16) * ldc + col0;
#pragma unroll
                for (int bj = 0; bj < 2; ++bj) { const f32x4 v0 = acc[ai][bj][m][0], v1 = acc[ai][bj][m][1];
                    u32x4 w; w.x = cvt_pk_bf16(v0[0], v0[1]); w.y = cvt_pk_bf16(v0[2], v0[3]); w.z = cvt_pk_bf16(v1[0], v1[1]); w.w = cvt_pk_bf16(v1[2], v1[3]);
                    *(u32x4*)(rowp + bj * HALF) = w; } }
    }
};
struct EpiGlu {
    static constexpr bool PERM = true, AFTER_DRAIN = false;
    bf16_t* O; int ldo; const bf16_t* Y; int ldy; const float* bias;
    __device__ __forceinline__ void operator()(const f32x4 (&acc)[2][2][4][2], const Unit& u, int wr, int wc, int fr, int fq) const {
        const int row0 = u.pm * BM + wr * 64 + fr, col0 = u.pn * BM + wc * 32 + 8 * fq;
        f32x4 bv[2][2];
#pragma unroll
        for (int bj = 0; bj < 2; ++bj)
#pragma unroll
            for (int n = 0; n < 2; ++n) bv[bj][n] = *(const f32x4*)(bias + col0 + bj * HALF + 4 * n);
#pragma unroll
        for (int ai = 0; ai < 2; ++ai)
#pragma unroll
            for (int m = 0; m < 4; ++m) { const size_t row = (size_t)(row0 + ai * HALF + m * 16);
#pragma unroll
                for (int bj = 0; bj < 2; ++bj) {
                    const u32x4 yw = *(const u32x4*)(Y + row * ldy + col0 + bj * HALF);
                    float o[8];
#pragma unroll
                    for (int e = 0; e < 8; ++e) { const float a = acc[ai][bj][m][e >> 2][e & 3] + bv[bj][e >> 2][e & 3];
                        const unsigned yy = yw[e >> 1]; const float y = __uint_as_float((e & 1) ? (yy & 0xffff0000u) : (yy << 16));
                        o[e] = y / (1.0f + __expf(-a)); }
                    u32x4 w; w.x = cvt_pk_bf16(o[0], o[1]); w.y = cvt_pk_bf16(o[2], o[3]); w.z = cvt_pk_bf16(o[4], o[5]); w.w = cvt_pk_bf16(o[6], o[7]);
                    *(u32x4*)(O + row * ldo + col0 + bj * HALF) = w; } }
    }
};
struct EpiResF32 {
    static constexpr bool PERM = false, AFTER_DRAIN = false;
    float* C; const float* R; int ldc;
    __device__ __forceinline__ void operator()(const f32x4 (&acc)[2][2][4][2], const Unit& u, int wr, int wc, int fr, int fq) const {
        const int row0 = u.pm * BM + wr * 64 + fr, col0 = u.pn * BM + wc * 32 + 4 * fq;
#pragma unroll
        for (int ai = 0; ai < 2; ++ai)
#pragma unroll
            for (int m = 0; m < 4; ++m) { const size_t off = (size_t)(row0 + ai * HALF + m * 16) * ldc + col0;
#pragma unroll
                for (int bj = 0; bj < 2; ++bj)
#pragma unroll
                    for (int n = 0; n < 2; ++n) { f32x4 v = acc[ai][bj][m][n]; if (R) v = v + *(const f32x4*)(R + off + bj * HALF + n * 16); *(f32x4*)(C + off + bj * HALF + n * 16) = v; } }
    }
};
__device__ __forceinline__ float row_rnorm(const float* PS, size_t row) {
    const f32x4* p = (const f32x4*)(PS + row * 32); float s = 0.f;
#pragma unroll
    for (int i = 0; i < 8; ++i) { const f32x4 v = p[i]; s += (v[0] + v[1]) + (v[2] + v[3]); }
    return __builtin_amdgcn_rsqf(s * (1.0f / 2048.0f) + 1e-6f);
}
template <bool RBF16> struct EpiResBf16 {
    static constexpr bool PERM = true, AFTER_DRAIN = false;
    bf16_t* H; const void* R; float* PS;
    __device__ __forceinline__ void operator()(const f32x4 (&acc)[2][2][4][2], const Unit& u, int wr, int wc, int fr, int fq) const {
        const int row0 = u.pm * BM + wr * 64 + fr, col0 = u.pn * BM + wc * 32 + 8 * fq;
#pragma unroll
        for (int ai = 0; ai < 2; ++ai)
#pragma unroll
            for (int m = 0; m < 4; ++m) { const size_t row = (size_t)(row0 + ai * HALF + m * 16), off = row * 2048 + col0; float ss = 0.f;
#pragma unroll
                for (int bj = 0; bj < 2; ++bj) {
                    f32x4 r0, r1;
                    if (RBF16) { const u32x4 rw = *(const u32x4*)((const bf16_t*)R + off + bj * HALF);
                        r0 = (f32x4){__uint_as_float(rw.x << 16), __uint_as_float(rw.x & 0xffff0000u), __uint_as_float(rw.y << 16), __uint_as_float(rw.y & 0xffff0000u)};
                        r1 = (f32x4){__uint_as_float(rw.z << 16), __uint_as_float(rw.z & 0xffff0000u), __uint_as_float(rw.w << 16), __uint_as_float(rw.w & 0xffff0000u)}; }
                    else { r0 = *(const f32x4*)((const float*)R + off + bj * HALF); r1 = *(const f32x4*)((const float*)R + off + bj * HALF + 4); }
                    const f32x4 v0 = acc[ai][bj][m][0] + r0, v1 = acc[ai][bj][m][1] + r1;
                    ss += ((v0[0] * v0[0] + v0[1] * v0[1]) + (v0[2] * v0[2] + v0[3] * v0[3])) + ((v1[0] * v1[0] + v1[1] * v1[1]) + (v1[2] * v1[2] + v1[3] * v1[3]));
                    u32x4 w; w.x = cvt_pk_bf16(v0[0], v0[1]); w.y = cvt_pk_bf16(v0[2], v0[3]); w.z = cvt_pk_bf16(v1[0], v1[1]); w.w = cvt_pk_bf16(v1[2], v1[3]);
                    *(u32x4*)(H + off + bj * HALF) = w; }
                ss += __shfl_xor(ss, 16); ss += __shfl_xor(ss, 32);
                if (fq == 0) PS[row * 32 + u.pn * 4 + wc] = ss; }
    }
};
struct EpiBf16RowScale {
    static constexpr bool PERM = true, AFTER_DRAIN = false;
    bf16_t* O; int ldc; const float* PS;
    __device__ __forceinline__ void operator()(const f32x4 (&acc)[2][2][4][2], const Unit& u, int wr, int wc, int fr, int fq) const {
        const int row0 = u.pm * BM + wr * 64 + fr, col0 = u.pn * BM + wc * 32 + 8 * fq;
#pragma unroll
        for (int ai = 0; ai < 2; ++ai)
#pragma unroll
            for (int m = 0; m < 4; ++m) { const size_t row = (size_t)(row0 + ai * HALF + m * 16); const float r = row_rnorm(PS, row); bf16_t* rowp = O + row * ldc + col0;
#pragma unroll
                for (int bj = 0; bj < 2; ++bj) { const f32x4 v0 = acc[ai][bj][m][0] * r, v1 = acc[ai][bj][m][1] * r;
                    u32x4 w; w.x = cvt_pk_bf16(v0[0], v0[1]); w.y = cvt_pk_bf16(v0[2], v0[3]); w.z = cvt_pk_bf16(v1[0], v1[1]); w.w = cvt_pk_bf16(v1[2], v1[3]);
                    *(u32x4*)(rowp + bj * HALF) = w; } }
    }
};
struct EpiF32RowScale {
    static constexpr bool PERM = true, AFTER_DRAIN = false;
    float* C; int ldc; const float* PS;
    __device__ __forceinline__ void operator()(const f32x4 (&acc)[2][2][4][2], const Unit& u, int wr, int wc, int fr, int fq) const {
        const int row0 = u.pm * BM + wr * 64 + fr, col0 = u.pn * BM + wc * 32 + 8 * fq;
#pragma unroll
        for (int ai = 0; ai < 2; ++ai)
#pragma unroll
            for (int m = 0; m < 4; ++m) { const size_t row = (size_t)(row0 + ai * HALF + m * 16); const float r = row_rnorm(PS, row); const size_t off = row * ldc + col0;
#pragma unroll
                for (int bj = 0; bj < 2; ++bj) { *(f32x4*)(C + off + bj * HALF) = acc[ai][bj][m][0] * r; *(f32x4*)(C + off + bj * HALF + 4) = acc[ai][bj][m][1] * r; } }
    }
};
}

#ifndef PG8_SP2
#define PG8_SP2 false
#endif
#ifndef PG8_ALIGN
#define PG8_ALIGN true
#endif
constexpr int NTOK = 32768, DM = 2048, SEQ = 4096, NB = 8;
constexpr int NWAVES = 8, NTHREADS = 512;
constexpr int LDS_BYTES = 147456;
constexpr float NORM_EPS = 1e-6f;

#define LAS __attribute__((address_space(3)))
typedef unsigned short bf16;
typedef unsigned u32;
typedef short bf16x8 __attribute__((ext_vector_type(8)));
typedef short s16x4 __attribute__((ext_vector_type(4)));
typedef float f32x4 __attribute__((ext_vector_type(4)));
typedef float f32x16 __attribute__((ext_vector_type(16)));
typedef unsigned u32x4 __attribute__((ext_vector_type(4)));
typedef unsigned u32x2 __attribute__((ext_vector_type(2)));

constexpr size_t MiB = 1u << 20;
constexpr size_t WS_CTL = 0, CTL_ZERO_BYTES = 64 * 1024;
constexpr size_t WS_W_IN_T = 1 * MiB, WS_W_GLU_T = 11 * MiB, WS_W_OUT_T = 13 * MiB, WS_W_CQ_T = 21 * MiB, WS_W_CKV_T = 23 * MiB, WS_W_CO_T = 27 * MiB, WS_W_S_T = 29 * MiB;
constexpr size_t WS_S5_WIN = 37 * MiB, WS_S5_WOUT = 41 * MiB, WS_S5_K = 45 * MiB, WS_S5_LAM = 46 * MiB, WS_BIAS_TAB = 46 * MiB + 512 * 1024;
constexpr size_t WS_MEM_N = 47 * MiB, WS_KV_C = 55 * MiB, WS_PS = 59 * MiB;
#ifndef FP6_PACK_INTERLEAVED
#define FP6_PACK_INTERLEAVED 1
#endif
typedef unsigned v6u_t __attribute__((ext_vector_type(6)));
constexpr int PEER_ROW_BYTES = 1536;
constexpr int PEER_SROW = 384;
constexpr size_t PEER_SLICE_BYTES = (size_t)16384 * PEER_SROW;
constexpr size_t WS_PEER_U = 64 * MiB, WS_PEER_V = 96 * MiB;
constexpr size_t WS_PEER_SU = 128 * MiB, WS_PEER_SV = 128 * MiB + 65536;
constexpr size_t WS_HN = 192 * MiB;
constexpr size_t WS_U = 320 * MiB, WS_Q = 384 * MiB, WS_K = 448 * MiB, WS_V = 464 * MiB, WS_YPRE = 480 * MiB, WS_YMIX = 544 * MiB;
constexpr size_t WS_SCORES = 320 * MiB;
constexpr size_t WS_QC = 672 * MiB, WS_OC = 704 * MiB, WS_TK_IDX = 736 * MiB, WS_TK_G = 752 * MiB, WS_END = 768 * MiB;

__device__ __forceinline__ unsigned f2bf(float f) { unsigned u = __float_as_uint(f); return (u + 0x7fffu + ((u >> 16) & 1u)) >> 16; }
__device__ __forceinline__ unsigned pk2(float lo, float hi) { return pg8::cvt_pk_bf16(lo, hi); }
__device__ __forceinline__ unsigned cvtpk(float lo, float hi) { return pg8::cvt_pk_bf16(lo, hi); }
__device__ __forceinline__ float bflo(unsigned w) { return __uint_as_float(w << 16); }
__device__ __forceinline__ float bfhi(unsigned w) { return __uint_as_float(w & 0xffff0000u); }
__device__ __forceinline__ float wave_sum(float v) {
#pragma unroll
    for (int o = 1; o < 64; o <<= 1) v += __shfl_xor(v, o);
    return v;
}
__device__ __forceinline__ float gelu_tanh(float x) { const float z = 0.7978845608028654f * (x + 0.044715f * x * x * x); return x / (1.0f + __expf(-2.0f * z)); }
#define LDS_WAIT() asm volatile("s_waitcnt lgkmcnt(0)" ::: "memory")
#define MFMA16(a, b, c) __builtin_amdgcn_mfma_f32_16x16x32_bf16((a), (b), (c), 0, 0, 0)
#define MFMA32(a, b, c) __builtin_amdgcn_mfma_f32_32x32x16_bf16((a), (b), (c), 0, 0, 0)

__device__ __forceinline__ void p0_transpose_item(const float* W, int K, int N, bf16* WT, LAS float* scr, int item, int lane, const float* kgain = nullptr) {
    const int nblk = N / 32, kb = item / nblk, nb = item % nblk, k0 = 64 * kb, n0 = 32 * nb;
    f32x4 v[8];
#pragma unroll
    for (int i = 0; i < 8; ++i) v[i] = *(const f32x4*)(W + (size_t)(k0 + 8 * i + (lane >> 3)) * N + n0 + 4 * (lane & 7));
#pragma unroll
    for (int i = 0; i < 8; ++i) { const int kk = 8 * i + (lane >> 3); f32x4 x = v[i]; if (kgain) x = x * kgain[k0 + kk];
#pragma unroll
        for (int c = 0; c < 4; ++c) scr[kk * 33 + 4 * (lane & 7) + c] = x[c]; }
    LDS_WAIT(); asm volatile("" ::: "memory");
    const int c = lane & 7;
#pragma unroll
    for (int j = 0; j < 4; ++j) { const int n = (lane >> 3) + 8 * j; const LAS float* s = scr + (8 * c) * 33 + n;
        u32x4 o; o.x = pk2(s[0 * 33], s[1 * 33]); o.y = pk2(s[2 * 33], s[3 * 33]); o.z = pk2(s[4 * 33], s[5 * 33]); o.w = pk2(s[6 * 33], s[7 * 33]);
        *(u32x4*)(WT + (size_t)(n0 + n) * K + k0 + 8 * c) = o; }
    LDS_WAIT(); asm volatile("" ::: "memory");
}
__device__ __forceinline__ void rms_row_to_bf16(const float* xrow, const float* gain, bf16* orow, int lane) {
    const f32x4* xr = (const f32x4*)xrow + lane; const f32x4* gr = (const f32x4*)gain + lane;
    f32x4 v[8]; float s = 0.f;
#pragma unroll
    for (int j = 0; j < 8; ++j) { v[j] = xr[64 * j]; s += (v[j].x * v[j].x + v[j].y * v[j].y) + (v[j].z * v[j].z + v[j].w * v[j].w); }
    const float r = rsqrtf(wave_sum(s) * (1.f / DM) + NORM_EPS);
    u32x2* o8 = (u32x2*)orow + lane;
#pragma unroll
    for (int j = 0; j < 8; ++j) { const f32x4 g = gr[64 * j]; u32x2 w; w.x = pk2(v[j].x * r * g.x, v[j].y * r * g.y); w.y = pk2(v[j].z * r * g.z, v[j].w * r * g.w); o8[64 * j] = w; }
}

struct Ptrs {
    const float* in[28]; float* out; unsigned char* ws;
};

__device__ __forceinline__ void phase_prologue(const Ptrs& P, LAS unsigned char* lds, int G) {
    const int tid = threadIdx.x, lane = tid & 63, wave = __builtin_amdgcn_readfirstlane(tid >> 6);
    unsigned char* ws = P.ws;
    {
        const float* wq = P.in[23]; const float* sk = P.in[24]; bf16* WsT = (bf16*)(ws + WS_W_S_T);
        LAS float* wq_l = (LAS float*)lds;
        LAS float* sk_l = wq_l + 64 * 129;
        for (int it = blockIdx.x; it < 512; it += G) {
            const int hc = it >> 5, d0 = (it & 31) * 64;
            __syncthreads();
#pragma unroll
            for (int i = 0; i < 4; ++i) { const int e = tid + 512 * i, dl = e >> 5, j4 = (e & 31) * 4; f32x4 v = *(const f32x4*)(wq + (size_t)(d0 + dl) * 2048 + hc * 128 + j4); v = v * P.in[22][d0 + dl];
#pragma unroll
                for (int c = 0; c < 4; ++c) wq_l[dl * 129 + j4 + c] = v[c]; }
#pragma unroll
            for (int i = 0; i < 8; ++i) { const int e = tid + 512 * i, kk = e >> 5, j4 = (e & 31) * 4; const f32x4 v = *(const f32x4*)(sk + ((size_t)hc * 128 + kk) * 128 + j4);
#pragma unroll
                for (int c = 0; c < 4; ++c) sk_l[kk * 129 + j4 + c] = v[c]; }
            __syncthreads();
            const int kb = wave & 3, db = wave >> 2;
            const LAS float* ap = sk_l + (32 * kb + (lane & 31)) * 129 + (lane >> 5); const LAS float* bp = wq_l + (32 * db + (lane & 31)) * 129 + (lane >> 5);
            f32x16 acc;
#pragma unroll
            for (int i = 0; i < 16; ++i) acc[i] = 0.f;
#pragma unroll 16
            for (int st = 0; st < 64; ++st) acc = __builtin_amdgcn_mfma_f32_32x32x2f32(ap[2 * st], bp[2 * st], acc, 0, 0, 0);
#pragma unroll
            for (int r = 0; r < 16; ++r) { const int key = (r & 3) + 8 * (r >> 2) + 4 * (lane >> 5);
                WsT[(size_t)(hc * 128 + 32 * kb + key) * 2048 + d0 + 32 * db + (lane & 31)] = (bf16)f2bf(acc[r]); }
        }
        __syncthreads();
    }
    {
        const float *lam_re = P.in[5], *lam_im = P.in[6], *b_re = P.in[7], *b_im = P.in[8], *c_re = P.in[9], *c_im = P.in[10], *dd = P.in[11], *log_dt = P.in[12];
        LAS float* pwr = (LAS float*)lds;
        LAS float* bbar = pwr + 17 * 64 * 2;
        LAS float* cc = bbar + 64 * 16 * 2;
        for (int gi = blockIdx.x; gi < 256; gi += G) {
            const int g = gi >> 2, qt = gi & 3;
            __syncthreads();
            if (tid < 64) {
                const int p = tid; const float lre = lam_re[g * 64 + p], lim = lam_im[g * 64 + p], dt = expf(log_dt[g]);
                const float er = expf(lre * dt); float sn, cs; sincosf(lim * dt, &sn, &cs);
                const float lbr = er * cs, lbi = er * sn;
                const float nr = lbr - 1.0f, ni = lbi, den = lre * lre + lim * lim;
                const float fr = (nr * lre + ni * lim) / den, fi = (ni * lre - nr * lim) / den;
#pragma unroll
                for (int h = 0; h < 16; ++h) { const float br = b_re[(g * 64 + p) * 16 + h], bi = b_im[(g * 64 + p) * 16 + h];
                    bbar[(p * 16 + h) * 2] = fr * br - fi * bi; bbar[(p * 16 + h) * 2 + 1] = fr * bi + fi * br; }
                float pr = 1.f, pi = 0.f;
                for (int j = 0; j <= 16; ++j) { pwr[(j * 64 + p) * 2] = pr; pwr[(j * 64 + p) * 2 + 1] = pi; const float t = pr * lbr - pi * lbi; pi = pr * lbi + pi * lbr; pr = t; }
            }
            for (int e = tid; e < 1024; e += NTHREADS) { cc[e * 2] = c_re[g * 1024 + e]; cc[e * 2 + 1] = c_im[g * 1024 + e]; }
            __syncthreads();
            bf16* Win = (bf16*)(ws + WS_S5_WIN) + (size_t)g * 32768; bf16* Wout = (bf16*)(ws + WS_S5_WOUT) + (size_t)g * 32768; bf16* Kt = (bf16*)(ws + WS_S5_K) + (size_t)g * 4096;
            for (int e = qt * 8192 + tid; e < (qt + 1) * 8192; e += NTHREADS) {
                const int m = e >> 8, kk = e & 255, p = m & 63, ri = m >> 6, sg = kk >> 4, hp = kk & 15;
                const float ar = pwr[((15 - sg) * 64 + p) * 2], ai = pwr[((15 - sg) * 64 + p) * 2 + 1], xr = bbar[(p * 16 + hp) * 2], xi = bbar[(p * 16 + hp) * 2 + 1];
                Win[e] = (bf16)f2bf(ri ? (ar * xi + ai * xr) : (ar * xr - ai * xi));
            }
            for (int e = qt * 8192 + tid; e < (qt + 1) * 8192; e += NTHREADS) {
                const int mm = e >> 7, m = e & 127, tau = mm >> 4, h = mm & 15, p = m & 63, ri = m >> 6;
                const float ar = pwr[((tau + 1) * 64 + p) * 2], ai = pwr[((tau + 1) * 64 + p) * 2 + 1], cr = cc[(h * 64 + p) * 2], ci = cc[(h * 64 + p) * 2 + 1];
                Wout[e] = (bf16)f2bf(ri ? -(cr * ai + ci * ar) : (cr * ar - ci * ai));
            }
            for (int e = qt * 1024 + tid; e < (qt + 1) * 1024; e += NTHREADS) {
                const int j = e >> 8, h = (e >> 4) & 15, hp = e & 15; float s = 0.f;
                for (int p = 0; p < 64; ++p) { const float ar = pwr[(j * 64 + p) * 2], ai = pwr[(j * 64 + p) * 2 + 1], cr = cc[(h * 64 + p) * 2], ci = cc[(h * 64 + p) * 2 + 1];
                    const float wr = cr * ar - ci * ai, wi = cr * ai + ci * ar; s += wr * bbar[(p * 16 + hp) * 2] - wi * bbar[(p * 16 + hp) * 2 + 1]; }
                if (j == 0 && h == hp) s += dd[g * 16 + h];
                Kt[e] = (bf16)f2bf(s);
            }
            if (tid < 64 && qt == 0) { float* lamq = (float*)(ws + WS_S5_LAM) + g * 128; lamq[2 * tid] = pwr[(16 * 64 + tid) * 2]; lamq[2 * tid + 1] = pwr[(16 * 64 + tid) * 2 + 1]; }
        }
        __syncthreads();
    }
    {
        const float* rel_bias = P.in[2]; float* bt = (float*)(ws + WS_BIAS_TAB);
        for (int e = blockIdx.x * NTHREADS + tid; e < 2048; e += G * NTHREADS) {
            const int hq = e >> 7, dist = e & 127; int bucket = dist;
            if (dist >= 16) { int lg = 16 + (int)(logf((float)dist / 16.0f) / logf(8.0f) * 16.0f); bucket = lg < 31 ? lg : 31; }
            bt[e] = rel_bias[bucket * 16 + hq];
        }
    }
    {
        LAS float* scr = (LAS float*)(lds + wave * 16384);
        const int gw = blockIdx.x * NWAVES + wave, NGW = G * NWAVES;
        constexpr int I0 = 32 * 80, I1 = 16 * 32, I2 = 32 * 64, I3 = 32 * 16, I4 = 32 * 32, I5 = 8 * 64;
        for (int it = gw; it < I0 + I1 + I2 + I3 + I4 + I5; it += NGW) {
            int r = it;
            if (r < I0) { p0_transpose_item(P.in[4], 2048, 2560, (bf16*)(ws + WS_W_IN_T), scr, r, lane); continue; } r -= I0;
            if (r < I1) { p0_transpose_item(P.in[13], 1024, 1024, (bf16*)(ws + WS_W_GLU_T), scr, r, lane); continue; } r -= I1;
            if (r < I2) { p0_transpose_item(P.in[16], 2048, 2048, (bf16*)(ws + WS_W_OUT_T), scr, r, lane); continue; } r -= I2;
            if (r < I3) { p0_transpose_item(P.in[19], 2048, 512, (bf16*)(ws + WS_W_CQ_T), scr, r, lane, P.in[17]); continue; } r -= I3;
            if (r < I4) { p0_transpose_item(P.in[20], 2048, 1024, (bf16*)(ws + WS_W_CKV_T), scr, r, lane); continue; } r -= I4;
            p0_transpose_item(P.in[21], 512, 2048, (bf16*)(ws + WS_W_CO_T), scr, r, lane);
        }
        {
            f32x4 a[8], b[8];
#pragma unroll
            for (int j = 0; j < 8; ++j) { a[j] = ((const f32x4*)(P.in[0] + (size_t)gw * DM))[lane + 64 * j]; b[j] = ((const f32x4*)(P.in[0] + (size_t)(gw + NGW) * DM))[lane + 64 * j]; }
#pragma unroll 1
            for (int m = gw; m < NTOK; m += 2 * NGW) {
                const int mn = (m + 2 * NGW < NTOK) ? m + 2 * NGW : m;
                f32x4 na[8], nb[8];
#pragma unroll
                for (int j = 0; j < 8; ++j) { na[j] = ((const f32x4*)(P.in[0] + (size_t)mn * DM))[lane + 64 * j]; nb[j] = ((const f32x4*)(P.in[0] + (size_t)(mn + NGW) * DM))[lane + 64 * j]; }
                float s0 = 0.f, s1 = 0.f;
#pragma unroll
                for (int j = 0; j < 8; ++j) { s0 += (a[j].x * a[j].x + a[j].y * a[j].y) + (a[j].z * a[j].z + a[j].w * a[j].w); s1 += (b[j].x * b[j].x + b[j].y * b[j].y) + (b[j].z * b[j].z + b[j].w * b[j].w); }
                const float r0 = rsqrtf(wave_sum(s0) * (1.f / DM) + NORM_EPS), r1 = rsqrtf(wave_sum(s1) * (1.f / DM) + NORM_EPS);
                u32x2* o0 = (u32x2*)((bf16*)(ws + WS_HN) + (size_t)m * DM) + lane; u32x2* o1 = (u32x2*)((bf16*)(ws + WS_HN) + (size_t)(m + NGW) * DM) + lane;
#pragma unroll
                for (int j = 0; j < 8; ++j) { const f32x4 g = ((const f32x4*)P.in[3])[lane + 64 * j];
                    u32x2 w0, w1; w0.x = pk2(a[j].x * r0 * g.x, a[j].y * r0 * g.y); w0.y = pk2(a[j].z * r0 * g.z, a[j].w * r0 * g.w); w1.x = pk2(b[j].x * r1 * g.x, b[j].y * r1 * g.y); w1.y = pk2(b[j].z * r1 * g.z, b[j].w * r1 * g.w);
                    o0[64 * j] = w0; o1[64 * j] = w1; }
#pragma unroll
                for (int j = 0; j < 8; ++j) { a[j] = na[j]; b[j] = nb[j]; }
            }
        }
        for (int m = gw; m < 2048; m += NGW) rms_row_to_bf16(P.in[1] + (size_t)m * DM, P.in[18], (bf16*)(ws + WS_MEM_N) + (size_t)m * DM, lane);
    }
}

__device__ __forceinline__ void peer_quant_rows(const Ptrs& P, LAS unsigned char* lds, int wave, int lane, int first, int step, int r_hi) {
    unsigned char* ws = P.ws;
    if (first >= r_hi) return;
    {
        LAS float* img = (LAS float*)(lds + wave * 16384);
        f32x4 v[8];
        { const float* src0 = ((first >> 14) ? P.in[26] : P.in[25]) + (size_t)(first & 16383) * DM;
#pragma unroll
          for (int j = 0; j < 8; ++j) v[j] = ((const f32x4*)src0)[lane + 64 * j]; }
#pragma unroll 1
        for (int rr = first; rr < r_hi; rr += step) {
            const int t = rr >> 14, e = rr & 16383;
            const int rn = (rr + step < r_hi) ? rr + step : rr; const float* nsrc = ((rn >> 14) ? P.in[26] : P.in[25]) + (size_t)(rn & 16383) * DM;
            f32x4 nv[8];
#pragma unroll
            for (int j = 0; j < 8; ++j) nv[j] = ((const f32x4*)nsrc)[lane + 64 * j];
            float mx = 0.f;
            if (t == 0) {
#pragma unroll
                for (int j = 0; j < 8; ++j) v[j] = v[j] * ((const f32x4*)P.in[22])[lane + 64 * j];
            }
#pragma unroll
            for (int i = 0; i < 8; ++i) mx = fmaxf(mx, fmaxf(fmaxf(fabsf(v[i].x), fabsf(v[i].y)), fmaxf(fabsf(v[i].z), fabsf(v[i].w))));
#pragma unroll
            for (int o = 1; o < 64; o <<= 1) mx = fmaxf(mx, __shfl_xor(mx, o));
            const float sc = mx > 0.f ? mx * (1.0f / 7.5f) : 1.0f, inv = 1.0f / sc;
#pragma unroll
            for (int j = 0; j < 8; ++j) { const int idx = 256 * j + 4 * lane; *(LAS f32x4*)(img + idx + (idx >> 5) * 4) = v[j] * inv; }
            LDS_WAIT(); asm volatile("" ::: "memory");
            typedef float v16f_t __attribute__((ext_vector_type(16)));
            v16f_t lo16, hi16;
#pragma unroll
            for (int q = 0; q < 8; ++q) { const f32x4 xv = *(const LAS f32x4*)(img + 36 * lane + 4 * q);
#pragma unroll
                for (int c = 0; c < 4; ++c) { if (FP6_PACK_INTERLEAVED) { if (c & 1) hi16[2 * q + (c >> 1)] = xv[c]; else lo16[2 * q + (c >> 1)] = xv[c]; }
                                              else { if (q < 4) lo16[4 * q + c] = xv[c]; else hi16[4 * (q - 4) + c] = xv[c]; } } }
            LDS_WAIT(); asm volatile("" ::: "memory");
            const v6u_t wq = __builtin_amdgcn_cvt_scalef32_2xpk16_fp6_f32(lo16, hi16, 1.0f);
            unsigned char* dst = ws + (t ? WS_PEER_V : WS_PEER_U) + (size_t)(lane >> 4) * PEER_SLICE_BYTES + (size_t)e * PEER_SROW;
            *(u32x4*)(dst + 16 * (lane & 15)) = (u32x4){wq[0], wq[1], wq[2], wq[3]}; *(u32x2*)(dst + 256 + 8 * (lane & 15)) = (u32x2){wq[4], wq[5]};
            if (lane == 0) ((float*)(ws + WS_PEER_SU))[2 * e + t] = sc;
#pragma unroll
            for (int i = 0; i < 8; ++i) v[i] = nv[i];
        }
    }
}

__device__ __forceinline__ void phase_norm(const float* h, const float* gain, bf16* hn, int G) {
    const int lane = threadIdx.x & 63, wave = __builtin_amdgcn_readfirstlane(threadIdx.x >> 6);
    for (int m = blockIdx.x * NWAVES + wave; m < NTOK; m += G * NWAVES) rms_row_to_bf16(h + (size_t)m * DM, gain, hn + (size_t)m * DM, lane);
}

__device__ __forceinline__ void phase_s5(const Ptrs& P, LAS unsigned char* lds, int G) {
    const int tid = threadIdx.x, l = tid & 63, w = __builtin_amdgcn_readfirstlane(tid >> 6);
    unsigned char* ws = P.ws;
    const bf16* U = (const bf16*)(ws + WS_U); bf16* Y = (bf16*)(ws + WS_YPRE);
    LAS unsigned char* U_l = lds;
    LAS float* S_l = (LAS float*)(lds + 33792);
    LAS bf16* Xs_l = (LAS bf16*)(lds + 33792 + 33280);
    LAS float* Eseg = (LAS float*)(lds + 33792 + 33280 + 17408);
    LAS float* Gcar = (LAS float*)(lds + 33792 + 33280 + 17408 + 4096);
    const int l15 = l & 15, l4 = l >> 4;
    const int uoff = l15 * 528 + (l >> 5) * 32 + (l4 & 1) * 16;
    for (int it = blockIdx.x; it < 512; it += G) {
        const int b = it >> 6, g = it & 63;
        const bf16* Win = (const bf16*)(ws + WS_S5_WIN) + (size_t)g * 32768; const bf16* Wout = (const bf16*)(ws + WS_S5_WOUT) + (size_t)g * 32768; const bf16* Kt = (const bf16*)(ws + WS_S5_K) + (size_t)g * 4096;
        const float* lamq = (const float*)(ws + WS_S5_LAM) + g * 128;
        const bf16* Ug = U + (size_t)(b * 64 + g) * 65536;
        const int p = tid & 63, seg = tid >> 6;
        const float lqr = lamq[2 * p], lqi = lamq[2 * p + 1];
        float l8r = lqr, l8i = lqi;
#pragma unroll
        for (int i = 0; i < 3; ++i) { const float t = l8r * l8r - l8i * l8i; l8i = 2.f * l8r * l8i; l8r = t; }
        __syncthreads();
        if (tid < 64) { Gcar[2 * tid] = 0.f; Gcar[2 * tid + 1] = 0.f; }
#pragma unroll 1
        for (int ps = 0; ps < 4; ++ps) {
#pragma unroll
            for (int i = 0; i < 4; ++i) { const int e = tid + 512 * i, t = e >> 1;
                *(LAS u32x4*)(U_l + (t >> 4) * 528 + (t & 15) * 32 + (e & 1) * 16) = *(const u32x4*)(Ug + (size_t)ps * 16384 + e * 8); }
            bf16x8 Aw[8];
#pragma unroll
            for (int ks = 0; ks < 8; ++ks) Aw[ks] = *(const bf16x8*)(Win + (16 * w + l15) * 256 + 32 * ks + 8 * l4);
            __syncthreads();
#pragma unroll
            for (int cb = 0; cb < 4; ++cb) {
                f32x4 acc = (f32x4){0.f, 0.f, 0.f, 0.f};
#pragma unroll
                for (int ks = 0; ks < 8; ++ks) { const bf16x8 Bf = *(const LAS bf16x8*)(U_l + cb * 8448 + uoff + 64 * ks); acc = MFMA16(Aw[ks], Bf, acc); }
#pragma unroll
                for (int r = 0; r < 4; ++r) S_l[(16 * w + 4 * l4 + r) * 65 + cb * 16 + l15] = acc[r];
            }
            __syncthreads();
            {
                float er = 0.f, ei = 0.f; const int c0 = seg * 8;
#pragma unroll
                for (int i = 0; i < 8; ++i) { const int c = c0 + i; const float sr = S_l[p * 65 + c], si = S_l[(64 + p) * 65 + c];
                    const float t = lqr * er - lqi * ei + sr; ei = lqr * ei + lqi * er + si; er = t; S_l[p * 65 + c] = er; S_l[(64 + p) * 65 + c] = ei; }
                Eseg[(seg * 64 + p) * 2] = er; Eseg[(seg * 64 + p) * 2 + 1] = ei;
                __syncthreads();
                float gr = Gcar[((ps & 1) * 64 + p) * 2], gi = Gcar[((ps & 1) * 64 + p) * 2 + 1];
                for (int s = 0; s < seg; ++s) { const float t = l8r * gr - l8i * gi + Eseg[(s * 64 + p) * 2]; gi = l8r * gi + l8i * gr + Eseg[(s * 64 + p) * 2 + 1]; gr = t; }
                if (seg == 7) { Gcar[(((ps + 1) & 1) * 64 + p) * 2] = l8r * gr - l8i * gi + er; Gcar[(((ps + 1) & 1) * 64 + p) * 2 + 1] = l8r * gi + l8i * gr + ei; }
                float pr = 1.f, pi = 0.f;
#pragma unroll
                for (int i = 0; i < 8; ++i) { const int c = c0 + i;
                    float xr = pr * gr - pi * gi, xi = pr * gi + pi * gr;
                    if (i > 0) { xr += S_l[p * 65 + c - 1]; xi += S_l[(64 + p) * 65 + c - 1]; }
                    Xs_l[c * 136 + p] = (bf16)f2bf(xr); Xs_l[c * 136 + 64 + p] = (bf16)f2bf(xi);
                    const float t = pr * lqr - pi * lqi; pi = pr * lqi + pi * lqr; pr = t; }
            }
            __syncthreads();
#pragma unroll 1
            for (int tt = 0; tt < 2; ++tt) {
                const int tau = tt ? 15 - w : w;
                bf16x8 Tf[8], Wo[4];
#pragma unroll
                for (int ks = 0; ks < 8; ++ks) { const int lag = tau - (2 * ks + (l >> 5));
                    bf16x8 z = (bf16x8){0, 0, 0, 0, 0, 0, 0, 0};
                    if (lag >= 0) z = *(const bf16x8*)(Kt + (lag * 16 + l15) * 16 + 8 * (l4 & 1));
                    Tf[ks] = z; }
#pragma unroll
                for (int k2 = 0; k2 < 4; ++k2) Wo[k2] = *(const bf16x8*)(Wout + (tau * 16 + l15) * 128 + 32 * k2 + 8 * l4);
#pragma unroll
                for (int cb = 0; cb < 4; ++cb) {
                    f32x4 acc = (f32x4){0.f, 0.f, 0.f, 0.f};
#pragma unroll
                    for (int ks = 0; ks < 8; ++ks) if (2 * ks <= tau) { const bf16x8 Bf = *(const LAS bf16x8*)(U_l + cb * 8448 + uoff + 64 * ks); acc = MFMA16(Tf[ks], Bf, acc); }
#pragma unroll
                    for (int k2 = 0; k2 < 4; ++k2) { const bf16x8 Bx = *(const LAS bf16x8*)(Xs_l + (cb * 16 + l15) * 136 + 32 * k2 + 8 * l4); acc = MFMA16(Wo[k2], Bx, acc); }
                    u32x2 o; o.x = pk2(gelu_tanh(acc[0]), gelu_tanh(acc[1])); o.y = pk2(gelu_tanh(acc[2]), gelu_tanh(acc[3]));
                    const size_t tok = (size_t)b * SEQ + 16 * (ps * 64 + cb * 16 + l15) + tau;
                    *(u32x2*)(Y + tok * 1024 + 16 * g + 4 * l4) = o;
                }
            }
            __syncthreads();
        }
    }
}

template <int D, int NKB, bool SWA>
__device__ __forceinline__ void attn_task(const bf16* qrow, const LAS unsigned char* Kl, int kstrideB, const LAS unsigned char* Vl, int vstrideB, int kb0,
                                          const LAS float* biasr, int qloc, bool first_blk, float sink, float scale, bf16* orow, int l) {
    const int r32 = l & 31, h = l >> 5;
    bf16x8 qf[D / 16];
#pragma unroll
    for (int s = 0; s < D / 16; ++s) qf[s] = *(const bf16x8*)(qrow + 16 * s + 8 * h);
    f32x16 x[NKB];
#pragma unroll
    for (int kbi = 0; kbi < NKB; ++kbi) {
#pragma unroll
        for (int i = 0; i < 16; ++i) x[kbi][i] = 0.f;
#pragma unroll
        for (int s = 0; s < D / 16; ++s) { const bf16x8 a = *(const LAS bf16x8*)(Kl + ((kb0 + kbi) * 32 + r32) * kstrideB + (16 * s + 8 * h) * 2); x[kbi] = MFMA32(a, qf[s], x[kbi]); }
    }
    float m = -INFINITY;
#pragma unroll
    for (int kbi = 0; kbi < NKB; ++kbi)
#pragma unroll
        for (int i = 0; i < 16; ++i) {
            float s = x[kbi][i] * scale;
            if (SWA) { const int kloc = (kb0 + kbi) * 32 + (i & 3) + 8 * (i >> 2) + 4 * h, dist = qloc - kloc;
                const bool valid = (dist >= 0) && (dist < 128) && (!first_blk || kloc >= 128);
                const int dcl = dist < 0 ? 0 : (dist > 127 ? 127 : dist);
                s = valid ? s + biasr[dcl] : -INFINITY; }
            x[kbi][i] = s; m = fmaxf(m, s);
        }
    m = fmaxf(m, __shfl_xor(m, 32)); if (SWA) m = fmaxf(m, sink);
    float sum = 0.f;
    u32 pk[NKB][8];
#pragma unroll
    for (int kbi = 0; kbi < NKB; ++kbi)
#pragma unroll
        for (int i = 0; i < 16; i += 2) { const float e0 = __expf(x[kbi][i] - m), e1 = __expf(x[kbi][i + 1] - m); sum += e0 + e1; pk[kbi][i >> 1] = cvtpk(e0, e1); }
    sum += __shfl_xor(sum, 32); if (SWA) sum += __expf(sink - m);
    const float inv = 1.0f / sum;
    f32x16 o[D / 32];
#pragma unroll
    for (int db = 0; db < D / 32; ++db)
#pragma unroll
        for (int i = 0; i < 16; ++i) o[db][i] = 0.f;
#pragma unroll
    for (int kbi = 0; kbi < NKB; ++kbi)
#pragma unroll
        for (int s2 = 0; s2 < 2; ++s2) {
            u32x4 pw; pw.x = pk[kbi][4 * s2]; pw.y = pk[kbi][4 * s2 + 1]; pw.z = pk[kbi][4 * s2 + 2]; pw.w = pk[kbi][4 * s2 + 3];
            const bf16x8 pb = __builtin_bit_cast(bf16x8, pw);
#pragma unroll
            for (int db = 0; db < D / 32; ++db) {
                const LAS unsigned char* vp = Vl + (db * 32 + r32) * vstrideB + ((kb0 + kbi) * 32 + 16 * s2 + 4 * h) * 2;
                const s16x4 lo = *(const LAS s16x4*)vp, hi = *(const LAS s16x4*)(vp + 16);
                const bf16x8 a = __builtin_shufflevector(lo, hi, 0, 1, 2, 3, 4, 5, 6, 7);
                o[db] = MFMA32(a, pb, o[db]);
            }
        }
#pragma unroll
    for (int db = 0; db < D / 32; ++db)
#pragma unroll
        for (int g4 = 0; g4 < 4; ++g4) { u32x2 wv; wv.x = cvtpk(o[db][4 * g4] * inv, o[db][4 * g4 + 1] * inv); wv.y = cvtpk(o[db][4 * g4 + 2] * inv, o[db][4 * g4 + 3] * inv);
            *(u32x2*)(orow + db * 32 + 8 * g4 + 4 * h) = wv; }
}

__device__ __forceinline__ void phase_swa(const Ptrs& P, LAS unsigned char* lds, int G) {
    const int tid = threadIdx.x, l = tid & 63, w = __builtin_amdgcn_readfirstlane(tid >> 6);
    unsigned char* ws = P.ws;
    const bf16* Qb = (const bf16*)(ws + WS_Q); const bf16* Kb = (const bf16*)(ws + WS_K); const bf16* Vb = (const bf16*)(ws + WS_V); bf16* Ym = (bf16*)(ws + WS_YMIX);
    const float* bt = (const float*)(ws + WS_BIAS_TAB); const float* sinks = P.in[15];
    LAS unsigned char* Kl = lds;
    LAS unsigned char* Vl = lds + 36864;
    LAS float* bias_l = (LAS float*)(lds + 36864 + 33280);
    for (int it = blockIdx.x; it < 1024; it += G) {
        const int g = it & 3, n = (it >> 2) & 31, b = it >> 7;
        __syncthreads();
#pragma unroll
        for (int i = 0; i < 4; ++i) { const int e = tid + 512 * i, key = e >> 3, part = e & 7; const int kpos = n * 128 - 128 + key;
            u32x4 v = (u32x4){0u, 0u, 0u, 0u};
            if (kpos >= 0) v = *(const u32x4*)(Kb + ((size_t)b * SEQ + kpos) * 256 + g * 64 + part * 8);
            *(LAS u32x4*)(Kl + key * 144 + part * 16) = v; }
#pragma unroll
        for (int i = 0; i < 4; ++i) { const int e = tid + 512 * i, key = e & 255, part = e >> 8; const int kpos = n * 128 - 128 + key;
            u32x4 v = (u32x4){0u, 0u, 0u, 0u};
            if (kpos >= 0) v = *(const u32x4*)(Vb + ((size_t)b * SEQ + kpos) * 256 + g * 64 + part * 8);
#pragma unroll
            for (int jj = 0; jj < 8; ++jj) { const unsigned wv = v[jj >> 1]; *(LAS bf16*)(Vl + (part * 8 + jj) * 520 + key * 2) = (bf16)((jj & 1) ? (wv >> 16) : (wv & 0xffffu)); } }
        bias_l[tid] = bt[(4 * g + (tid >> 7)) * 128 + (tid & 127)];
        __syncthreads();
        const int r = w >> 1, hq = 4 * g + r; const float sink = sinks[hq];
#pragma unroll 1
        for (int t = 0; t < 2; ++t) {
            const int qq = 2 * (w & 1) + t, r32 = l & 31;
            const size_t qtok = (size_t)b * SEQ + n * 128 + 32 * qq + r32;
            attn_task<64, 5, true>(Qb + qtok * 1024 + hq * 64, Kl, 144, Vl, 520, qq, bias_l + r * 128, 128 + 32 * qq + r32, n == 0, sink, 0.125f,
                                   Ym + qtok * 2048 + 1024 + hq * 64, l);
        }
    }
}

__device__ __forceinline__ void phase_cross(const Ptrs& P, LAS unsigned char* lds, int G) {
    const int tid = threadIdx.x, l = tid & 63, w = __builtin_amdgcn_readfirstlane(tid >> 6);
    unsigned char* ws = P.ws;
    const bf16* Qc = (const bf16*)(ws + WS_QC); const bf16* KV = (const bf16*)(ws + WS_KV_C); bf16* Oc = (bf16*)(ws + WS_OC);
    LAS unsigned char* Kl = lds;
    LAS unsigned char* Vl = lds + 69632;
    int prev = -1;
    for (int it = blockIdx.x; it < 512; it += G) {
        const int qb = it & 15, hd = (it >> 4) & 3, b = it >> 6;
        if ((it >> 4) != prev) {
            prev = it >> 4;
            __syncthreads();
#pragma unroll
            for (int i = 0; i < 8; ++i) { const int e = tid + 512 * i, key = e >> 4, part = e & 15;
                *(LAS u32x4*)(Kl + key * 272 + part * 16) = *(const u32x4*)(KV + ((size_t)b * 256 + key) * 1024 + hd * 128 + part * 8); }
#pragma unroll
            for (int i = 0; i < 8; ++i) { const int e = tid + 512 * i, key = e & 255, part = e >> 8;
                const u32x4 v = *(const u32x4*)(KV + ((size_t)b * 256 + key) * 1024 + 512 + hd * 128 + part * 8);
#pragma unroll
                for (int jj = 0; jj < 8; ++jj) { const unsigned wv = v[jj >> 1]; *(LAS bf16*)(Vl + (part * 8 + jj) * 520 + key * 2) = (bf16)((jj & 1) ? (wv >> 16) : (wv & 0xffffu)); } }
            __syncthreads();
        }
        const size_t qtok = (size_t)b * SEQ + qb * 256 + 32 * w + (l & 31);
        attn_task<128, 8, false>(Qc + qtok * 512 + hd * 128, Kl, 272, Vl, 520, 0, (const LAS float*)lds, 0, false, 0.f, 0.08838834764831845f, Oc + qtok * 512 + hd * 128, l);
    }
}
__device__ __forceinline__ void topk_wave32(LAS unsigned char* wb, int l, int* TI, float* TG, size_t obase, size_t ostride) {
    const int j = l >> 1, half = l & 1, sw = 2 * (j & 7);
    u32 v[16];
#pragma unroll
    for (int gq = 0; gq < 4; ++gq) {
        u32 t[16];
#pragma unroll
        for (int i4 = 0; i4 < 4; ++i4) { const int i = 4 * gq + i4, ci = 2 * i + half, phys = ci ^ sw; const f32x4 f = *(const LAS f32x4*)(wb + j * 512 + phys * 16);
#pragma unroll
            for (int e = 0; e < 4; ++e) t[4 * i4 + e] = (f2key(f[e]) & ~0x7Fu) | (u32)(127 - (8 * i + 4 * half + e)); }
        sort16_desc(t);
        if (gq == 0) {
#pragma unroll
            for (int i = 0; i < 16; ++i) v[i] = t[i];
        } else merge_top16_desc(v, t);
    }
    LDS_WAIT(); asm volatile("" ::: "memory");
    {
        u32 o[16];
#pragma unroll
        for (int i = 0; i < 16; ++i) o[i] = (u32)__shfl_xor((int)v[i], 1);
        merge_top16_desc(v, o);
    }
    LAS u32* lut = (LAS u32*)wb;
#pragma unroll
    for (int i = 0; i < 16; ++i) lut[l * 16 + i] = v[i];
    float va[16], vb[16];
    {
        const bool c1 = (l >> 1) & 1;
#pragma unroll
        for (int i = 0; i < 16; ++i) { const u32 o = (u32)__shfl_xor((int)v[i], 2); const u32 a = c1 ? o : v[i], b = c1 ? v[i] : o; va[i] = key2f(a & ~0x7Fu); vb[i] = key2f(b & ~0x7Fu); }
    }
#define CAND(i, q) ((f2key(va[i] + vb[q]) & ~0xFFu) | (u32)(255 - (16 * (i) + (q))))
    u32 c[16];
    {
        u32 t[16];
#pragma unroll
        for (int q = 0; q < 16; ++q) c[q] = CAND(0, q);
        sort16_desc(c);
#pragma unroll
        for (int q = 0; q < 8; ++q) t[q] = CAND(1, q);
#pragma unroll
        for (int q = 0; q < 5; ++q) t[8 + q] = CAND(2, q);
        t[13] = CAND(3, 0); t[14] = CAND(3, 1); t[15] = CAND(3, 2);
        sort16_desc(t); merge_top16_desc(c, t);
        t[0] = CAND(3, 3); t[1] = CAND(4, 0); t[2] = CAND(4, 1); t[3] = CAND(4, 2); t[4] = CAND(5, 0); t[5] = CAND(5, 1); t[6] = CAND(6, 0); t[7] = CAND(6, 1);
        t[8] = CAND(7, 0); t[9] = CAND(7, 1); t[10] = CAND(8, 0); t[11] = CAND(9, 0); t[12] = CAND(10, 0); t[13] = CAND(11, 0); t[14] = CAND(12, 0); t[15] = CAND(13, 0);
        sort16_desc(t); merge_top16_desc(c, t);
        insert_top16_desc(c, CAND(14, 0)); insert_top16_desc(c, CAND(15, 0));
    }
#undef CAND
    LDS_WAIT(); asm volatile("" ::: "memory");
    float best[16]; int eidx[16];
    const int la = (l & ~2) * 16, lb = (l | 2) * 16;
#pragma unroll
    for (int r = 0; r < 16; ++r) { const u32 key = c[r]; const int pos = 255 - (int)(key & 0xFFu); best[r] = key2f(key & ~0xFFu);
        const int k0 = 127 - (int)(lut[la + (pos >> 4)] & 0x7Fu), k1 = 127 - (int)(lut[lb + (pos & 15)] & 0x7Fu); eidx[r] = k0 * 128 + k1; }
    float s = 0.f;
#pragma unroll
    for (int r = 0; r < 16; ++r) { best[r] = __expf(best[r] - key2f(c[0] & ~0xFFu)); s += best[r]; }
    const float inv = 1.0f / s;
    if ((l & 3) == 0) {
        const size_t o = obase + (size_t)(l >> 2) * ostride;
#pragma unroll
        for (int r4 = 0; r4 < 4; ++r4) { *(int4*)(TI + o + 4 * r4) = make_int4(eidx[4 * r4], eidx[4 * r4 + 1], eidx[4 * r4 + 2], eidx[4 * r4 + 3]);
            *(f32x4*)(TG + o + 4 * r4) = (f32x4){best[4 * r4] * inv, best[4 * r4 + 1] * inv, best[4 * r4 + 2] * inv, best[4 * r4 + 3] * inv}; }
    }
    LDS_WAIT(); asm volatile("" ::: "memory");
}
struct EpiTopk {
    static constexpr bool PERM = true, AFTER_DRAIN = true;
    const float* PS; int* TI; float* TG;
    __device__ __forceinline__ void fused(const pg8::f32x4 (&acc)[2][2][4][2], const pg8::Unit& u, int wr, int wc, int fr, int fq, LAS unsigned char* lds, int wid, int lane) const {
        const int cb0 = (8 * wc + 2 * fq) ^ (4 * (fr & 3));
        LAS unsigned char* wq0 = lds + (4 * wr) * 16384 + (2 * fr) * 512 + cb0 * 16;
        LAS unsigned char* wq1 = lds + (4 * wr) * 16384 + (2 * fr + 1) * 512 + (cb0 ^ 2) * 16;
#pragma unroll
        for (int ai = 0; ai < 2; ++ai) {
#pragma unroll
            for (int m = 0; m < 4; ++m) { const size_t row = (size_t)(u.pm * 256 + ai * 128 + wr * 64 + m * 16 + fr); const float r = pg8::row_rnorm(PS, row);
#pragma unroll
                for (int n = 0; n < 2; ++n) { *(LAS f32x4*)(wq0 + m * 16384 + n * 16) = acc[ai][0][m][n] * r; *(LAS f32x4*)(wq1 + m * 16384 + n * 16) = acc[ai][1][m][n] * r; } }
            __syncthreads();
            topk_wave32(lds + wid * 16384, lane, TI, TG, ((size_t)(u.pm * 256 + ai * 128 + 16 * wid) * 8 + u.pn) * 16, 128);
            __syncthreads();
        }
    }
};

typedef float f32x2 __attribute__((ext_vector_type(2)));

typedef float v32f_t __attribute__((ext_vector_type(32)));
struct PeerBuf { v6u_t u0, u1, v0, v1; u32x2 sc0, sc1; };
#define PEER_LD6(rs, so) ({ const u32x4 a_ = __builtin_bit_cast(u32x4, __builtin_amdgcn_raw_buffer_load_b128(rs, 16 * l, so, 0)); const u32x2 b_ = __builtin_bit_cast(u32x2, __builtin_amdgcn_raw_buffer_load_b64(rs, 1024 + 8 * l, so, 0)); (v6u_t){a_.x, a_.y, a_.z, a_.w, b_.x, b_.y}; })
template <class RS> __device__ __forceinline__ void peer_issue(PeerBuf& B, const RS& rsU, const RS& rsV, const RS& rsS, int ivA, int ivB, int k0, int l) {
    const int iv = (k0 & 64) ? ivB : ivA;
    const int e0 = __builtin_amdgcn_readlane(iv, (k0 & 63)), e1 = __builtin_amdgcn_readlane(iv, (k0 & 63) + 1);
    B.sc0 = __builtin_bit_cast(u32x2, __builtin_amdgcn_raw_buffer_load_b64(rsS, 0, e0 * 8, 0)); B.sc1 = __builtin_bit_cast(u32x2, __builtin_amdgcn_raw_buffer_load_b64(rsS, 0, e1 * 8, 0));
    B.u0 = PEER_LD6(rsU, e0 * PEER_ROW_BYTES); B.u1 = PEER_LD6(rsU, e1 * PEER_ROW_BYTES); B.v0 = PEER_LD6(rsV, e0 * PEER_ROW_BYTES); B.v1 = PEER_LD6(rsV, e1 * PEER_ROW_BYTES);
}
typedef __bf16 v32bf_t __attribute__((ext_vector_type(32)));
typedef __bf16 bf16x2v __attribute__((ext_vector_type(2)));
__device__ __forceinline__ float peer_dot6(v6u_t w, const u32 (&xp)[16]) { const v32bf_t f = __builtin_amdgcn_cvt_scalef32_pk32_bf16_fp6(w, 1.0f); float s = 0.f;
#define PD2(pp) s = __builtin_amdgcn_fdot2_f32_bf16(__builtin_bit_cast(bf16x2v, xp[pp]), __builtin_shufflevector(f, f, 2 * (pp), 2 * (pp) + 1), s, false);
    PD2(0) PD2(1) PD2(2) PD2(3) PD2(4) PD2(5) PD2(6) PD2(7) PD2(8) PD2(9) PD2(10) PD2(11) PD2(12) PD2(13) PD2(14) PD2(15)
#undef PD2
    return s; }
__device__ __forceinline__ void peer_axpy6(v6u_t w, float c, float (&acc)[32]) { const v32f_t f = __builtin_amdgcn_cvt_scalef32_pk32_f32_fp6(w, 1.0f);
#pragma unroll
    for (int i = 0; i < 32; ++i) acc[i] += c * f[i]; }
__device__ __forceinline__ void peer_axpy6v(v6u_t w, float c, v32f_t& acc) { const v32f_t f = __builtin_amdgcn_cvt_scalef32_pk32_f32_fp6(w, 1.0f); acc = acc + f * c; }
__device__ __forceinline__ void peer_compute(const PeerBuf& B, const u32 (&xr)[16], float (&acc)[32], float rn, int ivA, int ivB, float gvA, float gvB, int k0, int l) {
    const float gv = (k0 & 64) ? gvB : gvA; const int kk = k0 & 63;
    const float d0 = peer_dot6(B.u0, xr); __builtin_amdgcn_sched_barrier(0);
    const float d1 = peer_dot6(B.u1, xr); __builtin_amdgcn_sched_barrier(0);
    const bool o1 = l & 1;
    float t = (o1 ? d1 : d0) + __shfl_xor(o1 ? d0 : d1, 1);
#pragma unroll
    for (int o = 2; o < 64; o <<= 1) t += __shfl_xor(t, o);
    const float g0 = __uint_as_float(__builtin_amdgcn_readlane(__float_as_uint(gv), kk)), g1 = __uint_as_float(__builtin_amdgcn_readlane(__float_as_uint(gv), kk + 1));
    const float su = __uint_as_float(o1 ? B.sc1.x : B.sc0.x), sv = __uint_as_float(o1 ? B.sc1.y : B.sc0.y), gg = o1 ? g1 : g0;
    const float cf = gg * gelu_tanh(t * su * rn) * sv;
    const float c0 = __uint_as_float(__builtin_amdgcn_readlane(__float_as_uint(cf), 0)), c1 = __uint_as_float(__builtin_amdgcn_readlane(__float_as_uint(cf), 1));
    __builtin_amdgcn_sched_barrier(0);
    peer_axpy6(B.v0, c0, acc); __builtin_amdgcn_sched_barrier(0);
    peer_axpy6(B.v1, c1, acc); __builtin_amdgcn_sched_barrier(0);
}
#define XB_TMO      128
#define XB_XCNT(j)  (256  + 64 * (j))
#define XB_XSUB(j)  (1280 + 64 * (j))
#define XB_XGEN(j)  (2304 + 64 * (j))
#define XB_TOP      3328
#define XB_TOPGEN   3392
#define XCD_BAR_WORDS 3456
#define XB_SPIN_CAP (1u << 20)
__device__ __forceinline__ unsigned xb_ld(unsigned* p)              { return __hip_atomic_load(p, __ATOMIC_RELAXED, __HIP_MEMORY_SCOPE_AGENT); }
__device__ __forceinline__ unsigned xb_add(unsigned* p, unsigned v) { return __hip_atomic_fetch_add(p, v, __ATOMIC_RELAXED, __HIP_MEMORY_SCOPE_AGENT); }
__device__ __forceinline__ unsigned xb_xcc_id() { return (unsigned)__builtin_amdgcn_s_getreg((3 << 11) | 20) & 0xFu; }
#define XB_SPIN(cond, bar) do { unsigned _sp = 0; while (cond) { __builtin_amdgcn_s_sleep(1); \
    if ((++_sp & 255u) == 0u) { if (xb_ld(&(bar)[XB_TMO])) break; if (_sp > XB_SPIN_CAP) { atomicAdd(&(bar)[XB_TMO], 1u); break; } } } } while (0)
struct XcdBarrier { unsigned* bar; unsigned x; volatile LAS unsigned* st; };
__device__ __forceinline__ XcdBarrier xcd_barrier_post(unsigned* bar, volatile LAS unsigned* st) {
    XcdBarrier b; b.bar = bar; b.x = xb_xcc_id(); b.st = st;
    if (threadIdx.x == 0) (void)xb_add(&bar[XB_XCNT(b.x)], 1u);
    return b;
}
__device__ __forceinline__ void xcd_barrier_complete(unsigned* bar, unsigned x, unsigned& nloc, unsigned& nx) {
    const unsigned G = gridDim.x * gridDim.y * gridDim.z;
    unsigned sum, cnt, mine, sp = 0u;
    for (;;) {
        sum = 0u; cnt = 0u; mine = 0u;
#pragma unroll
        for (unsigned j = 0; j < 16; ++j) { const unsigned c = xb_ld(&bar[XB_XCNT(j)]); sum += c; cnt += (c > 0u) ? 1u : 0u; mine = (j == x) ? c : mine; }
        if (sum == G) break;
        __builtin_amdgcn_s_sleep(1);
        if ((++sp & 255u) == 0u) { if (xb_ld(&bar[XB_TMO])) break; if (sp > XB_SPIN_CAP) { atomicAdd(&bar[XB_TMO], 1u); break; } }
    }
    nloc = mine > 0u ? mine : 1u; nx = cnt > 0u ? cnt : 1u;
}
__device__ __forceinline__ void xcd_barrier(const XcdBarrier& b) {
    asm volatile("s_waitcnt vmcnt(0)" ::: "memory");
    __syncthreads();
    if (threadIdx.x == 0) {
        unsigned* bar = b.bar;
        __builtin_amdgcn_s_waitcnt(0);
        unsigned nloc = b.st[0], nx = b.st[1];
        if (nloc == 0u) { xcd_barrier_complete(bar, b.x, nloc, nx); b.st[0] = nloc; b.st[1] = nx; }
        const unsigned old = xb_add(&bar[XB_XSUB(b.x)], 1u);
        const unsigned gen = old / nloc;
        if (old + 1u == (gen + 1u) * nloc) {
            __builtin_amdgcn_fence(__ATOMIC_RELEASE, "agent");
            asm volatile("s_waitcnt vmcnt(0)" ::: "memory");
            const unsigned og = xb_add(&bar[XB_TOP], 1u);
            const unsigned tg = og / nx;
            if (og + 1u == (tg + 1u) * nx) xb_add(&bar[XB_TOPGEN], 1u);
            else XB_SPIN(xb_ld(&bar[XB_TOPGEN]) == tg, bar);
            __builtin_amdgcn_fence(__ATOMIC_ACQUIRE, "agent");
            xb_add(&bar[XB_XGEN(b.x)], 1u);
            asm volatile("s_waitcnt vmcnt(0)" ::: "memory");
        } else {
            XB_SPIN(xb_ld(&bar[XB_XGEN(b.x)]) == gen, bar);
            __builtin_amdgcn_fence(__ATOMIC_ACQUIRE, "agent");
            asm volatile("s_waitcnt vmcnt(0)" ::: "memory");
        }
    }
    __syncthreads();
}

struct PeerHalf { v6u_t w0, w1, w2, w3, w4, w5, w6, w7; };
__device__ __forceinline__ void peer_q_ids(int (&el)[8], const int* p  ) {
#pragma unroll
    for (int st = 0; st < 8; ++st) el[st] = p[4 * st];
}
template <class RS> __device__ __forceinline__ void peer_q_issue(PeerHalf& B, const RS& rs, const int (&el)[8], int ch) {
#define PH_LD(st) ({ const int vo_ = el[st] * PEER_SROW; \
        const u32x4 a_ = __builtin_bit_cast(u32x4, __builtin_amdgcn_raw_buffer_load_b128(rs, vo_ + 16 * ch, 0, 0)); const u32x2 b_ = __builtin_bit_cast(u32x2, __builtin_amdgcn_raw_buffer_load_b64(rs, vo_ + 256 + 8 * ch, 0, 0)); \
        (v6u_t){a_.x, a_.y, a_.z, a_.w, b_.x, b_.y}; })
    B.w0 = PH_LD(0); B.w1 = PH_LD(1); B.w2 = PH_LD(2); B.w3 = PH_LD(3); B.w4 = PH_LD(4); B.w5 = PH_LD(5); B.w6 = PH_LD(6); B.w7 = PH_LD(7);
#undef PH_LD
}
__device__ __forceinline__ void peer_q_dots(const PeerHalf& B, const u32 (&xs)[16], LAS float* pd  , int ch) {
    float d[8], old[8];
#pragma unroll
    for (int st = 0; st < 8; ++st) old[st] = pd[4 * st];
    d[0] = peer_dot6(B.w0, xs); __builtin_amdgcn_sched_barrier(0); d[1] = peer_dot6(B.w1, xs); __builtin_amdgcn_sched_barrier(0);
    d[2] = peer_dot6(B.w2, xs); __builtin_amdgcn_sched_barrier(0); d[3] = peer_dot6(B.w3, xs); __builtin_amdgcn_sched_barrier(0);
    d[4] = peer_dot6(B.w4, xs); __builtin_amdgcn_sched_barrier(0); d[5] = peer_dot6(B.w5, xs); __builtin_amdgcn_sched_barrier(0);
    d[6] = peer_dot6(B.w6, xs); __builtin_amdgcn_sched_barrier(0); d[7] = peer_dot6(B.w7, xs); __builtin_amdgcn_sched_barrier(0);
#pragma unroll
    for (int o = 1; o < 16; o <<= 1)
#pragma unroll
        for (int st = 0; st < 8; ++st) d[st] += __shfl_xor(d[st], o);
    if (ch == 0) {
#pragma unroll
        for (int st = 0; st < 8; ++st) pd[4 * st] = old[st] + d[st];
    }
}
__device__ __forceinline__ void peer_q_axpy(const PeerHalf& B, const LAS float* pd  , v32f_t& acc) {
    float cf[8];
#pragma unroll
    for (int st = 0; st < 8; ++st) cf[st] = pd[4 * st];
    peer_axpy6v(B.w0, cf[0], acc); __builtin_amdgcn_sched_barrier(0); peer_axpy6v(B.w1, cf[1], acc); __builtin_amdgcn_sched_barrier(0);
    peer_axpy6v(B.w2, cf[2], acc); __builtin_amdgcn_sched_barrier(0); peer_axpy6v(B.w3, cf[3], acc); __builtin_amdgcn_sched_barrier(0);
    peer_axpy6v(B.w4, cf[4], acc); __builtin_amdgcn_sched_barrier(0); peer_axpy6v(B.w5, cf[5], acc); __builtin_amdgcn_sched_barrier(0);
    peer_axpy6v(B.w6, cf[6], acc); __builtin_amdgcn_sched_barrier(0); peer_axpy6v(B.w7, cf[7], acc); __builtin_amdgcn_sched_barrier(0);
}
__device__ __forceinline__ void phase_peer(const Ptrs& P, LAS unsigned char* lds, int G, const XcdBarrier* bar) {
    const int tid = threadIdx.x, l = tid & 63, w = __builtin_amdgcn_readfirstlane(tid >> 6);
    unsigned char* ws = P.ws;
    const bf16* HN = (const bf16*)(ws + WS_HN); const float* SUV = (const float*)(ws + WS_PEER_SU);
    const int* TI = (const int*)(ws + WS_TK_IDX); const float* TG = (const float*)(ws + WS_TK_G); float* out = P.out; const float* gfin = P.in[27]; const float* PS = (const float*)(ws + WS_PS);
    LAS float* PD = (LAS float*)(lds + w * 8192);
    LAS float* SS = (LAS float*)(lds + 65536 + w * 64);
    const int es = l >> 4, ch = l & 15, stride = G * NWAVES, tok0 = blockIdx.x * NWAVES + w;
    (void)bar;
    if (l < 16) SS[l] = 0.f;
#pragma unroll
    for (int q = 0; q < 8; ++q) *(LAS f32x4*)(PD + 4 * l + 256 * q) = (f32x4){0.f, 0.f, 0.f, 0.f};
#pragma unroll 1
    for (int s = 0; s < 4; ++s) {
        const auto rsU = __builtin_amdgcn_make_buffer_rsrc((void*)(ws + WS_PEER_U + (size_t)s * PEER_SLICE_BYTES), 0, (int)PEER_SLICE_BYTES, 0x00020000);
        PeerHalf A, B;
        int elA[8], elB[8];
        u32 xs[16];
#pragma unroll
        for (int q = 0; q < 4; ++q) { const u32x4 a = *(const u32x4*)(HN + (size_t)tok0 * DM + 512 * s + 32 * ch + 8 * q); xs[4 * q] = a.x; xs[4 * q + 1] = a.y; xs[4 * q + 2] = a.z; xs[4 * q + 3] = a.w; }
        peer_q_ids(elA, TI + (size_t)tok0 * 128 + es); peer_q_ids(elB, TI + (size_t)tok0 * 128 + 32 + es);
        peer_q_issue(A, rsU, elA, ch);
#pragma unroll 1
        for (int i = 0; i < 16; ++i) {
            const size_t tok = (size_t)(tok0 + i * stride), ntok = (size_t)(tok0 + (i < 15 ? i + 1 : i) * stride);
            u32 nxs[16];
#pragma unroll
            for (int q = 0; q < 4; ++q) { const u32x4 a = *(const u32x4*)(HN + ntok * DM + 512 * s + 32 * ch + 8 * q); nxs[4 * q] = a.x; nxs[4 * q + 1] = a.y; nxs[4 * q + 2] = a.z; nxs[4 * q + 3] = a.w; }
            peer_q_issue(B, rsU, elB, ch);      peer_q_ids(elA, TI + tok * 128 + 64 + es);   peer_q_dots(A, xs, PD + i * 128 + es, ch);
            peer_q_issue(A, rsU, elA, ch);      peer_q_ids(elB, TI + tok * 128 + 96 + es);   peer_q_dots(B, xs, PD + i * 128 + 32 + es, ch);
            peer_q_issue(B, rsU, elB, ch);      peer_q_ids(elA, TI + ntok * 128 + es);       peer_q_dots(A, xs, PD + i * 128 + 64 + es, ch);
            peer_q_issue(A, rsU, elA, ch);      peer_q_ids(elB, TI + ntok * 128 + 32 + es);  peer_q_dots(B, xs, PD + i * 128 + 96 + es, ch);
#pragma unroll
            for (int q = 0; q < 16; ++q) xs[q] = nxs[q];
        }
    }
#pragma unroll 1
    for (int i = 0; i < 16; ++i) {
        const size_t tok = (size_t)(tok0 + i * stride);
        const float rn = __builtin_amdgcn_rsqf(wave_sum(l < 32 ? PS[tok * 32 + l] : 0.f) * (1.0f / 2048.0f) + NORM_EPS);
#pragma unroll
        for (int hh = 0; hh < 2; ++hh) { const int k = 64 * hh + l; const int e = TI[tok * 128 + k]; const float g = TG[tok * 128 + k]; const f32x2 sc = *(const f32x2*)(SUV + 2 * e);
            PD[i * 128 + k] = g * gelu_tanh(PD[i * 128 + k] * sc.x * rn) * sc.y; }
    }
#pragma unroll 1
    for (int s = 0; s < 4; ++s) {
        const auto rsV = __builtin_amdgcn_make_buffer_rsrc((void*)(ws + WS_PEER_V + (size_t)s * PEER_SLICE_BYTES), 0, (int)PEER_SLICE_BYTES, 0x00020000);
        PeerHalf A, B;
        int elA[8], elB[8];
        peer_q_ids(elA, TI + (size_t)tok0 * 128 + es); peer_q_ids(elB, TI + (size_t)tok0 * 128 + 32 + es);
        peer_q_issue(A, rsV, elA, ch);
#pragma unroll 1
        for (int i = 0; i < 16; ++i) {
            const size_t tok = (size_t)(tok0 + i * stride), ntok = (size_t)(tok0 + (i < 15 ? i + 1 : i) * stride);
            u32x4 hw[4];
#pragma unroll
            for (int q = 0; q < 4; ++q) hw[q] = *(const u32x4*)(HN + tok * DM + 512 * s + 32 * ch + 8 * q);
            v32f_t acc;
#pragma unroll
            for (int c = 0; c < 32; ++c) acc[c] = 0.f;
            peer_q_issue(B, rsV, elB, ch);      peer_q_ids(elA, TI + tok * 128 + 64 + es);   peer_q_axpy(A, PD + i * 128 + es, acc);
            peer_q_issue(A, rsV, elA, ch);      peer_q_ids(elB, TI + tok * 128 + 96 + es);   peer_q_axpy(B, PD + i * 128 + 32 + es, acc);
            peer_q_issue(B, rsV, elB, ch);      peer_q_ids(elA, TI + ntok * 128 + es);       peer_q_axpy(A, PD + i * 128 + 64 + es, acc);
            peer_q_issue(A, rsV, elA, ch);      peer_q_ids(elB, TI + ntok * 128 + 32 + es);  peer_q_axpy(B, PD + i * 128 + 96 + es, acc);
#pragma unroll
            for (int c = 0; c < 32; ++c) { float a = acc[c]; a += __shfl_xor(a, 16); a += __shfl_xor(a, 32); acc[c] = a; }
            float ss = 0.f;
            {
                float* op = out + tok * DM + 512 * s + 32 * ch;
#pragma unroll
                for (int q = 0; q < 4; ++q) {
                    const f32x4 o0 = {acc[8 * q] + bflo(hw[q].x), acc[8 * q + 1] + bfhi(hw[q].x), acc[8 * q + 2] + bflo(hw[q].y), acc[8 * q + 3] + bfhi(hw[q].y)};
                    const f32x4 o1 = {acc[8 * q + 4] + bflo(hw[q].z), acc[8 * q + 5] + bfhi(hw[q].z), acc[8 * q + 6] + bflo(hw[q].w), acc[8 * q + 7] + bfhi(hw[q].w)};
                    ss += ((o0[0] * o0[0] + o0[1] * o0[1]) + (o0[2] * o0[2] + o0[3] * o0[3])) + ((o1[0] * o1[0] + o1[1] * o1[1]) + (o1[2] * o1[2] + o1[3] * o1[3]));
                    if (es == 0) { *(f32x4*)(op + 8 * q) = o0; *(f32x4*)(op + 8 * q + 4) = o1; } }
                if (es != 0) ss = 0.f;
            }
            ss += __shfl_xor(ss, 1); ss += __shfl_xor(ss, 2); ss += __shfl_xor(ss, 4); ss += __shfl_xor(ss, 8);
            if (l == 0) SS[i] += ss;
        }
    }
    asm volatile("s_waitcnt vmcnt(0) lgkmcnt(0)" ::: "memory");
#pragma unroll 1
    for (int i = 0; i < 16; ++i) {
        const size_t tok = (size_t)(tok0 + i * stride);
        const float r = rsqrtf(SS[i] * (1.f / DM) + NORM_EPS);
        f32x4* op = (f32x4*)(out + tok * DM);
#pragma unroll
        for (int j = 0; j < 8; ++j) { const f32x4 ga = ((const f32x4*)gfin)[l + 64 * j]; const f32x4 o = op[l + 64 * j]; op[l + 64 * j] = (f32x4){o.x * r * ga.x, o.y * r * ga.y, o.z * r * ga.z, o.w * r * ga.w}; }
    }
}

struct Params { const float* in[28]; float* out; unsigned char* ws; int ph_lo, ph_hi; };
constexpr int N_PHASES = 13;
#ifndef STOP_AFTER
#define STOP_AFTER 12
#endif

__global__ void __launch_bounds__(NTHREADS, 2) mega(Params prm) {
    extern __shared__ __attribute__((aligned(16))) unsigned char lds_raw[];
    LAS unsigned char* lds = (LAS unsigned char*)lds_raw;
    const int G = gridDim.x;
    Ptrs P;
#pragma unroll
    for (int i = 0; i < 28; ++i) P.in[i] = prm.in[i];
    P.out = prm.out; P.ws = prm.ws;
    unsigned char* ws = prm.ws;
    const int lo = prm.ph_lo, hi = prm.ph_hi;
#ifndef PHMASK
#define PHMASK 0x1fff
#endif
#define IN(k) (((PHMASK >> (k)) & 1) && lo <= (k) && (k) < hi)
#if ONE_LAUNCH
    volatile LAS unsigned* bst = (volatile LAS unsigned*)(lds + LDS_BYTES - 64);
    if (threadIdx.x == 0) { bst[0] = 0u; bst[1] = 0u; }
    __syncthreads();
    const XcdBarrier bar = xcd_barrier_post((unsigned*)(ws + WS_CTL), bst);
#define SEAM(k) do { if (IN(k) && IN((k) + 1)) xcd_barrier(bar); } while (0)
#ifndef PEER_SYNC
#define PEER_SYNC 0
#endif
#define PEER_BAR (PEER_SYNC ? &bar : (const XcdBarrier*)nullptr)
#else
#define SEAM(k) do { } while (0)
#define PEER_BAR ((const XcdBarrier*)nullptr)
#endif
    bf16* HN = (bf16*)(ws + WS_HN);
    if (IN(0)) { phase_prologue(P, lds, G); }
    SEAM(0);
    if (IN(1)) {
        __syncthreads();
        { pg8::Gemm g{HN, (const bf16*)(ws + WS_W_IN_T), NTOK, 2560, 2048}; pg8::StaticOrder S; S.init(NTOK, 2560, G, (int)blockIdx.x);
          pg8::EpiInProj E{(bf16*)(ws + WS_U), (bf16*)(ws + WS_Q), (bf16*)(ws + WS_K), (bf16*)(ws + WS_V)};
          pg8::gemm_phase<pg8::EpiInProj, pg8::StaticOrder, PG8_ALIGN, PG8_SP2>(lds, g, S, E); }
        __syncthreads();
        { pg8::Gemm g{(const bf16*)(ws + WS_MEM_N), (const bf16*)(ws + WS_W_CKV_T), 2048, 1024, 2048}; pg8::StaticOrder S; S.init(2048, 1024, G, (int)blockIdx.x);
          pg8::EpiBf16Plain E{(bf16*)(ws + WS_KV_C), 1024};
          pg8::gemm_phase<pg8::EpiBf16Plain, pg8::StaticOrder, PG8_ALIGN, PG8_SP2>(lds, g, S, E); }
        __syncthreads();
        {
            const int wv = __builtin_amdgcn_readfirstlane(threadIdx.x >> 6), ln = threadIdx.x & 63;
            constexpr int R1 = 32768;
            if (blockIdx.x >= 32) peer_quant_rows(P, lds, wv, ln, ((int)blockIdx.x - 32) * NWAVES + wv, (G - 32) * NWAVES, R1);
            else peer_quant_rows(P, lds, wv, ln, R1 + (int)blockIdx.x * NWAVES + wv, 32 * NWAVES, 32768);
        }
    }
    SEAM(1);
    if (IN(2)) {
#ifndef NO_S5
        __syncthreads(); phase_s5(P, lds, G);
#endif
#ifndef NO_SWA
        __syncthreads(); phase_swa(P, lds, G);
#endif
    }
    SEAM(2);
    if (IN(3)) {
        __syncthreads();
        pg8::Gemm g{(const bf16*)(ws + WS_YPRE), (const bf16*)(ws + WS_W_GLU_T), NTOK, 1024, 1024}; pg8::StaticOrder S; S.init(NTOK, 1024, G, (int)blockIdx.x);
        pg8::EpiGlu E{(bf16*)(ws + WS_YMIX), 2048, (const bf16*)(ws + WS_YPRE), 1024, P.in[14]};
        pg8::gemm_phase<pg8::EpiGlu, pg8::StaticOrder, PG8_ALIGN, PG8_SP2>(lds, g, S, E);
    }
    SEAM(3);
    if (IN(4)) {
        __syncthreads();
        pg8::Gemm g{(const bf16*)(ws + WS_YMIX), (const bf16*)(ws + WS_W_OUT_T), NTOK, 2048, 2048}; pg8::StaticOrder S; S.init(NTOK, 2048, G, (int)blockIdx.x);
        pg8::EpiResBf16<false> E{HN, P.in[0], (float*)(ws + WS_PS)};
        pg8::gemm_phase<pg8::EpiResBf16<false>, pg8::StaticOrder, PG8_ALIGN, PG8_SP2>(lds, g, S, E);
    }
    SEAM(4);
    if (IN(6)) {
        __syncthreads();
        pg8::Gemm g{HN, (const bf16*)(ws + WS_W_CQ_T), NTOK, 512, 2048}; pg8::StaticOrder S; S.init(NTOK, 512, G, (int)blockIdx.x);
        pg8::EpiBf16RowScale E{(bf16*)(ws + WS_QC), 512, (const float*)(ws + WS_PS)};
        pg8::gemm_phase<pg8::EpiBf16RowScale, pg8::StaticOrder, PG8_ALIGN, PG8_SP2>(lds, g, S, E);
    }
    SEAM(6);
    if (IN(7)) { __syncthreads(); phase_cross(P, lds, G); }
    SEAM(7);
    if (IN(8)) {
        __syncthreads();
        pg8::Gemm g{(const bf16*)(ws + WS_OC), (const bf16*)(ws + WS_W_CO_T), NTOK, 2048, 512}; pg8::StaticOrder S; S.init(NTOK, 2048, G, (int)blockIdx.x);
        pg8::EpiResBf16<true> E{HN, HN, (float*)(ws + WS_PS)};
        pg8::gemm_phase<pg8::EpiResBf16<true>, pg8::StaticOrder, PG8_ALIGN, PG8_SP2>(lds, g, S, E);
    }
    SEAM(8);
    if (IN(10)) {
        __syncthreads();
        pg8::Gemm g{HN, (const bf16*)(ws + WS_W_S_T), NTOK, 2048, 2048}; pg8::StaticOrder S; S.init(NTOK, 2048, G, (int)blockIdx.x);
        EpiTopk E{(const float*)(ws + WS_PS), (int*)(ws + WS_TK_IDX), (float*)(ws + WS_TK_G)};
        for (int i = 0; ; ++i) { pg8::Unit uu; if (!S.next(i, uu)) break; pg8::OneUnit O1{uu}; pg8::gemm_phase<EpiTopk, pg8::OneUnit, false, false>(lds, g, O1, E); }
    }
    SEAM(11);
    if (IN(12)) { __syncthreads(); phase_peer(P, lds, G, PEER_BAR); }
    if (lo <= 13 && 13 < hi) {
        const int lane = threadIdx.x & 63, wave = threadIdx.x >> 6;
        for (int m = blockIdx.x * NWAVES + wave; m < NTOK; m += G * NWAVES) {
            f32x4* xr = (f32x4*)(P.out + (size_t)m * DM) + lane; const f32x4* gr = (const f32x4*)P.in[27] + lane;
            f32x4 v[8]; float ss = 0.f;
#pragma unroll
            for (int j = 0; j < 8; ++j) { v[j] = xr[64 * j]; ss += (v[j].x * v[j].x + v[j].y * v[j].y) + (v[j].z * v[j].z + v[j].w * v[j].w); }
            const float r = rsqrtf(wave_sum(ss) * (1.f / DM) + NORM_EPS);
#pragma unroll
            for (int j = 0; j < 8; ++j) { const f32x4 g = gr[64 * j]; xr[64 * j] = (f32x4){v[j].x * r * g.x, v[j].y * r * g.y, v[j].z * r * g.z, v[j].w * r * g.w}; }
        }
    }
}

extern "C" void kernel_launch(void* const* d_in, const int* in_sizes, int n_in, void* d_out, int out_size, void* d_ws, size_t ws_size, hipStream_t stream) {
    static int grid = 0;
    if (!grid) {
        int dev = 0, cus = 0, per_cu = 0;
        if (hipGetDevice(&dev) != hipSuccess || hipDeviceGetAttribute(&cus, hipDeviceAttributeMultiprocessorCount, dev) != hipSuccess) { fprintf(stderr, "kernel_launch: device query failed\n"); return; }
        if (hipFuncSetAttribute((const void*)mega, hipFuncAttributeMaxDynamicSharedMemorySize, LDS_BYTES) != hipSuccess) { fprintf(stderr, "kernel_launch: hipFuncSetAttribute failed\n"); return; }
        if (hipOccupancyMaxActiveBlocksPerMultiprocessor(&per_cu, (const void*)mega, NTHREADS, LDS_BYTES) != hipSuccess || per_cu < 1) { fprintf(stderr, "kernel_launch: occupancy query says %d\n", per_cu); per_cu = 1; }
        grid = 256;
        if (cus != 256) fprintf(stderr, "kernel_launch: built for 256 CUs, device reports %d\n", cus);
        if (ws_size < WS_END || n_in != 28) fprintf(stderr, "kernel_launch: unexpected ws_size %zu / n_in %d\n", ws_size, n_in);
    }
    Params p{};
    for (int i = 0; i < 28; ++i) p.in[i] = (const float*)d_in[i];
    p.out = (float*)d_out; p.ws = (unsigned char*)d_ws;
#if ONE_LAUNCH
    p.ph_lo = 0; p.ph_hi = N_PHASES;
    if (hipMemsetAsync((char*)d_ws + WS_CTL, 0, CTL_ZERO_BYTES, stream) != hipSuccess) { fprintf(stderr, "kernel_launch: memset of the barrier words failed\n"); return; }
    hipLaunchKernelGGL(mega, dim3(grid), dim3(NTHREADS), LDS_BYTES, stream, p);
#else
#ifndef REPEAT_MASK
#define REPEAT_MASK 0
#endif
    for (int ph = 0; ph <= STOP_AFTER; ++ph) { p.ph_lo = ph; p.ph_hi = ph + 1;
        for (int rep = 0; rep < (((REPEAT_MASK >> ph) & 1) ? 2 : 1); ++rep) hipLaunchKernelGGL(mega, dim3(grid), dim3(NTHREADS), LDS_BYTES, stream, p); }
    if (STOP_AFTER < 12) { p.ph_lo = 13; p.ph_hi = 14; hipLaunchKernelGGL(mega, dim3(grid), dim3(NTHREADS), LDS_BYTES, stream, p); }
#endif
}
```

```cpp
#include <hip/hip_runtime.h>
#include <cstdio>
#include <cstdint>
#ifndef ONE_LAUNCH
#define ONE_LAUNCH 1
#endif
#define SN_HD __host__ __device__ __forceinline__
#ifndef SN_HD
#define SN_HD __host__ __device__ __forceinline__
#endif
typedef unsigned int u32;
SN_HD u32 sn_max(u32 a, u32 b) { return a > b ? a : b; }
SN_HD u32 sn_min(u32 a, u32 b) { return a < b ? a : b; }
SN_HD u32 f2key(float f) { u32 u = __builtin_bit_cast(u32, f); return (u & 0x80000000u) ? ~u : (u | 0x80000000u); }
SN_HD float key2f(u32 k) { u32 u = (k & 0x80000000u) ? (k & 0x7fffffffu) : ~k; return __builtin_bit_cast(float, u); }
template <int BASE> SN_HD void bitonic_merge16_desc(u32 (&v)[64]) {
#pragma unroll
    for (int j = 8; j > 0; j >>= 1) {
#pragma unroll
        for (int i = 0; i < 16; ++i) { const int l = i ^ j; if (l > i) { const u32 a = v[BASE + i], b = v[BASE + l]; v[BASE + i] = sn_max(a, b); v[BASE + l] = sn_min(a, b); } }
    }
}
template <int BASE> SN_HD void bitonic_sort16_desc(u32 (&v)[64]) {
#pragma unroll
    for (int k = 2; k <= 16; k <<= 1) {
#pragma unroll
        for (int j = k >> 1; j > 0; j >>= 1) {
#pragma unroll
            for (int i = 0; i < 16; ++i) { const int l = i ^ j; if (l > i) { const u32 a = v[BASE + i], b = v[BASE + l]; const bool desc = ((i & k) == 0);
                v[BASE + i] = desc ? sn_max(a, b) : sn_min(a, b); v[BASE + l] = desc ? sn_min(a, b) : sn_max(a, b); } }
        }
    }
}
template <int A, int B> SN_HD void merge_top16(u32 (&v)[64]) {
#pragma unroll
    for (int i = 0; i < 16; ++i) v[A + i] = sn_max(v[A + i], v[B + 15 - i]);
    bitonic_merge16_desc<A>(v);
}
SN_HD void top16_of_64(u32 (&v)[64]) {
    bitonic_sort16_desc<0>(v); bitonic_sort16_desc<16>(v); bitonic_sort16_desc<32>(v); bitonic_sort16_desc<48>(v);
    merge_top16<0, 16>(v); merge_top16<32, 48>(v); merge_top16<0, 32>(v);
}

SN_HD void merge_sorted16_desc(u32 (&a)[16]) {
#pragma unroll
    for (int j = 8; j > 0; j >>= 1) {
#pragma unroll
        for (int i = 0; i < 16; ++i) { const int l = i ^ j; if (l > i) { const u32 x = a[i], y = a[l]; a[i] = sn_max(x, y); a[l] = sn_min(x, y); } }
    }
}
SN_HD void sort16_desc(u32 (&a)[16]) {
#pragma unroll
    for (int k = 2; k <= 16; k <<= 1) {
#pragma unroll
        for (int j = k >> 1; j > 0; j >>= 1) {
#pragma unroll
            for (int i = 0; i < 16; ++i) { const int l = i ^ j; if (l > i) { const u32 x = a[i], y = a[l]; const bool desc = ((i & k) == 0);
                a[i] = desc ? sn_max(x, y) : sn_min(x, y); a[l] = desc ? sn_min(x, y) : sn_max(x, y); } }
        }
    }
}
SN_HD void merge_top16_desc(u32 (&a)[16], const u32 (&b)[16]) {
#pragma unroll
    for (int i = 0; i < 16; ++i) a[i] = sn_max(a[i], b[15 - i]);
    merge_sorted16_desc(a);
}
SN_HD void insert_top16_desc(u32 (&a)[16], u32 x) {
#pragma unroll
    for (int k = 15; k > 0; --k) a[k] = sn_max(a[k], sn_min(a[k - 1], x));
    a[0] = sn_max(a[0], x);
}
namespace pg8 {
#define PG8_LAS __attribute__((address_space(3)))
typedef unsigned short bf16_t;
typedef short bf16x8 __attribute__((ext_vector_type(8)));
typedef float f32x4 __attribute__((ext_vector_type(4)));
typedef unsigned u32x4 __attribute__((ext_vector_type(4)));
constexpr int BM = 256, BK = 64, HALF = 128, HTB = HALF * BK * 2  , STAGE_BYTES = 8 * HTB, NXCD = 8, WGM = 4;

__host__ __device__ __forceinline__ int lds_byte(int r, int c) { const int st = (r >> 4) * 2 + (c >> 5), rr = r & 15, cc = c & 31, ob = rr * 64 + cc * 2; return st * 1024 + (ob ^ (((ob >> 9) & 1) << 5)); }
__host__ __device__ __forceinline__ void stage_rc(int b, int& R, int& C) { const int st = b / 1024, sb = b % 1024, swz = sb ^ (((sb >> 9) & 1) << 5); R = (st >> 1) * 16 + swz / 64; C = (st & 1) * 32 + (swz % 64) / 2; }
__host__ __device__ __forceinline__ int perm32(int rho) { const int n = rho >> 4, i = rho & 15; return 8 * (i >> 2) + 4 * n + (i & 3); }

struct Unit { int pm, pn; };
struct Gemm { const bf16_t* A; const bf16_t* Bt; int M, N, K; };

struct StaticOrder {
    int nM, nN, nwg, G, c;
    __host__ __device__ void init(int M, int N, int G_, int c_) { nM = M / BM; nN = N / BM; nwg = nM * nN; G = G_; c = c_; }
    __host__ __device__ bool next(int i, Unit& u) const {
        const long L = (long)i * G + c; if (L >= nwg) return false;
        int wgid = (int)L; { const int q = nwg / NXCD, r = nwg % NXCD, xcd = wgid % NXCD, off = wgid / NXCD; wgid = (xcd < r ? xcd * (q + 1) : r * (q + 1) + (xcd - r) * q) + off; }
        const int nig = WGM * nN, gid = wgid / nig, fm = gid * WGM, gsz = (nM - fm) < WGM ? (nM - fm) : WGM;
        u.pm = fm + ((wgid % nig) % gsz); u.pn = (wgid % nig) / gsz; return true;
    }
    __device__ __forceinline__ void a_ready(const Unit&) const {}
    __device__ __forceinline__ void done(const Unit&) const {}
};

typedef float f32x2_t __attribute__((ext_vector_type(2)));
typedef __bf16 bf16x2_t __attribute__((ext_vector_type(2)));
struct OneUnit { Unit u;
    __device__ __forceinline__ bool next(int i, Unit& o) const { if (i) return false; o = u; return true; }
    __device__ __forceinline__ void a_ready(const Unit&) const {}
    __device__ __forceinline__ void done(const Unit&) const {} };

__device__ __forceinline__ unsigned cvt_pk_bf16(float lo, float hi) { const f32x2_t f = {lo, hi}; const bf16x2_t b = __builtin_convertvector(f, bf16x2_t); return __builtin_bit_cast(unsigned, b); }


template <class Epi, class Sched, bool ALIGN_EPI = false, bool SP2 = false>
__device__ __forceinline__ void gemm_phase(PG8_LAS unsigned char* lds, const Gemm g, const Sched& S, const Epi& E) {
    const int tid = threadIdx.x, wid = __builtin_amdgcn_readfirstlane(tid >> 6), lane = tid & 63, wr = wid >> 2, wc = wid & 3, fr = lane & 15, fq = lane >> 4;
    const int K = g.K, nt = K / BK;
    unsigned voffA[2], voffB[2];
#pragma unroll
    for (int i = 0; i < 2; ++i) { int R, C; stage_rc(tid * 16 + i * 8192, R, C); const int Rb = Epi::PERM ? ((R & ~31) + perm32(R & 31)) : R;
        voffA[i] = (unsigned)(R * K + C) * 2u; voffB[i] = (unsigned)(Rb * K + C) * 2u; }
    const size_t kstep = (size_t)(BK * 2);
    const size_t hstep = (size_t)HALF * K * 2;
    const size_t tstep = 2 * hstep;
    const unsigned ldsw = (unsigned)wid * 1024u;
    const int aoff = lds_byte(wr * 64 + fr, fq * 8), boff = lds_byte(wc * 32 + fr, fq * 8);
#define PG8_SA(b, h) (((b) * 2 + (h)) * HTB)
#define PG8_SB(b, h) ((4 + (b) * 2 + (h)) * HTB)
#define PG8_STAGE(bufoff, gbase, voff) do { _Pragma("unroll") for (int _i = 0; _i < 2; ++_i) \
        __builtin_amdgcn_global_load_lds((const unsigned*)((const char*)(gbase) + (voff)[_i]), (PG8_LAS unsigned*)(lds + (bufoff) + ldsw + _i * 8192), 16, 0, 0); } while (0)
#define PG8_LDA(dst, b, h) do { _Pragma("unroll") for (int m = 0; m < 4; ++m) _Pragma("unroll") for (int k = 0; k < 2; ++k) dst[m][k] = *(const PG8_LAS bf16x8*)(lds + PG8_SA(b, h) + aoff + m * 2048 + k * 1024); } while (0)
#define PG8_LDB(dst, b, h) do { _Pragma("unroll") for (int n = 0; n < 2; ++n) _Pragma("unroll") for (int k = 0; k < 2; ++k) dst[n][k] = *(const PG8_LAS bf16x8*)(lds + PG8_SB(b, h) + boff + n * 2048 + k * 1024); } while (0)
#define PG8_MMA(ai, bj, At, Bt) do { __builtin_amdgcn_s_setprio(1); _Pragma("unroll") for (int m = 0; m < 4; ++m) _Pragma("unroll") for (int n = 0; n < 2; ++n) _Pragma("unroll") for (int k = 0; k < 2; ++k) \
        acc[ai][bj][m][n] = __builtin_amdgcn_mfma_f32_16x16x32_bf16(Bt[n][k], At[m][k], acc[ai][bj][m][n], 0, 0, 0); __builtin_amdgcn_s_setprio(0); } while (0)
#define PG8_WAIT_V(n) asm volatile("s_waitcnt vmcnt(" #n ")" ::: "memory")
#define PG8_WAIT_L(n) asm volatile("s_waitcnt lgkmcnt(" #n ")" ::: "memory")
#define PG8_BAR __builtin_amdgcn_s_barrier()
#define PG8_SCHED __builtin_amdgcn_sched_barrier(0)
    Unit cur, nxt; int ui = 0;
    if (!S.next(0, cur)) return;
    f32x4 acc[2][2][4][2];
#pragma unroll
    for (int a = 0; a < 2; ++a)
#pragma unroll
        for (int b = 0; b < 2; ++b)
#pragma unroll
            for (int m = 0; m < 4; ++m)
#pragma unroll
                for (int n = 0; n < 2; ++n) acc[a][b][m][n] = (f32x4){0.f, 0.f, 0.f, 0.f};
    bf16x8 At[4][2], B0[2][2], B1[2][2];
    const char* cA = (const char*)g.A + (size_t)cur.pm * tstep; const char* cB = (const char*)g.Bt + (size_t)cur.pn * tstep;
    S.a_ready(cur);
    if constexpr (SP2) {
        PG8_STAGE(PG8_SB(0, 0), cB, voffB); PG8_STAGE(PG8_SB(0, 1), cB + hstep, voffB); PG8_STAGE(PG8_SA(0, 0), cA, voffA); PG8_STAGE(PG8_SA(0, 1), cA + hstep, voffA);
        if (wr == 1) PG8_BAR;
        PG8_WAIT_V(2); PG8_BAR;
        PG8_STAGE(PG8_SB(1, 0), cB + kstep, voffB); PG8_STAGE(PG8_SA(1, 0), cA + kstep, voffA); PG8_STAGE(PG8_SB(1, 1), cB + hstep + kstep, voffB);
        PG8_WAIT_V(6); PG8_BAR;
    } else {
        PG8_STAGE(PG8_SB(0, 0), cB, voffB); PG8_STAGE(PG8_SA(0, 0), cA, voffA); PG8_STAGE(PG8_SB(0, 1), cB + hstep, voffB); PG8_STAGE(PG8_SA(0, 1), cA + hstep, voffA);
        if (wr == 1) PG8_BAR;
        PG8_WAIT_V(4); PG8_BAR;
        PG8_STAGE(PG8_SB(1, 0), cB + kstep, voffB); PG8_STAGE(PG8_SA(1, 0), cA + kstep, voffA); PG8_STAGE(PG8_SB(1, 1), cB + hstep + kstep, voffB);
        PG8_WAIT_V(6); PG8_BAR;
    }
    for (;;) {
        const bool has_next = S.next(ui + 1, nxt);
        const char* nA = has_next ? (const char*)g.A + (size_t)nxt.pm * tstep : cA; const char* nB = has_next ? (const char*)g.Bt + (size_t)nxt.pn * tstep : cB;
        for (int t = 0; t < nt; t += 2) {
            const bool last = (t == nt - 2);
            const char* a1 = cA + (size_t)(t + 1) * kstep;
            const char* a2 = last ? nA : cA + (size_t)(t + 2) * kstep; const char* b2 = last ? nB : cB + (size_t)(t + 2) * kstep;
            const char* a3 = a2 + kstep; const char* b3 = b2 + kstep;
            if (last && has_next) S.a_ready(nxt);
            if constexpr (SP2) {
            PG8_LDB(B0, 0, 0); PG8_LDB(B1, 0, 1); PG8_SCHED; PG8_LDA(At, 0, 0); PG8_STAGE(PG8_SA(1, 1), a1 + hstep, voffA);
            PG8_WAIT_V(8); PG8_WAIT_L(0); PG8_BAR; PG8_MMA(0, 0, At, B0); PG8_MMA(0, 1, At, B1); PG8_BAR; PG8_SCHED;
            PG8_LDA(At, 0, 1); PG8_STAGE(PG8_SB(0, 0), b2, voffB); PG8_STAGE(PG8_SB(0, 1), b2 + hstep, voffB); PG8_STAGE(PG8_SA(0, 0), a2, voffA);
            PG8_WAIT_V(8); PG8_WAIT_L(0); PG8_BAR; PG8_MMA(1, 0, At, B0); PG8_MMA(1, 1, At, B1); PG8_BAR; PG8_SCHED;
            PG8_LDB(B0, 1, 0); PG8_LDB(B1, 1, 1); PG8_SCHED; PG8_LDA(At, 1, 0); PG8_STAGE(PG8_SA(0, 1), a2 + hstep, voffA);
            PG8_WAIT_V(8); PG8_WAIT_L(0); PG8_BAR; PG8_MMA(0, 0, At, B0); PG8_MMA(0, 1, At, B1); PG8_BAR; PG8_SCHED;
            PG8_LDA(At, 1, 1); PG8_STAGE(PG8_SB(1, 0), b3, voffB); PG8_STAGE(PG8_SB(1, 1), b3 + hstep, voffB); PG8_STAGE(PG8_SA(1, 0), a3, voffA);
            PG8_WAIT_V(8); PG8_WAIT_L(0); PG8_BAR; PG8_MMA(1, 0, At, B0); PG8_MMA(1, 1, At, B1); PG8_BAR; PG8_SCHED;
            } else {
            PG8_LDB(B0, 0, 0); PG8_SCHED; PG8_LDA(At, 0, 0); PG8_STAGE(PG8_SA(1, 1), a1 + hstep, voffA);
            PG8_WAIT_L(8); PG8_BAR; PG8_WAIT_L(0); PG8_MMA(0, 0, At, B0); PG8_BAR; PG8_SCHED;
            PG8_LDB(B1, 0, 1); PG8_STAGE(PG8_SB(0, 0), b2, voffB);
            PG8_BAR; PG8_WAIT_L(0); PG8_MMA(0, 1, At, B1); PG8_BAR;
            PG8_LDA(At, 0, 1); PG8_STAGE(PG8_SA(0, 0), a2, voffA);
            PG8_BAR; PG8_WAIT_L(0); PG8_MMA(1, 0, At, B0); PG8_BAR; PG8_SCHED;
            PG8_STAGE(PG8_SB(0, 1), b2 + hstep, voffB);
            PG8_WAIT_V(6); PG8_BAR; PG8_MMA(1, 1, At, B1); PG8_BAR;
            PG8_LDB(B0, 1, 0); PG8_SCHED; PG8_LDA(At, 1, 0); PG8_STAGE(PG8_SA(0, 1), a2 + hstep, voffA);
            PG8_WAIT_L(8); PG8_BAR; PG8_WAIT_L(0); PG8_MMA(0, 0, At, B0); PG8_BAR; PG8_SCHED;
            PG8_LDB(B1, 1, 1); PG8_STAGE(PG8_SB(1, 0), b3, voffB);
            PG8_BAR; PG8_WAIT_L(0); PG8_MMA(0, 1, At, B1); PG8_BAR;
            PG8_LDA(At, 1, 1); PG8_STAGE(PG8_SA(1, 0), a3, voffA);
            PG8_BAR; PG8_WAIT_L(0); PG8_MMA(1, 0, At, B0); PG8_BAR; PG8_SCHED;
            PG8_STAGE(PG8_SB(1, 1), b3 + hstep, voffB);
            PG8_WAIT_V(6); PG8_BAR; PG8_MMA(1, 1, At, B1); PG8_BAR;
            }
        }
        if constexpr (ALIGN_EPI) { if (wr == 0) PG8_BAR; }
        if constexpr (!Epi::AFTER_DRAIN) { E(acc, cur, wr, wc, fr, fq); S.done(cur); }
        if (!has_next) break;
#pragma unroll
        for (int a = 0; a < 2; ++a)
#pragma unroll
            for (int b = 0; b < 2; ++b)
#pragma unroll
                for (int m = 0; m < 4; ++m)
#pragma unroll
                    for (int n = 0; n < 2; ++n) acc[a][b][m][n] = (f32x4){0.f, 0.f, 0.f, 0.f};
        cur = nxt; cA = nA; cB = nB; ++ui;
        if constexpr (ALIGN_EPI) { if (wr == 1) PG8_BAR; }
    }
    PG8_WAIT_V(0);
    if constexpr (!ALIGN_EPI) { if (wr == 0) PG8_BAR; }
    PG8_BAR;
    if constexpr (Epi::AFTER_DRAIN) { E.fused(acc, cur, wr, wc, fr, fq, lds, wid, lane); S.done(cur); }
#undef PG8_SA
#undef PG8_SB
#undef PG8_STAGE
#undef PG8_LDA
#undef PG8_LDB
#undef PG8_MMA
#undef PG8_WAIT_V
#undef PG8_WAIT_L
#undef PG8_BAR
#undef PG8_SCHED
}

struct EpiInProj {
    static constexpr bool PERM = true, AFTER_DRAIN = false;
    bf16_t *U, *Q, *Kb, *Vb;
    __device__ __forceinline__ void operator()(const f32x4 (&acc)[2][2][4][2], const Unit& u, int wr, int wc, int fr, int fq) const {
        const int row0 = u.pm * BM + wr * 64 + fr;
        if (u.pn < 4) {
            const int col0 = u.pn * BM + wc * 32 + 8 * fq;
#pragma unroll
            for (int ai = 0; ai < 2; ++ai)
#pragma unroll
                for (int m = 0; m < 4; ++m) { const int row = row0 + ai * HALF + m * 16, b = row >> 12, t = row & 4095;
#pragma unroll
                    for (int bj = 0; bj < 2; ++bj) { const int col = col0 + bj * HALF; const f32x4 v0 = acc[ai][bj][m][0], v1 = acc[ai][bj][m][1];
                        u32x4 w; w.x = cvt_pk_bf16(v0[0], v0[1]); w.y = cvt_pk_bf16(v0[2], v0[3]); w.z = cvt_pk_bf16(v1[0], v1[1]); w.w = cvt_pk_bf16(v1[2], v1[3]);
                        *(u32x4*)(U + (((size_t)(b * 64 + (col >> 4)) * 4096 + t) * 16 + (col & 8))) = w; } }
            return;
        }
        bf16_t* base; int ldc, colt;
        if (u.pn < 8) { base = Q; ldc = 1024; colt = (u.pn - 4) * BM; } else if (u.pn == 8) { base = Kb; ldc = 256; colt = 0; } else { base = Vb; ldc = 256; colt = 0; }
        const int col0 = colt + wc * 32 + 8 * fq;
#pragma unroll
        for (int ai = 0; ai < 2; ++ai)
#pragma unroll
            for (int m = 0; m < 4; ++m) { bf16_t* rowp = base + (size_t)(row0 + ai * HALF + m * 16) * ldc + col0;
#pragma unroll
                for (int bj = 0; bj < 2; ++bj) { const f32x4 v0 = acc[ai][bj][m][0], v1 = acc[ai][bj][m][1];
                    u32x4 w; w.x = cvt_pk_bf16(v0[0], v0[1]); w.y = cvt_pk_bf16(v0[2], v0[3]); w.z = cvt_pk_bf16(v1[0], v1[1]); w.w = cvt_pk_bf16(v1[2], v1[3]);
                    *(u32x4*)(rowp + bj * HALF) = w; } }
    }
};
struct EpiBf16Plain {
    static constexpr bool PERM = true, AFTER_DRAIN = false;
    bf16_t* O; int ldc;
    __device__ __forceinline__ void operator()(const f32x4 (&acc)[2][2][4][2], const Unit& u, int wr, int wc, int fr, int fq) const {
        const int row0 = u.pm * BM + wr * 64 + fr, col0 = u.pn * BM + wc * 32 + 8 * fq;
#pragma unroll
        for (int ai = 0; ai < 2; ++ai)
#pragma unroll
            for (int m = 0; m < 4; ++m) { bf16_t* rowp = O + (size_t)(row0 + ai * HALF + m * 16) * ldc + col0;
#pragma unroll
                for (int bj = 0; bj < 2; ++bj) { const f32x4 v0 = acc[ai][bj][m][0], v1 = acc[ai][bj][m][1];
                    u32x4 w; w.x = cvt_pk_bf16(v0[0], v0[1]); w.y = cvt_pk_bf16(v0[2], v0[3]); w.z = cvt_pk_bf16(v1[0], v1[1]); w.w = cvt_pk_bf16(v1[2], v1[3]);
                    *(u32x4*)(rowp + bj * HALF) = w; } }
    }
};
struct EpiGlu {
    static constexpr bool PERM = true, AFTER_DRAIN = false;
    bf16_t* O; int ldo; const bf16_t* Y; int ldy; const float* bias;
    __device__ __forceinline__ void operator()(const f32x4 (&acc)[2][2][4][2], const Unit& u, int wr, int wc, int fr, int fq) const {
        const int row0 = u.pm * BM + wr * 64 + fr, col0 = u.pn * BM + wc * 32 + 8 * fq;
        f32x4 bv[2][2];
#pragma unroll
        for (int bj = 0; bj < 2; ++bj)
#pragma unroll
            for (int n = 0; n < 2; ++n) bv[bj][n] = *(const f32x4*)(bias + col0 + bj * HALF + 4 * n);
#pragma unroll
        for (int ai = 0; ai < 2; ++ai)
#pragma unroll
            for (int m = 0; m < 4; ++m) { const size_t row = (size_t)(row0 + ai * HALF + m * 16);
#pragma unroll
                for (int bj = 0; bj < 2; ++bj) {
                    const u32x4 yw = *(const u32x4*)(Y + row * ldy + col0 + bj * HALF);
                    float o[8];
#pragma unroll
                    for (int e = 0; e < 8; ++e) { const float a = acc[ai][bj][m][e >> 2][e & 3] + bv[bj][e >> 2][e & 3];
                        const unsigned yy = yw[e >> 1]; const float y = __uint_as_float((e & 1) ? (yy & 0xffff0000u) : (yy << 16));
                        o[e] = y / (1.0f + __expf(-a)); }
                    u32x4 w; w.x = cvt_pk_bf16(o[0], o[1]); w.y = cvt_pk_bf16(o[2], o[3]); w.z = cvt_pk_bf16(o[4], o[5]); w.w = cvt_pk_bf16(o[6], o[7]);
                    *(u32x4*)(O + row * ldo + col0 + bj * HALF) = w; } }
    }
};
struct EpiResF32 {
    static constexpr bool PERM = false, AFTER_DRAIN = false;
    float* C; const float* R; int ldc;
    __device__ __forceinline__ void operator()(const f32x4 (&acc)[2][2][4][2], const Unit& u, int wr, int wc, int fr, int fq) const {
        const int row0 = u.pm * BM + wr * 64 + fr, col0 = u.pn * BM + wc * 32 + 4 * fq;
#pragma unroll
        for (int ai = 0; ai < 2; ++ai)
#pragma unroll
            for (int m = 0; m < 4; ++m) { const size_t off = (size_t)(row0 + ai * HALF + m * 16) * ldc + col0;
#pragma unroll
                for (int bj = 0; bj < 2; ++bj)
#pragma unroll
                    for (int n = 0; n < 2; ++n) { f32x4 v = acc[ai][bj][m][n]; if (R) v = v + *(const f32x4*)(R + off + bj * HALF + n * 16); *(f32x4*)(C + off + bj * HALF + n * 16) = v; } }
    }
};
__device__ __forceinline__ float row_rnorm(const float* PS, size_t row) {
    const f32x4* p = (const f32x4*)(PS + row * 32); float s = 0.f;
#pragma unroll
    for (int i = 0; i < 8; ++i) { const f32x4 v = p[i]; s += (v[0] + v[1]) + (v[2] + v[3]); }
    return __builtin_amdgcn_rsqf(s * (1.0f / 2048.0f) + 1e-6f);
}
template <bool RBF16> struct EpiResBf16 {
    static constexpr bool PERM = true, AFTER_DRAIN = false;
    bf16_t* H; const void* R; float* PS;
    __device__ __forceinline__ void operator()(const f32x4 (&acc)[2][2][4][2], const Unit& u, int wr, int wc, int fr, int fq) const {
        const int row0 = u.pm * BM + wr * 64 + fr, col0 = u.pn * BM + wc * 32 + 8 * fq;
#pragma unroll
        for (int ai = 0; ai < 2; ++ai)
#pragma unroll
            for (int m = 0; m < 4; ++m) { const size_t row = (size_t)(row0 + ai * HALF + m * 16), off = row * 2048 + col0; float ss = 0.f;
#pragma unroll
                for (int bj = 0; bj < 2; ++bj) {
                    f32x4 r0, r1;
                    if (RBF16) { const u32x4 rw = *(const u32x4*)((const bf16_t*)R + off + bj * HALF);
                        r0 = (f32x4){__uint_as_float(rw.x << 16), __uint_as_float(rw.x & 0xffff0000u), __uint_as_float(rw.y << 16), __uint_as_float(rw.y & 0xffff0000u)};
                        r1 = (f32x4){__uint_as_float(rw.z << 16), __uint_as_float(rw.z & 0xffff0000u), __uint_as_float(rw.w << 16), __uint_as_float(rw.w & 0xffff0000u)}; }
                    else { r0 = *(const f32x4*)((const float*)R + off + bj * HALF); r1 = *(const f32x4*)((const float*)R + off + bj * HALF + 4); }
                    const f32x4 v0 = acc[ai][bj][m][0] + r0, v1 = acc[ai][bj][m][1] + r1;
                    ss += ((v0[0] * v0[0] + v0[1] * v0[1]) + (v0[2] * v0[2] + v0[3] * v0[3])) + ((v1[0] * v1[0] + v1[1] * v1[1]) + (v1[2] * v1[2] + v1[3] * v1[3]));
                    u32x4 w; w.x = cvt_pk_bf16(v0[0], v0[1]); w.y = cvt_pk_bf16(v0[2], v0[3]); w.z = cvt_pk_bf16(v1[0], v1[1]); w.w = cvt_pk_bf16(v1[2], v1[3]);
                    *(u32x4*)(H + off + bj * HALF) = w; }
                ss += __shfl_xor(ss, 16); ss += __shfl_xor(ss, 32);
                if (fq == 0) PS[row * 32 + u.pn * 4 + wc] = ss; }
    }
};
struct EpiBf16RowScale {
    static constexpr bool PERM = true, AFTER_DRAIN = false;
    bf16_t* O; int ldc; const float* PS;
    __device__ __forceinline__ void operator()(const f32x4 (&acc)[2][2][4][2], const Unit& u, int wr, int wc, int fr, int fq) const {
        const int row0 = u.pm * BM + wr * 64 + fr, col0 = u.pn * BM + wc * 32 + 8 * fq;
#pragma unroll
        for (int ai = 0; ai < 2; ++ai)
#pragma unroll
            for (int m = 0; m < 4; ++m) { const size_t row = (size_t)(row0 + ai * HALF + m * 16); const float r = row_rnorm(PS, row); bf16_t* rowp = O + row * ldc + col0;
#pragma unroll
                for (int bj = 0; bj < 2; ++bj) { const f32x4 v0 = acc[ai][bj][m][0] * r, v1 = acc[ai][bj][m][1] * r;
                    u32x4 w; w.x = cvt_pk_bf16(v0[0], v0[1]); w.y = cvt_pk_bf16(v0[2], v0[3]); w.z = cvt_pk_bf16(v1[0], v1[1]); w.w = cvt_pk_bf16(v1[2], v1[3]);
                    *(u32x4*)(rowp + bj * HALF) = w; } }
    }
};
struct EpiF32RowScale {
    static constexpr bool PERM = true, AFTER_DRAIN = false;
    float* C; int ldc; const float* PS;
    __device__ __forceinline__ void operator()(const f32x4 (&acc)[2][2][4][2], const Unit& u, int wr, int wc, int fr, int fq) const {
        const int row0 = u.pm * BM + wr * 64 + fr, col0 = u.pn * BM + wc * 32 + 8 * fq;
#pragma unroll
        for (int ai = 0; ai < 2; ++ai)
#pragma unroll
            for (int m = 0; m < 4; ++m) { const size_t row = (size_t)(row0 + ai * HALF + m * 16); const float r = row_rnorm(PS, row); const size_t off = row * ldc + col0;
#pragma unroll
                for (int bj = 0; bj < 2; ++bj) { *(f32x4*)(C + off + bj * HALF) = acc[ai][bj][m][0] * r; *(f32x4*)(C + off + bj * HALF + 4) = acc[ai][bj][m][1] * r; } }
    }
};
}

#ifndef PG8_SP2
#define PG8_SP2 false
#endif
#ifndef PG8_ALIGN
#define PG8_ALIGN true
#endif
constexpr int NTOK = 32768, DM = 2048, SEQ = 4096, NB = 8;
constexpr int NWAVES = 8, NTHREADS = 512;
constexpr int LDS_BYTES = 147456;
constexpr float NORM_EPS = 1e-6f;

#define LAS __attribute__((address_space(3)))
typedef unsigned short bf16;
typedef unsigned u32;
typedef short bf16x8 __attribute__((ext_vector_type(8)));
typedef short s16x4 __attribute__((ext_vector_type(4)));
typedef float f32x4 __attribute__((ext_vector_type(4)));
typedef float f32x16 __attribute__((ext_vector_type(16)));
typedef unsigned u32x4 __attribute__((ext_vector_type(4)));
typedef unsigned u32x2 __attribute__((ext_vector_type(2)));

constexpr size_t MiB = 1u << 20;
constexpr size_t WS_CTL = 0, CTL_ZERO_BYTES = 64 * 1024;
constexpr size_t WS_W_IN_T = 1 * MiB, WS_W_GLU_T = 11 * MiB, WS_W_OUT_T = 13 * MiB, WS_W_CQ_T = 21 * MiB, WS_W_CKV_T = 23 * MiB, WS_W_CO_T = 27 * MiB, WS_W_S_T = 29 * MiB;
constexpr size_t WS_S5_WIN = 37 * MiB, WS_S5_WOUT = 41 * MiB, WS_S5_K = 45 * MiB, WS_S5_LAM = 46 * MiB, WS_BIAS_TAB = 46 * MiB + 512 * 1024;
constexpr size_t WS_MEM_N = 47 * MiB, WS_KV_C = 55 * MiB, WS_PS = 59 * MiB;
#ifndef FP6_PACK_INTERLEAVED
#define FP6_PACK_INTERLEAVED 1
#endif
typedef unsigned v6u_t __attribute__((ext_vector_type(6)));
constexpr int PEER_ROW_BYTES = 1536;
constexpr int PEER_SROW = 384;
constexpr size_t PEER_SLICE_BYTES = (size_t)16384 * PEER_SROW;
constexpr size_t WS_PEER_U = 64 * MiB, WS_PEER_V = 96 * MiB;
constexpr size_t WS_PEER_SU = 128 * MiB, WS_PEER_SV = 128 * MiB + 65536;
constexpr size_t WS_HN = 192 * MiB;
constexpr size_t WS_U = 320 * MiB, WS_Q = 384 * MiB, WS_K = 448 * MiB, WS_V = 464 * MiB, WS_YPRE = 480 * MiB, WS_YMIX = 544 * MiB;
constexpr size_t WS_SCORES = 320 * MiB;
constexpr size_t WS_QC = 672 * MiB, WS_OC = 704 * MiB, WS_TK_IDX = 736 * MiB, WS_TK_G = 752 * MiB, WS_END = 768 * MiB;

__device__ __forceinline__ unsigned f2bf(float f) { unsigned u = __float_as_uint(f); return (u + 0x7fffu + ((u >> 16) & 1u)) >> 16; }
__device__ __forceinline__ unsigned pk2(float lo, float hi) { return pg8::cvt_pk_bf16(lo, hi); }
__device__ __forceinline__ unsigned cvtpk(float lo, float hi) { return pg8::cvt_pk_bf16(lo, hi); }
__device__ __forceinline__ float bflo(unsigned w) { return __uint_as_float(w << 16); }
__device__ __forceinline__ float bfhi(unsigned w) { return __uint_as_float(w & 0xffff0000u); }
__device__ __forceinline__ float wave_sum(float v) {
#pragma unroll
    for (int o = 1; o < 64; o <<= 1) v += __shfl_xor(v, o);
    return v;
}
__device__ __forceinline__ float gelu_tanh(float x) { const float z = 0.7978845608028654f * (x + 0.044715f * x * x * x); return x / (1.0f + __expf(-2.0f * z)); }
#define LDS_WAIT() asm volatile("s_waitcnt lgkmcnt(0)" ::: "memory")
#define MFMA16(a, b, c) __builtin_amdgcn_mfma_f32_16x16x32_bf16((a), (b), (c), 0, 0, 0)
#define MFMA32(a, b, c) __builtin_amdgcn_mfma_f32_32x32x16_bf16((a), (b), (c), 0, 0, 0)

__device__ __forceinline__ void p0_transpose_item(const float* W, int K, int N, bf16* WT, LAS float* scr, int item, int lane, const float* kgain = nullptr) {
    const int nblk = N / 32, kb = item / nblk, nb = item % nblk, k0 = 64 * kb, n0 = 32 * nb;
    f32x4 v[8];
#pragma unroll
    for (int i = 0; i < 8; ++i) v[i] = *(const f32x4*)(W + (size_t)(k0 + 8 * i + (lane >> 3)) * N + n0 + 4 * (lane & 7));
#pragma unroll
    for (int i = 0; i < 8; ++i) { const int kk = 8 * i + (lane >> 3); f32x4 x = v[i]; if (kgain) x = x * kgain[k0 + kk];
#pragma unroll
        for (int c = 0; c < 4; ++c) scr[kk * 33 + 4 * (lane & 7) + c] = x[c]; }
    LDS_WAIT(); asm volatile("" ::: "memory");
    const int c = lane & 7;
#pragma unroll
    for (int j = 0; j < 4; ++j) { const int n = (lane >> 3) + 8 * j; const LAS float* s = scr + (8 * c) * 33 + n;
        u32x4 o; o.x = pk2(s[0 * 33], s[1 * 33]); o.y = pk2(s[2 * 33], s[3 * 33]); o.z = pk2(s[4 * 33], s[5 * 33]); o.w = pk2(s[6 * 33], s[7 * 33]);
        *(u32x4*)(WT + (size_t)(n0 + n) * K + k0 + 8 * c) = o; }
    LDS_WAIT(); asm volatile("" ::: "memory");
}
__device__ __forceinline__ void rms_row_to_bf16(const float* xrow, const float* gain, bf16* orow, int lane) {
    const f32x4* xr = (const f32x4*)xrow + lane; const f32x4* gr = (const f32x4*)gain + lane;
    f32x4 v[8]; float s = 0.f;
#pragma unroll
    for (int j = 0; j < 8; ++j) { v[j] = xr[64 * j]; s += (v[j].x * v[j].x + v[j].y * v[j].y) + (v[j].z * v[j].z + v[j].w * v[j].w); }
    const float r = rsqrtf(wave_sum(s) * (1.f / DM) + NORM_EPS);
    u32x2* o8 = (u32x2*)orow + lane;
#pragma unroll
    for (int j = 0; j < 8; ++j) { const f32x4 g = gr[64 * j]; u32x2 w; w.x = pk2(v[j].x * r * g.x, v[j].y * r * g.y); w.y = pk2(v[j].z * r * g.z, v[j].w * r * g.w); o8[64 * j] = w; }
}

struct Ptrs {
    const float* in[28]; float* out; unsigned char* ws;
};

__device__ __forceinline__ void phase_prologue(const Ptrs& P, LAS unsigned char* lds, int G) {
    const int tid = threadIdx.x, lane = tid & 63, wave = __builtin_amdgcn_readfirstlane(tid >> 6);
    unsigned char* ws = P.ws;
    {
        const float* wq = P.in[23]; const float* sk = P.in[24]; bf16* WsT = (bf16*)(ws + WS_W_S_T);
        LAS float* wq_l = (LAS float*)lds;
        LAS float* sk_l = wq_l + 64 * 129;
        for (int it = blockIdx.x; it < 512; it += G) {
            const int hc = it >> 5, d0 = (it & 31) * 64;
            __syncthreads();
#pragma unroll
            for (int i = 0; i < 4; ++i) { const int e = tid + 512 * i, dl = e >> 5, j4 = (e & 31) * 4; f32x4 v = *(const f32x4*)(wq + (size_t)(d0 + dl) * 2048 + hc * 128 + j4); v = v * P.in[22][d0 + dl];
#pragma unroll
                for (int c = 0; c < 4; ++c) wq_l[dl * 129 + j4 + c] = v[c]; }
#pragma unroll
            for (int i = 0; i < 8; ++i) { const int e = tid + 512 * i, kk = e >> 5, j4 = (e & 31) * 4; const f32x4 v = *(const f32x4*)(sk + ((size_t)hc * 128 + kk) * 128 + j4);
#pragma unroll
                for (int c = 0; c < 4; ++c) sk_l[kk * 129 + j4 + c] = v[c]; }
            __syncthreads();
            const int kb = wave & 3, db = wave >> 2;
            const LAS float* ap = sk_l + (32 * kb + (lane & 31)) * 129 + (lane >> 5); const LAS float* bp = wq_l + (32 * db + (lane & 31)) * 129 + (lane >> 5);
            f32x16 acc;
#pragma unroll
            for (int i = 0; i < 16; ++i) acc[i] = 0.f;
#pragma unroll 16
            for (int st = 0; st < 64; ++st) acc = __builtin_amdgcn_mfma_f32_32x32x2f32(ap[2 * st], bp[2 * st], acc, 0, 0, 0);
#pragma unroll
            for (int r = 0; r < 16; ++r) { const int key = (r & 3) + 8 * (r >> 2) + 4 * (lane >> 5);
                WsT[(size_t)(hc * 128 + 32 * kb + key) * 2048 + d0 + 32 * db + (lane & 31)] = (bf16)f2bf(acc[r]); }
        }
        __syncthreads();
    }
    {
        const float *lam_re = P.in[5], *lam_im = P.in[6], *b_re = P.in[7], *b_im = P.in[8], *c_re = P.in[9], *c_im = P.in[10], *dd = P.in[11], *log_dt = P.in[12];
        LAS float* pwr = (LAS float*)lds;
        LAS float* bbar = pwr + 17 * 64 * 2;
        LAS float* cc = bbar + 64 * 16 * 2;
        for (int gi = blockIdx.x; gi < 256; gi += G) {
            const int g = gi >> 2, qt = gi & 3;
            __syncthreads();
            if (tid < 64) {
                const int p = tid; const float lre = lam_re[g * 64 + p], lim = lam_im[g * 64 + p], dt = expf(log_dt[g]);
                const float er = expf(lre * dt); float sn, cs; sincosf(lim * dt, &sn, &cs);
                const float lbr = er * cs, lbi = er * sn;
                const float nr = lbr - 1.0f, ni = lbi, den = lre * lre + lim * lim;
                const float fr = (nr * lre + ni * lim) / den, fi = (ni * lre - nr * lim) / den;
#pragma unroll
                for (int h = 0; h < 16; ++h) { const float br = b_re[(g * 64 + p) * 16 + h], bi = b_im[(g * 64 + p) * 16 + h];
                    bbar[(p * 16 + h) * 2] = fr * br - fi * bi; bbar[(p * 16 + h) * 2 + 1] = fr * bi + fi * br; }
                float pr = 1.f, pi = 0.f;
                for (int j = 0; j <= 16; ++j) { pwr[(j * 64 + p) * 2] = pr; pwr[(j * 64 + p) * 2 + 1] = pi; const float t = pr * lbr - pi * lbi; pi = pr * lbi + pi * lbr; pr = t; }
            }
            for (int e = tid; e < 1024; e += NTHREADS) { cc[e * 2] = c_re[g * 1024 + e]; cc[e * 2 + 1] = c_im[g * 1024 + e]; }
            __syncthreads();
            bf16* Win = (bf16*)(ws + WS_S5_WIN) + (size_t)g * 32768; bf16* Wout = (bf16*)(ws + WS_S5_WOUT) + (size_t)g * 32768; bf16* Kt = (bf16*)(ws + WS_S5_K) + (size_t)g * 4096;
            for (int e = qt * 8192 + tid; e < (qt + 1) * 8192; e += NTHREADS) {
                const int m = e >> 8, kk = e & 255, p = m & 63, ri = m >> 6, sg = kk >> 4, hp = kk & 15;
                const float ar = pwr[((15 - sg) * 64 + p) * 2], ai = pwr[((15 - sg) * 64 + p) * 2 + 1], xr = bbar[(p * 16 + hp) * 2], xi = bbar[(p * 16 + hp) * 2 + 1];
                Win[e] = (bf16)f2bf(ri ? (ar * xi + ai * xr) : (ar * xr - ai * xi));
            }
            for (int e = qt * 8192 + tid; e < (qt + 1) * 8192; e += NTHREADS) {
                const int mm = e >> 7, m = e & 127, tau = mm >> 4, h = mm & 15, p = m & 63, ri = m >> 6;
                const float ar = pwr[((tau + 1) * 64 + p) * 2], ai = pwr[((tau + 1) * 64 + p) * 2 + 1], cr = cc[(h * 64 + p) * 2], ci = cc[(h * 64 + p) * 2 + 1];
                Wout[e] = (bf16)f2bf(ri ? -(cr * ai + ci * ar) : (cr * ar - ci * ai));
            }
            for (int e = qt * 1024 + tid; e < (qt + 1) * 1024; e += NTHREADS) {
                const int j = e >> 8, h = (e >> 4) & 15, hp = e & 15; float s = 0.f;
                for (int p = 0; p < 64; ++p) { const float ar = pwr[(j * 64 + p) * 2], ai = pwr[(j * 64 + p) * 2 + 1], cr = cc[(h * 64 + p) * 2], ci = cc[(h * 64 + p) * 2 + 1];
                    const float wr = cr * ar - ci * ai, wi = cr * ai + ci * ar; s += wr * bbar[(p * 16 + hp) * 2] - wi * bbar[(p * 16 + hp) * 2 + 1]; }
                if (j == 0 && h == hp) s += dd[g * 16 + h];
                Kt[e] = (bf16)f2bf(s);
            }
            if (tid < 64 && qt == 0) { float* lamq = (float*)(ws + WS_S5_LAM) + g * 128; lamq[2 * tid] = pwr[(16 * 64 + tid) * 2]; lamq[2 * tid + 1] = pwr[(16 * 64 + tid) * 2 + 1]; }
        }
        __syncthreads();
    }
    {
        const float* rel_bias = P.in[2]; float* bt = (float*)(ws + WS_BIAS_TAB);
        for (int e = blockIdx.x * NTHREADS + tid; e < 2048; e += G * NTHREADS) {
            const int hq = e >> 7, dist = e & 127; int bucket = dist;
            if (dist >= 16) { int lg = 16 + (int)(logf((float)dist / 16.0f) / logf(8.0f) * 16.0f); bucket = lg < 31 ? lg : 31; }
            bt[e] = rel_bias[bucket * 16 + hq];
        }
    }
    {
        LAS float* scr = (LAS float*)(lds + wave * 16384);
        const int gw = blockIdx.x * NWAVES + wave, NGW = G * NWAVES;
        constexpr int I0 = 32 * 80, I1 = 16 * 32, I2 = 32 * 64, I3 = 32 * 16, I4 = 32 * 32, I5 = 8 * 64;
        for (int it = gw; it < I0 + I1 + I2 + I3 + I4 + I5; it += NGW) {
            int r = it;
            if (r < I0) { p0_transpose_item(P.in[4], 2048, 2560, (bf16*)(ws + WS_W_IN_T), scr, r, lane); continue; } r -= I0;
            if (r < I1) { p0_transpose_item(P.in[13], 1024, 1024, (bf16*)(ws + WS_W_GLU_T), scr, r, lane); continue; } r -= I1;
            if (r < I2) { p0_transpose_item(P.in[16], 2048, 2048, (bf16*)(ws + WS_W_OUT_T), scr, r, lane); continue; } r -= I2;
            if (r < I3) { p0_transpose_item(P.in[19], 2048, 512, (bf16*)(ws + WS_W_CQ_T), scr, r, lane, P.in[17]); continue; } r -= I3;
            if (r < I4) { p0_transpose_item(P.in[20], 2048, 1024, (bf16*)(ws + WS_W_CKV_T), scr, r, lane); continue; } r -= I4;
            p0_transpose_item(P.in[21], 512, 2048, (bf16*)(ws + WS_W_CO_T), scr, r, lane);
        }
        {
            f32x4 a[8], b[8];
#pragma unroll
            for (int j = 0; j < 8; ++j) { a[j] = ((const f32x4*)(P.in[0] + (size_t)gw * DM))[lane + 64 * j]; b[j] = ((const f32x4*)(P.in[0] + (size_t)(gw + NGW) * DM))[lane + 64 * j]; }
#pragma unroll 1
            for (int m = gw; m < NTOK; m += 2 * NGW) {
                const int mn = (m + 2 * NGW < NTOK) ? m + 2 * NGW : m;
                f32x4 na[8], nb[8];
#pragma unroll
                for (int j = 0; j < 8; ++j) { na[j] = ((const f32x4*)(P.in[0] + (size_t)mn * DM))[lane + 64 * j]; nb[j] = ((const f32x4*)(P.in[0] + (size_t)(mn + NGW) * DM))[lane + 64 * j]; }
                float s0 = 0.f, s1 = 0.f;
#pragma unroll
                for (int j = 0; j < 8; ++j) { s0 += (a[j].x * a[j].x + a[j].y * a[j].y) + (a[j].z * a[j].z + a[j].w * a[j].w); s1 += (b[j].x * b[j].x + b[j].y * b[j].y) + (b[j].z * b[j].z + b[j].w * b[j].w); }
                const float r0 = rsqrtf(wave_sum(s0) * (1.f / DM) + NORM_EPS), r1 = rsqrtf(wave_sum(s1) * (1.f / DM) + NORM_EPS);
                u32x2* o0 = (u32x2*)((bf16*)(ws + WS_HN) + (size_t)m * DM) + lane; u32x2* o1 = (u32x2*)((bf16*)(ws + WS_HN) + (size_t)(m + NGW) * DM) + lane;
#pragma unroll
                for (int j = 0; j < 8; ++j) { const f32x4 g = ((const f32x4*)P.in[3])[lane + 64 * j];
                    u32x2 w0, w1; w0.x = pk2(a[j].x * r0 * g.x, a[j].y * r0 * g.y); w0.y = pk2(a[j].z * r0 * g.z, a[j].w * r0 * g.w); w1.x = pk2(b[j].x * r1 * g.x, b[j].y * r1 * g.y); w1.y = pk2(b[j].z * r1 * g.z, b[j].w * r1 * g.w);
                    o0[64 * j] = w0; o1[64 * j] = w1; }
#pragma unroll
                for (int j = 0; j < 8; ++j) { a[j] = na[j]; b[j] = nb[j]; }
            }
        }
        for (int m = gw; m < 2048; m += NGW) rms_row_to_bf16(P.in[1] + (size_t)m * DM, P.in[18], (bf16*)(ws + WS_MEM_N) + (size_t)m * DM, lane);
    }
}

__device__ __forceinline__ void peer_quant_rows(const Ptrs& P, LAS unsigned char* lds, int wave, int lane, int first, int step, int r_hi) {
    unsigned char* ws = P.ws; (void)lds; (void)wave;
    if (first >= r_hi) return;
    typedef float v16f_t __attribute__((ext_vector_type(16)));
    const int lo4 = 128 * (lane >> 4) + (lane & 15);
#define PQ_SRC(r) (((r) >> 14) ? P.in[26] : P.in[25]) + (size_t)((r) & 16383) * DM
#define PQ_LOAD(V, r) { const f32x4* s4_ = (const f32x4*)(PQ_SRC(r)) + lo4; _Pragma("unroll") for (int q = 0; q < 8; ++q) V[q] = s4_[16 * q]; }
#define PQ_ROW(V, r) { const int t_ = (r) >> 14, e_ = (r) & 16383; float mx = 0.f; \
        if (t_ == 0) { _Pragma("unroll") for (int q = 0; q < 8; ++q) V[q] = V[q] * ((const f32x4*)P.in[22])[lo4 + 16 * q]; } \
        _Pragma("unroll") for (int q = 0; q < 8; ++q) mx = fmaxf(mx, fmaxf(fmaxf(fabsf(V[q].x), fabsf(V[q].y)), fmaxf(fabsf(V[q].z), fabsf(V[q].w)))); \
        _Pragma("unroll") for (int o = 1; o < 64; o <<= 1) mx = fmaxf(mx, __shfl_xor(mx, o)); \
        const float sc = mx > 0.f ? mx * (1.0f / 7.5f) : 1.0f, inv = 1.0f / sc; \
        v16f_t lo16, hi16; \
        _Pragma("unroll") for (int q = 0; q < 8; ++q) { lo16[2 * q] = V[q].x * inv; hi16[2 * q] = V[q].y * inv; lo16[2 * q + 1] = V[q].z * inv; hi16[2 * q + 1] = V[q].w * inv; } \
        const v6u_t wq = __builtin_amdgcn_cvt_scalef32_2xpk16_fp6_f32(lo16, hi16, 1.0f);        \
        unsigned char* dst = ws + (t_ ? WS_PEER_V : WS_PEER_U) + (size_t)(lane >> 4) * PEER_SLICE_BYTES + (size_t)e_ * PEER_SROW + (lane & 15) * 24; \
        *(u32x2*)(dst) = (u32x2){wq[0], wq[1]}; *(u32x2*)(dst + 8) = (u32x2){wq[2], wq[3]}; *(u32x2*)(dst + 16) = (u32x2){wq[4], wq[5]}; \
        if (lane == 0) ((float*)(ws + WS_PEER_SU))[2 * e_ + t_] = sc;        }
    f32x4 va[8], vb[8];
    { const int r1 = first + step < r_hi ? first + step : first; PQ_LOAD(va, first) PQ_LOAD(vb, r1) }
#pragma unroll 1
    for (int rr = first; rr < r_hi; rr += 2 * step) {
        const bool two = rr + step < r_hi;
        const int n0 = rr + 2 * step < r_hi ? rr + 2 * step : rr, n1 = rr + 3 * step < r_hi ? rr + 3 * step : n0;
        f32x4 na[8], nb[8];
        PQ_LOAD(na, n0) PQ_LOAD(nb, n1)
        PQ_ROW(va, rr)
        if (two) PQ_ROW(vb, rr + step)
#pragma unroll
        for (int q = 0; q < 8; ++q) { va[q] = na[q]; vb[q] = nb[q]; }
    }
#undef PQ_SRC
#undef PQ_LOAD
#undef PQ_ROW
}

__device__ __forceinline__ void phase_norm(const float* h, const float* gain, bf16* hn, int G) {
    const int lane = threadIdx.x & 63, wave = __builtin_amdgcn_readfirstlane(threadIdx.x >> 6);
    for (int m = blockIdx.x * NWAVES + wave; m < NTOK; m += G * NWAVES) rms_row_to_bf16(h + (size_t)m * DM, gain, hn + (size_t)m * DM, lane);
}

__device__ __forceinline__ void phase_s5(const Ptrs& P, LAS unsigned char* lds, int G) {
    const int tid = threadIdx.x, l = tid & 63, w = __builtin_amdgcn_readfirstlane(tid >> 6);
    unsigned char* ws = P.ws;
    const bf16* U = (const bf16*)(ws + WS_U); bf16* Y = (bf16*)(ws + WS_YPRE);
    LAS unsigned char* U_l = lds;
    LAS float* S_l = (LAS float*)(lds + 33792);
    LAS bf16* Xs_l = (LAS bf16*)(lds + 33792 + 33280);
    LAS float* Eseg = (LAS float*)(lds + 33792 + 33280 + 17408);
    LAS float* Gcar = (LAS float*)(lds + 33792 + 33280 + 17408 + 4096);
    const int l15 = l & 15, l4 = l >> 4;
    const int uoff = l15 * 528 + (l >> 5) * 32 + (l4 & 1) * 16;
    for (int it = blockIdx.x; it < 512; it += G) {
        const int b = it >> 6, g = it & 63;
        const bf16* Win = (const bf16*)(ws + WS_S5_WIN) + (size_t)g * 32768; const bf16* Wout = (const bf16*)(ws + WS_S5_WOUT) + (size_t)g * 32768; const bf16* Kt = (const bf16*)(ws + WS_S5_K) + (size_t)g * 4096;
        const float* lamq = (const float*)(ws + WS_S5_LAM) + g * 128;
        const bf16* Ug = U + (size_t)(b * 64 + g) * 65536;
        const int p = tid & 63, seg = tid >> 6;
        const float lqr = lamq[2 * p], lqi = lamq[2 * p + 1];
        float l8r = lqr, l8i = lqi;
#pragma unroll
        for (int i = 0; i < 3; ++i) { const float t = l8r * l8r - l8i * l8i; l8i = 2.f * l8r * l8i; l8r = t; }
        __syncthreads();
        if (tid < 64) { Gcar[2 * tid] = 0.f; Gcar[2 * tid + 1] = 0.f; }
#pragma unroll 1
        for (int ps = 0; ps < 4; ++ps) {
#pragma unroll
            for (int i = 0; i < 4; ++i) { const int e = tid + 512 * i, t = e >> 1;
                *(LAS u32x4*)(U_l + (t >> 4) * 528 + (t & 15) * 32 + (e & 1) * 16) = *(const u32x4*)(Ug + (size_t)ps * 16384 + e * 8); }
            bf16x8 Aw[8];
#pragma unroll
            for (int ks = 0; ks < 8; ++ks) Aw[ks] = *(const bf16x8*)(Win + (16 * w + l15) * 256 + 32 * ks + 8 * l4);
            __syncthreads();
#pragma unroll
            for (int cb = 0; cb < 4; ++cb) {
                f32x4 acc = (f32x4){0.f, 0.f, 0.f, 0.f};
#pragma unroll
                for (int ks = 0; ks < 8; ++ks) { const bf16x8 Bf = *(const LAS bf16x8*)(U_l + cb * 8448 + uoff + 64 * ks); acc = MFMA16(Aw[ks], Bf, acc); }
#pragma unroll
                for (int r = 0; r < 4; ++r) S_l[(16 * w + 4 * l4 + r) * 65 + cb * 16 + l15] = acc[r];
            }
            __syncthreads();
            {
                float er = 0.f, ei = 0.f; const int c0 = seg * 8;
#pragma unroll
                for (int i = 0; i < 8; ++i) { const int c = c0 + i; const float sr = S_l[p * 65 + c], si = S_l[(64 + p) * 65 + c];
                    const float t = lqr * er - lqi * ei + sr; ei = lqr * ei + lqi * er + si; er = t; S_l[p * 65 + c] = er; S_l[(64 + p) * 65 + c] = ei; }
                Eseg[(seg * 64 + p) * 2] = er; Eseg[(seg * 64 + p) * 2 + 1] = ei;
                __syncthreads();
                float gr = Gcar[((ps & 1) * 64 + p) * 2], gi = Gcar[((ps & 1) * 64 + p) * 2 + 1];
                for (int s = 0; s < seg; ++s) { const float t = l8r * gr - l8i * gi + Eseg[(s * 64 + p) * 2]; gi = l8r * gi + l8i * gr + Eseg[(s * 64 + p) * 2 + 1]; gr = t; }
                if (seg == 7) { Gcar[(((ps + 1) & 1) * 64 + p) * 2] = l8r * gr - l8i * gi + er; Gcar[(((ps + 1) & 1) * 64 + p) * 2 + 1] = l8r * gi + l8i * gr + ei; }
                float pr = 1.f, pi = 0.f;
#pragma unroll
                for (int i = 0; i < 8; ++i) { const int c = c0 + i;
                    float xr = pr * gr - pi * gi, xi = pr * gi + pi * gr;
                    if (i > 0) { xr += S_l[p * 65 + c - 1]; xi += S_l[(64 + p) * 65 + c - 1]; }
                    Xs_l[c * 136 + p] = (bf16)f2bf(xr); Xs_l[c * 136 + 64 + p] = (bf16)f2bf(xi);
                    const float t = pr * lqr - pi * lqi; pi = pr * lqi + pi * lqr; pr = t; }
            }
            __syncthreads();
#pragma unroll 1
            for (int tt = 0; tt < 2; ++tt) {
                const int tau = tt ? 15 - w : w;
                bf16x8 Tf[8], Wo[4];
#pragma unroll
                for (int ks = 0; ks < 8; ++ks) { const int lag = tau - (2 * ks + (l >> 5));
                    bf16x8 z = (bf16x8){0, 0, 0, 0, 0, 0, 0, 0};
                    if (lag >= 0) z = *(const bf16x8*)(Kt + (lag * 16 + l15) * 16 + 8 * (l4 & 1));
                    Tf[ks] = z; }
#pragma unroll
                for (int k2 = 0; k2 < 4; ++k2) Wo[k2] = *(const bf16x8*)(Wout + (tau * 16 + l15) * 128 + 32 * k2 + 8 * l4);
#pragma unroll
                for (int cb = 0; cb < 4; ++cb) {
                    f32x4 acc = (f32x4){0.f, 0.f, 0.f, 0.f};
#pragma unroll
                    for (int ks = 0; ks < 8; ++ks) if (2 * ks <= tau) { const bf16x8 Bf = *(const LAS bf16x8*)(U_l + cb * 8448 + uoff + 64 * ks); acc = MFMA16(Tf[ks], Bf, acc); }
#pragma unroll
                    for (int k2 = 0; k2 < 4; ++k2) { const bf16x8 Bx = *(const LAS bf16x8*)(Xs_l + (cb * 16 + l15) * 136 + 32 * k2 + 8 * l4); acc = MFMA16(Wo[k2], Bx, acc); }
                    u32x2 o; o.x = pk2(gelu_tanh(acc[0]), gelu_tanh(acc[1])); o.y = pk2(gelu_tanh(acc[2]), gelu_tanh(acc[3]));
                    const size_t tok = (size_t)b * SEQ + 16 * (ps * 64 + cb * 16 + l15) + tau;
                    *(u32x2*)(Y + tok * 1024 + 16 * g + 4 * l4) = o;
                }
            }
            __syncthreads();
        }
    }
}

template <int D, int NKB, bool SWA>
__device__ __forceinline__ void attn_task(const bf16* qrow, const LAS unsigned char* Kl, int kstrideB, const LAS unsigned char* Vl, int vstrideB, int kb0,
                                          const LAS float* biasr, int qloc, bool first_blk, float sink, float scale, bf16* orow, int l) {
    const int r32 = l & 31, h = l >> 5;
    bf16x8 qf[D / 16];
#pragma unroll
    for (int s = 0; s < D / 16; ++s) qf[s] = *(const bf16x8*)(qrow + 16 * s + 8 * h);
    f32x16 x[NKB];
#pragma unroll
    for (int kbi = 0; kbi < NKB; ++kbi) {
#pragma unroll
        for (int i = 0; i < 16; ++i) x[kbi][i] = 0.f;
#pragma unroll
        for (int s = 0; s < D / 16; ++s) { const bf16x8 a = *(const LAS bf16x8*)(Kl + ((kb0 + kbi) * 32 + r32) * kstrideB + (16 * s + 8 * h) * 2); x[kbi] = MFMA32(a, qf[s], x[kbi]); }
    }
    float m = -INFINITY;
#pragma unroll
    for (int kbi = 0; kbi < NKB; ++kbi)
#pragma unroll
        for (int i = 0; i < 16; ++i) {
            float s = x[kbi][i] * scale;
            if (SWA) { const int kloc = (kb0 + kbi) * 32 + (i & 3) + 8 * (i >> 2) + 4 * h, dist = qloc - kloc;
                const bool valid = (dist >= 0) && (dist < 128) && (!first_blk || kloc >= 128);
                const int dcl = dist < 0 ? 0 : (dist > 127 ? 127 : dist);
                s = valid ? s + biasr[dcl] : -INFINITY; }
            x[kbi][i] = s; m = fmaxf(m, s);
        }
    m = fmaxf(m, __shfl_xor(m, 32)); if (SWA) m = fmaxf(m, sink);
    float sum = 0.f;
    u32 pk[NKB][8];
#pragma unroll
    for (int kbi = 0; kbi < NKB; ++kbi)
#pragma unroll
        for (int i = 0; i < 16; i += 2) { const float e0 = __expf(x[kbi][i] - m), e1 = __expf(x[kbi][i + 1] - m); sum += e0 + e1; pk[kbi][i >> 1] = cvtpk(e0, e1); }
    sum += __shfl_xor(sum, 32); if (SWA) sum += __expf(sink - m);
    const float inv = 1.0f / sum;
    f32x16 o[D / 32];
#pragma unroll
    for (int db = 0; db < D / 32; ++db)
#pragma unroll
        for (int i = 0; i < 16; ++i) o[db][i] = 0.f;
#pragma unroll
    for (int kbi = 0; kbi < NKB; ++kbi)
#pragma unroll
        for (int s2 = 0; s2 < 2; ++s2) {
            u32x4 pw; pw.x = pk[kbi][4 * s2]; pw.y = pk[kbi][4 * s2 + 1]; pw.z = pk[kbi][4 * s2 + 2]; pw.w = pk[kbi][4 * s2 + 3];
            const bf16x8 pb = __builtin_bit_cast(bf16x8, pw);
#pragma unroll
            for (int db = 0; db < D / 32; ++db) {
                const LAS unsigned char* vp = Vl + (db * 32 + r32) * vstrideB + ((kb0 + kbi) * 32 + 16 * s2 + 4 * h) * 2;
                const s16x4 lo = *(const LAS s16x4*)vp, hi = *(const LAS s16x4*)(vp + 16);
                const bf16x8 a = __builtin_shufflevector(lo, hi, 0, 1, 2, 3, 4, 5, 6, 7);
                o[db] = MFMA32(a, pb, o[db]);
            }
        }
#pragma unroll
    for (int db = 0; db < D / 32; ++db)
#pragma unroll
        for (int g4 = 0; g4 < 4; ++g4) { u32x2 wv; wv.x = cvtpk(o[db][4 * g4] * inv, o[db][4 * g4 + 1] * inv); wv.y = cvtpk(o[db][4 * g4 + 2] * inv, o[db][4 * g4 + 3] * inv);
            *(u32x2*)(orow + db * 32 + 8 * g4 + 4 * h) = wv; }
}

__device__ __forceinline__ void phase_swa(const Ptrs& P, LAS unsigned char* lds, int G) {
    const int tid = threadIdx.x, l = tid & 63, w = __builtin_amdgcn_readfirstlane(tid >> 6);
    unsigned char* ws = P.ws;
    const bf16* Qb = (const bf16*)(ws + WS_Q); const bf16* Kb = (const bf16*)(ws + WS_K); const bf16* Vb = (const bf16*)(ws + WS_V); bf16* Ym = (bf16*)(ws + WS_YMIX);
    const float* bt = (const float*)(ws + WS_BIAS_TAB); const float* sinks = P.in[15];
    LAS unsigned char* Kl = lds;
    LAS unsigned char* Vl = lds + 36864;
    LAS float* bias_l = (LAS float*)(lds + 36864 + 33280);
    for (int it = blockIdx.x; it < 1024; it += G) {
        const int g = it & 3, n = (it >> 2) & 31, b = it >> 7;
        __syncthreads();
#pragma unroll
        for (int i = 0; i < 4; ++i) { const int e = tid + 512 * i, key = e >> 3, part = e & 7; const int kpos = n * 128 - 128 + key;
            u32x4 v = (u32x4){0u, 0u, 0u, 0u};
            if (kpos >= 0) v = *(const u32x4*)(Kb + ((size_t)b * SEQ + kpos) * 256 + g * 64 + part * 8);
            *(LAS u32x4*)(Kl + key * 144 + part * 16) = v; }
#pragma unroll
        for (int i = 0; i < 4; ++i) { const int e = tid + 512 * i, key = e & 255, part = e >> 8; const int kpos = n * 128 - 128 + key;
            u32x4 v = (u32x4){0u, 0u, 0u, 0u};
            if (kpos >= 0) v = *(const u32x4*)(Vb + ((size_t)b * SEQ + kpos) * 256 + g * 64 + part * 8);
#pragma unroll
            for (int jj = 0; jj < 8; ++jj) { const unsigned wv = v[jj >> 1]; *(LAS bf16*)(Vl + (part * 8 + jj) * 520 + key * 2) = (bf16)((jj & 1) ? (wv >> 16) : (wv & 0xffffu)); } }
        bias_l[tid] = bt[(4 * g + (tid >> 7)) * 128 + (tid & 127)];
        __syncthreads();
        const int r = w >> 1, hq = 4 * g + r; const float sink = sinks[hq];
#pragma unroll 1
        for (int t = 0; t < 2; ++t) {
            const int qq = 2 * (w & 1) + t, r32 = l & 31;
            const size_t qtok = (size_t)b * SEQ + n * 128 + 32 * qq + r32;
            attn_task<64, 5, true>(Qb + qtok * 1024 + hq * 64, Kl, 144, Vl, 520, qq, bias_l + r * 128, 128 + 32 * qq + r32, n == 0, sink, 0.125f,
                                   Ym + qtok * 2048 + 1024 + hq * 64, l);
        }
    }
}

__device__ __forceinline__ void phase_cross(const Ptrs& P, LAS unsigned char* lds, int G) {
    const int tid = threadIdx.x, l = tid & 63, w = __builtin_amdgcn_readfirstlane(tid >> 6);
    unsigned char* ws = P.ws;
    const bf16* Qc = (const bf16*)(ws + WS_QC); const bf16* KV = (const bf16*)(ws + WS_KV_C); bf16* Oc = (bf16*)(ws + WS_OC);
    LAS unsigned char* Kl = lds;
    LAS unsigned char* Vl = lds + 69632;
    int prev = -1;
    for (int it = blockIdx.x; it < 512; it += G) {
        const int qb = it & 15, hd = (it >> 4) & 3, b = it >> 6;
        if ((it >> 4) != prev) {
            prev = it >> 4;
            __syncthreads();
#pragma unroll
            for (int i = 0; i < 8; ++i) { const int e = tid + 512 * i, key = e >> 4, part = e & 15;
                *(LAS u32x4*)(Kl + key * 272 + part * 16) = *(const u32x4*)(KV + ((size_t)b * 256 + key) * 1024 + hd * 128 + part * 8); }
#pragma unroll
            for (int i = 0; i < 8; ++i) { const int e = tid + 512 * i, key = e & 255, part = e >> 8;
                const u32x4 v = *(const u32x4*)(KV + ((size_t)b * 256 + key) * 1024 + 512 + hd * 128 + part * 8);
#pragma unroll
                for (int jj = 0; jj < 8; ++jj) { const unsigned wv = v[jj >> 1]; *(LAS bf16*)(Vl + (part * 8 + jj) * 520 + key * 2) = (bf16)((jj & 1) ? (wv >> 16) : (wv & 0xffffu)); } }
            __syncthreads();
        }
        const size_t qtok = (size_t)b * SEQ + qb * 256 + 32 * w + (l & 31);
        attn_task<128, 8, false>(Qc + qtok * 512 + hd * 128, Kl, 272, Vl, 520, 0, (const LAS float*)lds, 0, false, 0.f, 0.08838834764831845f, Oc + qtok * 512 + hd * 128, l);
    }
}
__device__ __forceinline__ void topk_wave32(LAS unsigned char* wb, int l, int* TI, float* TG, size_t obase, size_t ostride) {
    const int j = l >> 1, half = l & 1, sw = 2 * (j & 7);
    u32 v[16];
#pragma unroll
    for (int gq = 0; gq < 4; ++gq) {
        u32 t[16];
#pragma unroll
        for (int i4 = 0; i4 < 4; ++i4) { const int i = 4 * gq + i4, ci = 2 * i + half, phys = ci ^ sw; const f32x4 f = *(const LAS f32x4*)(wb + j * 512 + phys * 16);
#pragma unroll
            for (int e = 0; e < 4; ++e) t[4 * i4 + e] = (f2key(f[e]) & ~0x7Fu) | (u32)(127 - (8 * i + 4 * half + e)); }
        sort16_desc(t);
        if (gq == 0) {
#pragma unroll
            for (int i = 0; i < 16; ++i) v[i] = t[i];
        } else merge_top16_desc(v, t);
    }
    LDS_WAIT(); asm volatile("" ::: "memory");
    {
        u32 o[16];
#pragma unroll
        for (int i = 0; i < 16; ++i) o[i] = (u32)__shfl_xor((int)v[i], 1);
        merge_top16_desc(v, o);
    }
    LAS u32* lut = (LAS u32*)wb;
#pragma unroll
    for (int i = 0; i < 16; ++i) lut[l * 16 + i] = v[i];
    float va[16], vb[16];
    {
        const bool c1 = (l >> 1) & 1;
#pragma unroll
        for (int i = 0; i < 16; ++i) { const u32 o = (u32)__shfl_xor((int)v[i], 2); const u32 a = c1 ? o : v[i], b = c1 ? v[i] : o; va[i] = key2f(a & ~0x7Fu); vb[i] = key2f(b & ~0x7Fu); }
    }
#define CAND(i, q) ((f2key(va[i] + vb[q]) & ~0xFFu) | (u32)(255 - (16 * (i) + (q))))
    u32 c[16];
    {
        u32 t[16];
#pragma unroll
        for (int q = 0; q < 16; ++q) c[q] = CAND(0, q);
        sort16_desc(c);
#pragma unroll
        for (int q = 0; q < 8; ++q) t[q] = CAND(1, q);
#pragma unroll
        for (int q = 0; q < 5; ++q) t[8 + q] = CAND(2, q);
        t[13] = CAND(3, 0); t[14] = CAND(3, 1); t[15] = CAND(3, 2);
        sort16_desc(t); merge_top16_desc(c, t);
        t[0] = CAND(3, 3); t[1] = CAND(4, 0); t[2] = CAND(4, 1); t[3] = CAND(4, 2); t[4] = CAND(5, 0); t[5] = CAND(5, 1); t[6] = CAND(6, 0); t[7] = CAND(6, 1);
        t[8] = CAND(7, 0); t[9] = CAND(7, 1); t[10] = CAND(8, 0); t[11] = CAND(9, 0); t[12] = CAND(10, 0); t[13] = CAND(11, 0); t[14] = CAND(12, 0); t[15] = CAND(13, 0);
        sort16_desc(t); merge_top16_desc(c, t);
        insert_top16_desc(c, CAND(14, 0)); insert_top16_desc(c, CAND(15, 0));
    }
#undef CAND
    LDS_WAIT(); asm volatile("" ::: "memory");
    float best[16]; int eidx[16];
    const int la = (l & ~2) * 16, lb = (l | 2) * 16;
#pragma unroll
    for (int r = 0; r < 16; ++r) { const u32 key = c[r]; const int pos = 255 - (int)(key & 0xFFu); best[r] = key2f(key & ~0xFFu);
        const int k0 = 127 - (int)(lut[la + (pos >> 4)] & 0x7Fu), k1 = 127 - (int)(lut[lb + (pos & 15)] & 0x7Fu); eidx[r] = k0 * 128 + k1; }
    float s = 0.f;
#pragma unroll
    for (int r = 0; r < 16; ++r) { best[r] = __expf(best[r] - key2f(c[0] & ~0xFFu)); s += best[r]; }
    const float inv = 1.0f / s;
    if ((l & 3) == 0) {
        const size_t o = obase + (size_t)(l >> 2) * ostride;
#pragma unroll
        for (int r4 = 0; r4 < 4; ++r4) { *(int4*)(TI + o + 4 * r4) = make_int4(eidx[4 * r4], eidx[4 * r4 + 1], eidx[4 * r4 + 2], eidx[4 * r4 + 3]);
            *(f32x4*)(TG + o + 4 * r4) = (f32x4){best[4 * r4] * inv, best[4 * r4 + 1] * inv, best[4 * r4 + 2] * inv, best[4 * r4 + 3] * inv}; }
    }
    LDS_WAIT(); asm volatile("" ::: "memory");
}
struct EpiTopk {
    static constexpr bool PERM = true, AFTER_DRAIN = true;
    const float* PS; int* TI; float* TG;
    __device__ __forceinline__ void fused(const pg8::f32x4 (&acc)[2][2][4][2], const pg8::Unit& u, int wr, int wc, int fr, int fq, LAS unsigned char* lds, int wid, int lane) const {
        const int cb0 = (8 * wc + 2 * fq) ^ (4 * (fr & 3));
        LAS unsigned char* wq0 = lds + (4 * wr) * 16384 + (2 * fr) * 512 + cb0 * 16;
        LAS unsigned char* wq1 = lds + (4 * wr) * 16384 + (2 * fr + 1) * 512 + (cb0 ^ 2) * 16;
#pragma unroll
        for (int ai = 0; ai < 2; ++ai) {
#pragma unroll
            for (int m = 0; m < 4; ++m) { const size_t row = (size_t)(u.pm * 256 + ai * 128 + wr * 64 + m * 16 + fr); const float r = pg8::row_rnorm(PS, row);
#pragma unroll
                for (int n = 0; n < 2; ++n) { *(LAS f32x4*)(wq0 + m * 16384 + n * 16) = acc[ai][0][m][n] * r; *(LAS f32x4*)(wq1 + m * 16384 + n * 16) = acc[ai][1][m][n] * r; } }
            __syncthreads();
            topk_wave32(lds + wid * 16384, lane, TI, TG, ((size_t)(u.pm * 256 + ai * 128 + 16 * wid) * 8 + u.pn) * 16, 128);
            __syncthreads();
        }
    }
};

typedef float f32x2 __attribute__((ext_vector_type(2)));

typedef float v32f_t __attribute__((ext_vector_type(32)));
struct PeerBuf { v6u_t u0, u1, v0, v1; u32x2 sc0, sc1; };
#define PEER_LD6(rs, so) ({ const u32x4 a_ = __builtin_bit_cast(u32x4, __builtin_amdgcn_raw_buffer_load_b128(rs, 16 * l, so, 0)); const u32x2 b_ = __builtin_bit_cast(u32x2, __builtin_amdgcn_raw_buffer_load_b64(rs, 1024 + 8 * l, so, 0)); (v6u_t){a_.x, a_.y, a_.z, a_.w, b_.x, b_.y}; })
template <class RS> __device__ __forceinline__ void peer_issue(PeerBuf& B, const RS& rsU, const RS& rsV, const RS& rsS, int ivA, int ivB, int k0, int l) {
    const int iv = (k0 & 64) ? ivB : ivA;
    const int e0 = __builtin_amdgcn_readlane(iv, (k0 & 63)), e1 = __builtin_amdgcn_readlane(iv, (k0 & 63) + 1);
    B.sc0 = __builtin_bit_cast(u32x2, __builtin_amdgcn_raw_buffer_load_b64(rsS, 0, e0 * 8, 0)); B.sc1 = __builtin_bit_cast(u32x2, __builtin_amdgcn_raw_buffer_load_b64(rsS, 0, e1 * 8, 0));
    B.u0 = PEER_LD6(rsU, e0 * PEER_ROW_BYTES); B.u1 = PEER_LD6(rsU, e1 * PEER_ROW_BYTES); B.v0 = PEER_LD6(rsV, e0 * PEER_ROW_BYTES); B.v1 = PEER_LD6(rsV, e1 * PEER_ROW_BYTES);
}
typedef __bf16 v32bf_t __attribute__((ext_vector_type(32)));
typedef __bf16 bf16x2v __attribute__((ext_vector_type(2)));
__device__ __forceinline__ float peer_dot6(v6u_t w, const u32 (&xp)[16]) { const v32bf_t f = __builtin_amdgcn_cvt_scalef32_pk32_bf16_fp6(w, 1.0f); float s = 0.f;
#define PD2(pp) s = __builtin_amdgcn_fdot2_f32_bf16(__builtin_bit_cast(bf16x2v, xp[pp]), __builtin_shufflevector(f, f, 2 * (pp), 2 * (pp) + 1), s, false);
    PD2(0) PD2(1) PD2(2) PD2(3) PD2(4) PD2(5) PD2(6) PD2(7) PD2(8) PD2(9) PD2(10) PD2(11) PD2(12) PD2(13) PD2(14) PD2(15)
#undef PD2
    return s; }
__device__ __forceinline__ void peer_axpy6(v6u_t w, float c, float (&acc)[32]) { const v32f_t f = __builtin_amdgcn_cvt_scalef32_pk32_f32_fp6(w, 1.0f);
#pragma unroll
    for (int i = 0; i < 32; ++i) acc[i] += c * f[i]; }
__device__ __forceinline__ void peer_axpy6v(v6u_t w, float c, v32f_t& acc) { const v32f_t f = __builtin_amdgcn_cvt_scalef32_pk32_f32_fp6(w, 1.0f); acc = acc + f * c; }
__device__ __forceinline__ void peer_compute(const PeerBuf& B, const u32 (&xr)[16], float (&acc)[32], float rn, int ivA, int ivB, float gvA, float gvB, int k0, int l) {
    const float gv = (k0 & 64) ? gvB : gvA; const int kk = k0 & 63;
    const float d0 = peer_dot6(B.u0, xr); __builtin_amdgcn_sched_barrier(0);
    const float d1 = peer_dot6(B.u1, xr); __builtin_amdgcn_sched_barrier(0);
    const bool o1 = l & 1;
    float t = (o1 ? d1 : d0) + __shfl_xor(o1 ? d0 : d1, 1);
#pragma unroll
    for (int o = 2; o < 64; o <<= 1) t += __shfl_xor(t, o);
    const float g0 = __uint_as_float(__builtin_amdgcn_readlane(__float_as_uint(gv), kk)), g1 = __uint_as_float(__builtin_amdgcn_readlane(__float_as_uint(gv), kk + 1));
    const float su = __uint_as_float(o1 ? B.sc1.x : B.sc0.x), sv = __uint_as_float(o1 ? B.sc1.y : B.sc0.y), gg = o1 ? g1 : g0;
    const float cf = gg * gelu_tanh(t * su * rn) * sv;
    const float c0 = __uint_as_float(__builtin_amdgcn_readlane(__float_as_uint(cf), 0)), c1 = __uint_as_float(__builtin_amdgcn_readlane(__float_as_uint(cf), 1));
    __builtin_amdgcn_sched_barrier(0);
    peer_axpy6(B.v0, c0, acc); __builtin_amdgcn_sched_barrier(0);
    peer_axpy6(B.v1, c1, acc); __builtin_amdgcn_sched_barrier(0);
}
#define XB_TMO      128
#define XB_XCNT(j)  (256  + 64 * (j))
#define XB_XSUB(j)  (1280 + 64 * (j))
#define XB_XGEN(j)  (2304 + 64 * (j))
#define XB_TOP      3328
#define XB_TOPGEN   3392
#define XCD_BAR_WORDS 3456
#define XB_SPIN_CAP (1u << 20)
__device__ __forceinline__ unsigned xb_ld(unsigned* p)              { return __hip_atomic_load(p, __ATOMIC_RELAXED, __HIP_MEMORY_SCOPE_AGENT); }
__device__ __forceinline__ unsigned xb_add(unsigned* p, unsigned v) { return __hip_atomic_fetch_add(p, v, __ATOMIC_RELAXED, __HIP_MEMORY_SCOPE_AGENT); }
__device__ __forceinline__ unsigned xb_xcc_id() { return (unsigned)__builtin_amdgcn_s_getreg((3 << 11) | 20) & 0xFu; }
#define XB_SPIN(cond, bar) do { unsigned _sp = 0; while (cond) { __builtin_amdgcn_s_sleep(1); \
    if ((++_sp & 255u) == 0u) { if (xb_ld(&(bar)[XB_TMO])) break; if (_sp > XB_SPIN_CAP) { atomicAdd(&(bar)[XB_TMO], 1u); break; } } } } while (0)
struct XcdBarrier { unsigned* bar; unsigned x; volatile LAS unsigned* st; };
__device__ __forceinline__ XcdBarrier xcd_barrier_post(unsigned* bar, volatile LAS unsigned* st) {
    XcdBarrier b; b.bar = bar; b.x = xb_xcc_id(); b.st = st;
    if (threadIdx.x == 0) (void)xb_add(&bar[XB_XCNT(b.x)], 1u);
    return b;
}
__device__ __forceinline__ void xcd_barrier_complete(unsigned* bar, unsigned x, unsigned& nloc, unsigned& nx) {
    const unsigned G = gridDim.x * gridDim.y * gridDim.z;
    unsigned sum, cnt, mine, sp = 0u;
    for (;;) {
        sum = 0u; cnt = 0u; mine = 0u;
#pragma unroll
        for (unsigned j = 0; j < 16; ++j) { const unsigned c = xb_ld(&bar[XB_XCNT(j)]); sum += c; cnt += (c > 0u) ? 1u : 0u; mine = (j == x) ? c : mine; }
        if (sum == G) break;
        __builtin_amdgcn_s_sleep(1);
        if ((++sp & 255u) == 0u) { if (xb_ld(&bar[XB_TMO])) break; if (sp > XB_SPIN_CAP) { atomicAdd(&bar[XB_TMO], 1u); break; } }
    }
    nloc = mine > 0u ? mine : 1u; nx = cnt > 0u ? cnt : 1u;
}
__device__ __forceinline__ void xcd_barrier(const XcdBarrier& b) {
    asm volatile("s_waitcnt vmcnt(0)" ::: "memory");
    __syncthreads();
    if (threadIdx.x == 0) {
        unsigned* bar = b.bar;
        __builtin_amdgcn_s_waitcnt(0);
        unsigned nloc = b.st[0], nx = b.st[1];
        if (nloc == 0u) { xcd_barrier_complete(bar, b.x, nloc, nx); b.st[0] = nloc; b.st[1] = nx; }
        const unsigned old = xb_add(&bar[XB_XSUB(b.x)], 1u);
        const unsigned gen = old / nloc;
        if (old + 1u == (gen + 1u) * nloc) {
            __builtin_amdgcn_fence(__ATOMIC_RELEASE, "agent");
            asm volatile("s_waitcnt vmcnt(0)" ::: "memory");
            const unsigned og = xb_add(&bar[XB_TOP], 1u);
            const unsigned tg = og / nx;
            if (og + 1u == (tg + 1u) * nx) xb_add(&bar[XB_TOPGEN], 1u);
            else XB_SPIN(xb_ld(&bar[XB_TOPGEN]) == tg, bar);
            __builtin_amdgcn_fence(__ATOMIC_ACQUIRE, "agent");
            xb_add(&bar[XB_XGEN(b.x)], 1u);
            asm volatile("s_waitcnt vmcnt(0)" ::: "memory");
        } else {
            XB_SPIN(xb_ld(&bar[XB_XGEN(b.x)]) == gen, bar);
            __builtin_amdgcn_fence(__ATOMIC_ACQUIRE, "agent");
            asm volatile("s_waitcnt vmcnt(0)" ::: "memory");
        }
    }
    __syncthreads();
}

struct PeerHalf { v6u_t w0, w1, w2, w3, w4, w5, w6, w7; };
__device__ __forceinline__ void peer_q_ids(int (&el)[8], const int* p  ) {
#pragma unroll
    for (int st = 0; st < 8; ++st) el[st] = p[4 * st];
}
template <class RS> __device__ __forceinline__ void peer_q_issue(PeerHalf& B, const RS& rs, const int (&el)[8], int ch) {
#define PH_LD(st) ({ const int vo_ = el[st] * PEER_SROW + ch * 24; \
        const u32x4 a_ = __builtin_bit_cast(u32x4, __builtin_amdgcn_raw_buffer_load_b128(rs, vo_, 0, 0)); const u32x2 b_ = __builtin_bit_cast(u32x2, __builtin_amdgcn_raw_buffer_load_b64(rs, vo_ + 16, 0, 0)); \
        (v6u_t){a_.x, a_.y, a_.z, a_.w, b_.x, b_.y}; })
    B.w0 = PH_LD(0); B.w1 = PH_LD(1); B.w2 = PH_LD(2); B.w3 = PH_LD(3); B.w4 = PH_LD(4); B.w5 = PH_LD(5); B.w6 = PH_LD(6); B.w7 = PH_LD(7);
#undef PH_LD
}
__device__ __forceinline__ void peer_q_dots(const PeerHalf& B, const u32 (&xs)[16], LAS float* pd  , int ch) {
    float d[8], old[8];
#pragma unroll
    for (int st = 0; st < 8; ++st) old[st] = pd[4 * st];
    d[0] = peer_dot6(B.w0, xs); __builtin_amdgcn_sched_barrier(0); d[1] = peer_dot6(B.w1, xs); __builtin_amdgcn_sched_barrier(0);
    d[2] = peer_dot6(B.w2, xs); __builtin_amdgcn_sched_barrier(0); d[3] = peer_dot6(B.w3, xs); __builtin_amdgcn_sched_barrier(0);
    d[4] = peer_dot6(B.w4, xs); __builtin_amdgcn_sched_barrier(0); d[5] = peer_dot6(B.w5, xs); __builtin_amdgcn_sched_barrier(0);
    d[6] = peer_dot6(B.w6, xs); __builtin_amdgcn_sched_barrier(0); d[7] = peer_dot6(B.w7, xs); __builtin_amdgcn_sched_barrier(0);
#pragma unroll
    for (int o = 1; o < 16; o <<= 1)
#pragma unroll
        for (int st = 0; st < 8; ++st) d[st] += __shfl_xor(d[st], o);
    if (ch == 0) {
#pragma unroll
        for (int st = 0; st < 8; ++st) pd[4 * st] = old[st] + d[st];
    }
}
__device__ __forceinline__ void peer_q_axpy(const PeerHalf& B, const LAS float* pd  , v32f_t& acc) {
    float cf[8];
#pragma unroll
    for (int st = 0; st < 8; ++st) cf[st] = pd[4 * st];
    peer_axpy6v(B.w0, cf[0], acc); __builtin_amdgcn_sched_barrier(0); peer_axpy6v(B.w1, cf[1], acc); __builtin_amdgcn_sched_barrier(0);
    peer_axpy6v(B.w2, cf[2], acc); __builtin_amdgcn_sched_barrier(0); peer_axpy6v(B.w3, cf[3], acc); __builtin_amdgcn_sched_barrier(0);
    peer_axpy6v(B.w4, cf[4], acc); __builtin_amdgcn_sched_barrier(0); peer_axpy6v(B.w5, cf[5], acc); __builtin_amdgcn_sched_barrier(0);
    peer_axpy6v(B.w6, cf[6], acc); __builtin_amdgcn_sched_barrier(0); peer_axpy6v(B.w7, cf[7], acc); __builtin_amdgcn_sched_barrier(0);
}
__device__ __forceinline__ void phase_peer(const Ptrs& P, LAS unsigned char* lds, int G, const XcdBarrier* bar) {
    const int tid = threadIdx.x, l = tid & 63, w = __builtin_amdgcn_readfirstlane(tid >> 6);
    unsigned char* ws = P.ws;
    const bf16* HN = (const bf16*)(ws + WS_HN); const float* SUV = (const float*)(ws + WS_PEER_SU);
    const int* TI = (const int*)(ws + WS_TK_IDX); const float* TG = (const float*)(ws + WS_TK_G); float* out = P.out; const float* gfin = P.in[27]; const float* PS = (const float*)(ws + WS_PS);
    LAS float* PD = (LAS float*)(lds + w * 8192);
    LAS float* SS = (LAS float*)(lds + 65536 + w * 64);
    const int es = l >> 4, ch = l & 15, stride = G * NWAVES, tok0 = blockIdx.x * NWAVES + w;
    (void)bar;
    if (l < 16) SS[l] = 0.f;
#pragma unroll
    for (int q = 0; q < 8; ++q) *(LAS f32x4*)(PD + 4 * l + 256 * q) = (f32x4){0.f, 0.f, 0.f, 0.f};
#pragma unroll 1
    for (int s = 0; s < 4; ++s) {
        const auto rsU = __builtin_amdgcn_make_buffer_rsrc((void*)(ws + WS_PEER_U + (size_t)s * PEER_SLICE_BYTES), 0, (int)PEER_SLICE_BYTES, 0x00020000);
        PeerHalf A, B;
        int elA[8], elB[8];
        u32 xs[16];
#pragma unroll
        for (int q = 0; q < 8; ++q) { const u32x2 a = *(const u32x2*)(HN + (size_t)tok0 * DM + 512 * s + 64 * q + 4 * ch); xs[2 * q] = a.x; xs[2 * q + 1] = a.y; }
        peer_q_ids(elA, TI + (size_t)tok0 * 128 + es); peer_q_ids(elB, TI + (size_t)tok0 * 128 + 32 + es);
        peer_q_issue(A, rsU, elA, ch);
#pragma unroll 1
        for (int i = 0; i < 16; ++i) {
            const size_t tok = (size_t)(tok0 + i * stride), ntok = (size_t)(tok0 + (i < 15 ? i + 1 : i) * stride);
            u32 nxs[16];
#pragma unroll
            for (int q = 0; q < 8; ++q) { const u32x2 a = *(const u32x2*)(HN + ntok * DM + 512 * s + 64 * q + 4 * ch); nxs[2 * q] = a.x; nxs[2 * q + 1] = a.y; }
            peer_q_issue(B, rsU, elB, ch);      peer_q_ids(elA, TI + tok * 128 + 64 + es);   peer_q_dots(A, xs, PD + i * 128 + es, ch);
            peer_q_issue(A, rsU, elA, ch);      peer_q_ids(elB, TI + tok * 128 + 96 + es);   peer_q_dots(B, xs, PD + i * 128 + 32 + es, ch);
            peer_q_issue(B, rsU, elB, ch);      peer_q_ids(elA, TI + ntok * 128 + es);       peer_q_dots(A, xs, PD + i * 128 + 64 + es, ch);
            peer_q_issue(A, rsU, elA, ch);      peer_q_ids(elB, TI + ntok * 128 + 32 + es);  peer_q_dots(B, xs, PD + i * 128 + 96 + es, ch);
#pragma unroll
            for (int q = 0; q < 16; ++q) xs[q] = nxs[q];
        }
    }
#pragma unroll 1
    for (int i = 0; i < 16; ++i) {
        const size_t tok = (size_t)(tok0 + i * stride);
        const float rn = __builtin_amdgcn_rsqf(wave_sum(l < 32 ? PS[tok * 32 + l] : 0.f) * (1.0f / 2048.0f) + NORM_EPS);
#pragma unroll
        for (int hh = 0; hh < 2; ++hh) { const int k = 64 * hh + l; const int e = TI[tok * 128 + k]; const float g = TG[tok * 128 + k]; const f32x2 sc = *(const f32x2*)(SUV + 2 * e);
            PD[i * 128 + k] = g * gelu_tanh(PD[i * 128 + k] * sc.x * rn) * sc.y; }
    }
#pragma unroll 1
    for (int s = 0; s < 4; ++s) {
        const auto rsV = __builtin_amdgcn_make_buffer_rsrc((void*)(ws + WS_PEER_V + (size_t)s * PEER_SLICE_BYTES), 0, (int)PEER_SLICE_BYTES, 0x00020000);
        PeerHalf A, B;
        int elA[8], elB[8];
        peer_q_ids(elA, TI + (size_t)tok0 * 128 + es); peer_q_ids(elB, TI + (size_t)tok0 * 128 + 32 + es);
        peer_q_issue(A, rsV, elA, ch);
#pragma unroll 1
        for (int i = 0; i < 16; ++i) {
            const size_t tok = (size_t)(tok0 + i * stride), ntok = (size_t)(tok0 + (i < 15 ? i + 1 : i) * stride);
            u32x2 hw[8];
#pragma unroll
            for (int q = 0; q < 8; ++q) hw[q] = *(const u32x2*)(HN + tok * DM + 512 * s + 64 * q + 4 * ch);
            v32f_t acc;
#pragma unroll
            for (int c = 0; c < 32; ++c) acc[c] = 0.f;
            peer_q_issue(B, rsV, elB, ch);      peer_q_ids(elA, TI + tok * 128 + 64 + es);   peer_q_axpy(A, PD + i * 128 + es, acc);
            peer_q_issue(A, rsV, elA, ch);      peer_q_ids(elB, TI + tok * 128 + 96 + es);   peer_q_axpy(B, PD + i * 128 + 32 + es, acc);
            peer_q_issue(B, rsV, elB, ch);      peer_q_ids(elA, TI + ntok * 128 + es);       peer_q_axpy(A, PD + i * 128 + 64 + es, acc);
            peer_q_issue(A, rsV, elA, ch);      peer_q_ids(elB, TI + ntok * 128 + 32 + es);  peer_q_axpy(B, PD + i * 128 + 96 + es, acc);
#pragma unroll
            for (int c = 0; c < 32; ++c) { float a = acc[c]; a += __shfl_xor(a, 16); a += __shfl_xor(a, 32); acc[c] = a; }
            float ss = 0.f;
            {
                float* op = out + tok * DM + 512 * s + 4 * ch;
#pragma unroll
                for (int q = 0; q < 8; ++q) {
                    const f32x4 o0 = {acc[4 * q] + bflo(hw[q].x), acc[4 * q + 1] + bfhi(hw[q].x), acc[4 * q + 2] + bflo(hw[q].y), acc[4 * q + 3] + bfhi(hw[q].y)};
                    ss += (o0[0] * o0[0] + o0[1] * o0[1]) + (o0[2] * o0[2] + o0[3] * o0[3]);
                    if (es == 0) *(f32x4*)(op + 64 * q) = o0; }
                if (es != 0) ss = 0.f;
            }
            ss += __shfl_xor(ss, 1); ss += __shfl_xor(ss, 2); ss += __shfl_xor(ss, 4); ss += __shfl_xor(ss, 8);
            if (l == 0) SS[i] += ss;
        }
    }
    asm volatile("s_waitcnt vmcnt(0) lgkmcnt(0)" ::: "memory");
#pragma unroll 1
    for (int i = 0; i < 16; ++i) {
        const size_t tok = (size_t)(tok0 + i * stride);
        const float r = rsqrtf(SS[i] * (1.f / DM) + NORM_EPS);
        f32x4* op = (f32x4*)(out + tok * DM);
#pragma unroll
        for (int j = 0; j < 8; ++j) { const f32x4 ga = ((const f32x4*)gfin)[l + 64 * j]; const f32x4 o = op[l + 64 * j]; op[l + 64 * j] = (f32x4){o.x * r * ga.x, o.y * r * ga.y, o.z * r * ga.z, o.w * r * ga.w}; }
    }
}

struct Params { const float* in[28]; float* out; unsigned char* ws; int ph_lo, ph_hi; };
constexpr int N_PHASES = 13;
#ifndef STOP_AFTER
#define STOP_AFTER 12
#endif

__global__ void __launch_bounds__(NTHREADS, 2) mega(Params prm) {
    extern __shared__ __attribute__((aligned(16))) unsigned char lds_raw[];
    LAS unsigned char* lds = (LAS unsigned char*)lds_raw;
    const int G = gridDim.x;
    Ptrs P;
#pragma unroll
    for (int i = 0; i < 28; ++i) P.in[i] = prm.in[i];
    P.out = prm.out; P.ws = prm.ws;
    unsigned char* ws = prm.ws;
    const int lo = prm.ph_lo, hi = prm.ph_hi;
#ifndef PHMASK
#define PHMASK 0x1fff
#endif
#define IN(k) (((PHMASK >> (k)) & 1) && lo <= (k) && (k) < hi)
#if ONE_LAUNCH
    volatile LAS unsigned* bst = (volatile LAS unsigned*)(lds + LDS_BYTES - 64);
    if (threadIdx.x == 0) { bst[0] = 0u; bst[1] = 0u; }
    __syncthreads();
    const XcdBarrier bar = xcd_barrier_post((unsigned*)(ws + WS_CTL), bst);
#define SEAM(k) do { if (IN(k) && IN((k) + 1)) xcd_barrier(bar); } while (0)
#ifndef PEER_SYNC
#define PEER_SYNC 0
#endif
#define PEER_BAR (PEER_SYNC ? &bar : (const XcdBarrier*)nullptr)
#else
#define SEAM(k) do { } while (0)
#define PEER_BAR ((const XcdBarrier*)nullptr)
#endif
    bf16* HN = (bf16*)(ws + WS_HN);
    if (IN(0)) { phase_prologue(P, lds, G); }
    SEAM(0);
    if (IN(1)) {
        __syncthreads();
        { pg8::Gemm g{HN, (const bf16*)(ws + WS_W_IN_T), NTOK, 2560, 2048}; pg8::StaticOrder S; S.init(NTOK, 2560, G, (int)blockIdx.x);
          pg8::EpiInProj E{(bf16*)(ws + WS_U), (bf16*)(ws + WS_Q), (bf16*)(ws + WS_K), (bf16*)(ws + WS_V)};
          pg8::gemm_phase<pg8::EpiInProj, pg8::StaticOrder, PG8_ALIGN, PG8_SP2>(lds, g, S, E); }
        __syncthreads();
        { pg8::Gemm g{(const bf16*)(ws + WS_MEM_N), (const bf16*)(ws + WS_W_CKV_T), 2048, 1024, 2048}; pg8::StaticOrder S; S.init(2048, 1024, G, (int)blockIdx.x);
          pg8::EpiBf16Plain E{(bf16*)(ws + WS_KV_C), 1024};
          pg8::gemm_phase<pg8::EpiBf16Plain, pg8::StaticOrder, PG8_ALIGN, PG8_SP2>(lds, g, S, E); }
        __syncthreads();
        {
            const int wv = __builtin_amdgcn_readfirstlane(threadIdx.x >> 6), ln = threadIdx.x & 63;
            constexpr int R1 = 32768;
            if (blockIdx.x >= 32) peer_quant_rows(P, lds, wv, ln, ((int)blockIdx.x - 32) * NWAVES + wv, (G - 32) * NWAVES, R1);
            else peer_quant_rows(P, lds, wv, ln, R1 + (int)blockIdx.x * NWAVES + wv, 32 * NWAVES, 32768);
        }
    }
    SEAM(1);
    if (IN(2)) {
#ifndef NO_S5
        __syncthreads(); phase_s5(P, lds, G);
#endif
#ifndef NO_SWA
        __syncthreads(); phase_swa(P, lds, G);
#endif
    }
    SEAM(2);
    if (IN(3)) {
        __syncthreads();
        pg8::Gemm g{(const bf16*)(ws + WS_YPRE), (const bf16*)(ws + WS_W_GLU_T), NTOK, 1024, 1024}; pg8::StaticOrder S; S.init(NTOK, 1024, G, (int)blockIdx.x);
        pg8::EpiGlu E{(bf16*)(ws + WS_YMIX), 2048, (const bf16*)(ws + WS_YPRE), 1024, P.in[14]};
        pg8::gemm_phase<pg8::EpiGlu, pg8::StaticOrder, PG8_ALIGN, PG8_SP2>(lds, g, S, E);
    }
    SEAM(3);
    if (IN(4)) {
        __syncthreads();
        pg8::Gemm g{(const bf16*)(ws + WS_YMIX), (const bf16*)(ws + WS_W_OUT_T), NTOK, 2048, 2048}; pg8::StaticOrder S; S.init(NTOK, 2048, G, (int)blockIdx.x);
        pg8::EpiResBf16<false> E{HN, P.in[0], (float*)(ws + WS_PS)};
        pg8::gemm_phase<pg8::EpiResBf16<false>, pg8::StaticOrder, PG8_ALIGN, PG8_SP2>(lds, g, S, E);
    }
    SEAM(4);
    if (IN(6)) {
        __syncthreads();
        pg8::Gemm g{HN, (const bf16*)(ws + WS_W_CQ_T), NTOK, 512, 2048}; pg8::StaticOrder S; S.init(NTOK, 512, G, (int)blockIdx.x);
        pg8::EpiBf16RowScale E{(bf16*)(ws + WS_QC), 512, (const float*)(ws + WS_PS)};
        pg8::gemm_phase<pg8::EpiBf16RowScale, pg8::StaticOrder, PG8_ALIGN, PG8_SP2>(lds, g, S, E);
    }
    SEAM(6);
    if (IN(7)) { __syncthreads(); phase_cross(P, lds, G); }
    SEAM(7);
    if (IN(8)) {
        __syncthreads();
        pg8::Gemm g{(const bf16*)(ws + WS_OC), (const bf16*)(ws + WS_W_CO_T), NTOK, 2048, 512}; pg8::StaticOrder S; S.init(NTOK, 2048, G, (int)blockIdx.x);
        pg8::EpiResBf16<true> E{HN, HN, (float*)(ws + WS_PS)};
        pg8::gemm_phase<pg8::EpiResBf16<true>, pg8::StaticOrder, PG8_ALIGN, PG8_SP2>(lds, g, S, E);
    }
    SEAM(8);
    if (IN(10)) {
        __syncthreads();
        pg8::Gemm g{HN, (const bf16*)(ws + WS_W_S_T), NTOK, 2048, 2048}; pg8::StaticOrder S; S.init(NTOK, 2048, G, (int)blockIdx.x);
        EpiTopk E{(const float*)(ws + WS_PS), (int*)(ws + WS_TK_IDX), (float*)(ws + WS_TK_G)};
        for (int i = 0; ; ++i) { pg8::Unit uu; if (!S.next(i, uu)) break; pg8::OneUnit O1{uu}; pg8::gemm_phase<EpiTopk, pg8::OneUnit, false, false>(lds, g, O1, E); }
    }
    SEAM(11);
    if (IN(12)) { __syncthreads(); phase_peer(P, lds, G, PEER_BAR); }
    if (lo <= 13 && 13 < hi) {
        const int lane = threadIdx.x & 63, wave = threadIdx.x >> 6;
        for (int m = blockIdx.x * NWAVES + wave; m < NTOK; m += G * NWAVES) {
            f32x4* xr = (f32x4*)(P.out + (size_t)m * DM) + lane; const f32x4* gr = (const f32x4*)P.in[27] + lane;
            f32x4 v[8]; float ss = 0.f;
#pragma unroll
            for (int j = 0; j < 8; ++j) { v[j] = xr[64 * j]; ss += (v[j].x * v[j].x + v[j].y * v[j].y) + (v[j].z * v[j].z + v[j].w * v[j].w); }
            const float r = rsqrtf(wave_sum(ss) * (1.f / DM) + NORM_EPS);
#pragma unroll
            for (int j = 0; j < 8; ++j) { const f32x4 g = gr[64 * j]; xr[64 * j] = (f32x4){v[j].x * r * g.x, v[j].y * r * g.y, v[j].z * r * g.z, v[j].w * r * g.w}; }
        }
    }
}

extern "C" void kernel_launch(void* const* d_in, const int* in_sizes, int n_in, void* d_out, int out_size, void* d_ws, size_t ws_size, hipStream_t stream) {
    static int grid = 0;
    if (!grid) {
        int dev = 0, cus = 0, per_cu = 0;
        if (hipGetDevice(&dev) != hipSuccess || hipDeviceGetAttribute(&cus, hipDeviceAttributeMultiprocessorCount, dev) != hipSuccess) { fprintf(stderr, "kernel_launch: device query failed\n"); return; }
        if (hipFuncSetAttribute((const void*)mega, hipFuncAttributeMaxDynamicSharedMemorySize, LDS_BYTES) != hipSuccess) { fprintf(stderr, "kernel_launch: hipFuncSetAttribute failed\n"); return; }
        if (hipOccupancyMaxActiveBlocksPerMultiprocessor(&per_cu, (const void*)mega, NTHREADS, LDS_BYTES) != hipSuccess || per_cu < 1) { fprintf(stderr, "kernel_launch: occupancy query says %d\n", per_cu); per_cu = 1; }
        grid = 256;
        if (cus != 256) fprintf(stderr, "kernel_launch: built for 256 CUs, device reports %d\n", cus);
        if (ws_size < WS_END || n_in != 28) fprintf(stderr, "kernel_launch: unexpected ws_size %zu / n_in %d\n", ws_size, n_in);
    }
    Params p{};
    for (int i = 0; i < 28; ++i) p.in[i] = (const float*)d_in[i];
    p.out = (float*)d_out; p.ws = (unsigned char*)d_ws;
#if ONE_LAUNCH
    p.ph_lo = 0; p.ph_hi = N_PHASES;
    if (hipMemsetAsync((char*)d_ws + WS_CTL, 0, CTL_ZERO_BYTES, stream) != hipSuccess) { fprintf(stderr, "kernel_launch: memset of the barrier words failed\n"); return; }
    hipLaunchKernelGGL(mega, dim3(grid), dim3(NTHREADS), LDS_BYTES, stream, p);
#else
#ifndef REPEAT_MASK
#define REPEAT_MASK 0
#endif
    for (int ph = 0; ph <= STOP_AFTER; ++ph) { p.ph_lo = ph; p.ph_hi = ph + 1;
        for (int rep = 0; rep < (((REPEAT_MASK >> ph) & 1) ? 2 : 1); ++rep) hipLaunchKernelGGL(mega, dim3(grid), dim3(NTHREADS), LDS_BYTES, stream, p); }
    if (STOP_AFTER < 12) { p.ph_lo = 13; p.ph_hi = 14; hipLaunchKernelGGL(mega, dim3(grid), dim3(NTHREADS), LDS_BYTES, stream, p); }
#endif
}
```

```cpp
#include <hip/hip_runtime.h>
#include <cstdio>
#include <cstdint>
#ifndef ONE_LAUNCH
#define ONE_LAUNCH 1
#endif
#define SN_HD __host__ __device__ __forceinline__
#ifndef SN_HD
#define SN_HD __host__ __device__ __forceinline__
#endif
typedef unsigned int u32;
SN_HD u32 sn_max(u32 a, u32 b) { return a > b ? a : b; }
SN_HD u32 sn_min(u32 a, u32 b) { return a < b ? a : b; }
SN_HD u32 f2key(float f) { u32 u = __builtin_bit_cast(u32, f); return (u & 0x80000000u) ? ~u : (u | 0x80000000u); }
SN_HD float key2f(u32 k) { u32 u = (k & 0x80000000u) ? (k & 0x7fffffffu) : ~k; return __builtin_bit_cast(float, u); }
template <int BASE> SN_HD void bitonic_merge16_desc(u32 (&v)[64]) {
#pragma unroll
    for (int j = 8; j > 0; j >>= 1) {
#pragma unroll
        for (int i = 0; i < 16; ++i) { const int l = i ^ j; if (l > i) { const u32 a = v[BASE + i], b = v[BASE + l]; v[BASE + i] = sn_max(a, b); v[BASE + l] = sn_min(a, b); } }
    }
}
template <int BASE> SN_HD void bitonic_sort16_desc(u32 (&v)[64]) {
#pragma unroll
    for (int k = 2; k <= 16; k <<= 1) {
#pragma unroll
        for (int j = k >> 1; j > 0; j >>= 1) {
#pragma unroll
            for (int i = 0; i < 16; ++i) { const int l = i ^ j; if (l > i) { const u32 a = v[BASE + i], b = v[BASE + l]; const bool desc = ((i & k) == 0);
                v[BASE + i] = desc ? sn_max(a, b) : sn_min(a, b); v[BASE + l] = desc ? sn_min(a, b) : sn_max(a, b); } }
        }
    }
}
template <int A, int B> SN_HD void merge_top16(u32 (&v)[64]) {
#pragma unroll
    for (int i = 0; i < 16; ++i) v[A + i] = sn_max(v[A + i], v[B + 15 - i]);
    bitonic_merge16_desc<A>(v);
}
SN_HD void top16_of_64(u32 (&v)[64]) {
    bitonic_sort16_desc<0>(v); bitonic_sort16_desc<16>(v); bitonic_sort16_desc<32>(v); bitonic_sort16_desc<48>(v);
    merge_top16<0, 16>(v); merge_top16<32, 48>(v); merge_top16<0, 32>(v);
}

SN_HD void merge_sorted16_desc(u32 (&a)[16]) {
#pragma unroll
    for (int j = 8; j > 0; j >>= 1) {
#pragma unroll
        for (int i = 0; i < 16; ++i) { const int l = i ^ j; if (l > i) { const u32 x = a[i], y = a[l]; a[i] = sn_max(x, y); a[l] = sn_min(x, y); } }
    }
}
SN_HD void sort16_desc(u32 (&a)[16]) {
#pragma unroll
    for (int k = 2; k <= 16; k <<= 1) {
#pragma unroll
        for (int j = k >> 1; j > 0; j >>= 1) {
#pragma unroll
            for (int i = 0; i < 16; ++i) { const int l = i ^ j; if (l > i) { const u32 x = a[i], y = a[l]; const bool desc = ((i & k) == 0);
                a[i] = desc ? sn_max(x, y) : sn_min(x, y); a[l] = desc ? sn_min(x, y) : sn_max(x, y); } }
        }
    }
}
SN_HD void merge_top16_desc(u32 (&a)[16], const u32 (&b)[16]) {
#pragma unroll
    for (int i = 0; i < 16; ++i) a[i] = sn_max(a[i], b[15 - i]);
    merge_sorted16_desc(a);
}
SN_HD void insert_top16_desc(u32 (&a)[16], u32 x) {
#pragma unroll
    for (int k = 15; k > 0; --k) a[k] = sn_max(a[k], sn_min(a[k - 1], x));
    a[0] = sn_max(a[0], x);
}
namespace pg8 {
#define PG8_LAS __attribute__((address_space(3)))
typedef unsigned short bf16_t;
typedef short bf16x8 __attribute__((ext_vector_type(8)));
typedef float f32x4 __attribute__((ext_vector_type(4)));
typedef unsigned u32x4 __attribute__((ext_vector_type(4)));
constexpr int BM = 256, BK = 64, HALF = 128, HTB = HALF * BK * 2  , STAGE_BYTES = 8 * HTB, NXCD = 8, WGM = 4;

__host__ __device__ __forceinline__ int lds_byte(int r, int c) { const int st = (r >> 4) * 2 + (c >> 5), rr = r & 15, cc = c & 31, ob = rr * 64 + cc * 2; return st * 1024 + (ob ^ (((ob >> 9) & 1) << 5)); }
__host__ __device__ __forceinline__ void stage_rc(int b, int& R, int& C) { const int st = b / 1024, sb = b % 1024, swz = sb ^ (((sb >> 9) & 1) << 5); R = (st >> 1) * 16 + swz / 64; C = (st & 1) * 32 + (swz % 64) / 2; }
__host__ __device__ __forceinline__ int perm32(int rho) { const int n = rho >> 4, i = rho & 15; return 8 * (i >> 2) + 4 * n + (i & 3); }

struct Unit { int pm, pn; };
struct Gemm { const bf16_t* A; const bf16_t* Bt; int M, N, K; };

struct StaticOrder {
    int nM, nN, nwg, G, c;
    __host__ __device__ void init(int M, int N, int G_, int c_) { nM = M / BM; nN = N / BM; nwg = nM * nN; G = G_; c = c_; }
    __host__ __device__ bool next(int i, Unit& u) const {
        const long L = (long)i * G + c; if (L >= nwg) return false;
        int wgid = (int)L; { const int q = nwg / NXCD, r = nwg % NXCD, xcd = wgid % NXCD, off = wgid / NXCD; wgid = (xcd < r ? xcd * (q + 1) : r * (q + 1) + (xcd - r) * q) + off; }
        const int nig = WGM * nN, gid = wgid / nig, fm = gid * WGM, gsz = (nM - fm) < WGM ? (nM - fm) : WGM;
        u.pm = fm + ((wgid % nig) % gsz); u.pn = (wgid % nig) / gsz; return true;
    }
    __device__ __forceinline__ void a_ready(const Unit&) const {}
    __device__ __forceinline__ void done(const Unit&) const {}
};

typedef float f32x2_t __attribute__((ext_vector_type(2)));
typedef __bf16 bf16x2_t __attribute__((ext_vector_type(2)));
struct OneUnit { Unit u;
    __device__ __forceinline__ bool next(int i, Unit& o) const { if (i) return false; o = u; return true; }
    __device__ __forceinline__ void a_ready(const Unit&) const {}
    __device__ __forceinline__ void done(const Unit&) const {} };

__device__ __forceinline__ unsigned cvt_pk_bf16(float lo, float hi) { const f32x2_t f = {lo, hi}; const bf16x2_t b = __builtin_convertvector(f, bf16x2_t); return __builtin_bit_cast(unsigned, b); }


template <class Epi, class Sched, bool ALIGN_EPI = false, bool SP2 = false>
__device__ __forceinline__ void gemm_phase(PG8_LAS unsigned char* lds, const Gemm g, const Sched& S, const Epi& E) {
    const int tid = threadIdx.x, wid = __builtin_amdgcn_readfirstlane(tid >> 6), lane = tid & 63, wr = wid >> 2, wc = wid & 3, fr = lane & 15, fq = lane >> 4;
    const int K = g.K, nt = K / BK;
    unsigned voffA[2], voffB[2];
#pragma unroll
    for (int i = 0; i < 2; ++i) { int R, C; stage_rc(tid * 16 + i * 8192, R, C); const int Rb = Epi::PERM ? ((R & ~31) + perm32(R & 31)) : R;
        voffA[i] = (unsigned)(R * K + C) * 2u; voffB[i] = (unsigned)(Rb * K + C) * 2u; }
    const size_t kstep = (size_t)(BK * 2);
    const size_t hstep = (size_t)HALF * K * 2;
    const size_t tstep = 2 * hstep;
    const unsigned ldsw = (unsigned)wid * 1024u;
    const int aoff = lds_byte(wr * 64 + fr, fq * 8), boff = lds_byte(wc * 32 + fr, fq * 8);
#define PG8_SA(b, h) (((b) * 2 + (h)) * HTB)
#define PG8_SB(b, h) ((4 + (b) * 2 + (h)) * HTB)
#define PG8_STAGE(bufoff, gbase, voff) do { _Pragma("unroll") for (int _i = 0; _i < 2; ++_i) \
        __builtin_amdgcn_global_load_lds((const unsigned*)((const char*)(gbase) + (voff)[_i]), (PG8_LAS unsigned*)(lds + (bufoff) + ldsw + _i * 8192), 16, 0, 0); } while (0)
#define PG8_LDA(dst, b, h) do { _Pragma("unroll") for (int m = 0; m < 4; ++m) _Pragma("unroll") for (int k = 0; k < 2; ++k) dst[m][k] = *(const PG8_LAS bf16x8*)(lds + PG8_SA(b, h) + aoff + m * 2048 + k * 1024); } while (0)
#define PG8_LDB(dst, b, h) do { _Pragma("unroll") for (int n = 0; n < 2; ++n) _Pragma("unroll") for (int k = 0; k < 2; ++k) dst[n][k] = *(const PG8_LAS bf16x8*)(lds + PG8_SB(b, h) + boff + n * 2048 + k * 1024); } while (0)
#define PG8_MMA(ai, bj, At, Bt) do { __builtin_amdgcn_s_setprio(1); _Pragma("unroll") for (int m = 0; m < 4; ++m) _Pragma("unroll") for (int n = 0; n < 2; ++n) _Pragma("unroll") for (int k = 0; k < 2; ++k) \
        acc[ai][bj][m][n] = __builtin_amdgcn_mfma_f32_16x16x32_bf16(Bt[n][k], At[m][k], acc[ai][bj][m][n], 0, 0, 0); __builtin_amdgcn_s_setprio(0); } while (0)
#define PG8_WAIT_V(n) asm volatile("s_waitcnt vmcnt(" #n ")" ::: "memory")
#define PG8_WAIT_L(n) asm volatile("s_waitcnt lgkmcnt(" #n ")" ::: "memory")
#define PG8_BAR __builtin_amdgcn_s_barrier()
#define PG8_SCHED __builtin_amdgcn_sched_barrier(0)
    Unit cur, nxt; int ui = 0;
    if (!S.next(0, cur)) return;
    f32x4 acc[2][2][4][2];
#pragma unroll
    for (int a = 0; a < 2; ++a)
#pragma unroll
        for (int b = 0; b < 2; ++b)
#pragma unroll
            for (int m = 0; m < 4; ++m)
#pragma unroll
                for (int n = 0; n < 2; ++n) acc[a][b][m][n] = (f32x4){0.f, 0.f, 0.f, 0.f};
    bf16x8 At[4][2], B0[2][2], B1[2][2];
    const char* cA = (const char*)g.A + (size_t)cur.pm * tstep; const char* cB = (const char*)g.Bt + (size_t)cur.pn * tstep;
    S.a_ready(cur);
    if constexpr (SP2) {
        PG8_STAGE(PG8_SB(0, 0), cB, voffB); PG8_STAGE(PG8_SB(0, 1), cB + hstep, voffB); PG8_STAGE(PG8_SA(0, 0), cA, voffA); PG8_STAGE(PG8_SA(0, 1), cA + hstep, voffA);
        if (wr == 1) PG8_BAR;
        PG8_WAIT_V(2); PG8_BAR;
        PG8_STAGE(PG8_SB(1, 0), cB + kstep, voffB); PG8_STAGE(PG8_SA(1, 0), cA + kstep, voffA); PG8_STAGE(PG8_SB(1, 1), cB + hstep + kstep, voffB);
        PG8_WAIT_V(6); PG8_BAR;
    } else {
        PG8_STAGE(PG8_SB(0, 0), cB, voffB); PG8_STAGE(PG8_SA(0, 0), cA, voffA); PG8_STAGE(PG8_SB(0, 1), cB + hstep, voffB); PG8_STAGE(PG8_SA(0, 1), cA + hstep, voffA);
        if (wr == 1) PG8_BAR;
        PG8_WAIT_V(4); PG8_BAR;
        PG8_STAGE(PG8_SB(1, 0), cB + kstep, voffB); PG8_STAGE(PG8_SA(1, 0), cA + kstep, voffA); PG8_STAGE(PG8_SB(1, 1), cB + hstep + kstep, voffB);
        PG8_WAIT_V(6); PG8_BAR;
    }
    for (;;) {
        const bool has_next = S.next(ui + 1, nxt);
        const char* nA = has_next ? (const char*)g.A + (size_t)nxt.pm * tstep : cA; const char* nB = has_next ? (const char*)g.Bt + (size_t)nxt.pn * tstep : cB;
        for (int t = 0; t < nt; t += 2) {
            const bool last = (t == nt - 2);
            const char* a1 = cA + (size_t)(t + 1) * kstep;
            const char* a2 = last ? nA : cA + (size_t)(t + 2) * kstep; const char* b2 = last ? nB : cB + (size_t)(t + 2) * kstep;
            const char* a3 = a2 + kstep; const char* b3 = b2 + kstep;
            if (last && has_next) S.a_ready(nxt);
            if constexpr (SP2) {
            PG8_LDB(B0, 0, 0); PG8_LDB(B1, 0, 1); PG8_SCHED; PG8_LDA(At, 0, 0); PG8_STAGE(PG8_SA(1, 1), a1 + hstep, voffA);
            PG8_WAIT_V(8); PG8_WAIT_L(0); PG8_BAR; PG8_MMA(0, 0, At, B0); PG8_MMA(0, 1, At, B1); PG8_BAR; PG8_SCHED;
            PG8_LDA(At, 0, 1); PG8_STAGE(PG8_SB(0, 0), b2, voffB); PG8_STAGE(PG8_SB(0, 1), b2 + hstep, voffB); PG8_STAGE(PG8_SA(0, 0), a2, voffA);
            PG8_WAIT_V(8); PG8_WAIT_L(0); PG8_BAR; PG8_MMA(1, 0, At, B0); PG8_MMA(1, 1, At, B1); PG8_BAR; PG8_SCHED;
            PG8_LDB(B0, 1, 0); PG8_LDB(B1, 1, 1); PG8_SCHED; PG8_LDA(At, 1, 0); PG8_STAGE(PG8_SA(0, 1), a2 + hstep, voffA);
            PG8_WAIT_V(8); PG8_WAIT_L(0); PG8_BAR; PG8_MMA(0, 0, At, B0); PG8_MMA(0, 1, At, B1); PG8_BAR; PG8_SCHED;
            PG8_LDA(At, 1, 1); PG8_STAGE(PG8_SB(1, 0), b3, voffB); PG8_STAGE(PG8_SB(1, 1), b3 + hstep, voffB); PG8_STAGE(PG8_SA(1, 0), a3, voffA);
            PG8_WAIT_V(8); PG8_WAIT_L(0); PG8_BAR; PG8_MMA(1, 0, At, B0); PG8_MMA(1, 1, At, B1); PG8_BAR; PG8_SCHED;
            } else {
            PG8_LDB(B0, 0, 0); PG8_SCHED; PG8_LDA(At, 0, 0); PG8_STAGE(PG8_SA(1, 1), a1 + hstep, voffA);
            PG8_WAIT_L(8); PG8_BAR; PG8_WAIT_L(0); PG8_MMA(0, 0, At, B0); PG8_BAR; PG8_SCHED;
            PG8_LDB(B1, 0, 1); PG8_STAGE(PG8_SB(0, 0), b2, voffB);
            PG8_BAR; PG8_WAIT_L(0); PG8_MMA(0, 1, At, B1); PG8_BAR;
            PG8_LDA(At, 0, 1); PG8_STAGE(PG8_SA(0, 0), a2, voffA);
            PG8_BAR; PG8_WAIT_L(0); PG8_MMA(1, 0, At, B0); PG8_BAR; PG8_SCHED;
            PG8_STAGE(PG8_SB(0, 1), b2 + hstep, voffB);
            PG8_WAIT_V(6); PG8_BAR; PG8_MMA(1, 1, At, B1); PG8_BAR;
            PG8_LDB(B0, 1, 0); PG8_SCHED; PG8_LDA(At, 1, 0); PG8_STAGE(PG8_SA(0, 1), a2 + hstep, voffA);
            PG8_WAIT_L(8); PG8_BAR; PG8_WAIT_L(0); PG8_MMA(0, 0, At, B0); PG8_BAR; PG8_SCHED;
            PG8_LDB(B1, 1, 1); PG8_STAGE(PG8_SB(1, 0), b3, voffB);
            PG8_BAR; PG8_WAIT_L(0); PG8_MMA(0, 1, At, B1); PG8_BAR;
            PG8_LDA(At, 1, 1); PG8_STAGE(PG8_SA(1, 0), a3, voffA);
            PG8_BAR; PG8_WAIT_L(0); PG8_MMA(1, 0, At, B0); PG8_BAR; PG8_SCHED;
            PG8_STAGE(PG8_SB(1, 1), b3 + hstep, voffB);
            PG8_WAIT_V(6); PG8_BAR; PG8_MMA(1, 1, At, B1); PG8_BAR;
            }
        }
        if constexpr (ALIGN_EPI) { if (wr == 0) PG8_BAR; }
        if constexpr (!Epi::AFTER_DRAIN) { E(acc, cur, wr, wc, fr, fq); S.done(cur); }
        if (!has_next) break;
#pragma unroll
        for (int a = 0; a < 2; ++a)
#pragma unroll
            for (int b = 0; b < 2; ++b)
#pragma unroll
                for (int m = 0; m < 4; ++m)
#pragma unroll
                    for (int n = 0; n < 2; ++n) acc[a][b][m][n] = (f32x4){0.f, 0.f, 0.f, 0.f};
        cur = nxt; cA = nA; cB = nB; ++ui;
        if constexpr (ALIGN_EPI) { if (wr == 1) PG8_BAR; }
    }
    PG8_WAIT_V(0);
    if constexpr (!ALIGN_EPI) { if (wr == 0) PG8_BAR; }
    PG8_BAR;
    if constexpr (Epi::AFTER_DRAIN) { E.fused(acc, cur, wr, wc, fr, fq, lds, wid, lane); S.done(cur); }
#undef PG8_SA
#undef PG8_SB
#undef PG8_STAGE
#undef PG8_LDA
#undef PG8_LDB
#undef PG8_MMA
#undef PG8_WAIT_V
#undef PG8_WAIT_L
#undef PG8_BAR
#undef PG8_SCHED
}

struct EpiInProj {
    static constexpr bool PERM = true, AFTER_DRAIN = false;
    bf16_t *U, *Q, *Kb, *Vb;
    __device__ __forceinline__ void operator()(const f32x4 (&acc)[2][2][4][2], const Unit& u, int wr, int wc, int fr, int fq) const {
        const int row0 = u.pm * BM + wr * 64 + fr;
        if (u.pn < 4) {
            const int col0 = u.pn * BM + wc * 32 + 8 * fq;
#pragma unroll
            for (int ai = 0; ai < 2; ++ai)
#pragma unroll
                for (int m = 0; m < 4; ++m) { const int row = row0 + ai * HALF + m * 16, b = row >> 12, t = row & 4095;
#pragma unroll
                    for (int bj = 0; bj < 2; ++bj) { const int col = col0 + bj * HALF; const f32x4 v0 = acc[ai][bj][m][0], v1 = acc[ai][bj][m][1];
                        u32x4 w; w.x = cvt_pk_bf16(v0[0], v0[1]); w.y = cvt_pk_bf16(v0[2], v0[3]); w.z = cvt_pk_bf16(v1[0], v1[1]); w.w = cvt_pk_bf16(v1[2], v1[3]);
                        *(u32x4*)(U + (((size_t)(b * 64 + (col >> 4)) * 4096 + t) * 16 + (col & 8))) = w; } }
            return;
        }
        bf16_t* base; int ldc, colt;
        if (u.pn < 8) { base = Q; ldc = 1024; colt = (u.pn - 4) * BM; } else if (u.pn == 8) { base = Kb; ldc = 256; colt = 0; } else { base = Vb; ldc = 256; colt = 0; }
        const int col0 = colt + wc * 32 + 8 * fq;
#pragma unroll
        for (int ai = 0; ai < 2; ++ai)
#pragma unroll
            for (int m = 0; m < 4; ++m) { bf16_t* rowp = base + (size_t)(row0 + ai * HALF + m * 16) * ldc + col0;
#pragma unroll
                for (int bj = 0; bj < 2; ++bj) { const f32x4 v0 = acc[ai][bj][m][0], v1 = acc[ai][bj][m][1];
                    u32x4 w; w.x = cvt_pk_bf16(v0[0], v0[1]); w.y = cvt_pk_bf16(v0[2], v0[3]); w.z = cvt_pk_bf16(v1[0], v1[1]); w.w = cvt_pk_bf16(v1[2], v1[3]);
                    *(u32x4*)(rowp + bj * HALF) = w; } }
    }
};
struct EpiBf16Plain {
    static constexpr bool PERM = true, AFTER_DRAIN = false;
    bf16_t* O; int ldc;
    __device__ __forceinline__ void operator()(const f32x4 (&acc)[2][2][4][2], const Unit& u, int wr, int wc, int fr, int fq) const {
        const int row0 = u.pm * BM + wr * 64 + fr, col0 = u.pn * BM + wc * 32 + 8 * fq;
#pragma unroll
        for (int ai = 0; ai < 2; ++ai)
#pragma unroll
            for (int m = 0; m < 4; ++m) { bf16_t* rowp = O + (size_t)(row0 + ai * HALF + m * 16) * ldc + col0;
#pragma unroll
                for (int bj = 0; bj < 2; ++bj) { const f32x4 v0 = acc[ai][bj][m][0], v1 = acc[ai][bj][m][1];
                    u32x4 w; w.x = cvt_pk_bf16(v0[0], v0[1]); w.y = cvt_pk_bf16(v0[2], v0[3]); w.z = cvt_pk_bf16(v1[0], v1[1]); w.w = cvt_pk_bf16(v1[2], v1[3]);
                    *(u32x4*)(rowp + bj * HALF) = w; } }
    }
};
struct EpiGlu {
    static constexpr bool PERM = true, AFTER_DRAIN = false;
    bf16_t* O; int ldo; const bf16_t* Y; int ldy; const float* bias;
    __device__ __forceinline__ void operator()(const f32x4 (&acc)[2][2][4][2], const Unit& u, int wr, int wc, int fr, int fq) const {
        const int row0 = u.pm * BM + wr * 64 + fr, col0 = u.pn * BM + wc * 32 + 8 * fq;
        f32x4 bv[2][2];
#pragma unroll
        for (int bj = 0; bj < 2; ++bj)
#pragma unroll
            for (int n = 0; n < 2; ++n) bv[bj][n] = *(const f32x4*)(bias + col0 + bj * HALF + 4 * n);
#pragma unroll
        for (int ai = 0; ai < 2; ++ai)
#pragma unroll
            for (int m = 0; m < 4; ++m) { const size_t row = (size_t)(row0 + ai * HALF + m * 16);
#pragma unroll
                for (int bj = 0; bj < 2; ++bj) {
                    const u32x4 yw = *(const u32x4*)(Y + row * ldy + col0 + bj * HALF);
                    float o[8];
#pragma unroll
                    for (int e = 0; e < 8; ++e) { const float a = acc[ai][bj][m][e >> 2][e & 3] + bv[bj][e >> 2][e & 3];
                        const unsigned yy = yw[e >> 1]; const float y = __uint_as_float((e & 1) ? (yy & 0xffff0000u) : (yy << 16));
                        o[e] = y / (1.0f + __expf(-a)); }
                    u32x4 w; w.x = cvt_pk_bf16(o[0], o[1]); w.y = cvt_pk_bf16(o[2], o[3]); w.z = cvt_pk_bf16(o[4], o[5]); w.w = cvt_pk_bf16(o[6], o[7]);
                    *(u32x4*)(O + row * ldo + col0 + bj * HALF) = w; } }
    }
};
struct EpiResF32 {
    static constexpr bool PERM = false, AFTER_DRAIN = false;
    float* C; const float* R; int ldc;
    __device__ __forceinline__ void operator()(const f32x4 (&acc)[2][2][4][2], const Unit& u, int wr, int wc, int fr, int fq) const {
        const int row0 = u.pm * BM + wr * 64 + fr, col0 = u.pn * BM + wc * 32 + 4 * fq;
#pragma unroll
        for (int ai = 0; ai < 2; ++ai)
#pragma unroll
            for (int m = 0; m < 4; ++m) { const size_t off = (size_t)(row0 + ai * HALF + m * 16) * ldc + col0;
#pragma unroll
                for (int bj = 0; bj < 2; ++bj)
#pragma unroll
                    for (int n = 0; n < 2; ++n) { f32x4 v = acc[ai][bj][m][n]; if (R) v = v + *(const f32x4*)(R + off + bj * HALF + n * 16); *(f32x4*)(C + off + bj * HALF + n * 16) = v; } }
    }
};
__device__ __forceinline__ float row_rnorm(const float* PS, size_t row) {
    const f32x4* p = (const f32x4*)(PS + row * 32); float s = 0.f;
#pragma unroll
    for (int i = 0; i < 8; ++i) { const f32x4 v = p[i]; s += (v[0] + v[1]) + (v[2] + v[3]); }
    return __builtin_amdgcn_rsqf(s * (1.0f / 2048.0f) + 1e-6f);
}
template <bool RBF16> struct EpiResBf16 {
    static constexpr bool PERM = true, AFTER_DRAIN = false;
    bf16_t* H; const void* R; float* PS;
    __device__ __forceinline__ void operator()(const f32x4 (&acc)[2][2][4][2], const Unit& u, int wr, int wc, int fr, int fq) const {
        const int row0 = u.pm * BM + wr * 64 + fr, col0 = u.pn * BM + wc * 32 + 8 * fq;
#pragma unroll
        for (int ai = 0; ai < 2; ++ai)
#pragma unroll
            for (int m = 0; m < 4; ++m) { const size_t row = (size_t)(row0 + ai * HALF + m * 16), off = row * 2048 + col0; float ss = 0.f;
#pragma unroll
                for (int bj = 0; bj < 2; ++bj) {
                    f32x4 r0, r1;
                    if (RBF16) { const u32x4 rw = *(const u32x4*)((const bf16_t*)R + off + bj * HALF);
                        r0 = (f32x4){__uint_as_float(rw.x << 16), __uint_as_float(rw.x & 0xffff0000u), __uint_as_float(rw.y << 16), __uint_as_float(rw.y & 0xffff0000u)};
                        r1 = (f32x4){__uint_as_float(rw.z << 16), __uint_as_float(rw.z & 0xffff0000u), __uint_as_float(rw.w << 16), __uint_as_float(rw.w & 0xffff0000u)}; }
                    else { r0 = *(const f32x4*)((const float*)R + off + bj * HALF); r1 = *(const f32x4*)((const float*)R + off + bj * HALF + 4); }
                    const f32x4 v0 = acc[ai][bj][m][0] + r0, v1 = acc[ai][bj][m][1] + r1;
                    ss += ((v0[0] * v0[0] + v0[1] * v0[1]) + (v0[2] * v0[2] + v0[3] * v0[3])) + ((v1[0] * v1[0] + v1[1] * v1[1]) + (v1[2] * v1[2] + v1[3] * v1[3]));
                    u32x4 w; w.x = cvt_pk_bf16(v0[0], v0[1]); w.y = cvt_pk_bf16(v0[2], v0[3]); w.z = cvt_pk_bf16(v1[0], v1[1]); w.w = cvt_pk_bf16(v1[2], v1[3]);
                    *(u32x4*)(H + off + bj * HALF) = w; }
                ss += __shfl_xor(ss, 16); ss += __shfl_xor(ss, 32);
                if (fq == 0) PS[row * 32 + u.pn * 4 + wc] = ss; }
    }
};
struct EpiBf16RowScale {
    static constexpr bool PERM = true, AFTER_DRAIN = false;
    bf16_t* O; int ldc; const float* PS;
    __device__ __forceinline__ void operator()(const f32x4 (&acc)[2][2][4][2], const Unit& u, int wr, int wc, int fr, int fq) const {
        const int row0 = u.pm * BM + wr * 64 + fr, col0 = u.pn * BM + wc * 32 + 8 * fq;
#pragma unroll
        for (int ai = 0; ai < 2; ++ai)
#pragma unroll
            for (int m = 0; m < 4; ++m) { const size_t row = (size_t)(row0 + ai * HALF + m * 16); const float r = row_rnorm(PS, row); bf16_t* rowp = O + row * ldc + col0;
#pragma unroll
                for (int bj = 0; bj < 2; ++bj) { const f32x4 v0 = acc[ai][bj][m][0] * r, v1 = acc[ai][bj][m][1] * r;
                    u32x4 w; w.x = cvt_pk_bf16(v0[0], v0[1]); w.y = cvt_pk_bf16(v0[2], v0[3]); w.z = cvt_pk_bf16(v1[0], v1[1]); w.w = cvt_pk_bf16(v1[2], v1[3]);
                    *(u32x4*)(rowp + bj * HALF) = w; } }
    }
};
struct EpiF32RowScale {
    static constexpr bool PERM = true, AFTER_DRAIN = false;
    float* C; int ldc; const float* PS;
    __device__ __forceinline__ void operator()(const f32x4 (&acc)[2][2][4][2], const Unit& u, int wr, int wc, int fr, int fq) const {
        const int row0 = u.pm * BM + wr * 64 + fr, col0 = u.pn * BM + wc * 32 + 8 * fq;
#pragma unroll
        for (int ai = 0; ai < 2; ++ai)
#pragma unroll
            for (int m = 0; m < 4; ++m) { const size_t row = (size_t)(row0 + ai * HALF + m * 16); const float r = row_rnorm(PS, row); const size_t off = row * ldc + col0;
#pragma unroll
                for (int bj = 0; bj < 2; ++bj) { *(f32x4*)(C + off + bj * HALF) = acc[ai][bj][m][0] * r; *(f32x4*)(C + off + bj * HALF + 4) = acc[ai][bj][m][1] * r; } }
    }
};
}

#ifndef PG8_SP2
#define PG8_SP2 false
#endif
#ifndef PG8_ALIGN
#define PG8_ALIGN true
#endif
constexpr int NTOK = 32768, DM = 2048, SEQ = 4096, NB = 8;
constexpr int NWAVES = 8, NTHREADS = 512;
constexpr int LDS_BYTES = 147456;
constexpr float NORM_EPS = 1e-6f;

#define LAS __attribute__((address_space(3)))
typedef unsigned short bf16;
typedef unsigned u32;
typedef short bf16x8 __attribute__((ext_vector_type(8)));
typedef short s16x4 __attribute__((ext_vector_type(4)));
typedef float f32x4 __attribute__((ext_vector_type(4)));
typedef float f32x16 __attribute__((ext_vector_type(16)));
typedef unsigned u32x4 __attribute__((ext_vector_type(4)));
typedef unsigned u32x2 __attribute__((ext_vector_type(2)));

constexpr size_t MiB = 1u << 20;
constexpr size_t WS_CTL = 0, CTL_ZERO_BYTES = 64 * 1024;
constexpr size_t WS_W_IN_T = 1 * MiB, WS_W_GLU_T = 11 * MiB, WS_W_OUT_T = 13 * MiB, WS_W_CQ_T = 21 * MiB, WS_W_CKV_T = 23 * MiB, WS_W_CO_T = 27 * MiB, WS_W_S_T = 29 * MiB;
constexpr size_t WS_S5_WIN = 37 * MiB, WS_S5_WOUT = 41 * MiB, WS_S5_K = 45 * MiB, WS_S5_LAM = 46 * MiB, WS_BIAS_TAB = 46 * MiB + 512 * 1024;
constexpr size_t WS_MEM_N = 47 * MiB, WS_KV_C = 55 * MiB, WS_PS = 59 * MiB;
#ifndef FP6_PACK_INTERLEAVED
#define FP6_PACK_INTERLEAVED 1
#endif
typedef unsigned v6u_t __attribute__((ext_vector_type(6)));
constexpr int PEER_ROW_BYTES = 1536;
constexpr int PEER_SROW = 384;
constexpr size_t PEER_SLICE_BYTES = (size_t)16384 * PEER_SROW;
constexpr size_t WS_PEER_U = 64 * MiB, WS_PEER_V = 96 * MiB;
constexpr size_t WS_PEER_SU = 128 * MiB, WS_PEER_SV = 128 * MiB + 65536;
constexpr size_t WS_HN = 192 * MiB;
constexpr size_t WS_U = 320 * MiB, WS_Q = 384 * MiB, WS_K = 448 * MiB, WS_V = 464 * MiB, WS_YPRE = 480 * MiB, WS_YMIX = 544 * MiB;
constexpr size_t WS_SCORES = 320 * MiB;
constexpr size_t WS_QC = 672 * MiB, WS_OC = 704 * MiB, WS_TK_IDX = 736 * MiB, WS_TK_G = 752 * MiB, WS_END = 768 * MiB;

__device__ __forceinline__ unsigned f2bf(float f) { unsigned u = __float_as_uint(f); return (u + 0x7fffu + ((u >> 16) & 1u)) >> 16; }
__device__ __forceinline__ unsigned pk2(float lo, float hi) { return pg8::cvt_pk_bf16(lo, hi); }
__device__ __forceinline__ unsigned cvtpk(float lo, float hi) { return pg8::cvt_pk_bf16(lo, hi); }
__device__ __forceinline__ float bflo(unsigned w) { return __uint_as_float(w << 16); }
__device__ __forceinline__ float bfhi(unsigned w) { return __uint_as_float(w & 0xffff0000u); }
__device__ __forceinline__ float wave_sum(float v) {
#pragma unroll
    for (int o = 1; o < 64; o <<= 1) v += __shfl_xor(v, o);
    return v;
}
__device__ __forceinline__ float gelu_tanh(float x) { const float z = 0.7978845608028654f * (x + 0.044715f * x * x * x); return x / (1.0f + __expf(-2.0f * z)); }
#define LDS_WAIT() asm volatile("s_waitcnt lgkmcnt(0)" ::: "memory")
#define MFMA16(a, b, c) __builtin_amdgcn_mfma_f32_16x16x32_bf16((a), (b), (c), 0, 0, 0)
#define MFMA32(a, b, c) __builtin_amdgcn_mfma_f32_32x32x16_bf16((a), (b), (c), 0, 0, 0)

__device__ __forceinline__ void p0_transpose_item(const float* W, int K, int N, bf16* WT, LAS float* scr, int item, int lane, const float* kgain = nullptr) {
    const int nblk = N / 32, kb = item / nblk, nb = item % nblk, k0 = 64 * kb, n0 = 32 * nb;
    f32x4 v[8];
#pragma unroll
    for (int i = 0; i < 8; ++i) v[i] = *(const f32x4*)(W + (size_t)(k0 + 8 * i + (lane >> 3)) * N + n0 + 4 * (lane & 7));
#pragma unroll
    for (int i = 0; i < 8; ++i) { const int kk = 8 * i + (lane >> 3); f32x4 x = v[i]; if (kgain) x = x * kgain[k0 + kk];
#pragma unroll
        for (int c = 0; c < 4; ++c) scr[kk * 33 + 4 * (lane & 7) + c] = x[c]; }
    LDS_WAIT(); asm volatile("" ::: "memory");
    const int c = lane & 7;
#pragma unroll
    for (int j = 0; j < 4; ++j) { const int n = (lane >> 3) + 8 * j; const LAS float* s = scr + (8 * c) * 33 + n;
        u32x4 o; o.x = pk2(s[0 * 33], s[1 * 33]); o.y = pk2(s[2 * 33], s[3 * 33]); o.z = pk2(s[4 * 33], s[5 * 33]); o.w = pk2(s[6 * 33], s[7 * 33]);
        *(u32x4*)(WT + (size_t)(n0 + n) * K + k0 + 8 * c) = o; }
    LDS_WAIT(); asm volatile("" ::: "memory");
}
__device__ __forceinline__ void rms_row_to_bf16(const float* xrow, const float* gain, bf16* orow, int lane) {
    const f32x4* xr = (const f32x4*)xrow + lane; const f32x4* gr = (const f32x4*)gain + lane;
    f32x4 v[8]; float s = 0.f;
#pragma unroll
    for (int j = 0; j < 8; ++j) { v[j] = xr[64 * j]; s += (v[j].x * v[j].x + v[j].y * v[j].y) + (v[j].z * v[j].z + v[j].w * v[j].w); }
    const float r = rsqrtf(wave_sum(s) * (1.f / DM) + NORM_EPS);
    u32x2* o8 = (u32x2*)orow + lane;
#pragma unroll
    for (int j = 0; j < 8; ++j) { const f32x4 g = gr[64 * j]; u32x2 w; w.x = pk2(v[j].x * r * g.x, v[j].y * r * g.y); w.y = pk2(v[j].z * r * g.z, v[j].w * r * g.w); o8[64 * j] = w; }
}

struct Ptrs {
    const float* in[28]; float* out; unsigned char* ws;
};

__device__ __forceinline__ void phase_prologue(const Ptrs& P, LAS unsigned char* lds, int G) {
    const int tid = threadIdx.x, lane = tid & 63, wave = __builtin_amdgcn_readfirstlane(tid >> 6);
    unsigned char* ws = P.ws;
    {
        const float* wq = P.in[23]; const float* sk = P.in[24]; bf16* WsT = (bf16*)(ws + WS_W_S_T);
        LAS float* wq_l = (LAS float*)lds;
        LAS float* sk_l = wq_l + 64 * 129;
        for (int it = blockIdx.x; it < 512; it += G) {
            const int hc = it >> 5, d0 = (it & 31) * 64;
            __syncthreads();
#pragma unroll
            for (int i = 0; i < 4; ++i) { const int e = tid + 512 * i, dl = e >> 5, j4 = (e & 31) * 4; f32x4 v = *(const f32x4*)(wq + (size_t)(d0 + dl) * 2048 + hc * 128 + j4); v = v * P.in[22][d0 + dl];
#pragma unroll
                for (int c = 0; c < 4; ++c) wq_l[dl * 129 + j4 + c] = v[c]; }
#pragma unroll
            for (int i = 0; i < 8; ++i) { const int e = tid + 512 * i, kk = e >> 5, j4 = (e & 31) * 4; const f32x4 v = *(const f32x4*)(sk + ((size_t)hc * 128 + kk) * 128 + j4);
#pragma unroll
                for (int c = 0; c < 4; ++c) sk_l[kk * 129 + j4 + c] = v[c]; }
            __syncthreads();
            const int kb = wave & 3, db = wave >> 2;
            const LAS float* ap = sk_l + (32 * kb + (lane & 31)) * 129 + (lane >> 5); const LAS float* bp = wq_l + (32 * db + (lane & 31)) * 129 + (lane >> 5);
            f32x16 acc;
#pragma unroll
            for (int i = 0; i < 16; ++i) acc[i] = 0.f;
#pragma unroll 16
            for (int st = 0; st < 64; ++st) acc = __builtin_amdgcn_mfma_f32_32x32x2f32(ap[2 * st], bp[2 * st], acc, 0, 0, 0);
#pragma unroll
            for (int r = 0; r < 16; ++r) { const int key = (r & 3) + 8 * (r >> 2) + 4 * (lane >> 5);
                WsT[(size_t)(hc * 128 + 32 * kb + key) * 2048 + d0 + 32 * db + (lane & 31)] = (bf16)f2bf(acc[r]); }
        }
        __syncthreads();
    }
    {
        const float *lam_re = P.in[5], *lam_im = P.in[6], *b_re = P.in[7], *b_im = P.in[8], *c_re = P.in[9], *c_im = P.in[10], *dd = P.in[11], *log_dt = P.in[12];
        LAS float* pwr = (LAS float*)lds;
        LAS float* bbar = pwr + 17 * 64 * 2;
        LAS float* cc = bbar + 64 * 16 * 2;
        for (int gi = blockIdx.x; gi < 256; gi += G) {
            const int g = gi >> 2, qt = gi & 3;
            __syncthreads();
            if (tid < 64) {
                const int p = tid; const float lre = lam_re[g * 64 + p], lim = lam_im[g * 64 + p], dt = expf(log_dt[g]);
                const float er = expf(lre * dt); float sn, cs; sincosf(lim * dt, &sn, &cs);
                const float lbr = er * cs, lbi = er * sn;
                const float nr = lbr - 1.0f, ni = lbi, den = lre * lre + lim * lim;
                const float fr = (nr * lre + ni * lim) / den, fi = (ni * lre - nr * lim) / den;
#pragma unroll
                for (int h = 0; h < 16; ++h) { const float br = b_re[(g * 64 + p) * 16 + h], bi = b_im[(g * 64 + p) * 16 + h];
                    bbar[(p * 16 + h) * 2] = fr * br - fi * bi; bbar[(p * 16 + h) * 2 + 1] = fr * bi + fi * br; }
                float pr = 1.f, pi = 0.f;
                for (int j = 0; j <= 16; ++j) { pwr[(j * 64 + p) * 2] = pr; pwr[(j * 64 + p) * 2 + 1] = pi; const float t = pr * lbr - pi * lbi; pi = pr * lbi + pi * lbr; pr = t; }
            }
            for (int e = tid; e < 1024; e += NTHREADS) { cc[e * 2] = c_re[g * 1024 + e]; cc[e * 2 + 1] = c_im[g * 1024 + e]; }
            __syncthreads();
            bf16* Win = (bf16*)(ws + WS_S5_WIN) + (size_t)g * 32768; bf16* Wout = (bf16*)(ws + WS_S5_WOUT) + (size_t)g * 32768; bf16* Kt = (bf16*)(ws + WS_S5_K) + (size_t)g * 4096;
            for (int e = qt * 8192 + tid; e < (qt + 1) * 8192; e += NTHREADS) {
                const int m = e >> 8, kk = e & 255, p = m & 63, ri = m >> 6, sg = kk >> 4, hp = kk & 15;
                const float ar = pwr[((15 - sg) * 64 + p) * 2], ai = pwr[((15 - sg) * 64 + p) * 2 + 1], xr = bbar[(p * 16 + hp) * 2], xi = bbar[(p * 16 + hp) * 2 + 1];
                Win[e] = (bf16)f2bf(ri ? (ar * xi + ai * xr) : (ar * xr - ai * xi));
            }
            for (int e = qt * 8192 + tid; e < (qt + 1) * 8192; e += NTHREADS) {
                const int mm = e >> 7, m = e & 127, tau = mm >> 4, h = mm & 15, p = m & 63, ri = m >> 6;
                const float ar = pwr[((tau + 1) * 64 + p) * 2], ai = pwr[((tau + 1) * 64 + p) * 2 + 1], cr = cc[(h * 64 + p) * 2], ci = cc[(h * 64 + p) * 2 + 1];
                Wout[e] = (bf16)f2bf(ri ? -(cr * ai + ci * ar) : (cr * ar - ci * ai));
            }
            for (int e = qt * 1024 + tid; e < (qt + 1) * 1024; e += NTHREADS) {
                const int j = e >> 8, h = (e >> 4) & 15, hp = e & 15; float s = 0.f;
                for (int p = 0; p < 64; ++p) { const float ar = pwr[(j * 64 + p) * 2], ai = pwr[(j * 64 + p) * 2 + 1], cr = cc[(h * 64 + p) * 2], ci = cc[(h * 64 + p) * 2 + 1];
                    const float wr = cr * ar - ci * ai, wi = cr * ai + ci * ar; s += wr * bbar[(p * 16 + hp) * 2] - wi * bbar[(p * 16 + hp) * 2 + 1]; }
                if (j == 0 && h == hp) s += dd[g * 16 + h];
                Kt[e] = (bf16)f2bf(s);
            }
            if (tid < 64 && qt == 0) { float* lamq = (float*)(ws + WS_S5_LAM) + g * 128; lamq[2 * tid] = pwr[(16 * 64 + tid) * 2]; lamq[2 * tid + 1] = pwr[(16 * 64 + tid) * 2 + 1]; }
        }
        __syncthreads();
    }
    {
        const float* rel_bias = P.in[2]; float* bt = (float*)(ws + WS_BIAS_TAB);
        for (int e = blockIdx.x * NTHREADS + tid; e < 2048; e += G * NTHREADS) {
            const int hq = e >> 7, dist = e & 127; int bucket = dist;
            if (dist >= 16) { int lg = 16 + (int)(logf((float)dist / 16.0f) / logf(8.0f) * 16.0f); bucket = lg < 31 ? lg : 31; }
            bt[e] = rel_bias[bucket * 16 + hq];
        }
    }
    {
        LAS float* scr = (LAS float*)(lds + wave * 16384);
        const int gw = blockIdx.x * NWAVES + wave, NGW = G * NWAVES;
        constexpr int I0 = 32 * 80, I1 = 16 * 32, I2 = 32 * 64, I3 = 32 * 16, I4 = 32 * 32, I5 = 8 * 64;
        for (int it = gw; it < I0 + I1 + I2 + I3 + I4 + I5; it += NGW) {
            int r = it;
            if (r < I0) { p0_transpose_item(P.in[4], 2048, 2560, (bf16*)(ws + WS_W_IN_T), scr, r, lane); continue; } r -= I0;
            if (r < I1) { p0_transpose_item(P.in[13], 1024, 1024, (bf16*)(ws + WS_W_GLU_T), scr, r, lane); continue; } r -= I1;
            if (r < I2) { p0_transpose_item(P.in[16], 2048, 2048, (bf16*)(ws + WS_W_OUT_T), scr, r, lane); continue; } r -= I2;
            if (r < I3) { p0_transpose_item(P.in[19], 2048, 512, (bf16*)(ws + WS_W_CQ_T), scr, r, lane, P.in[17]); continue; } r -= I3;
            if (r < I4) { p0_transpose_item(P.in[20], 2048, 1024, (bf16*)(ws + WS_W_CKV_T), scr, r, lane); continue; } r -= I4;
            p0_transpose_item(P.in[21], 512, 2048, (bf16*)(ws + WS_W_CO_T), scr, r, lane);
        }
        {
            f32x4 a[8], b[8];
#pragma unroll
            for (int j = 0; j < 8; ++j) { a[j] = ((const f32x4*)(P.in[0] + (size_t)gw * DM))[lane + 64 * j]; b[j] = ((const f32x4*)(P.in[0] + (size_t)(gw + NGW) * DM))[lane + 64 * j]; }
#pragma unroll 1
            for (int m = gw; m < NTOK; m += 2 * NGW) {
                const int mn = (m + 2 * NGW < NTOK) ? m + 2 * NGW : m;
                f32x4 na[8], nb[8];
#pragma unroll
                for (int j = 0; j < 8; ++j) { na[j] = ((const f32x4*)(P.in[0] + (size_t)mn * DM))[lane + 64 * j]; nb[j] = ((const f32x4*)(P.in[0] + (size_t)(mn + NGW) * DM))[lane + 64 * j]; }
                float s0 = 0.f, s1 = 0.f;
#pragma unroll
                for (int j = 0; j < 8; ++j) { s0 += (a[j].x * a[j].x + a[j].y * a[j].y) + (a[j].z * a[j].z + a[j].w * a[j].w); s1 += (b[j].x * b[j].x + b[j].y * b[j].y) + (b[j].z * b[j].z + b[j].w * b[j].w); }
                const float r0 = rsqrtf(wave_sum(s0) * (1.f / DM) + NORM_EPS), r1 = rsqrtf(wave_sum(s1) * (1.f / DM) + NORM_EPS);
                u32x2* o0 = (u32x2*)((bf16*)(ws + WS_HN) + (size_t)m * DM) + lane; u32x2* o1 = (u32x2*)((bf16*)(ws + WS_HN) + (size_t)(m + NGW) * DM) + lane;
#pragma unroll
                for (int j = 0; j < 8; ++j) { const f32x4 g = ((const f32x4*)P.in[3])[lane + 64 * j];
                    u32x2 w0, w1; w0.x = pk2(a[j].x * r0 * g.x, a[j].y * r0 * g.y); w0.y = pk2(a[j].z * r0 * g.z, a[j].w * r0 * g.w); w1.x = pk2(b[j].x * r1 * g.x, b[j].y * r1 * g.y); w1.y = pk2(b[j].z * r1 * g.z, b[j].w * r1 * g.w);
                    o0[64 * j] = w0; o1[64 * j] = w1; }
#pragma unroll
                for (int j = 0; j < 8; ++j) { a[j] = na[j]; b[j] = nb[j]; }
            }
        }
        for (int m = gw; m < 2048; m += NGW) rms_row_to_bf16(P.in[1] + (size_t)m * DM, P.in[18], (bf16*)(ws + WS_MEM_N) + (size_t)m * DM, lane);
    }
}

__device__ __forceinline__ void peer_quant_rows(const Ptrs& P, LAS unsigned char* lds, int wave, int lane, int first, int step, int r_hi) {
    unsigned char* ws = P.ws; (void)lds; (void)wave;
    if (first >= r_hi) return;
    typedef float v16f_t __attribute__((ext_vector_type(16)));
    const int lo4 = 128 * (lane >> 4) + (lane & 15);
#define PQ_SRC(r) (((r) >> 14) ? P.in[26] : P.in[25]) + (size_t)((r) & 16383) * DM
#define PQ_LOAD(V, r) { const f32x4* s4_ = (const f32x4*)(PQ_SRC(r)) + lo4; _Pragma("unroll") for (int q = 0; q < 8; ++q) V[q] = s4_[16 * q]; }
#define PQ_ROW(V, r) { const int t_ = (r) >> 14, e_ = (r) & 16383; float mx = 0.f; \
        if (t_ == 0) { _Pragma("unroll") for (int q = 0; q < 8; ++q) V[q] = V[q] * ((const f32x4*)P.in[22])[lo4 + 16 * q]; } \
        _Pragma("unroll") for (int q = 0; q < 8; ++q) mx = fmaxf(mx, fmaxf(fmaxf(fabsf(V[q].x), fabsf(V[q].y)), fmaxf(fabsf(V[q].z), fabsf(V[q].w)))); \
        _Pragma("unroll") for (int o = 1; o < 64; o <<= 1) mx = fmaxf(mx, __shfl_xor(mx, o)); \
        const float sc = mx > 0.f ? mx * (1.0f / 7.5f) : 1.0f, inv = 1.0f / sc; \
        v16f_t lo16, hi16; \
        _Pragma("unroll") for (int q = 0; q < 8; ++q) { lo16[2 * q] = V[q].x * inv; hi16[2 * q] = V[q].y * inv; lo16[2 * q + 1] = V[q].z * inv; hi16[2 * q + 1] = V[q].w * inv; } \
        const v6u_t wq = __builtin_amdgcn_cvt_scalef32_2xpk16_fp6_f32(lo16, hi16, 1.0f);        \
        unsigned char* dst = ws + (t_ ? WS_PEER_V : WS_PEER_U) + (size_t)(lane >> 4) * PEER_SLICE_BYTES + (size_t)e_ * PEER_SROW + (lane & 15) * 24; \
        *(u32x2*)(dst) = (u32x2){wq[0], wq[1]}; *(u32x2*)(dst + 8) = (u32x2){wq[2], wq[3]}; *(u32x2*)(dst + 16) = (u32x2){wq[4], wq[5]}; \
        if (lane == 0) ((float*)(ws + WS_PEER_SU))[2 * e_ + t_] = sc;        }
    f32x4 va[8], vb[8];
    { const int r1 = first + step < r_hi ? first + step : first; PQ_LOAD(va, first) PQ_LOAD(vb, r1) }
#pragma unroll 1
    for (int rr = first; rr < r_hi; rr += 2 * step) {
        const bool two = rr + step < r_hi;
        const int n0 = rr + 2 * step < r_hi ? rr + 2 * step : rr, n1 = rr + 3 * step < r_hi ? rr + 3 * step : n0;
        f32x4 na[8], nb[8];
        PQ_LOAD(na, n0) PQ_LOAD(nb, n1)
        PQ_ROW(va, rr)
        if (two) PQ_ROW(vb, rr + step)
#pragma unroll
        for (int q = 0; q < 8; ++q) { va[q] = na[q]; vb[q] = nb[q]; }
    }
#undef PQ_SRC
#undef PQ_LOAD
#undef PQ_ROW
}

__device__ __forceinline__ void phase_norm(const float* h, const float* gain, bf16* hn, int G) {
    const int lane = threadIdx.x & 63, wave = __builtin_amdgcn_readfirstlane(threadIdx.x >> 6);
    for (int m = blockIdx.x * NWAVES + wave; m < NTOK; m += G * NWAVES) rms_row_to_bf16(h + (size_t)m * DM, gain, hn + (size_t)m * DM, lane);
}

__device__ __forceinline__ void phase_s5(const Ptrs& P, LAS unsigned char* lds, int G) {
    const int tid = threadIdx.x, l = tid & 63, w = __builtin_amdgcn_readfirstlane(tid >> 6);
    unsigned char* ws = P.ws;
    const bf16* U = (const bf16*)(ws + WS_U); bf16* Y = (bf16*)(ws + WS_YPRE);
    LAS unsigned char* U_l = lds;
    LAS float* S_l = (LAS float*)(lds + 33792);
    LAS bf16* Xs_l = (LAS bf16*)(lds + 33792 + 33280);
    LAS float* Eseg = (LAS float*)(lds + 33792 + 33280 + 17408);
    LAS float* Gcar = (LAS float*)(lds + 33792 + 33280 + 17408 + 4096);
    const int l15 = l & 15, l4 = l >> 4;
    const int uoff = l15 * 528 + (l >> 5) * 32 + (l4 & 1) * 16;
    for (int it = blockIdx.x; it < 512; it += G) {
        const int b = it >> 6, g = it & 63;
        const bf16* Win = (const bf16*)(ws + WS_S5_WIN) + (size_t)g * 32768; const bf16* Wout = (const bf16*)(ws + WS_S5_WOUT) + (size_t)g * 32768; const bf16* Kt = (const bf16*)(ws + WS_S5_K) + (size_t)g * 4096;
        const float* lamq = (const float*)(ws + WS_S5_LAM) + g * 128;
        const bf16* Ug = U + (size_t)(b * 64 + g) * 65536;
        const int p = tid & 63, seg = tid >> 6;
        const float lqr = lamq[2 * p], lqi = lamq[2 * p + 1];
        float l8r = lqr, l8i = lqi;
#pragma unroll
        for (int i = 0; i < 3; ++i) { const float t = l8r * l8r - l8i * l8i; l8i = 2.f * l8r * l8i; l8r = t; }
        __syncthreads();
        if (tid < 64) { Gcar[2 * tid] = 0.f; Gcar[2 * tid + 1] = 0.f; }
#pragma unroll 1
        for (int ps = 0; ps < 4; ++ps) {
#pragma unroll
            for (int i = 0; i < 4; ++i) { const int e = tid + 512 * i, t = e >> 1;
                *(LAS u32x4*)(U_l + (t >> 4) * 528 + (t & 15) * 32 + (e & 1) * 16) = *(const u32x4*)(Ug + (size_t)ps * 16384 + e * 8); }
            bf16x8 Aw[8];
#pragma unroll
            for (int ks = 0; ks < 8; ++ks) Aw[ks] = *(const bf16x8*)(Win + (16 * w + l15) * 256 + 32 * ks + 8 * l4);
            __syncthreads();
#pragma unroll
            for (int cb = 0; cb < 4; ++cb) {
                f32x4 acc = (f32x4){0.f, 0.f, 0.f, 0.f};
#pragma unroll
                for (int ks = 0; ks < 8; ++ks) { const bf16x8 Bf = *(const LAS bf16x8*)(U_l + cb * 8448 + uoff + 64 * ks); acc = MFMA16(Aw[ks], Bf, acc); }
#pragma unroll
                for (int r = 0; r < 4; ++r) S_l[(16 * w + 4 * l4 + r) * 65 + cb * 16 + l15] = acc[r];
            }
            __syncthreads();
            {
                float er = 0.f, ei = 0.f; const int c0 = seg * 8;
#pragma unroll
                for (int i = 0; i < 8; ++i) { const int c = c0 + i; const float sr = S_l[p * 65 + c], si = S_l[(64 + p) * 65 + c];
                    const float t = lqr * er - lqi * ei + sr; ei = lqr * ei + lqi * er + si; er = t; S_l[p * 65 + c] = er; S_l[(64 + p) * 65 + c] = ei; }
                Eseg[(seg * 64 + p) * 2] = er; Eseg[(seg * 64 + p) * 2 + 1] = ei;
                __syncthreads();
                float gr = Gcar[((ps & 1) * 64 + p) * 2], gi = Gcar[((ps & 1) * 64 + p) * 2 + 1];
                for (int s = 0; s < seg; ++s) { const float t = l8r * gr - l8i * gi + Eseg[(s * 64 + p) * 2]; gi = l8r * gi + l8i * gr + Eseg[(s * 64 + p) * 2 + 1]; gr = t; }
                if (seg == 7) { Gcar[(((ps + 1) & 1) * 64 + p) * 2] = l8r * gr - l8i * gi + er; Gcar[(((ps + 1) & 1) * 64 + p) * 2 + 1] = l8r * gi + l8i * gr + ei; }
                float pr = 1.f, pi = 0.f;
#pragma unroll
                for (int i = 0; i < 8; ++i) { const int c = c0 + i;
                    float xr = pr * gr - pi * gi, xi = pr * gi + pi * gr;
                    if (i > 0) { xr += S_l[p * 65 + c - 1]; xi += S_l[(64 + p) * 65 + c - 1]; }
                    Xs_l[c * 136 + p] = (bf16)f2bf(xr); Xs_l[c * 136 + 64 + p] = (bf16)f2bf(xi);
                    const float t = pr * lqr - pi * lqi; pi = pr * lqi + pi * lqr; pr = t; }
            }
            __syncthreads();
#pragma unroll 1
            for (int tt = 0; tt < 2; ++tt) {
                const int tau = tt ? 15 - w : w;
                bf16x8 Tf[8], Wo[4];
#pragma unroll
                for (int ks = 0; ks < 8; ++ks) { const int lag = tau - (2 * ks + (l >> 5));
                    bf16x8 z = (bf16x8){0, 0, 0, 0, 0, 0, 0, 0};
                    if (lag >= 0) z = *(const bf16x8*)(Kt + (lag * 16 + l15) * 16 + 8 * (l4 & 1));
                    Tf[ks] = z; }
#pragma unroll
                for (int k2 = 0; k2 < 4; ++k2) Wo[k2] = *(const bf16x8*)(Wout + (tau * 16 + l15) * 128 + 32 * k2 + 8 * l4);
#pragma unroll
                for (int cb = 0; cb < 4; ++cb) {
                    f32x4 acc = (f32x4){0.f, 0.f, 0.f, 0.f};
#pragma unroll
                    for (int ks = 0; ks < 8; ++ks) if (2 * ks <= tau) { const bf16x8 Bf = *(const LAS bf16x8*)(U_l + cb * 8448 + uoff + 64 * ks); acc = MFMA16(Tf[ks], Bf, acc); }
#pragma unroll
                    for (int k2 = 0; k2 < 4; ++k2) { const bf16x8 Bx = *(const LAS bf16x8*)(Xs_l + (cb * 16 + l15) * 136 + 32 * k2 + 8 * l4); acc = MFMA16(Wo[k2], Bx, acc); }
                    u32x2 o; o.x = pk2(gelu_tanh(acc[0]), gelu_tanh(acc[1])); o.y = pk2(gelu_tanh(acc[2]), gelu_tanh(acc[3]));
                    const size_t tok = (size_t)b * SEQ + 16 * (ps * 64 + cb * 16 + l15) + tau;
                    *(u32x2*)(Y + tok * 1024 + 16 * g + 4 * l4) = o;
                }
            }
            __syncthreads();
        }
    }
}

template <int D, int NKB, bool SWA>
__device__ __forceinline__ void attn_task(const bf16* qrow, const LAS unsigned char* Kl, int kstrideB, const LAS unsigned char* Vl, int vstrideB, int kb0,
                                          const LAS float* biasr, int qloc, bool first_blk, float sink, float scale, bf16* orow, int l) {
    const int r32 = l & 31, h = l >> 5;
    bf16x8 qf[D / 16];
#pragma unroll
    for (int s = 0; s < D / 16; ++s) qf[s] = *(const bf16x8*)(qrow + 16 * s + 8 * h);
    f32x16 x[NKB];
#pragma unroll
    for (int kbi = 0; kbi < NKB; ++kbi) {
#pragma unroll
        for (int i = 0; i < 16; ++i) x[kbi][i] = 0.f;
#pragma unroll
        for (int s = 0; s < D / 16; ++s) { const bf16x8 a = *(const LAS bf16x8*)(Kl + ((kb0 + kbi) * 32 + r32) * kstrideB + (16 * s + 8 * h) * 2); x[kbi] = MFMA32(a, qf[s], x[kbi]); }
    }
    float m = -INFINITY;
#pragma unroll
    for (int kbi = 0; kbi < NKB; ++kbi)
#pragma unroll
        for (int i = 0; i < 16; ++i) {
            float s = x[kbi][i] * scale;
            if (SWA) { const int kloc = (kb0 + kbi) * 32 + (i & 3) + 8 * (i >> 2) + 4 * h, dist = qloc - kloc;
                const bool valid = (dist >= 0) && (dist < 128) && (!first_blk || kloc >= 128);
                const int dcl = dist < 0 ? 0 : (dist > 127 ? 127 : dist);
                s = valid ? s + biasr[dcl] : -INFINITY; }
            x[kbi][i] = s; m = fmaxf(m, s);
        }
    m = fmaxf(m, __shfl_xor(m, 32)); if (SWA) m = fmaxf(m, sink);
    float sum = 0.f;
    u32 pk[NKB][8];
#pragma unroll
    for (int kbi = 0; kbi < NKB; ++kbi)
#pragma unroll
        for (int i = 0; i < 16; i += 2) { const float e0 = __expf(x[kbi][i] - m), e1 = __expf(x[kbi][i + 1] - m); sum += e0 + e1; pk[kbi][i >> 1] = cvtpk(e0, e1); }
    sum += __shfl_xor(sum, 32); if (SWA) sum += __expf(sink - m);
    const float inv = 1.0f / sum;
    f32x16 o[D / 32];
#pragma unroll
    for (int db = 0; db < D / 32; ++db)
#pragma unroll
        for (int i = 0; i < 16; ++i) o[db][i] = 0.f;
#pragma unroll
    for (int kbi = 0; kbi < NKB; ++kbi)
#pragma unroll
        for (int s2 = 0; s2 < 2; ++s2) {
            u32x4 pw; pw.x = pk[kbi][4 * s2]; pw.y = pk[kbi][4 * s2 + 1]; pw.z = pk[kbi][4 * s2 + 2]; pw.w = pk[kbi][4 * s2 + 3];
            const bf16x8 pb = __builtin_bit_cast(bf16x8, pw);
#pragma unroll
            for (int db = 0; db < D / 32; ++db) {
                const LAS unsigned char* vp = Vl + (db * 32 + r32) * vstrideB + ((kb0 + kbi) * 32 + 16 * s2 + 4 * h) * 2;
                const s16x4 lo = *(const LAS s16x4*)vp, hi = *(const LAS s16x4*)(vp + 16);
                const bf16x8 a = __builtin_shufflevector(lo, hi, 0, 1, 2, 3, 4, 5, 6, 7);
                o[db] = MFMA32(a, pb, o[db]);
            }
        }
#pragma unroll
    for (int db = 0; db < D / 32; ++db)
#pragma unroll
        for (int g4 = 0; g4 < 4; ++g4) { u32x2 wv; wv.x = cvtpk(o[db][4 * g4] * inv, o[db][4 * g4 + 1] * inv); wv.y = cvtpk(o[db][4 * g4 + 2] * inv, o[db][4 * g4 + 3] * inv);
            *(u32x2*)(orow + db * 32 + 8 * g4 + 4 * h) = wv; }
}

__device__ __forceinline__ void phase_swa(const Ptrs& P, LAS unsigned char* lds, int G) {
    const int tid = threadIdx.x, l = tid & 63, w = __builtin_amdgcn_readfirstlane(tid >> 6);
    unsigned char* ws = P.ws;
    const bf16* Qb = (const bf16*)(ws + WS_Q); const bf16* Kb = (const bf16*)(ws + WS_K); const bf16* Vb = (const bf16*)(ws + WS_V); bf16* Ym = (bf16*)(ws + WS_YMIX);
    const float* bt = (const float*)(ws + WS_BIAS_TAB); const float* sinks = P.in[15];
    LAS unsigned char* Kl = lds;
    LAS unsigned char* Vl = lds + 36864;
    LAS float* bias_l = (LAS float*)(lds + 36864 + 33280);
    for (int it = blockIdx.x; it < 1024; it += G) {
        const int g = it & 3, n = (it >> 2) & 31, b = it >> 7;
        __syncthreads();
#pragma unroll
        for (int i = 0; i < 4; ++i) { const int e = tid + 512 * i, key = e >> 3, part = e & 7; const int kpos = n * 128 - 128 + key;
            u32x4 v = (u32x4){0u, 0u, 0u, 0u};
            if (kpos >= 0) v = *(const u32x4*)(Kb + ((size_t)b * SEQ + kpos) * 256 + g * 64 + part * 8);
            *(LAS u32x4*)(Kl + key * 144 + part * 16) = v; }
#pragma unroll
        for (int i = 0; i < 4; ++i) { const int e = tid + 512 * i, key = e & 255, part = e >> 8; const int kpos = n * 128 - 128 + key;
            u32x4 v = (u32x4){0u, 0u, 0u, 0u};
            if (kpos >= 0) v = *(const u32x4*)(Vb + ((size_t)b * SEQ + kpos) * 256 + g * 64 + part * 8);
#pragma unroll
            for (int jj = 0; jj < 8; ++jj) { const unsigned wv = v[jj >> 1]; *(LAS bf16*)(Vl + (part * 8 + jj) * 520 + key * 2) = (bf16)((jj & 1) ? (wv >> 16) : (wv & 0xffffu)); } }
        bias_l[tid] = bt[(4 * g + (tid >> 7)) * 128 + (tid & 127)];
        __syncthreads();
        const int r = w >> 1, hq = 4 * g + r; const float sink = sinks[hq];
#pragma unroll 1
        for (int t = 0; t < 2; ++t) {
            const int qq = 2 * (w & 1) + t, r32 = l & 31;
            const size_t qtok = (size_t)b * SEQ + n * 128 + 32 * qq + r32;
            attn_task<64, 5, true>(Qb + qtok * 1024 + hq * 64, Kl, 144, Vl, 520, qq, bias_l + r * 128, 128 + 32 * qq + r32, n == 0, sink, 0.125f,
                                   Ym + qtok * 2048 + 1024 + hq * 64, l);
        }
    }
}

__device__ __forceinline__ void phase_cross(const Ptrs& P, LAS unsigned char* lds, int G) {
    const int tid = threadIdx.x, l = tid & 63, w = __builtin_amdgcn_readfirstlane(tid >> 6);
    unsigned char* ws = P.ws;
    const bf16* Qc = (const bf16*)(ws + WS_QC); const bf16* KV = (const bf16*)(ws + WS_KV_C); bf16* Oc = (bf16*)(ws + WS_OC);
    LAS unsigned char* Kl = lds;
    LAS unsigned char* Vl = lds + 69632;
    int prev = -1;
    for (int it = blockIdx.x; it < 512; it += G) {
        const int qb = it & 15, hd = (it >> 4) & 3, b = it >> 6;
        if ((it >> 4) != prev) {
            prev = it >> 4;
            __syncthreads();
#pragma unroll
            for (int i = 0; i < 8; ++i) { const int e = tid + 512 * i, key = e >> 4, part = e & 15;
                *(LAS u32x4*)(Kl + key * 272 + part * 16) = *(const u32x4*)(KV + ((size_t)b * 256 + key) * 1024 + hd * 128 + part * 8); }
#pragma unroll
            for (int i = 0; i < 8; ++i) { const int e = tid + 512 * i, key = e & 255, part = e >> 8;
                const u32x4 v = *(const u32x4*)(KV + ((size_t)b * 256 + key) * 1024 + 512 + hd * 128 + part * 8);
#pragma unroll
                for (int jj = 0; jj < 8; ++jj) { const unsigned wv = v[jj >> 1]; *(LAS bf16*)(Vl + (part * 8 + jj) * 520 + key * 2) = (bf16)((jj & 1) ? (wv >> 16) : (wv & 0xffffu)); } }
            __syncthreads();
        }
        const size_t qtok = (size_t)b * SEQ + qb * 256 + 32 * w + (l & 31);
        attn_task<128, 8, false>(Qc + qtok * 512 + hd * 128, Kl, 272, Vl, 520, 0, (const LAS float*)lds, 0, false, 0.f, 0.08838834764831845f, Oc + qtok * 512 + hd * 128, l);
    }
}
__device__ __forceinline__ void topk_wave32(LAS unsigned char* wb, int l, int* TI, float* TG, size_t obase, size_t ostride) {
    const int j = l >> 1, half = l & 1, sw = 2 * (j & 7);
    u32 v[16];
#pragma unroll
    for (int gq = 0; gq < 4; ++gq) {
        u32 t[16];
#pragma unroll
        for (int i4 = 0; i4 < 4; ++i4) { const int i = 4 * gq + i4, ci = 2 * i + half, phys = ci ^ sw; const f32x4 f = *(const LAS f32x4*)(wb + j * 512 + phys * 16);
#pragma unroll
            for (int e = 0; e < 4; ++e) t[4 * i4 + e] = (f2key(f[e]) & ~0x7Fu) | (u32)(127 - (8 * i + 4 * half + e)); }
        sort16_desc(t);
        if (gq == 0) {
#pragma unroll
            for (int i = 0; i < 16; ++i) v[i] = t[i];
        } else merge_top16_desc(v, t);
    }
    LDS_WAIT(); asm volatile("" ::: "memory");
    {
        u32 o[16];
#pragma unroll
        for (int i = 0; i < 16; ++i) o[i] = (u32)__shfl_xor((int)v[i], 1);
        merge_top16_desc(v, o);
    }
    LAS u32* lut = (LAS u32*)wb;
#pragma unroll
    for (int i = 0; i < 16; ++i) lut[l * 16 + i] = v[i];
    float va[16], vb[16];
    {
        const bool c1 = (l >> 1) & 1;
#pragma unroll
        for (int i = 0; i < 16; ++i) { const u32 o = (u32)__shfl_xor((int)v[i], 2); const u32 a = c1 ? o : v[i], b = c1 ? v[i] : o; va[i] = key2f(a & ~0x7Fu); vb[i] = key2f(b & ~0x7Fu); }
    }
#define CAND(i, q) ((f2key(va[i] + vb[q]) & ~0xFFu) | (u32)(255 - (16 * (i) + (q))))
    u32 c[16];
    {
        u32 t[16];
#pragma unroll
        for (int q = 0; q < 16; ++q) c[q] = CAND(0, q);
        sort16_desc(c);
#pragma unroll
        for (int q = 0; q < 8; ++q) t[q] = CAND(1, q);
#pragma unroll
        for (int q = 0; q < 5; ++q) t[8 + q] = CAND(2, q);
        t[13] = CAND(3, 0); t[14] = CAND(3, 1); t[15] = CAND(3, 2);
        sort16_desc(t); merge_top16_desc(c, t);
        t[0] = CAND(3, 3); t[1] = CAND(4, 0); t[2] = CAND(4, 1); t[3] = CAND(4, 2); t[4] = CAND(5, 0); t[5] = CAND(5, 1); t[6] = CAND(6, 0); t[7] = CAND(6, 1);
        t[8] = CAND(7, 0); t[9] = CAND(7, 1); t[10] = CAND(8, 0); t[11] = CAND(9, 0); t[12] = CAND(10, 0); t[13] = CAND(11, 0); t[14] = CAND(12, 0); t[15] = CAND(13, 0);
        sort16_desc(t); merge_top16_desc(c, t);
        insert_top16_desc(c, CAND(14, 0)); insert_top16_desc(c, CAND(15, 0));
    }
#undef CAND
    LDS_WAIT(); asm volatile("" ::: "memory");
    float best[16]; int eidx[16];
    const int la = (l & ~2) * 16, lb = (l | 2) * 16;
#pragma unroll
    for (int r = 0; r < 16; ++r) { const u32 key = c[r]; const int pos = 255 - (int)(key & 0xFFu); best[r] = key2f(key & ~0xFFu);
        const int k0 = 127 - (int)(lut[la + (pos >> 4)] & 0x7Fu), k1 = 127 - (int)(lut[lb + (pos & 15)] & 0x7Fu); eidx[r] = k0 * 128 + k1; }
    float s = 0.f;
#pragma unroll
    for (int r = 0; r < 16; ++r) { best[r] = __expf(best[r] - key2f(c[0] & ~0xFFu)); s += best[r]; }
    const float inv = 1.0f / s;
    if ((l & 3) == 0) {
        const size_t o = obase + (size_t)(l >> 2) * ostride;
#pragma unroll
        for (int r4 = 0; r4 < 4; ++r4) { *(int4*)(TI + o + 4 * r4) = make_int4(eidx[4 * r4], eidx[4 * r4 + 1], eidx[4 * r4 + 2], eidx[4 * r4 + 3]);
            *(f32x4*)(TG + o + 4 * r4) = (f32x4){best[4 * r4] * inv, best[4 * r4 + 1] * inv, best[4 * r4 + 2] * inv, best[4 * r4 + 3] * inv}; }
    }
    LDS_WAIT(); asm volatile("" ::: "memory");
}
struct EpiTopk {
    static constexpr bool PERM = true, AFTER_DRAIN = true;
    const float* PS; int* TI; float* TG;
    __device__ __forceinline__ void fused(const pg8::f32x4 (&acc)[2][2][4][2], const pg8::Unit& u, int wr, int wc, int fr, int fq, LAS unsigned char* lds, int wid, int lane) const {
        const int cb0 = (8 * wc + 2 * fq) ^ (4 * (fr & 3));
        LAS unsigned char* wq0 = lds + (4 * wr) * 16384 + (2 * fr) * 512 + cb0 * 16;
        LAS unsigned char* wq1 = lds + (4 * wr) * 16384 + (2 * fr + 1) * 512 + (cb0 ^ 2) * 16;
#pragma unroll
        for (int ai = 0; ai < 2; ++ai) {
#pragma unroll
            for (int m = 0; m < 4; ++m) { const size_t row = (size_t)(u.pm * 256 + ai * 128 + wr * 64 + m * 16 + fr); const float r = pg8::row_rnorm(PS, row);
#pragma unroll
                for (int n = 0; n < 2; ++n) { *(LAS f32x4*)(wq0 + m * 16384 + n * 16) = acc[ai][0][m][n] * r; *(LAS f32x4*)(wq1 + m * 16384 + n * 16) = acc[ai][1][m][n] * r; } }
            __syncthreads();
            topk_wave32(lds + wid * 16384, lane, TI, TG, ((size_t)(u.pm * 256 + ai * 128 + 16 * wid) * 8 + u.pn) * 16, 128);
            __syncthreads();
        }
    }
};

typedef float f32x2 __attribute__((ext_vector_type(2)));

typedef float v32f_t __attribute__((ext_vector_type(32)));
struct PeerBuf { v6u_t u0, u1, v0, v1; u32x2 sc0, sc1; };
#define PEER_LD6(rs, so) ({ const u32x4 a_ = __builtin_bit_cast(u32x4, __builtin_amdgcn_raw_buffer_load_b128(rs, 16 * l, so, 0)); const u32x2 b_ = __builtin_bit_cast(u32x2, __builtin_amdgcn_raw_buffer_load_b64(rs, 1024 + 8 * l, so, 0)); (v6u_t){a_.x, a_.y, a_.z, a_.w, b_.x, b_.y}; })
template <class RS> __device__ __forceinline__ void peer_issue(PeerBuf& B, const RS& rsU, const RS& rsV, const RS& rsS, int ivA, int ivB, int k0, int l) {
    const int iv = (k0 & 64) ? ivB : ivA;
    const int e0 = __builtin_amdgcn_readlane(iv, (k0 & 63)), e1 = __builtin_amdgcn_readlane(iv, (k0 & 63) + 1);
    B.sc0 = __builtin_bit_cast(u32x2, __builtin_amdgcn_raw_buffer_load_b64(rsS, 0, e0 * 8, 0)); B.sc1 = __builtin_bit_cast(u32x2, __builtin_amdgcn_raw_buffer_load_b64(rsS, 0, e1 * 8, 0));
    B.u0 = PEER_LD6(rsU, e0 * PEER_ROW_BYTES); B.u1 = PEER_LD6(rsU, e1 * PEER_ROW_BYTES); B.v0 = PEER_LD6(rsV, e0 * PEER_ROW_BYTES); B.v1 = PEER_LD6(rsV, e1 * PEER_ROW_BYTES);
}
typedef __bf16 v32bf_t __attribute__((ext_vector_type(32)));
typedef __bf16 bf16x2v __attribute__((ext_vector_type(2)));
__device__ __forceinline__ float peer_dot6(v6u_t w, const u32 (&xp)[16]) { const v32bf_t f = __builtin_amdgcn_cvt_scalef32_pk32_bf16_fp6(w, 1.0f); float s = 0.f;
#define PD2(pp) s = __builtin_amdgcn_fdot2_f32_bf16(__builtin_bit_cast(bf16x2v, xp[pp]), __builtin_shufflevector(f, f, 2 * (pp), 2 * (pp) + 1), s, false);
    PD2(0) PD2(1) PD2(2) PD2(3) PD2(4) PD2(5) PD2(6) PD2(7) PD2(8) PD2(9) PD2(10) PD2(11) PD2(12) PD2(13) PD2(14) PD2(15)
#undef PD2
    return s; }
__device__ __forceinline__ void peer_axpy6(v6u_t w, float c, float (&acc)[32]) { const v32f_t f = __builtin_amdgcn_cvt_scalef32_pk32_f32_fp6(w, 1.0f);
#pragma unroll
    for (int i = 0; i < 32; ++i) acc[i] += c * f[i]; }
__device__ __forceinline__ void peer_axpy6v(v6u_t w, float c, v32f_t& acc) { const v32f_t f = __builtin_amdgcn_cvt_scalef32_pk32_f32_fp6(w, 1.0f); acc = acc + f * c; }
__device__ __forceinline__ void peer_compute(const PeerBuf& B, const u32 (&xr)[16], float (&acc)[32], float rn, int ivA, int ivB, float gvA, float gvB, int k0, int l) {
    const float gv = (k0 & 64) ? gvB : gvA; const int kk = k0 & 63;
    const float d0 = peer_dot6(B.u0, xr); __builtin_amdgcn_sched_barrier(0);
    const float d1 = peer_dot6(B.u1, xr); __builtin_amdgcn_sched_barrier(0);
    const bool o1 = l & 1;
    float t = (o1 ? d1 : d0) + __shfl_xor(o1 ? d0 : d1, 1);
#pragma unroll
    for (int o = 2; o < 64; o <<= 1) t += __shfl_xor(t, o);
    const float g0 = __uint_as_float(__builtin_amdgcn_readlane(__float_as_uint(gv), kk)), g1 = __uint_as_float(__builtin_amdgcn_readlane(__float_as_uint(gv), kk + 1));
    const float su = __uint_as_float(o1 ? B.sc1.x : B.sc0.x), sv = __uint_as_float(o1 ? B.sc1.y : B.sc0.y), gg = o1 ? g1 : g0;
    const float cf = gg * gelu_tanh(t * su * rn) * sv;
    const float c0 = __uint_as_float(__builtin_amdgcn_readlane(__float_as_uint(cf), 0)), c1 = __uint_as_float(__builtin_amdgcn_readlane(__float_as_uint(cf), 1));
    __builtin_amdgcn_sched_barrier(0);
    peer_axpy6(B.v0, c0, acc); __builtin_amdgcn_sched_barrier(0);
    peer_axpy6(B.v1, c1, acc); __builtin_amdgcn_sched_barrier(0);
}
#define XB_TMO      128
#define XB_XCNT(j)  (256  + 64 * (j))
#define XB_XSUB(j)  (1280 + 64 * (j))
#define XB_XGEN(j)  (2304 + 64 * (j))
#define XB_TOP      3328
#define XB_TOPGEN   3392
#define XCD_BAR_WORDS 3456
#define XB_SPIN_CAP (1u << 20)
__device__ __forceinline__ unsigned xb_ld(unsigned* p)              { return __hip_atomic_load(p, __ATOMIC_RELAXED, __HIP_MEMORY_SCOPE_AGENT); }
__device__ __forceinline__ unsigned xb_add(unsigned* p, unsigned v) { return __hip_atomic_fetch_add(p, v, __ATOMIC_RELAXED, __HIP_MEMORY_SCOPE_AGENT); }
__device__ __forceinline__ unsigned xb_xcc_id() { return (unsigned)__builtin_amdgcn_s_getreg((3 << 11) | 20) & 0xFu; }
#define XB_SPIN(cond, bar) do { unsigned _sp = 0; while (cond) { __builtin_amdgcn_s_sleep(1); \
    if ((++_sp & 255u) == 0u) { if (xb_ld(&(bar)[XB_TMO])) break; if (_sp > XB_SPIN_CAP) { atomicAdd(&(bar)[XB_TMO], 1u); break; } } } } while (0)
struct XcdBarrier { unsigned* bar; unsigned x; volatile LAS unsigned* st; };
__device__ __forceinline__ XcdBarrier xcd_barrier_post(unsigned* bar, volatile LAS unsigned* st) {
    XcdBarrier b; b.bar = bar; b.x = xb_xcc_id(); b.st = st;
    if (threadIdx.x == 0) (void)xb_add(&bar[XB_XCNT(b.x)], 1u);
    return b;
}
__device__ __forceinline__ void xcd_barrier_complete(unsigned* bar, unsigned x, unsigned& nloc, unsigned& nx) {
    const unsigned G = gridDim.x * gridDim.y * gridDim.z;
    unsigned sum, cnt, mine, sp = 0u;
    for (;;) {
        sum = 0u; cnt = 0u; mine = 0u;
#pragma unroll
        for (unsigned j = 0; j < 16; ++j) { const unsigned c = xb_ld(&bar[XB_XCNT(j)]); sum += c; cnt += (c > 0u) ? 1u : 0u; mine = (j == x) ? c : mine; }
        if (sum == G) break;
        __builtin_amdgcn_s_sleep(1);
        if ((++sp & 255u) == 0u) { if (xb_ld(&bar[XB_TMO])) break; if (sp > XB_SPIN_CAP) { atomicAdd(&bar[XB_TMO], 1u); break; } }
    }
    nloc = mine > 0u ? mine : 1u; nx = cnt > 0u ? cnt : 1u;
}
__device__ __forceinline__ void xcd_barrier(const XcdBarrier& b) {
    asm volatile("s_waitcnt vmcnt(0)" ::: "memory");
    __syncthreads();
    if (threadIdx.x == 0) {
        unsigned* bar = b.bar;
        __builtin_amdgcn_s_waitcnt(0);
        unsigned nloc = b.st[0], nx = b.st[1];
        if (nloc == 0u) { xcd_barrier_complete(bar, b.x, nloc, nx); b.st[0] = nloc; b.st[1] = nx; }
        const unsigned old = xb_add(&bar[XB_XSUB(b.x)], 1u);
        const unsigned gen = old / nloc;
        if (old + 1u == (gen + 1u) * nloc) {
            __builtin_amdgcn_fence(__ATOMIC_RELEASE, "agent");
            asm volatile("s_waitcnt vmcnt(0)" ::: "memory");
            const unsigned og = xb_add(&bar[XB_TOP], 1u);
            const unsigned tg = og / nx;
            if (og + 1u == (tg + 1u) * nx) xb_add(&bar[XB_TOPGEN], 1u);
            else XB_SPIN(xb_ld(&bar[XB_TOPGEN]) == tg, bar);
            __builtin_amdgcn_fence(__ATOMIC_ACQUIRE, "agent");
            xb_add(&bar[XB_XGEN(b.x)], 1u);
            asm volatile("s_waitcnt vmcnt(0)" ::: "memory");
        } else {
            XB_SPIN(xb_ld(&bar[XB_XGEN(b.x)]) == gen, bar);
            __builtin_amdgcn_fence(__ATOMIC_ACQUIRE, "agent");
            asm volatile("s_waitcnt vmcnt(0)" ::: "memory");
        }
    }
    __syncthreads();
}

template <int CTRL> __device__ __forceinline__ float dpp_f(float v) { return __int_as_float(__builtin_amdgcn_update_dpp(0, __float_as_int(v), CTRL, 0xF, 0xF, true)); }
__device__ __forceinline__ float row16_reduce8(const float (&d)[8], int ch) {
    const bool b0 = ch & 1, b1 = ch & 2;
    float e[4], f[2];
#pragma unroll
    for (int j = 0; j < 4; ++j) { const float keep = b0 ? d[2 * j + 1] : d[2 * j], give = b0 ? d[2 * j] : d[2 * j + 1]; e[j] = keep + dpp_f<0xB1>(give); }
#pragma unroll
    for (int m = 0; m < 2; ++m) { const float keep = b1 ? e[2 * m + 1] : e[2 * m], give = b1 ? e[2 * m] : e[2 * m + 1]; f[m] = keep + dpp_f<0x4E>(give); }
#pragma unroll
    for (int m = 0; m < 2; ++m) { f[m] += dpp_f<0x128>(f[m]); f[m] += dpp_f<0x124>(f[m]); }
    return (ch & 4) ? f[1] : f[0];
}
struct PeerHalf { v6u_t w0, w1, w2, w3, w4, w5, w6, w7; };
__device__ __forceinline__ void peer_q_ids(int (&el)[8], const int* p  ) {
#pragma unroll
    for (int st = 0; st < 8; ++st) el[st] = p[4 * st];
}
template <class RS> __device__ __forceinline__ void peer_q_issue(PeerHalf& B, const RS& rs, const int (&el)[8], int ch) {
#define PH_LD(st) ({ const int vo_ = el[st] * PEER_SROW + ch * 24; \
        const u32x4 a_ = __builtin_bit_cast(u32x4, __builtin_amdgcn_raw_buffer_load_b128(rs, vo_, 0, 0)); const u32x2 b_ = __builtin_bit_cast(u32x2, __builtin_amdgcn_raw_buffer_load_b64(rs, vo_ + 16, 0, 0)); \
        (v6u_t){a_.x, a_.y, a_.z, a_.w, b_.x, b_.y}; })
    B.w0 = PH_LD(0); B.w1 = PH_LD(1); B.w2 = PH_LD(2); B.w3 = PH_LD(3); B.w4 = PH_LD(4); B.w5 = PH_LD(5); B.w6 = PH_LD(6); B.w7 = PH_LD(7);
#undef PH_LD
}
__device__ __forceinline__ void peer_q_dots(const PeerHalf& B, const u32 (&xs)[16], LAS float* pd  , int ch) {
    float d[8], old[8];
#pragma unroll
    for (int st = 0; st < 8; ++st) old[st] = pd[4 * st];
    d[0] = peer_dot6(B.w0, xs); __builtin_amdgcn_sched_barrier(0); d[1] = peer_dot6(B.w1, xs); __builtin_amdgcn_sched_barrier(0);
    d[2] = peer_dot6(B.w2, xs); __builtin_amdgcn_sched_barrier(0); d[3] = peer_dot6(B.w3, xs); __builtin_amdgcn_sched_barrier(0);
    d[4] = peer_dot6(B.w4, xs); __builtin_amdgcn_sched_barrier(0); d[5] = peer_dot6(B.w5, xs); __builtin_amdgcn_sched_barrier(0);
    d[6] = peer_dot6(B.w6, xs); __builtin_amdgcn_sched_barrier(0); d[7] = peer_dot6(B.w7, xs); __builtin_amdgcn_sched_barrier(0);
#pragma unroll
    for (int o = 1; o < 16; o <<= 1)
#pragma unroll
        for (int st = 0; st < 8; ++st) d[st] += __shfl_xor(d[st], o);
    if (ch == 0) {
#pragma unroll
        for (int st = 0; st < 8; ++st) pd[4 * st] = old[st] + d[st];
    }
}
__device__ __forceinline__ void peer_q_axpy(const PeerHalf& B, const LAS float* pd  , v32f_t& acc) {
    float cf[8];
#pragma unroll
    for (int st = 0; st < 8; ++st) cf[st] = pd[4 * st];
    peer_axpy6v(B.w0, cf[0], acc); __builtin_amdgcn_sched_barrier(0); peer_axpy6v(B.w1, cf[1], acc); __builtin_amdgcn_sched_barrier(0);
    peer_axpy6v(B.w2, cf[2], acc); __builtin_amdgcn_sched_barrier(0); peer_axpy6v(B.w3, cf[3], acc); __builtin_amdgcn_sched_barrier(0);
    peer_axpy6v(B.w4, cf[4], acc); __builtin_amdgcn_sched_barrier(0); peer_axpy6v(B.w5, cf[5], acc); __builtin_amdgcn_sched_barrier(0);
    peer_axpy6v(B.w6, cf[6], acc); __builtin_amdgcn_sched_barrier(0); peer_axpy6v(B.w7, cf[7], acc); __builtin_amdgcn_sched_barrier(0);
}
#define PH_LD1(st) ({ const int vo_ = el[st] * PEER_SROW + ch * 24; \
        const u32x4 a_ = __builtin_bit_cast(u32x4, __builtin_amdgcn_raw_buffer_load_b128(rs, vo_, 0, 0)); const u32x2 b_ = __builtin_bit_cast(u32x2, __builtin_amdgcn_raw_buffer_load_b64(rs, vo_ + 16, 0, 0)); \
        (v6u_t){a_.x, a_.y, a_.z, a_.w, b_.x, b_.y}; })
template <class RS> __device__ __forceinline__ void peer_q_issue_dots(PeerHalf& N, const RS& rs, const int (&el)[8], const PeerHalf& B, const u32 (&xs)[16], LAS float* pd, int ch) {
    float d[8];
    const float old = pd[4 * (ch & 7)];
    N.w0 = PH_LD1(0); d[0] = peer_dot6(B.w0, xs); __builtin_amdgcn_sched_barrier(0); N.w1 = PH_LD1(1); d[1] = peer_dot6(B.w1, xs); __builtin_amdgcn_sched_barrier(0);
    N.w2 = PH_LD1(2); d[2] = peer_dot6(B.w2, xs); __builtin_amdgcn_sched_barrier(0); N.w3 = PH_LD1(3); d[3] = peer_dot6(B.w3, xs); __builtin_amdgcn_sched_barrier(0);
    N.w4 = PH_LD1(4); d[4] = peer_dot6(B.w4, xs); __builtin_amdgcn_sched_barrier(0); N.w5 = PH_LD1(5); d[5] = peer_dot6(B.w5, xs); __builtin_amdgcn_sched_barrier(0);
    N.w6 = PH_LD1(6); d[6] = peer_dot6(B.w6, xs); __builtin_amdgcn_sched_barrier(0); N.w7 = PH_LD1(7); d[7] = peer_dot6(B.w7, xs); __builtin_amdgcn_sched_barrier(0);
    const float tot = row16_reduce8(d, ch);
    if (ch < 8) pd[4 * ch] = old + tot;
}
template <class RS> __device__ __forceinline__ void peer_q_issue_axpy(PeerHalf& N, const RS& rs, const int (&el)[8], int ch, const PeerHalf& B, const LAS float* pd, v32f_t& acc) {
    float cf[8];
#pragma unroll
    for (int st = 0; st < 8; ++st) cf[st] = pd[4 * st];
    N.w0 = PH_LD1(0); peer_axpy6v(B.w0, cf[0], acc); __builtin_amdgcn_sched_barrier(0); N.w1 = PH_LD1(1); peer_axpy6v(B.w1, cf[1], acc); __builtin_amdgcn_sched_barrier(0);
    N.w2 = PH_LD1(2); peer_axpy6v(B.w2, cf[2], acc); __builtin_amdgcn_sched_barrier(0); N.w3 = PH_LD1(3); peer_axpy6v(B.w3, cf[3], acc); __builtin_amdgcn_sched_barrier(0);
    N.w4 = PH_LD1(4); peer_axpy6v(B.w4, cf[4], acc); __builtin_amdgcn_sched_barrier(0); N.w5 = PH_LD1(5); peer_axpy6v(B.w5, cf[5], acc); __builtin_amdgcn_sched_barrier(0);
    N.w6 = PH_LD1(6); peer_axpy6v(B.w6, cf[6], acc); __builtin_amdgcn_sched_barrier(0); N.w7 = PH_LD1(7); peer_axpy6v(B.w7, cf[7], acc); __builtin_amdgcn_sched_barrier(0);
}
#undef PH_LD1
__device__ __forceinline__ void phase_peer(const Ptrs& P, LAS unsigned char* lds, int G, const XcdBarrier* bar) {
    const int tid = threadIdx.x, l = tid & 63, w = __builtin_amdgcn_readfirstlane(tid >> 6);
    unsigned char* ws = P.ws;
    const bf16* HN = (const bf16*)(ws + WS_HN); const float* SUV = (const float*)(ws + WS_PEER_SU);
    const int* TI = (const int*)(ws + WS_TK_IDX); const float* TG = (const float*)(ws + WS_TK_G); float* out = P.out; const float* gfin = P.in[27]; const float* PS = (const float*)(ws + WS_PS);
    LAS float* PD = (LAS float*)(lds + w * 8192);
    LAS float* SS = (LAS float*)(lds + 65536 + w * 64);
    const int es = l >> 4, ch = l & 15, stride = G * NWAVES, tok0 = blockIdx.x * NWAVES + w;
    (void)bar;
    if (l < 16) SS[l] = 0.f;
#pragma unroll
    for (int q = 0; q < 8; ++q) *(LAS f32x4*)(PD + 4 * l + 256 * q) = (f32x4){0.f, 0.f, 0.f, 0.f};
#pragma unroll 1
    for (int s = 0; s < 4; ++s) {
        const auto rsU = __builtin_amdgcn_make_buffer_rsrc((void*)(ws + WS_PEER_U + (size_t)s * PEER_SLICE_BYTES), 0, (int)PEER_SLICE_BYTES, 0x00020000);
        PeerHalf A, B;
        int elA[8], elB[8];
        u32 xs[16];
#pragma unroll
        for (int q = 0; q < 8; ++q) { const u32x2 a = *(const u32x2*)(HN + (size_t)tok0 * DM + 512 * s + 64 * q + 4 * ch); xs[2 * q] = a.x; xs[2 * q + 1] = a.y; }
        peer_q_ids(elA, TI + (size_t)tok0 * 128 + es); peer_q_ids(elB, TI + (size_t)tok0 * 128 + 32 + es);
        peer_q_issue(A, rsU, elA, ch);
#pragma unroll 1
        for (int i = 0; i < 16; ++i) {
            const size_t tok = (size_t)(tok0 + i * stride), ntok = (size_t)(tok0 + (i < 15 ? i + 1 : i) * stride);
            u32 nxs[16];
#pragma unroll
            for (int q = 0; q < 8; ++q) { const u32x2 a = *(const u32x2*)(HN + ntok * DM + 512 * s + 64 * q + 4 * ch); nxs[2 * q] = a.x; nxs[2 * q + 1] = a.y; }
            peer_q_ids(elA, TI + tok * 128 + 64 + es);   __builtin_amdgcn_sched_barrier(0);   peer_q_issue_dots(B, rsU, elB, A, xs, PD + i * 128 + es, ch);
            peer_q_ids(elB, TI + tok * 128 + 96 + es);   __builtin_amdgcn_sched_barrier(0);   peer_q_issue_dots(A, rsU, elA, B, xs, PD + i * 128 + 32 + es, ch);
            peer_q_ids(elA, TI + ntok * 128 + es);   __builtin_amdgcn_sched_barrier(0);   peer_q_issue_dots(B, rsU, elB, A, xs, PD + i * 128 + 64 + es, ch);
            peer_q_ids(elB, TI + ntok * 128 + 32 + es);   __builtin_amdgcn_sched_barrier(0);   peer_q_issue_dots(A, rsU, elA, B, xs, PD + i * 128 + 96 + es, ch);
#pragma unroll
            for (int q = 0; q < 16; ++q) xs[q] = nxs[q];
        }
    }
#pragma unroll 1
    for (int i = 0; i < 16; ++i) {
        const size_t tok = (size_t)(tok0 + i * stride);
        const float rn = __builtin_amdgcn_rsqf(wave_sum(l < 32 ? PS[tok * 32 + l] : 0.f) * (1.0f / 2048.0f) + NORM_EPS);
#pragma unroll
        for (int hh = 0; hh < 2; ++hh) { const int k = 64 * hh + l; const int e = TI[tok * 128 + k]; const float g = TG[tok * 128 + k]; const f32x2 sc = *(const f32x2*)(SUV + 2 * e);
            PD[i * 128 + k] = g * gelu_tanh(PD[i * 128 + k] * sc.x * rn) * sc.y; }
    }
#pragma unroll 1
    for (int s = 0; s < 4; ++s) {
        const auto rsV = __builtin_amdgcn_make_buffer_rsrc((void*)(ws + WS_PEER_V + (size_t)s * PEER_SLICE_BYTES), 0, (int)PEER_SLICE_BYTES, 0x00020000);
        PeerHalf A, B;
        int elA[8], elB[8];
        peer_q_ids(elA, TI + (size_t)tok0 * 128 + es); peer_q_ids(elB, TI + (size_t)tok0 * 128 + 32 + es);
        peer_q_issue(A, rsV, elA, ch);
#pragma unroll 1
        for (int i = 0; i < 16; ++i) {
            const size_t tok = (size_t)(tok0 + i * stride), ntok = (size_t)(tok0 + (i < 15 ? i + 1 : i) * stride);
            u32x2 hw[2];
#pragma unroll
            for (int j = 0; j < 2; ++j) hw[j] = *(const u32x2*)(HN + tok * DM + 512 * s + 64 * (2 * es + j) + 4 * ch);
            v32f_t acc;
#pragma unroll
            for (int c = 0; c < 32; ++c) acc[c] = 0.f;
            peer_q_ids(elA, TI + tok * 128 + 64 + es);   __builtin_amdgcn_sched_barrier(0);   peer_q_issue_axpy(B, rsV, elB, ch, A, PD + i * 128 + es, acc);
            peer_q_ids(elB, TI + tok * 128 + 96 + es);   __builtin_amdgcn_sched_barrier(0);   peer_q_issue_axpy(A, rsV, elA, ch, B, PD + i * 128 + 32 + es, acc);
            peer_q_ids(elA, TI + ntok * 128 + es);   __builtin_amdgcn_sched_barrier(0);   peer_q_issue_axpy(B, rsV, elB, ch, A, PD + i * 128 + 64 + es, acc);
            peer_q_ids(elB, TI + ntok * 128 + 32 + es);   __builtin_amdgcn_sched_barrier(0);   peer_q_issue_axpy(A, rsV, elA, ch, B, PD + i * 128 + 96 + es, acc);
            float r1[16], r2[8];
#pragma unroll
            for (int c = 0; c < 16; ++c) { const auto pp = __builtin_amdgcn_permlane32_swap(__float_as_uint(acc[c]), __float_as_uint(acc[c + 16]), false, false); r1[c] = __uint_as_float(pp[0]) + __uint_as_float(pp[1]); }
#pragma unroll
            for (int c = 0; c < 8; ++c) { const auto pp = __builtin_amdgcn_permlane16_swap(__float_as_uint(r1[c]), __float_as_uint(r1[c + 8]), false, false); r2[c] = __uint_as_float(pp[0]) + __uint_as_float(pp[1]); }
            float ss = 0.f;
            {
                float* op = out + tok * DM + 512 * s + 128 * es + 4 * ch;
#pragma unroll
                for (int j = 0; j < 2; ++j) {
                    const f32x4 o0 = {r2[4 * j] + bflo(hw[j].x), r2[4 * j + 1] + bfhi(hw[j].x), r2[4 * j + 2] + bflo(hw[j].y), r2[4 * j + 3] + bfhi(hw[j].y)};
                    ss += (o0[0] * o0[0] + o0[1] * o0[1]) + (o0[2] * o0[2] + o0[3] * o0[3]);
                    *(f32x4*)(op + 64 * j) = o0; }
            }
            ss = wave_sum(ss);
            if (l == 0) SS[i] += ss;
        }
    }
    asm volatile("s_waitcnt vmcnt(0) lgkmcnt(0)" ::: "memory");
#pragma unroll 1
    for (int i = 0; i < 16; ++i) {
        const size_t tok = (size_t)(tok0 + i * stride);
        const float r = rsqrtf(SS[i] * (1.f / DM) + NORM_EPS);
        f32x4* op = (f32x4*)(out + tok * DM);
#pragma unroll
        for (int j = 0; j < 8; ++j) { const f32x4 ga = ((const f32x4*)gfin)[l + 64 * j]; const f32x4 o = op[l + 64 * j]; op[l + 64 * j] = (f32x4){o.x * r * ga.x, o.y * r * ga.y, o.z * r * ga.z, o.w * r * ga.w}; }
    }
}

struct Params { const float* in[28]; float* out; unsigned char* ws; int ph_lo, ph_hi; };
constexpr int N_PHASES = 13;
#ifndef STOP_AFTER
#define STOP_AFTER 12
#endif

__global__ void __launch_bounds__(NTHREADS, 2) mega(Params prm) {
    extern __shared__ __attribute__((aligned(16))) unsigned char lds_raw[];
    LAS unsigned char* lds = (LAS unsigned char*)lds_raw;
    const int G = gridDim.x;
    Ptrs P;
#pragma unroll
    for (int i = 0; i < 28; ++i) P.in[i] = prm.in[i];
    P.out = prm.out; P.ws = prm.ws;
    unsigned char* ws = prm.ws;
    const int lo = prm.ph_lo, hi = prm.ph_hi;
#ifndef PHMASK
#define PHMASK 0x1fff
#endif
#define IN(k) (((PHMASK >> (k)) & 1) && lo <= (k) && (k) < hi)
#if ONE_LAUNCH
    volatile LAS unsigned* bst = (volatile LAS unsigned*)(lds + LDS_BYTES - 64);
    if (threadIdx.x == 0) { bst[0] = 0u; bst[1] = 0u; }
    __syncthreads();
    const XcdBarrier bar = xcd_barrier_post((unsigned*)(ws + WS_CTL), bst);
#define SEAM(k) do { if (IN(k) && IN((k) + 1)) xcd_barrier(bar); } while (0)
#ifndef PEER_SYNC
#define PEER_SYNC 0
#endif
#define PEER_BAR (PEER_SYNC ? &bar : (const XcdBarrier*)nullptr)
#else
#define SEAM(k) do { } while (0)
#define PEER_BAR ((const XcdBarrier*)nullptr)
#endif
    bf16* HN = (bf16*)(ws + WS_HN);
    if (IN(0)) { phase_prologue(P, lds, G); }
    SEAM(0);
    if (IN(1)) {
        __syncthreads();
        { pg8::Gemm g{HN, (const bf16*)(ws + WS_W_IN_T), NTOK, 2560, 2048}; pg8::StaticOrder S; S.init(NTOK, 2560, G, (int)blockIdx.x);
          pg8::EpiInProj E{(bf16*)(ws + WS_U), (bf16*)(ws + WS_Q), (bf16*)(ws + WS_K), (bf16*)(ws + WS_V)};
          pg8::gemm_phase<pg8::EpiInProj, pg8::StaticOrder, PG8_ALIGN, PG8_SP2>(lds, g, S, E); }
        __syncthreads();
        { pg8::Gemm g{(const bf16*)(ws + WS_MEM_N), (const bf16*)(ws + WS_W_CKV_T), 2048, 1024, 2048}; pg8::StaticOrder S; S.init(2048, 1024, G, (int)blockIdx.x);
          pg8::EpiBf16Plain E{(bf16*)(ws + WS_KV_C), 1024};
          pg8::gemm_phase<pg8::EpiBf16Plain, pg8::StaticOrder, PG8_ALIGN, PG8_SP2>(lds, g, S, E); }
        __syncthreads();
        {
            const int wv = __builtin_amdgcn_readfirstlane(threadIdx.x >> 6), ln = threadIdx.x & 63;
            constexpr int R1 = 32768;
            if (blockIdx.x >= 32) peer_quant_rows(P, lds, wv, ln, ((int)blockIdx.x - 32) * NWAVES + wv, (G - 32) * NWAVES, R1);
            else peer_quant_rows(P, lds, wv, ln, R1 + (int)blockIdx.x * NWAVES + wv, 32 * NWAVES, 32768);
        }
    }
    SEAM(1);
    if (IN(2)) {
#ifndef NO_S5
        __syncthreads(); phase_s5(P, lds, G);
#endif
#ifndef NO_SWA
        __syncthreads(); phase_swa(P, lds, G);
#endif
    }
    SEAM(2);
    if (IN(3)) {
        __syncthreads();
        pg8::Gemm g{(const bf16*)(ws + WS_YPRE), (const bf16*)(ws + WS_W_GLU_T), NTOK, 1024, 1024}; pg8::StaticOrder S; S.init(NTOK, 1024, G, (int)blockIdx.x);
        pg8::EpiGlu E{(bf16*)(ws + WS_YMIX), 2048, (const bf16*)(ws + WS_YPRE), 1024, P.in[14]};
        pg8::gemm_phase<pg8::EpiGlu, pg8::StaticOrder, PG8_ALIGN, PG8_SP2>(lds, g, S, E);
    }
    SEAM(3);
    if (IN(4)) {
        __syncthreads();
        pg8::Gemm g{(const bf16*)(ws + WS_YMIX), (const bf16*)(ws + WS_W_OUT_T), NTOK, 2048, 2048}; pg8::StaticOrder S; S.init(NTOK, 2048, G, (int)blockIdx.x);
        pg8::EpiResBf16<false> E{HN, P.in[0], (float*)(ws + WS_PS)};
        pg8::gemm_phase<pg8::EpiResBf16<false>, pg8::StaticOrder, PG8_ALIGN, PG8_SP2>(lds, g, S, E);
    }
    SEAM(4);
    if (IN(6)) {
        __syncthreads();
        pg8::Gemm g{HN, (const bf16*)(ws + WS_W_CQ_T), NTOK, 512, 2048}; pg8::StaticOrder S; S.init(NTOK, 512, G, (int)blockIdx.x);
        pg8::EpiBf16RowScale E{(bf16*)(ws + WS_QC), 512, (const float*)(ws + WS_PS)};
        pg8::gemm_phase<pg8::EpiBf16RowScale, pg8::StaticOrder, PG8_ALIGN, PG8_SP2>(lds, g, S, E);
    }
    SEAM(6);
    if (IN(7)) { __syncthreads(); phase_cross(P, lds, G); }
    SEAM(7);
    if (IN(8)) {
        __syncthreads();
        pg8::Gemm g{(const bf16*)(ws + WS_OC), (const bf16*)(ws + WS_W_CO_T), NTOK, 2048, 512}; pg8::StaticOrder S; S.init(NTOK, 2048, G, (int)blockIdx.x);
        pg8::EpiResBf16<true> E{HN, HN, (float*)(ws + WS_PS)};
        pg8::gemm_phase<pg8::EpiResBf16<true>, pg8::StaticOrder, PG8_ALIGN, PG8_SP2>(lds, g, S, E);
    }
    SEAM(8);
    if (IN(10)) {
        __syncthreads();
        pg8::Gemm g{HN, (const bf16*)(ws + WS_W_S_T), NTOK, 2048, 2048}; pg8::StaticOrder S; S.init(NTOK, 2048, G, (int)blockIdx.x);
        EpiTopk E{(const float*)(ws + WS_PS), (int*)(ws + WS_TK_IDX), (float*)(ws + WS_TK_G)};
        for (int i = 0; ; ++i) { pg8::Unit uu; if (!S.next(i, uu)) break; pg8::OneUnit O1{uu}; pg8::gemm_phase<EpiTopk, pg8::OneUnit, false, false>(lds, g, O1, E); }
    }
    SEAM(11);
    if (IN(12)) { __syncthreads(); phase_peer(P, lds, G, PEER_BAR); }
    if (lo <= 13 && 13 < hi) {
        const int lane = threadIdx.x & 63, wave = threadIdx.x >> 6;
        for (int m = blockIdx.x * NWAVES + wave; m < NTOK; m += G * NWAVES) {
            f32x4* xr = (f32x4*)(P.out + (size_t)m * DM) + lane; const f32x4* gr = (const f32x4*)P.in[27] + lane;
            f32x4 v[8]; float ss = 0.f;
#pragma unroll
            for (int j = 0; j < 8; ++j) { v[j] = xr[64 * j]; ss += (v[j].x * v[j].x + v[j].y * v[j].y) + (v[j].z * v[j].z + v[j].w * v[j].w); }
            const float r = rsqrtf(wave_sum(ss) * (1.f / DM) + NORM_EPS);
#pragma unroll
            for (int j = 0; j < 8; ++j) { const f32x4 g = gr[64 * j]; xr[64 * j] = (f32x4){v[j].x * r * g.x, v[j].y * r * g.y, v[j].z * r * g.z, v[j].w * r * g.w}; }
        }
    }
}

extern "C" void kernel_launch(void* const* d_in, const int* in_sizes, int n_in, void* d_out, int out_size, void* d_ws, size_t ws_size, hipStream_t stream) {
    static int grid = 0;
    if (!grid) {
        int dev = 0, cus = 0, per_cu = 0;
        if (hipGetDevice(&dev) != hipSuccess || hipDeviceGetAttribute(&cus, hipDeviceAttributeMultiprocessorCount, dev) != hipSuccess) { fprintf(stderr, "kernel_launch: device query failed\n"); return; }
        if (hipFuncSetAttribute((const void*)mega, hipFuncAttributeMaxDynamicSharedMemorySize, LDS_BYTES) != hipSuccess) { fprintf(stderr, "kernel_launch: hipFuncSetAttribute failed\n"); return; }
        if (hipOccupancyMaxActiveBlocksPerMultiprocessor(&per_cu, (const void*)mega, NTHREADS, LDS_BYTES) != hipSuccess || per_cu < 1) { fprintf(stderr, "kernel_launch: occupancy query says %d\n", per_cu); per_cu = 1; }
        grid = 256;
        if (cus != 256) fprintf(stderr, "kernel_launch: built for 256 CUs, device reports %d\n", cus);
        if (ws_size < WS_END || n_in != 28) fprintf(stderr, "kernel_launch: unexpected ws_size %zu / n_in %d\n", ws_size, n_in);
    }
    Params p{};
    for (int i = 0; i < 28; ++i) p.in[i] = (const float*)d_in[i];
    p.out = (float*)d_out; p.ws = (unsigned char*)d_ws;
#if ONE_LAUNCH
    p.ph_lo = 0; p.ph_hi = N_PHASES;
    if (hipMemsetAsync((char*)d_ws + WS_CTL, 0, CTL_ZERO_BYTES, stream) != hipSuccess) { fprintf(stderr, "kernel_launch: memset of the barrier words failed\n"); return; }
    hipLaunchKernelGGL(mega, dim3(grid), dim3(NTHREADS), LDS_BYTES, stream, p);
#else
#ifndef REPEAT_MASK
#define REPEAT_MASK 0
#endif
    for (int ph = 0; ph <= STOP_AFTER; ++ph) { p.ph_lo = ph; p.ph_hi = ph + 1;
        for (int rep = 0; rep < (((REPEAT_MASK >> ph) & 1) ? 2 : 1); ++rep) hipLaunchKernelGGL(mega, dim3(grid), dim3(NTHREADS), LDS_BYTES, stream, p); }
    if (STOP_AFTER < 12) { p.ph_lo = 13; p.ph_hi = 14; hipLaunchKernelGGL(mega, dim3(grid), dim3(NTHREADS), LDS_BYTES, stream, p); }
#endif
}
```

```cpp
#include <hip/hip_runtime.h>
#include <cstdio>
#include <cstdint>
#ifndef ONE_LAUNCH
#define ONE_LAUNCH 1
#endif
#define SN_HD __host__ __device__ __forceinline__
#ifndef SN_HD
#define SN_HD __host__ __device__ __forceinline__
#endif
typedef unsigned int u32;
SN_HD u32 sn_max(u32 a, u32 b) { return a > b ? a : b; }
SN_HD u32 sn_min(u32 a, u32 b) { return a < b ? a : b; }
SN_HD u32 f2key(float f) { u32 u = __builtin_bit_cast(u32, f); return (u & 0x80000000u) ? ~u : (u | 0x80000000u); }
SN_HD float key2f(u32 k) { u32 u = (k & 0x80000000u) ? (k & 0x7fffffffu) : ~k; return __builtin_bit_cast(float, u); }
template <int BASE> SN_HD void bitonic_merge16_desc(u32 (&v)[64]) {
#pragma unroll
    for (int j = 8; j > 0; j >>= 1) {
#pragma unroll
        for (int i = 0; i < 16; ++i) { const int l = i ^ j; if (l > i) { const u32 a = v[BASE + i], b = v[BASE + l]; v[BASE + i] = sn_max(a, b); v[BASE + l] = sn_min(a, b); } }
    }
}
template <int BASE> SN_HD void bitonic_sort16_desc(u32 (&v)[64]) {
#pragma unroll
    for (int k = 2; k <= 16; k <<= 1) {
#pragma unroll
        for (int j = k >> 1; j > 0; j >>= 1) {
#pragma unroll
            for (int i = 0; i < 16; ++i) { const int l = i ^ j; if (l > i) { const u32 a = v[BASE + i], b = v[BASE + l]; const bool desc = ((i & k) == 0);
                v[BASE + i] = desc ? sn_max(a, b) : sn_min(a, b); v[BASE + l] = desc ? sn_min(a, b) : sn_max(a, b); } }
        }
    }
}
template <int A, int B> SN_HD void merge_top16(u32 (&v)[64]) {
#pragma unroll
    for (int i = 0; i < 16; ++i) v[A + i] = sn_max(v[A + i], v[B + 15 - i]);
    bitonic_merge16_desc<A>(v);
}
SN_HD void top16_of_64(u32 (&v)[64]) {
    bitonic_sort16_desc<0>(v); bitonic_sort16_desc<16>(v); bitonic_sort16_desc<32>(v); bitonic_sort16_desc<48>(v);
    merge_top16<0, 16>(v); merge_top16<32, 48>(v); merge_top16<0, 32>(v);
}

SN_HD void merge_sorted16_desc(u32 (&a)[16]) {
#pragma unroll
    for (int j = 8; j > 0; j >>= 1) {
#pragma unroll
        for (int i = 0; i < 16; ++i) { const int l = i ^ j; if (l > i) { const u32 x = a[i], y = a[l]; a[i] = sn_max(x, y); a[l] = sn_min(x, y); } }
    }
}
SN_HD void sort16_desc(u32 (&a)[16]) {
#pragma unroll
    for (int k = 2; k <= 16; k <<= 1) {
#pragma unroll
        for (int j = k >> 1; j > 0; j >>= 1) {
#pragma unroll
            for (int i = 0; i < 16; ++i) { const int l = i ^ j; if (l > i) { const u32 x = a[i], y = a[l]; const bool desc = ((i & k) == 0);
                a[i] = desc ? sn_max(x, y) : sn_min(x, y); a[l] = desc ? sn_min(x, y) : sn_max(x, y); } }
        }
    }
}
SN_HD void merge_top16_desc(u32 (&a)[16], const u32 (&b)[16]) {
#pragma unroll
    for (int i = 0; i < 16; ++i) a[i] = sn_max(a[i], b[15 - i]);
    merge_sorted16_desc(a);
}
SN_HD void insert_top16_desc(u32 (&a)[16], u32 x) {
#pragma unroll
    for (int k = 15; k > 0; --k) a[k] = sn_max(a[k], sn_min(a[k - 1], x));
    a[0] = sn_max(a[0], x);
}
namespace pg8 {
#define PG8_LAS __attribute__((address_space(3)))
typedef unsigned short bf16_t;
typedef short bf16x8 __attribute__((ext_vector_type(8)));
typedef float f32x4 __attribute__((ext_vector_type(4)));
typedef unsigned u32x4 __attribute__((ext_vector_type(4)));
constexpr int BM = 256, BK = 64, HALF = 128, HTB = HALF * BK * 2  , STAGE_BYTES = 8 * HTB, NXCD = 8, WGM = 4;

__host__ __device__ __forceinline__ int lds_byte(int r, int c) { const int st = (r >> 4) * 2 + (c >> 5), rr = r & 15, cc = c & 31, ob = rr * 64 + cc * 2; return st * 1024 + (ob ^ (((ob >> 9) & 1) << 5)); }
__host__ __device__ __forceinline__ void stage_rc(int b, int& R, int& C) { const int st = b / 1024, sb = b % 1024, swz = sb ^ (((sb >> 9) & 1) << 5); R = (st >> 1) * 16 + swz / 64; C = (st & 1) * 32 + (swz % 64) / 2; }
__host__ __device__ __forceinline__ int perm32(int rho) { const int n = rho >> 4, i = rho & 15; return 8 * (i >> 2) + 4 * n + (i & 3); }

struct Unit { int pm, pn; };
struct Gemm { const bf16_t* A; const bf16_t* Bt; int M, N, K; };

struct StaticOrder {
    int nM, nN, nwg, G, c;
    __host__ __device__ void init(int M, int N, int G_, int c_) { nM = M / BM; nN = N / BM; nwg = nM * nN; G = G_; c = c_; }
    __host__ __device__ bool next(int i, Unit& u) const {
        const long L = (long)i * G + c; if (L >= nwg) return false;
        int wgid = (int)L; { const int q = nwg / NXCD, r = nwg % NXCD, xcd = wgid % NXCD, off = wgid / NXCD; wgid = (xcd < r ? xcd * (q + 1) : r * (q + 1) + (xcd - r) * q) + off; }
        const int nig = WGM * nN, gid = wgid / nig, fm = gid * WGM, gsz = (nM - fm) < WGM ? (nM - fm) : WGM;
        u.pm = fm + ((wgid % nig) % gsz); u.pn = (wgid % nig) / gsz; return true;
    }
    __device__ __forceinline__ void a_ready(const Unit&) const {}
    __device__ __forceinline__ void done(const Unit&) const {}
};

typedef float f32x2_t __attribute__((ext_vector_type(2)));
typedef __bf16 bf16x2_t __attribute__((ext_vector_type(2)));
struct OneUnit { Unit u;
    __device__ __forceinline__ bool next(int i, Unit& o) const { if (i) return false; o = u; return true; }
    __device__ __forceinline__ void a_ready(const Unit&) const {}
    __device__ __forceinline__ void done(const Unit&) const {} };

__device__ __forceinline__ unsigned cvt_pk_bf16(float lo, float hi) { const f32x2_t f = {lo, hi}; const bf16x2_t b = __builtin_convertvector(f, bf16x2_t); return __builtin_bit_cast(unsigned, b); }


template <class Epi, class Sched, bool ALIGN_EPI = false, bool SP2 = false>
__device__ __forceinline__ void gemm_phase(PG8_LAS unsigned char* lds, const Gemm g, const Sched& S, const Epi& E) {
    const int tid = threadIdx.x, wid = __builtin_amdgcn_readfirstlane(tid >> 6), lane = tid & 63, wr = wid >> 2, wc = wid & 3, fr = lane & 15, fq = lane >> 4;
    const int K = g.K, nt = K / BK;
    unsigned voffA[2], voffB[2];
#pragma unroll
    for (int i = 0; i < 2; ++i) { int R, C; stage_rc(tid * 16 + i * 8192, R, C); const int Rb = Epi::PERM ? ((R & ~31) + perm32(R & 31)) : R;
        voffA[i] = (unsigned)(R * K + C) * 2u; voffB[i] = (unsigned)(Rb * K + C) * 2u; }
    const size_t kstep = (size_t)(BK * 2);
    const size_t hstep = (size_t)HALF * K * 2;
    const size_t tstep = 2 * hstep;
    const unsigned ldsw = (unsigned)wid * 1024u;
    const int aoff = lds_byte(wr * 64 + fr, fq * 8), boff = lds_byte(wc * 32 + fr, fq * 8);
#define PG8_SA(b, h) (((b) * 2 + (h)) * HTB)
#define PG8_SB(b, h) ((4 + (b) * 2 + (h)) * HTB)
#define PG8_STAGE(bufoff, gbase, voff) do { _Pragma("unroll") for (int _i = 0; _i < 2; ++_i) \
        __builtin_amdgcn_global_load_lds((const unsigned*)((const char*)(gbase) + (voff)[_i]), (PG8_LAS unsigned*)(lds + (bufoff) + ldsw + _i * 8192), 16, 0, 0); } while (0)
#define PG8_LDA(dst, b, h) do { _Pragma("unroll") for (int m = 0; m < 4; ++m) _Pragma("unroll") for (int k = 0; k < 2; ++k) dst[m][k] = *(const PG8_LAS bf16x8*)(lds + PG8_SA(b, h) + aoff + m * 2048 + k * 1024); } while (0)
#define PG8_LDB(dst, b, h) do { _Pragma("unroll") for (int n = 0; n < 2; ++n) _Pragma("unroll") for (int k = 0; k < 2; ++k) dst[n][k] = *(const PG8_LAS bf16x8*)(lds + PG8_SB(b, h) + boff + n * 2048 + k * 1024); } while (0)
#define PG8_MMA(ai, bj, At, Bt) do { __builtin_amdgcn_s_setprio(1); _Pragma("unroll") for (int m = 0; m < 4; ++m) _Pragma("unroll") for (int n = 0; n < 2; ++n) _Pragma("unroll") for (int k = 0; k < 2; ++k) \
        acc[ai][bj][m][n] = __builtin_amdgcn_mfma_f32_16x16x32_bf16(Bt[n][k], At[m][k], acc[ai][bj][m][n], 0, 0, 0); __builtin_amdgcn_s_setprio(0); } while (0)
#define PG8_WAIT_V(n) asm volatile("s_waitcnt vmcnt(" #n ")" ::: "memory")
#define PG8_WAIT_L(n) asm volatile("s_waitcnt lgkmcnt(" #n ")" ::: "memory")
#define PG8_BAR __builtin_amdgcn_s_barrier()
#define PG8_SCHED __builtin_amdgcn_sched_barrier(0)
    Unit cur, nxt; int ui = 0;
    if (!S.next(0, cur)) return;
    f32x4 acc[2][2][4][2];
#pragma unroll
    for (int a = 0; a < 2; ++a)
#pragma unroll
        for (int b = 0; b < 2; ++b)
#pragma unroll
            for (int m = 0; m < 4; ++m)
#pragma unroll
                for (int n = 0; n < 2; ++n) acc[a][b][m][n] = (f32x4){0.f, 0.f, 0.f, 0.f};
    bf16x8 At[4][2], B0[2][2], B1[2][2];
    const char* cA = (const char*)g.A + (size_t)cur.pm * tstep; const char* cB = (const char*)g.Bt + (size_t)cur.pn * tstep;
    S.a_ready(cur);
    if constexpr (SP2) {
        PG8_STAGE(PG8_SB(0, 0), cB, voffB); PG8_STAGE(PG8_SB(0, 1), cB + hstep, voffB); PG8_STAGE(PG8_SA(0, 0), cA, voffA); PG8_STAGE(PG8_SA(0, 1), cA + hstep, voffA);
        if (wr == 1) PG8_BAR;
        PG8_WAIT_V(2); PG8_BAR;
        PG8_STAGE(PG8_SB(1, 0), cB + kstep, voffB); PG8_STAGE(PG8_SA(1, 0), cA + kstep, voffA); PG8_STAGE(PG8_SB(1, 1), cB + hstep + kstep, voffB);
        PG8_WAIT_V(6); PG8_BAR;
    } else {
        PG8_STAGE(PG8_SB(0, 0), cB, voffB); PG8_STAGE(PG8_SA(0, 0), cA, voffA); PG8_STAGE(PG8_SB(0, 1), cB + hstep, voffB); PG8_STAGE(PG8_SA(0, 1), cA + hstep, voffA);
        if (wr == 1) PG8_BAR;
        PG8_WAIT_V(4); PG8_BAR;
        PG8_STAGE(PG8_SB(1, 0), cB + kstep, voffB); PG8_STAGE(PG8_SA(1, 0), cA + kstep, voffA); PG8_STAGE(PG8_SB(1, 1), cB + hstep + kstep, voffB);
        PG8_WAIT_V(6); PG8_BAR;
    }
    for (;;) {
        const bool has_next = S.next(ui + 1, nxt);
        const char* nA = has_next ? (const char*)g.A + (size_t)nxt.pm * tstep : cA; const char* nB = has_next ? (const char*)g.Bt + (size_t)nxt.pn * tstep : cB;
        for (int t = 0; t < nt; t += 2) {
            const bool last = (t == nt - 2);
            const char* a1 = cA + (size_t)(t + 1) * kstep;
            const char* a2 = last ? nA : cA + (size_t)(t + 2) * kstep; const char* b2 = last ? nB : cB + (size_t)(t + 2) * kstep;
            const char* a3 = a2 + kstep; const char* b3 = b2 + kstep;
            if (last && has_next) S.a_ready(nxt);
            if constexpr (SP2) {
            PG8_LDB(B0, 0, 0); PG8_LDB(B1, 0, 1); PG8_SCHED; PG8_LDA(At, 0, 0); PG8_STAGE(PG8_SA(1, 1), a1 + hstep, voffA);
            PG8_WAIT_V(8); PG8_WAIT_L(0); PG8_BAR; PG8_MMA(0, 0, At, B0); PG8_MMA(0, 1, At, B1); PG8_BAR; PG8_SCHED;
            PG8_LDA(At, 0, 1); PG8_STAGE(PG8_SB(0, 0), b2, voffB); PG8_STAGE(PG8_SB(0, 1), b2 + hstep, voffB); PG8_STAGE(PG8_SA(0, 0), a2, voffA);
            PG8_WAIT_V(8); PG8_WAIT_L(0); PG8_BAR; PG8_MMA(1, 0, At, B0); PG8_MMA(1, 1, At, B1); PG8_BAR; PG8_SCHED;
            PG8_LDB(B0, 1, 0); PG8_LDB(B1, 1, 1); PG8_SCHED; PG8_LDA(At, 1, 0); PG8_STAGE(PG8_SA(0, 1), a2 + hstep, voffA);
            PG8_WAIT_V(8); PG8_WAIT_L(0); PG8_BAR; PG8_MMA(0, 0, At, B0); PG8_MMA(0, 1, At, B1); PG8_BAR; PG8_SCHED;
            PG8_LDA(At, 1, 1); PG8_STAGE(PG8_SB(1, 0), b3, voffB); PG8_STAGE(PG8_SB(1, 1), b3 + hstep, voffB); PG8_STAGE(PG8_SA(1, 0), a3, voffA);
            PG8_WAIT_V(8); PG8_WAIT_L(0); PG8_BAR; PG8_MMA(1, 0, At, B0); PG8_MMA(1, 1, At, B1); PG8_BAR; PG8_SCHED;
            } else {
            PG8_LDB(B0, 0, 0); PG8_SCHED; PG8_LDA(At, 0, 0); PG8_STAGE(PG8_SA(1, 1), a1 + hstep, voffA);
            PG8_WAIT_L(8); PG8_BAR; PG8_WAIT_L(0); PG8_MMA(0, 0, At, B0); PG8_BAR; PG8_SCHED;
            PG8_LDB(B1, 0, 1); PG8_STAGE(PG8_SB(0, 0), b2, voffB);
            PG8_BAR; PG8_WAIT_L(0); PG8_MMA(0, 1, At, B1); PG8_BAR;
            PG8_LDA(At, 0, 1); PG8_STAGE(PG8_SA(0, 0), a2, voffA);
            PG8_BAR; PG8_WAIT_L(0); PG8_MMA(1, 0, At, B0); PG8_BAR; PG8_SCHED;
            PG8_STAGE(PG8_SB(0, 1), b2 + hstep, voffB);
            PG8_WAIT_V(6); PG8_BAR; PG8_MMA(1, 1, At, B1); PG8_BAR;
            PG8_LDB(B0, 1, 0); PG8_SCHED; PG8_LDA(At, 1, 0); PG8_STAGE(PG8_SA(0, 1), a2 + hstep, voffA);
            PG8_WAIT_L(8); PG8_BAR; PG8_WAIT_L(0); PG8_MMA(0, 0, At, B0); PG8_BAR; PG8_SCHED;
            PG8_LDB(B1, 1, 1); PG8_STAGE(PG8_SB(1, 0), b3, voffB);
            PG8_BAR; PG8_WAIT_L(0); PG8_MMA(0, 1, At, B1); PG8_BAR;
            PG8_LDA(At, 1, 1); PG8_STAGE(PG8_SA(1, 0), a3, voffA);
            PG8_BAR; PG8_WAIT_L(0); PG8_MMA(1, 0, At, B0); PG8_BAR; PG8_SCHED;
            PG8_STAGE(PG8_SB(1, 1), b3 + hstep, voffB);
            PG8_WAIT_V(6); PG8_BAR; PG8_MMA(1, 1, At, B1); PG8_BAR;
            }
        }
        if constexpr (ALIGN_EPI) { if (wr == 0) PG8_BAR; }
        if constexpr (!Epi::AFTER_DRAIN) { E(acc, cur, wr, wc, fr, fq); S.done(cur); }
        if (!has_next) break;
#pragma unroll
        for (int a = 0; a < 2; ++a)
#pragma unroll
            for (int b = 0; b < 2; ++b)
#pragma unroll
                for (int m = 0; m < 4; ++m)
#pragma unroll
                    for (int n = 0; n < 2; ++n) acc[a][b][m][n] = (f32x4){0.f, 0.f, 0.f, 0.f};
        cur = nxt; cA = nA; cB = nB; ++ui;
        if constexpr (ALIGN_EPI) { if (wr == 1) PG8_BAR; }
    }
    PG8_WAIT_V(0);
    if constexpr (!ALIGN_EPI) { if (wr == 0) PG8_BAR; }
    PG8_BAR;
    if constexpr (Epi::AFTER_DRAIN) { E.fused(acc, cur, wr, wc, fr, fq, lds, wid, lane); S.done(cur); }
#undef PG8_SA
#undef PG8_SB
#undef PG8_STAGE
#undef PG8_LDA
#undef PG8_LDB
#undef PG8_MMA
#undef PG8_WAIT_V
#undef PG8_WAIT_L
#undef PG8_BAR
#undef PG8_SCHED
}

struct EpiInProj {
    static constexpr bool PERM = true, AFTER_DRAIN = false;
    bf16_t *U, *Q, *Kb, *Vb;
    __device__ __forceinline__ void operator()(const f32x4 (&acc)[2][2][4][2], const Unit& u, int wr, int wc, int fr, int fq) const {
        const int row0 = u.pm * BM + wr * 64 + fr;
        if (u.pn < 4) {
            const int col0 = u.pn * BM + wc * 32 + 8 * fq;
#pragma unroll
            for (int ai = 0; ai < 2; ++ai)
#pragma unroll
                for (int m = 0; m < 4; ++m) { const int row = row0 + ai * HALF + m * 16, b = row >> 12, t = row & 4095;
#pragma unroll
                    for (int bj = 0; bj < 2; ++bj) { const int col = col0 + bj * HALF; const f32x4 v0 = acc[ai][bj][m][0], v1 = acc[ai][bj][m][1];
                        u32x4 w; w.x = cvt_pk_bf16(v0[0], v0[1]); w.y = cvt_pk_bf16(v0[2], v0[3]); w.z = cvt_pk_bf16(v1[0], v1[1]); w.w = cvt_pk_bf16(v1[2], v1[3]);
                        *(u32x4*)(U + (((size_t)(b * 64 + (col >> 4)) * 4096 + t) * 16 + (col & 8))) = w; } }
            return;
        }
        bf16_t* base; int ldc, colt;
        if (u.pn < 8) { base = Q; ldc = 1024; colt = (u.pn - 4) * BM; } else if (u.pn == 8) { base = Kb; ldc = 256; colt = 0; } else { base = Vb; ldc = 256; colt = 0; }
        const int col0 = colt + wc * 32 + 8 * fq;
#pragma unroll
        for (int ai = 0; ai < 2; ++ai)
#pragma unroll
            for (int m = 0; m < 4; ++m) { bf16_t* rowp = base + (size_t)(row0 + ai * HALF + m * 16) * ldc + col0;
#pragma unroll
                for (int bj = 0; bj < 2; ++bj) { const f32x4 v0 = acc[ai][bj][m][0], v1 = acc[ai][bj][m][1];
                    u32x4 w; w.x = cvt_pk_bf16(v0[0], v0[1]); w.y = cvt_pk_bf16(v0[2], v0[3]); w.z = cvt_pk_bf16(v1[0], v1[1]); w.w = cvt_pk_bf16(v1[2], v1[3]);
                    *(u32x4*)(rowp + bj * HALF) = w; } }
    }
};
struct EpiBf16Plain {
    static constexpr bool PERM = true, AFTER_DRAIN = false;
    bf16_t* O; int ldc;
    __device__ __forceinline__ void operator()(const f32x4 (&acc)[2][2][4][2], const Unit& u, int wr, int wc, int fr, int fq) const {
        const int row0 = u.pm * BM + wr * 64 + fr, col0 = u.pn * BM + wc * 32 + 8 * fq;
#pragma unroll
        for (int ai = 0; ai < 2; ++ai)
#pragma unroll
            for (int m = 0; m < 4; ++m) { bf16_t* rowp = O + (size_t)(row0 + ai * HALF + m * 16) * ldc + col0;
#pragma unroll
                for (int bj = 0; bj < 2; ++bj) { const f32x4 v0 = acc[ai][bj][m][0], v1 = acc[ai][bj][m][1];
                    u32x4 w; w.x = cvt_pk_bf16(v0[0], v0[1]); w.y = cvt_pk_bf16(v0[2], v0[3]); w.z = cvt_pk_bf16(v1[0], v1[1]); w.w = cvt_pk_bf16(v1[2], v1[3]);
                    *(u32x4*)(rowp + bj * HALF) = w; } }
    }
};
struct EpiGlu {
    static constexpr bool PERM = true, AFTER_DRAIN = false;
    bf16_t* O; int ldo; const bf16_t* Y; int ldy; const float* bias;
    __device__ __forceinline__ void operator()(const f32x4 (&acc)[2][2][4][2], const Unit& u, int wr, int wc, int fr, int fq) const {
        const int row0 = u.pm * BM + wr * 64 + fr, col0 = u.pn * BM + wc * 32 + 8 * fq;
        f32x4 bv[2][2];
#pragma unroll
        for (int bj = 0; bj < 2; ++bj)
#pragma unroll
            for (int n = 0; n < 2; ++n) bv[bj][n] = *(const f32x4*)(bias + col0 + bj * HALF + 4 * n);
#pragma unroll
        for (int ai = 0; ai < 2; ++ai)
#pragma unroll
            for (int m = 0; m < 4; ++m) { const size_t row = (size_t)(row0 + ai * HALF + m * 16);
#pragma unroll
                for (int bj = 0; bj < 2; ++bj) {
                    const u32x4 yw = *(const u32x4*)(Y + row * ldy + col0 + bj * HALF);
                    float o[8];
#pragma unroll
                    for (int e = 0; e < 8; ++e) { const float a = acc[ai][bj][m][e >> 2][e & 3] + bv[bj][e >> 2][e & 3];
                        const unsigned yy = yw[e >> 1]; const float y = __uint_as_float((e & 1) ? (yy & 0xffff0000u) : (yy << 16));
                        o[e] = y / (1.0f + __expf(-a)); }
                    u32x4 w; w.x = cvt_pk_bf16(o[0], o[1]); w.y = cvt_pk_bf16(o[2], o[3]); w.z = cvt_pk_bf16(o[4], o[5]); w.w = cvt_pk_bf16(o[6], o[7]);
                    *(u32x4*)(O + row * ldo + col0 + bj * HALF) = w; } }
    }
};
struct EpiResF32 {
    static constexpr bool PERM = false, AFTER_DRAIN = false;
    float* C; const float* R; int ldc;
    __device__ __forceinline__ void operator()(const f32x4 (&acc)[2][2][4][2], const Unit& u, int wr, int wc, int fr, int fq) const {
        const int row0 = u.pm * BM + wr * 64 + fr, col0 = u.pn * BM + wc * 32 + 4 * fq;
#pragma unroll
        for (int ai = 0; ai < 2; ++ai)
#pragma unroll
            for (int m = 0; m < 4; ++m) { const size_t off = (size_t)(row0 + ai * HALF + m * 16) * ldc + col0;
#pragma unroll
                for (int bj = 0; bj < 2; ++bj)
#pragma unroll
                    for (int n = 0; n < 2; ++n) { f32x4 v = acc[ai][bj][m][n]; if (R) v = v + *(const f32x4*)(R + off + bj * HALF + n * 16); *(f32x4*)(C + off + bj * HALF + n * 16) = v; } }
    }
};
__device__ __forceinline__ float row_rnorm(const float* PS, size_t row) {
    const f32x4* p = (const f32x4*)(PS + row * 32); float s = 0.f;
#pragma unroll
    for (int i = 0; i < 8; ++i) { const f32x4 v = p[i]; s += (v[0] + v[1]) + (v[2] + v[3]); }
    return __builtin_amdgcn_rsqf(s * (1.0f / 2048.0f) + 1e-6f);
}
template <bool RBF16> struct EpiResBf16 {
    static constexpr bool PERM = true, AFTER_DRAIN = false;
    bf16_t* H; const void* R; float* PS;
    __device__ __forceinline__ void operator()(const f32x4 (&acc)[2][2][4][2], const Unit& u, int wr, int wc, int fr, int fq) const {
        const int row0 = u.pm * BM + wr * 64 + fr, col0 = u.pn * BM + wc * 32 + 8 * fq;
#pragma unroll
        for (int ai = 0; ai < 2; ++ai)
#pragma unroll
            for (int m = 0; m < 4; ++m) { const size_t row = (size_t)(row0 + ai * HALF + m * 16), off = row * 2048 + col0; float ss = 0.f;
#pragma unroll
                for (int bj = 0; bj < 2; ++bj) {
                    f32x4 r0, r1;
                    if (RBF16) { const u32x4 rw = *(const u32x4*)((const bf16_t*)R + off + bj * HALF);
                        r0 = (f32x4){__uint_as_float(rw.x << 16), __uint_as_float(rw.x & 0xffff0000u), __uint_as_float(rw.y << 16), __uint_as_float(rw.y & 0xffff0000u)};
                        r1 = (f32x4){__uint_as_float(rw.z << 16), __uint_as_float(rw.z & 0xffff0000u), __uint_as_float(rw.w << 16), __uint_as_float(rw.w & 0xffff0000u)}; }
                    else { r0 = *(const f32x4*)((const float*)R + off + bj * HALF); r1 = *(const f32x4*)((const float*)R + off + bj * HALF + 4); }
                    const f32x4 v0 = acc[ai][bj][m][0] + r0, v1 = acc[ai][bj][m][1] + r1;
                    ss += ((v0[0] * v0[0] + v0[1] * v0[1]) + (v0[2] * v0[2] + v0[3] * v0[3])) + ((v1[0] * v1[0] + v1[1] * v1[1]) + (v1[2] * v1[2] + v1[3] * v1[3]));
                    u32x4 w; w.x = cvt_pk_bf16(v0[0], v0[1]); w.y = cvt_pk_bf16(v0[2], v0[3]); w.z = cvt_pk_bf16(v1[0], v1[1]); w.w = cvt_pk_bf16(v1[2], v1[3]);
                    *(u32x4*)(H + off + bj * HALF) = w; }
                ss += __shfl_xor(ss, 16); ss += __shfl_xor(ss, 32);
                if (fq == 0) PS[row * 32 + u.pn * 4 + wc] = ss; }
    }
};
struct EpiBf16RowScale {
    static constexpr bool PERM = true, AFTER_DRAIN = false;
    bf16_t* O; int ldc; const float* PS;
    __device__ __forceinline__ void operator()(const f32x4 (&acc)[2][2][4][2], const Unit& u, int wr, int wc, int fr, int fq) const {
        const int row0 = u.pm * BM + wr * 64 + fr, col0 = u.pn * BM + wc * 32 + 8 * fq;
#pragma unroll
        for (int ai = 0; ai < 2; ++ai)
#pragma unroll
            for (int m = 0; m < 4; ++m) { const size_t row = (size_t)(row0 + ai * HALF + m * 16); const float r = row_rnorm(PS, row); bf16_t* rowp = O + row * ldc + col0;
#pragma unroll
                for (int bj = 0; bj < 2; ++bj) { const f32x4 v0 = acc[ai][bj][m][0] * r, v1 = acc[ai][bj][m][1] * r;
                    u32x4 w; w.x = cvt_pk_bf16(v0[0], v0[1]); w.y = cvt_pk_bf16(v0[2], v0[3]); w.z = cvt_pk_bf16(v1[0], v1[1]); w.w = cvt_pk_bf16(v1[2], v1[3]);
                    *(u32x4*)(rowp + bj * HALF) = w; } }
    }
};
struct EpiF32RowScale {
    static constexpr bool PERM = true, AFTER_DRAIN = false;
    float* C; int ldc; const float* PS;
    __device__ __forceinline__ void operator()(const f32x4 (&acc)[2][2][4][2], const Unit& u, int wr, int wc, int fr, int fq) const {
        const int row0 = u.pm * BM + wr * 64 + fr, col0 = u.pn * BM + wc * 32 + 8 * fq;
#pragma unroll
        for (int ai = 0; ai < 2; ++ai)
#pragma unroll
            for (int m = 0; m < 4; ++m) { const size_t row = (size_t)(row0 + ai * HALF + m * 16); const float r = row_rnorm(PS, row); const size_t off = row * ldc + col0;
#pragma unroll
                for (int bj = 0; bj < 2; ++bj) { *(f32x4*)(C + off + bj * HALF) = acc[ai][bj][m][0] * r; *(f32x4*)(C + off + bj * HALF + 4) = acc[ai][bj][m][1] * r; } }
    }
};
}

#ifndef PG8_SP2
#define PG8_SP2 false
#endif
#ifndef PG8_ALIGN
#define PG8_ALIGN true
#endif
constexpr int NTOK = 32768, DM = 2048, SEQ = 4096, NB = 8;
constexpr int NWAVES = 8, NTHREADS = 512;
constexpr int LDS_BYTES = 147456;
constexpr float NORM_EPS = 1e-6f;

#define LAS __attribute__((address_space(3)))
typedef unsigned short bf16;
typedef unsigned u32;
typedef short bf16x8 __attribute__((ext_vector_type(8)));
typedef short s16x4 __attribute__((ext_vector_type(4)));
typedef float f32x4 __attribute__((ext_vector_type(4)));
typedef float f32x16 __attribute__((ext_vector_type(16)));
typedef unsigned u32x4 __attribute__((ext_vector_type(4)));
typedef unsigned u32x2 __attribute__((ext_vector_type(2)));

constexpr size_t MiB = 1u << 20;
constexpr size_t WS_CTL = 0, CTL_ZERO_BYTES = 64 * 1024;
constexpr size_t WS_W_IN_T = 1 * MiB, WS_W_GLU_T = 11 * MiB, WS_W_OUT_T = 13 * MiB, WS_W_CQ_T = 21 * MiB, WS_W_CKV_T = 23 * MiB, WS_W_CO_T = 27 * MiB, WS_W_S_T = 29 * MiB;
constexpr size_t WS_S5_WIN = 37 * MiB, WS_S5_WOUT = 41 * MiB, WS_S5_K = 45 * MiB, WS_S5_LAM = 46 * MiB, WS_BIAS_TAB = 46 * MiB + 512 * 1024;
constexpr size_t WS_MEM_N = 47 * MiB, WS_KV_C = 55 * MiB, WS_PS = 59 * MiB;
#ifndef FP6_PACK_INTERLEAVED
#define FP6_PACK_INTERLEAVED 1
#endif
typedef unsigned v6u_t __attribute__((ext_vector_type(6)));
constexpr int PEER_ROW_BYTES = 1536;
constexpr int PEER_SROW = 384;
constexpr size_t PEER_SLICE_BYTES = (size_t)16384 * PEER_SROW;
constexpr size_t WS_PEER_U = 64 * MiB, WS_PEER_V = 96 * MiB;
constexpr size_t WS_PEER_SU = 128 * MiB, WS_PEER_SV = 128 * MiB + 65536;
constexpr size_t WS_HN = 192 * MiB;
constexpr size_t WS_U = 320 * MiB, WS_Q = 384 * MiB, WS_K = 448 * MiB, WS_V = 464 * MiB, WS_YPRE = 480 * MiB, WS_YMIX = 544 * MiB;
constexpr size_t WS_SCORES = 320 * MiB;
constexpr size_t WS_QC = 672 * MiB, WS_OC = 704 * MiB, WS_TK_IDX = 736 * MiB, WS_TK_G = 752 * MiB, WS_END = 768 * MiB;

__device__ __forceinline__ unsigned f2bf(float f) { unsigned u = __float_as_uint(f); return (u + 0x7fffu + ((u >> 16) & 1u)) >> 16; }
__device__ __forceinline__ unsigned pk2(float lo, float hi) { return pg8::cvt_pk_bf16(lo, hi); }
__device__ __forceinline__ unsigned cvtpk(float lo, float hi) { return pg8::cvt_pk_bf16(lo, hi); }
__device__ __forceinline__ float bflo(unsigned w) { return __uint_as_float(w << 16); }
__device__ __forceinline__ float bfhi(unsigned w) { return __uint_as_float(w & 0xffff0000u); }
__device__ __forceinline__ float wave_sum(float v) {
#pragma unroll
    for (int o = 1; o < 64; o <<= 1) v += __shfl_xor(v, o);
    return v;
}
__device__ __forceinline__ float gelu_tanh(float x) { const float z = 0.7978845608028654f * (x + 0.044715f * x * x * x); return x / (1.0f + __expf(-2.0f * z)); }
#define LDS_WAIT() asm volatile("s_waitcnt lgkmcnt(0)" ::: "memory")
#define MFMA16(a, b, c) __builtin_amdgcn_mfma_f32_16x16x32_bf16((a), (b), (c), 0, 0, 0)
#define MFMA32(a, b, c) __builtin_amdgcn_mfma_f32_32x32x16_bf16((a), (b), (c), 0, 0, 0)

__device__ __forceinline__ void p0_transpose_item(const float* W, int K, int N, bf16* WT, LAS float* scr, int item, int lane, const float* kgain = nullptr) {
    const int nblk = N / 32, kb = item / nblk, nb = item % nblk, k0 = 64 * kb, n0 = 32 * nb;
    f32x4 v[8];
#pragma unroll
    for (int i = 0; i < 8; ++i) v[i] = *(const f32x4*)(W + (size_t)(k0 + 8 * i + (lane >> 3)) * N + n0 + 4 * (lane & 7));
#pragma unroll
    for (int i = 0; i < 8; ++i) { const int kk = 8 * i + (lane >> 3); f32x4 x = v[i]; if (kgain) x = x * kgain[k0 + kk];
#pragma unroll
        for (int c = 0; c < 4; ++c) scr[kk * 33 + 4 * (lane & 7) + c] = x[c]; }
    LDS_WAIT(); asm volatile("" ::: "memory");
    const int c = lane & 7;
#pragma unroll
    for (int j = 0; j < 4; ++j) { const int n = (lane >> 3) + 8 * j; const LAS float* s = scr + (8 * c) * 33 + n;
        u32x4 o; o.x = pk2(s[0 * 33], s[1 * 33]); o.y = pk2(s[2 * 33], s[3 * 33]); o.z = pk2(s[4 * 33], s[5 * 33]); o.w = pk2(s[6 * 33], s[7 * 33]);
        *(u32x4*)(WT + (size_t)(n0 + n) * K + k0 + 8 * c) = o; }
    LDS_WAIT(); asm volatile("" ::: "memory");
}
__device__ __forceinline__ void rms_row_to_bf16(const float* xrow, const float* gain, bf16* orow, int lane) {
    const f32x4* xr = (const f32x4*)xrow + lane; const f32x4* gr = (const f32x4*)gain + lane;
    f32x4 v[8]; float s = 0.f;
#pragma unroll
    for (int j = 0; j < 8; ++j) { v[j] = xr[64 * j]; s += (v[j].x * v[j].x + v[j].y * v[j].y) + (v[j].z * v[j].z + v[j].w * v[j].w); }
    const float r = rsqrtf(wave_sum(s) * (1.f / DM) + NORM_EPS);
    u32x2* o8 = (u32x2*)orow + lane;
#pragma unroll
    for (int j = 0; j < 8; ++j) { const f32x4 g = gr[64 * j]; u32x2 w; w.x = pk2(v[j].x * r * g.x, v[j].y * r * g.y); w.y = pk2(v[j].z * r * g.z, v[j].w * r * g.w); o8[64 * j] = w; }
}

struct Ptrs {
    const float* in[28]; float* out; unsigned char* ws;
};

__device__ __forceinline__ void phase_prologue(const Ptrs& P, LAS unsigned char* lds, int G) {
    const int tid = threadIdx.x, lane = tid & 63, wave = __builtin_amdgcn_readfirstlane(tid >> 6);
    unsigned char* ws = P.ws;
    {
        const float* wq = P.in[23]; const float* sk = P.in[24]; bf16* WsT = (bf16*)(ws + WS_W_S_T);
        LAS float* wq_l = (LAS float*)lds;
        LAS float* sk_l = wq_l + 64 * 129;
        for (int it = blockIdx.x; it < 512; it += G) {
            const int hc = it >> 5, d0 = (it & 31) * 64;
            __syncthreads();
#pragma unroll
            for (int i = 0; i < 4; ++i) { const int e = tid + 512 * i, dl = e >> 5, j4 = (e & 31) * 4; f32x4 v = *(const f32x4*)(wq + (size_t)(d0 + dl) * 2048 + hc * 128 + j4); v = v * P.in[22][d0 + dl];
#pragma unroll
                for (int c = 0; c < 4; ++c) wq_l[dl * 129 + j4 + c] = v[c]; }
#pragma unroll
            for (int i = 0; i < 8; ++i) { const int e = tid + 512 * i, kk = e >> 5, j4 = (e & 31) * 4; const f32x4 v = *(const f32x4*)(sk + ((size_t)hc * 128 + kk) * 128 + j4);
#pragma unroll
                for (int c = 0; c < 4; ++c) sk_l[kk * 129 + j4 + c] = v[c]; }
            __syncthreads();
            const int kb = wave & 3, db = wave >> 2;
            const LAS float* ap = sk_l + (32 * kb + (lane & 31)) * 129 + (lane >> 5); const LAS float* bp = wq_l + (32 * db + (lane & 31)) * 129 + (lane >> 5);
            f32x16 acc;
#pragma unroll
            for (int i = 0; i < 16; ++i) acc[i] = 0.f;
#pragma unroll 16
            for (int st = 0; st < 64; ++st) acc = __builtin_amdgcn_mfma_f32_32x32x2f32(ap[2 * st], bp[2 * st], acc, 0, 0, 0);
#pragma unroll
            for (int r = 0; r < 16; ++r) { const int key = (r & 3) + 8 * (r >> 2) + 4 * (lane >> 5);
                WsT[(size_t)(hc * 128 + 32 * kb + key) * 2048 + d0 + 32 * db + (lane & 31)] = (bf16)f2bf(acc[r]); }
        }
        __syncthreads();
    }
    {
        const float *lam_re = P.in[5], *lam_im = P.in[6], *b_re = P.in[7], *b_im = P.in[8], *c_re = P.in[9], *c_im = P.in[10], *dd = P.in[11], *log_dt = P.in[12];
        LAS float* pwr = (LAS float*)lds;
        LAS float* bbar = pwr + 17 * 64 * 2;
        LAS float* cc = bbar + 64 * 16 * 2;
        for (int gi = blockIdx.x; gi < 256; gi += G) {
            const int g = gi >> 2, qt = gi & 3;
            __syncthreads();
            if (tid < 64) {
                const int p = tid; const float lre = lam_re[g * 64 + p], lim = lam_im[g * 64 + p], dt = expf(log_dt[g]);
                const float er = expf(lre * dt); float sn, cs; sincosf(lim * dt, &sn, &cs);
                const float lbr = er * cs, lbi = er * sn;
                const float nr = lbr - 1.0f, ni = lbi, den = lre * lre + lim * lim;
                const float fr = (nr * lre + ni * lim) / den, fi = (ni * lre - nr * lim) / den;
#pragma unroll
                for (int h = 0; h < 16; ++h) { const float br = b_re[(g * 64 + p) * 16 + h], bi = b_im[(g * 64 + p) * 16 + h];
                    bbar[(p * 16 + h) * 2] = fr * br - fi * bi; bbar[(p * 16 + h) * 2 + 1] = fr * bi + fi * br; }
                float pr = 1.f, pi = 0.f;
                for (int j = 0; j <= 16; ++j) { pwr[(j * 64 + p) * 2] = pr; pwr[(j * 64 + p) * 2 + 1] = pi; const float t = pr * lbr - pi * lbi; pi = pr * lbi + pi * lbr; pr = t; }
            }
            for (int e = tid; e < 1024; e += NTHREADS) { cc[e * 2] = c_re[g * 1024 + e]; cc[e * 2 + 1] = c_im[g * 1024 + e]; }
            __syncthreads();
            bf16* Win = (bf16*)(ws + WS_S5_WIN) + (size_t)g * 32768; bf16* Wout = (bf16*)(ws + WS_S5_WOUT) + (size_t)g * 32768; bf16* Kt = (bf16*)(ws + WS_S5_K) + (size_t)g * 4096;
            for (int e = qt * 8192 + tid; e < (qt + 1) * 8192; e += NTHREADS) {
                const int m = e >> 8, kk = e & 255, p = m & 63, ri = m >> 6, sg = kk >> 4, hp = kk & 15;
                const float ar = pwr[((15 - sg) * 64 + p) * 2], ai = pwr[((15 - sg) * 64 + p) * 2 + 1], xr = bbar[(p * 16 + hp) * 2], xi = bbar[(p * 16 + hp) * 2 + 1];
                Win[e] = (bf16)f2bf(ri ? (ar * xi + ai * xr) : (ar * xr - ai * xi));
            }
            for (int e = qt * 8192 + tid; e < (qt + 1) * 8192; e += NTHREADS) {
                const int mm = e >> 7, m = e & 127, tau = mm >> 4, h = mm & 15, p = m & 63, ri = m >> 6;
                const float ar = pwr[((tau + 1) * 64 + p) * 2], ai = pwr[((tau + 1) * 64 + p) * 2 + 1], cr = cc[(h * 64 + p) * 2], ci = cc[(h * 64 + p) * 2 + 1];
                Wout[e] = (bf16)f2bf(ri ? -(cr * ai + ci * ar) : (cr * ar - ci * ai));
            }
            for (int e = qt * 1024 + tid; e < (qt + 1) * 1024; e += NTHREADS) {
                const int j = e >> 8, h = (e >> 4) & 15, hp = e & 15; float s = 0.f;
                for (int p = 0; p < 64; ++p) { const float ar = pwr[(j * 64 + p) * 2], ai = pwr[(j * 64 + p) * 2 + 1], cr = cc[(h * 64 + p) * 2], ci = cc[(h * 64 + p) * 2 + 1];
                    const float wr = cr * ar - ci * ai, wi = cr * ai + ci * ar; s += wr * bbar[(p * 16 + hp) * 2] - wi * bbar[(p * 16 + hp) * 2 + 1]; }
                if (j == 0 && h == hp) s += dd[g * 16 + h];
                Kt[e] = (bf16)f2bf(s);
            }
            if (tid < 64 && qt == 0) { float* lamq = (float*)(ws + WS_S5_LAM) + g * 128; lamq[2 * tid] = pwr[(16 * 64 + tid) * 2]; lamq[2 * tid + 1] = pwr[(16 * 64 + tid) * 2 + 1]; }
        }
        __syncthreads();
    }
    {
        const float* rel_bias = P.in[2]; float* bt = (float*)(ws + WS_BIAS_TAB);
        for (int e = blockIdx.x * NTHREADS + tid; e < 2048; e += G * NTHREADS) {
            const int hq = e >> 7, dist = e & 127; int bucket = dist;
            if (dist >= 16) { int lg = 16 + (int)(logf((float)dist / 16.0f) / logf(8.0f) * 16.0f); bucket = lg < 31 ? lg : 31; }
            bt[e] = rel_bias[bucket * 16 + hq];
        }
    }
    {
        LAS float* scr = (LAS float*)(lds + wave * 16384);
        const int gw = blockIdx.x * NWAVES + wave, NGW = G * NWAVES;
        constexpr int I0 = 32 * 80, I1 = 16 * 32, I2 = 32 * 64, I3 = 32 * 16, I4 = 32 * 32, I5 = 8 * 64;
        for (int it = gw; it < I0 + I1 + I2 + I3 + I4 + I5; it += NGW) {
            int r = it;
            if (r < I0) { p0_transpose_item(P.in[4], 2048, 2560, (bf16*)(ws + WS_W_IN_T), scr, r, lane); continue; } r -= I0;
            if (r < I1) { p0_transpose_item(P.in[13], 1024, 1024, (bf16*)(ws + WS_W_GLU_T), scr, r, lane); continue; } r -= I1;
            if (r < I2) { p0_transpose_item(P.in[16], 2048, 2048, (bf16*)(ws + WS_W_OUT_T), scr, r, lane); continue; } r -= I2;
            if (r < I3) { p0_transpose_item(P.in[19], 2048, 512, (bf16*)(ws + WS_W_CQ_T), scr, r, lane, P.in[17]); continue; } r -= I3;
            if (r < I4) { p0_transpose_item(P.in[20], 2048, 1024, (bf16*)(ws + WS_W_CKV_T), scr, r, lane); continue; } r -= I4;
            p0_transpose_item(P.in[21], 512, 2048, (bf16*)(ws + WS_W_CO_T), scr, r, lane);
        }
        {
            f32x4 a[8], b[8];
#pragma unroll
            for (int j = 0; j < 8; ++j) { a[j] = ((const f32x4*)(P.in[0] + (size_t)gw * DM))[lane + 64 * j]; b[j] = ((const f32x4*)(P.in[0] + (size_t)(gw + NGW) * DM))[lane + 64 * j]; }
#pragma unroll 1
            for (int m = gw; m < NTOK; m += 2 * NGW) {
                const int mn = (m + 2 * NGW < NTOK) ? m + 2 * NGW : m;
                f32x4 na[8], nb[8];
#pragma unroll
                for (int j = 0; j < 8; ++j) { na[j] = ((const f32x4*)(P.in[0] + (size_t)mn * DM))[lane + 64 * j]; nb[j] = ((const f32x4*)(P.in[0] + (size_t)(mn + NGW) * DM))[lane + 64 * j]; }
                float s0 = 0.f, s1 = 0.f;
#pragma unroll
                for (int j = 0; j < 8; ++j) { s0 += (a[j].x * a[j].x + a[j].y * a[j].y) + (a[j].z * a[j].z + a[j].w * a[j].w); s1 += (b[j].x * b[j].x + b[j].y * b[j].y) + (b[j].z * b[j].z + b[j].w * b[j].w); }
                const float r0 = rsqrtf(wave_sum(s0) * (1.f / DM) + NORM_EPS), r1 = rsqrtf(wave_sum(s1) * (1.f / DM) + NORM_EPS);
                u32x2* o0 = (u32x2*)((bf16*)(ws + WS_HN) + (size_t)m * DM) + lane; u32x2* o1 = (u32x2*)((bf16*)(ws + WS_HN) + (size_t)(m + NGW) * DM) + lane;
#pragma unroll
                for (int j = 0; j < 8; ++j) { const f32x4 g = ((const f32x4*)P.in[3])[lane + 64 * j];
                    u32x2 w0, w1; w0.x = pk2(a[j].x * r0 * g.x, a[j].y * r0 * g.y); w0.y = pk2(a[j].z * r0 * g.z, a[j].w * r0 * g.w); w1.x = pk2(b[j].x * r1 * g.x, b[j].y * r1 * g.y); w1.y = pk2(b[j].z * r1 * g.z, b[j].w * r1 * g.w);
                    o0[64 * j] = w0; o1[64 * j] = w1; }
#pragma unroll
                for (int j = 0; j < 8; ++j) { a[j] = na[j]; b[j] = nb[j]; }
            }
        }
        for (int m = gw; m < 2048; m += NGW) rms_row_to_bf16(P.in[1] + (size_t)m * DM, P.in[18], (bf16*)(ws + WS_MEM_N) + (size_t)m * DM, lane);
    }
}

__device__ __forceinline__ void peer_quant_rows(const Ptrs& P, LAS unsigned char* lds, int wave, int lane, int first, int step, int r_hi) {
    unsigned char* ws = P.ws; (void)lds; (void)wave;
    if (first >= r_hi) return;
    typedef float v16f_t __attribute__((ext_vector_type(16)));
    const int lo4 = 128 * (lane >> 4) + (lane & 15);
#define PQ_SRC(r) (((r) >> 14) ? P.in[26] : P.in[25]) + (size_t)((r) & 16383) * DM
#define PQ_LOAD(V, r) { const f32x4* s4_ = (const f32x4*)(PQ_SRC(r)) + lo4; _Pragma("unroll") for (int q = 0; q < 8; ++q) V[q] = s4_[16 * q]; }
#define PQ_ROW(V, r) { const int t_ = (r) >> 14, e_ = (r) & 16383; float mx = 0.f; \
        if (t_ == 0) { _Pragma("unroll") for (int q = 0; q < 8; ++q) V[q] = V[q] * ((const f32x4*)P.in[22])[lo4 + 16 * q]; } \
        _Pragma("unroll") for (int q = 0; q < 8; ++q) mx = fmaxf(mx, fmaxf(fmaxf(fabsf(V[q].x), fabsf(V[q].y)), fmaxf(fabsf(V[q].z), fabsf(V[q].w)))); \
        _Pragma("unroll") for (int o = 1; o < 64; o <<= 1) mx = fmaxf(mx, __shfl_xor(mx, o)); \
        const float sc = mx > 0.f ? mx * (1.0f / 7.5f) : 1.0f, inv = 1.0f / sc; \
        v16f_t lo16, hi16; \
        _Pragma("unroll") for (int q = 0; q < 8; ++q) { lo16[2 * q] = V[q].x * inv; hi16[2 * q] = V[q].y * inv; lo16[2 * q + 1] = V[q].z * inv; hi16[2 * q + 1] = V[q].w * inv; } \
        const v6u_t wq = __builtin_amdgcn_cvt_scalef32_2xpk16_fp6_f32(lo16, hi16, 1.0f);        \
        unsigned char* dst = ws + (t_ ? WS_PEER_V : WS_PEER_U) + (size_t)(lane >> 4) * PEER_SLICE_BYTES + (size_t)e_ * PEER_SROW; \
          \
        *(u32x4*)(dst + 16 * (lane & 15)) = (u32x4){wq[0], wq[1], wq[2], wq[3]}; *(u32x2*)(dst + 256 + 8 * (lane & 15)) = (u32x2){wq[4], wq[5]}; \
        if (lane == 0) ((float*)(ws + WS_PEER_SU))[2 * e_ + t_] = sc;        }
    f32x4 va[8], vb[8];
    { const int r1 = first + step < r_hi ? first + step : first; PQ_LOAD(va, first) PQ_LOAD(vb, r1) }
#pragma unroll 1
    for (int rr = first; rr < r_hi; rr += 2 * step) {
        const bool two = rr + step < r_hi;
        const int n0 = rr + 2 * step < r_hi ? rr + 2 * step : rr, n1 = rr + 3 * step < r_hi ? rr + 3 * step : n0;
        f32x4 na[8], nb[8];
        PQ_LOAD(na, n0) PQ_LOAD(nb, n1)
        PQ_ROW(va, rr)
        if (two) PQ_ROW(vb, rr + step)
#pragma unroll
        for (int q = 0; q < 8; ++q) { va[q] = na[q]; vb[q] = nb[q]; }
    }
#undef PQ_SRC
#undef PQ_LOAD
#undef PQ_ROW
}

__device__ __forceinline__ void phase_norm(const float* h, const float* gain, bf16* hn, int G) {
    const int lane = threadIdx.x & 63, wave = __builtin_amdgcn_readfirstlane(threadIdx.x >> 6);
    for (int m = blockIdx.x * NWAVES + wave; m < NTOK; m += G * NWAVES) rms_row_to_bf16(h + (size_t)m * DM, gain, hn + (size_t)m * DM, lane);
}

__device__ __forceinline__ void phase_s5(const Ptrs& P, LAS unsigned char* lds, int G) {
    const int tid = threadIdx.x, l = tid & 63, w = __builtin_amdgcn_readfirstlane(tid >> 6);
    unsigned char* ws = P.ws;
    const bf16* U = (const bf16*)(ws + WS_U); bf16* Y = (bf16*)(ws + WS_YPRE);
    LAS unsigned char* U_l = lds;
    LAS float* S_l = (LAS float*)(lds + 33792);
    LAS bf16* Xs_l = (LAS bf16*)(lds + 33792 + 33280);
    LAS float* Eseg = (LAS float*)(lds + 33792 + 33280 + 17408);
    LAS float* Gcar = (LAS float*)(lds + 33792 + 33280 + 17408 + 4096);
    const int l15 = l & 15, l4 = l >> 4;
    const int uoff = l15 * 528 + (l >> 5) * 32 + (l4 & 1) * 16;
    for (int it = blockIdx.x; it < 512; it += G) {
        const int b = it >> 6, g = it & 63;
        const bf16* Win = (const bf16*)(ws + WS_S5_WIN) + (size_t)g * 32768; const bf16* Wout = (const bf16*)(ws + WS_S5_WOUT) + (size_t)g * 32768; const bf16* Kt = (const bf16*)(ws + WS_S5_K) + (size_t)g * 4096;
        const float* lamq = (const float*)(ws + WS_S5_LAM) + g * 128;
        const bf16* Ug = U + (size_t)(b * 64 + g) * 65536;
        const int p = tid & 63, seg = tid >> 6;
        const float lqr = lamq[2 * p], lqi = lamq[2 * p + 1];
        float l8r = lqr, l8i = lqi;
#pragma unroll
        for (int i = 0; i < 3; ++i) { const float t = l8r * l8r - l8i * l8i; l8i = 2.f * l8r * l8i; l8r = t; }
        __syncthreads();
        if (tid < 64) { Gcar[2 * tid] = 0.f; Gcar[2 * tid + 1] = 0.f; }
#pragma unroll 1
        for (int ps = 0; ps < 4; ++ps) {
#pragma unroll
            for (int i = 0; i < 4; ++i) { const int e = tid + 512 * i, t = e >> 1;
                *(LAS u32x4*)(U_l + (t >> 4) * 528 + (t & 15) * 32 + (e & 1) * 16) = *(const u32x4*)(Ug + (size_t)ps * 16384 + e * 8); }
            bf16x8 Aw[8];
#pragma unroll
            for (int ks = 0; ks < 8; ++ks) Aw[ks] = *(const bf16x8*)(Win + (16 * w + l15) * 256 + 32 * ks + 8 * l4);
            __syncthreads();
#pragma unroll
            for (int cb = 0; cb < 4; ++cb) {
                f32x4 acc = (f32x4){0.f, 0.f, 0.f, 0.f};
#pragma unroll
                for (int ks = 0; ks < 8; ++ks) { const bf16x8 Bf = *(const LAS bf16x8*)(U_l + cb * 8448 + uoff + 64 * ks); acc = MFMA16(Aw[ks], Bf, acc); }
#pragma unroll
                for (int r = 0; r < 4; ++r) S_l[(16 * w + 4 * l4 + r) * 65 + cb * 16 + l15] = acc[r];
            }
            __syncthreads();
            {
                float er = 0.f, ei = 0.f; const int c0 = seg * 8;
#pragma unroll
                for (int i = 0; i < 8; ++i) { const int c = c0 + i; const float sr = S_l[p * 65 + c], si = S_l[(64 + p) * 65 + c];
                    const float t = lqr * er - lqi * ei + sr; ei = lqr * ei + lqi * er + si; er = t; S_l[p * 65 + c] = er; S_l[(64 + p) * 65 + c] = ei; }
                Eseg[(seg * 64 + p) * 2] = er; Eseg[(seg * 64 + p) * 2 + 1] = ei;
                __syncthreads();
                float gr = Gcar[((ps & 1) * 64 + p) * 2], gi = Gcar[((ps & 1) * 64 + p) * 2 + 1];
                for (int s = 0; s < seg; ++s) { const float t = l8r * gr - l8i * gi + Eseg[(s * 64 + p) * 2]; gi = l8r * gi + l8i * gr + Eseg[(s * 64 + p) * 2 + 1]; gr = t; }
                if (seg == 7) { Gcar[(((ps + 1) & 1) * 64 + p) * 2] = l8r * gr - l8i * gi + er; Gcar[(((ps + 1) & 1) * 64 + p) * 2 + 1] = l8r * gi + l8i * gr + ei; }
                float pr = 1.f, pi = 0.f;
#pragma unroll
                for (int i = 0; i < 8; ++i) { const int c = c0 + i;
                    float xr = pr * gr - pi * gi, xi = pr * gi + pi * gr;
                    if (i > 0) { xr += S_l[p * 65 + c - 1]; xi += S_l[(64 + p) * 65 + c - 1]; }
                    Xs_l[c * 136 + p] = (bf16)f2bf(xr); Xs_l[c * 136 + 64 + p] = (bf16)f2bf(xi);
                    const float t = pr * lqr - pi * lqi; pi = pr * lqi + pi * lqr; pr = t; }
            }
            __syncthreads();
#pragma unroll 1
            for (int tt = 0; tt < 2; ++tt) {
                const int tau = tt ? 15 - w : w;
                bf16x8 Tf[8], Wo[4];
#pragma unroll
                for (int ks = 0; ks < 8; ++ks) { const int lag = tau - (2 * ks + (l >> 5));
                    bf16x8 z = (bf16x8){0, 0, 0, 0, 0, 0, 0, 0};
                    if (lag >= 0) z = *(const bf16x8*)(Kt + (lag * 16 + l15) * 16 + 8 * (l4 & 1));
                    Tf[ks] = z; }
#pragma unroll
                for (int k2 = 0; k2 < 4; ++k2) Wo[k2] = *(const bf16x8*)(Wout + (tau * 16 + l15) * 128 + 32 * k2 + 8 * l4);
#pragma unroll
                for (int cb = 0; cb < 4; ++cb) {
                    f32x4 acc = (f32x4){0.f, 0.f, 0.f, 0.f};
#pragma unroll
                    for (int ks = 0; ks < 8; ++ks) if (2 * ks <= tau) { const bf16x8 Bf = *(const LAS bf16x8*)(U_l + cb * 8448 + uoff + 64 * ks); acc = MFMA16(Tf[ks], Bf, acc); }
#pragma unroll
                    for (int k2 = 0; k2 < 4; ++k2) { const bf16x8 Bx = *(const LAS bf16x8*)(Xs_l + (cb * 16 + l15) * 136 + 32 * k2 + 8 * l4); acc = MFMA16(Wo[k2], Bx, acc); }
                    u32x2 o; o.x = pk2(gelu_tanh(acc[0]), gelu_tanh(acc[1])); o.y = pk2(gelu_tanh(acc[2]), gelu_tanh(acc[3]));
                    const size_t tok = (size_t)b * SEQ + 16 * (ps * 64 + cb * 16 + l15) + tau;
                    *(u32x2*)(Y + tok * 1024 + 16 * g + 4 * l4) = o;
                }
            }
            __syncthreads();
        }
    }
}

template <int D, int NKB, bool SWA>
__device__ __forceinline__ void attn_task(const bf16* qrow, const LAS unsigned char* Kl, int kstrideB, const LAS unsigned char* Vl, int vstrideB, int kb0,
                                          const LAS float* biasr, int qloc, bool first_blk, float sink, float scale, bf16* orow, int l) {
    const int r32 = l & 31, h = l >> 5;
    bf16x8 qf[D / 16];
#pragma unroll
    for (int s = 0; s < D / 16; ++s) qf[s] = *(const bf16x8*)(qrow + 16 * s + 8 * h);
    f32x16 x[NKB];
#pragma unroll
    for (int kbi = 0; kbi < NKB; ++kbi) {
#pragma unroll
        for (int i = 0; i < 16; ++i) x[kbi][i] = 0.f;
#pragma unroll
        for (int s = 0; s < D / 16; ++s) { const bf16x8 a = *(const LAS bf16x8*)(Kl + ((kb0 + kbi) * 32 + r32) * kstrideB + (16 * s + 8 * h) * 2); x[kbi] = MFMA32(a, qf[s], x[kbi]); }
    }
    float m = -INFINITY;
#pragma unroll
    for (int kbi = 0; kbi < NKB; ++kbi)
#pragma unroll
        for (int i = 0; i < 16; ++i) {
            float s = x[kbi][i] * scale;
            if (SWA) { const int kloc = (kb0 + kbi) * 32 + (i & 3) + 8 * (i >> 2) + 4 * h, dist = qloc - kloc;
                const bool valid = (dist >= 0) && (dist < 128) && (!first_blk || kloc >= 128);
                const int dcl = dist < 0 ? 0 : (dist > 127 ? 127 : dist);
                s = valid ? s + biasr[dcl] : -INFINITY; }
            x[kbi][i] = s; m = fmaxf(m, s);
        }
    m = fmaxf(m, __shfl_xor(m, 32)); if (SWA) m = fmaxf(m, sink);
    float sum = 0.f;
    u32 pk[NKB][8];
#pragma unroll
    for (int kbi = 0; kbi < NKB; ++kbi)
#pragma unroll
        for (int i = 0; i < 16; i += 2) { const float e0 = __expf(x[kbi][i] - m), e1 = __expf(x[kbi][i + 1] - m); sum += e0 + e1; pk[kbi][i >> 1] = cvtpk(e0, e1); }
    sum += __shfl_xor(sum, 32); if (SWA) sum += __expf(sink - m);
    const float inv = 1.0f / sum;
    f32x16 o[D / 32];
#pragma unroll
    for (int db = 0; db < D / 32; ++db)
#pragma unroll
        for (int i = 0; i < 16; ++i) o[db][i] = 0.f;
#pragma unroll
    for (int kbi = 0; kbi < NKB; ++kbi)
#pragma unroll
        for (int s2 = 0; s2 < 2; ++s2) {
            u32x4 pw; pw.x = pk[kbi][4 * s2]; pw.y = pk[kbi][4 * s2 + 1]; pw.z = pk[kbi][4 * s2 + 2]; pw.w = pk[kbi][4 * s2 + 3];
            const bf16x8 pb = __builtin_bit_cast(bf16x8, pw);
#pragma unroll
            for (int db = 0; db < D / 32; ++db) {
                const LAS unsigned char* vp = Vl + (db * 32 + r32) * vstrideB + ((kb0 + kbi) * 32 + 16 * s2 + 4 * h) * 2;
                const s16x4 lo = *(const LAS s16x4*)vp, hi = *(const LAS s16x4*)(vp + 16);
                const bf16x8 a = __builtin_shufflevector(lo, hi, 0, 1, 2, 3, 4, 5, 6, 7);
                o[db] = MFMA32(a, pb, o[db]);
            }
        }
#pragma unroll
    for (int db = 0; db < D / 32; ++db)
#pragma unroll
        for (int g4 = 0; g4 < 4; ++g4) { u32x2 wv; wv.x = cvtpk(o[db][4 * g4] * inv, o[db][4 * g4 + 1] * inv); wv.y = cvtpk(o[db][4 * g4 + 2] * inv, o[db][4 * g4 + 3] * inv);
            *(u32x2*)(orow + db * 32 + 8 * g4 + 4 * h) = wv; }
}

__device__ __forceinline__ void phase_swa(const Ptrs& P, LAS unsigned char* lds, int G) {
    const int tid = threadIdx.x, l = tid & 63, w = __builtin_amdgcn_readfirstlane(tid >> 6);
    unsigned char* ws = P.ws;
    const bf16* Qb = (const bf16*)(ws + WS_Q); const bf16* Kb = (const bf16*)(ws + WS_K); const bf16* Vb = (const bf16*)(ws + WS_V); bf16* Ym = (bf16*)(ws + WS_YMIX);
    const float* bt = (const float*)(ws + WS_BIAS_TAB); const float* sinks = P.in[15];
    LAS unsigned char* Kl = lds;
    LAS unsigned char* Vl = lds + 36864;
    LAS float* bias_l = (LAS float*)(lds + 36864 + 33280);
    for (int it = blockIdx.x; it < 1024; it += G) {
        const int g = it & 3, n = (it >> 2) & 31, b = it >> 7;
        __syncthreads();
#pragma unroll
        for (int i = 0; i < 4; ++i) { const int e = tid + 512 * i, key = e >> 3, part = e & 7; const int kpos = n * 128 - 128 + key;
            u32x4 v = (u32x4){0u, 0u, 0u, 0u};
            if (kpos >= 0) v = *(const u32x4*)(Kb + ((size_t)b * SEQ + kpos) * 256 + g * 64 + part * 8);
            *(LAS u32x4*)(Kl + key * 144 + part * 16) = v; }
#pragma unroll
        for (int i = 0; i < 4; ++i) { const int e = tid + 512 * i, key = e & 255, part = e >> 8; const int kpos = n * 128 - 128 + key;
            u32x4 v = (u32x4){0u, 0u, 0u, 0u};
            if (kpos >= 0) v = *(const u32x4*)(Vb + ((size_t)b * SEQ + kpos) * 256 + g * 64 + part * 8);
#pragma unroll
            for (int jj = 0; jj < 8; ++jj) { const unsigned wv = v[jj >> 1]; *(LAS bf16*)(Vl + (part * 8 + jj) * 520 + key * 2) = (bf16)((jj & 1) ? (wv >> 16) : (wv & 0xffffu)); } }
        bias_l[tid] = bt[(4 * g + (tid >> 7)) * 128 + (tid & 127)];
        __syncthreads();
        const int r = w >> 1, hq = 4 * g + r; const float sink = sinks[hq];
#pragma unroll 1
        for (int t = 0; t < 2; ++t) {
            const int qq = 2 * (w & 1) + t, r32 = l & 31;
            const size_t qtok = (size_t)b * SEQ + n * 128 + 32 * qq + r32;
            attn_task<64, 5, true>(Qb + qtok * 1024 + hq * 64, Kl, 144, Vl, 520, qq, bias_l + r * 128, 128 + 32 * qq + r32, n == 0, sink, 0.125f,
                                   Ym + qtok * 2048 + 1024 + hq * 64, l);
        }
    }
}

__device__ __forceinline__ void phase_cross(const Ptrs& P, LAS unsigned char* lds, int G) {
    const int tid = threadIdx.x, l = tid & 63, w = __builtin_amdgcn_readfirstlane(tid >> 6);
    unsigned char* ws = P.ws;
    const bf16* Qc = (const bf16*)(ws + WS_QC); const bf16* KV = (const bf16*)(ws + WS_KV_C); bf16* Oc = (bf16*)(ws + WS_OC);
    LAS unsigned char* Kl = lds;
    LAS unsigned char* Vl = lds + 69632;
    int prev = -1;
    for (int it = blockIdx.x; it < 512; it += G) {
        const int qb = it & 15, hd = (it >> 4) & 3, b = it >> 6;
        if ((it >> 4) != prev) {
            prev = it >> 4;
            __syncthreads();
#pragma unroll
            for (int i = 0; i < 8; ++i) { const int e = tid + 512 * i, key = e >> 4, part = e & 15;
                *(LAS u32x4*)(Kl + key * 272 + part * 16) = *(const u32x4*)(KV + ((size_t)b * 256 + key) * 1024 + hd * 128 + part * 8); }
#pragma unroll
            for (int i = 0; i < 8; ++i) { const int e = tid + 512 * i, key = e & 255, part = e >> 8;
                const u32x4 v = *(const u32x4*)(KV + ((size_t)b * 256 + key) * 1024 + 512 + hd * 128 + part * 8);
#pragma unroll
                for (int jj = 0; jj < 8; ++jj) { const unsigned wv = v[jj >> 1]; *(LAS bf16*)(Vl + (part * 8 + jj) * 520 + key * 2) = (bf16)((jj & 1) ? (wv >> 16) : (wv & 0xffffu)); } }
            __syncthreads();
        }
        const size_t qtok = (size_t)b * SEQ + qb * 256 + 32 * w + (l & 31);
        attn_task<128, 8, false>(Qc + qtok * 512 + hd * 128, Kl, 272, Vl, 520, 0, (const LAS float*)lds, 0, false, 0.f, 0.08838834764831845f, Oc + qtok * 512 + hd * 128, l);
    }
}
__device__ __forceinline__ void topk_wave32(LAS unsigned char* wb, int l, int* TI, float* TG, size_t obase, size_t ostride) {
    const int j = l >> 1, half = l & 1, sw = 2 * (j & 7);
    u32 v[16];
#pragma unroll
    for (int gq = 0; gq < 4; ++gq) {
        u32 t[16];
#pragma unroll
        for (int i4 = 0; i4 < 4; ++i4) { const int i = 4 * gq + i4, ci = 2 * i + half, phys = ci ^ sw; const f32x4 f = *(const LAS f32x4*)(wb + j * 512 + phys * 16);
#pragma unroll
            for (int e = 0; e < 4; ++e) t[4 * i4 + e] = (f2key(f[e]) & ~0x7Fu) | (u32)(127 - (8 * i + 4 * half + e)); }
        sort16_desc(t);
        if (gq == 0) {
#pragma unroll
            for (int i = 0; i < 16; ++i) v[i] = t[i];
        } else merge_top16_desc(v, t);
    }
    LDS_WAIT(); asm volatile("" ::: "memory");
    {
        u32 o[16];
#pragma unroll
        for (int i = 0; i < 16; ++i) o[i] = (u32)__shfl_xor((int)v[i], 1);
        merge_top16_desc(v, o);
    }
    LAS u32* lut = (LAS u32*)wb;
#pragma unroll
    for (int i = 0; i < 16; ++i) lut[l * 16 + i] = v[i];
    float va[16], vb[16];
    {
        const bool c1 = (l >> 1) & 1;
#pragma unroll
        for (int i = 0; i < 16; ++i) { const u32 o = (u32)__shfl_xor((int)v[i], 2); const u32 a = c1 ? o : v[i], b = c1 ? v[i] : o; va[i] = key2f(a & ~0x7Fu); vb[i] = key2f(b & ~0x7Fu); }
    }
#define CAND(i, q) ((f2key(va[i] + vb[q]) & ~0xFFu) | (u32)(255 - (16 * (i) + (q))))
    u32 c[16];
    {
        u32 t[16];
#pragma unroll
        for (int q = 0; q < 16; ++q) c[q] = CAND(0, q);
        sort16_desc(c);
#pragma unroll
        for (int q = 0; q < 8; ++q) t[q] = CAND(1, q);
#pragma unroll
        for (int q = 0; q < 5; ++q) t[8 + q] = CAND(2, q);
        t[13] = CAND(3, 0); t[14] = CAND(3, 1); t[15] = CAND(3, 2);
        sort16_desc(t); merge_top16_desc(c, t);
        t[0] = CAND(3, 3); t[1] = CAND(4, 0); t[2] = CAND(4, 1); t[3] = CAND(4, 2); t[4] = CAND(5, 0); t[5] = CAND(5, 1); t[6] = CAND(6, 0); t[7] = CAND(6, 1);
        t[8] = CAND(7, 0); t[9] = CAND(7, 1); t[10] = CAND(8, 0); t[11] = CAND(9, 0); t[12] = CAND(10, 0); t[13] = CAND(11, 0); t[14] = CAND(12, 0); t[15] = CAND(13, 0);
        sort16_desc(t); merge_top16_desc(c, t);
        insert_top16_desc(c, CAND(14, 0)); insert_top16_desc(c, CAND(15, 0));
    }
#undef CAND
    LDS_WAIT(); asm volatile("" ::: "memory");
    float best[16]; int eidx[16];
    const int la = (l & ~2) * 16, lb = (l | 2) * 16;
#pragma unroll
    for (int r = 0; r < 16; ++r) { const u32 key = c[r]; const int pos = 255 - (int)(key & 0xFFu); best[r] = key2f(key & ~0xFFu);
        const int k0 = 127 - (int)(lut[la + (pos >> 4)] & 0x7Fu), k1 = 127 - (int)(lut[lb + (pos & 15)] & 0x7Fu); eidx[r] = k0 * 128 + k1; }
    float s = 0.f;
#pragma unroll
    for (int r = 0; r < 16; ++r) { best[r] = __expf(best[r] - key2f(c[0] & ~0xFFu)); s += best[r]; }
    const float inv = 1.0f / s;
    if ((l & 3) == 0) {
        const size_t o = obase + (size_t)(l >> 2) * ostride;
#pragma unroll
        for (int r4 = 0; r4 < 4; ++r4) { *(int4*)(TI + o + 4 * r4) = make_int4(eidx[4 * r4], eidx[4 * r4 + 1], eidx[4 * r4 + 2], eidx[4 * r4 + 3]);
            *(f32x4*)(TG + o + 4 * r4) = (f32x4){best[4 * r4] * inv, best[4 * r4 + 1] * inv, best[4 * r4 + 2] * inv, best[4 * r4 + 3] * inv}; }
    }
    LDS_WAIT(); asm volatile("" ::: "memory");
}
struct EpiTopk {
    static constexpr bool PERM = true, AFTER_DRAIN = true;
    const float* PS; int* TI; float* TG;
    __device__ __forceinline__ void fused(const pg8::f32x4 (&acc)[2][2][4][2], const pg8::Unit& u, int wr, int wc, int fr, int fq, LAS unsigned char* lds, int wid, int lane) const {
        const int cb0 = (8 * wc + 2 * fq) ^ (4 * (fr & 3));
        LAS unsigned char* wq0 = lds + (4 * wr) * 16384 + (2 * fr) * 512 + cb0 * 16;
        LAS unsigned char* wq1 = lds + (4 * wr) * 16384 + (2 * fr + 1) * 512 + (cb0 ^ 2) * 16;
#pragma unroll
        for (int ai = 0; ai < 2; ++ai) {
#pragma unroll
            for (int m = 0; m < 4; ++m) { const size_t row = (size_t)(u.pm * 256 + ai * 128 + wr * 64 + m * 16 + fr); const float r = pg8::row_rnorm(PS, row);
#pragma unroll
                for (int n = 0; n < 2; ++n) { *(LAS f32x4*)(wq0 + m * 16384 + n * 16) = acc[ai][0][m][n] * r; *(LAS f32x4*)(wq1 + m * 16384 + n * 16) = acc[ai][1][m][n] * r; } }
            __syncthreads();
            topk_wave32(lds + wid * 16384, lane, TI, TG, ((size_t)(u.pm * 256 + ai * 128 + 16 * wid) * 8 + u.pn) * 16, 128);
            __syncthreads();
        }
    }
};

typedef float f32x2 __attribute__((ext_vector_type(2)));

typedef float v32f_t __attribute__((ext_vector_type(32)));
struct PeerBuf { v6u_t u0, u1, v0, v1; u32x2 sc0, sc1; };
#define PEER_LD6(rs, so) ({ const u32x4 a_ = __builtin_bit_cast(u32x4, __builtin_amdgcn_raw_buffer_load_b128(rs, 16 * l, so, 0)); const u32x2 b_ = __builtin_bit_cast(u32x2, __builtin_amdgcn_raw_buffer_load_b64(rs, 1024 + 8 * l, so, 0)); (v6u_t){a_.x, a_.y, a_.z, a_.w, b_.x, b_.y}; })
template <class RS> __device__ __forceinline__ void peer_issue(PeerBuf& B, const RS& rsU, const RS& rsV, const RS& rsS, int ivA, int ivB, int k0, int l) {
    const int iv = (k0 & 64) ? ivB : ivA;
    const int e0 = __builtin_amdgcn_readlane(iv, (k0 & 63)), e1 = __builtin_amdgcn_readlane(iv, (k0 & 63) + 1);
    B.sc0 = __builtin_bit_cast(u32x2, __builtin_amdgcn_raw_buffer_load_b64(rsS, 0, e0 * 8, 0)); B.sc1 = __builtin_bit_cast(u32x2, __builtin_amdgcn_raw_buffer_load_b64(rsS, 0, e1 * 8, 0));
    B.u0 = PEER_LD6(rsU, e0 * PEER_ROW_BYTES); B.u1 = PEER_LD6(rsU, e1 * PEER_ROW_BYTES); B.v0 = PEER_LD6(rsV, e0 * PEER_ROW_BYTES); B.v1 = PEER_LD6(rsV, e1 * PEER_ROW_BYTES);
}
typedef __bf16 v32bf_t __attribute__((ext_vector_type(32)));
typedef __bf16 bf16x2v __attribute__((ext_vector_type(2)));
__device__ __forceinline__ float peer_dot6(v6u_t w, const u32 (&xp)[16]) { const v32bf_t f = __builtin_amdgcn_cvt_scalef32_pk32_bf16_fp6(w, 1.0f); float s = 0.f;
#define PD2(pp) s = __builtin_amdgcn_fdot2_f32_bf16(__builtin_bit_cast(bf16x2v, xp[pp]), __builtin_shufflevector(f, f, 2 * (pp), 2 * (pp) + 1), s, false);
    PD2(0) PD2(1) PD2(2) PD2(3) PD2(4) PD2(5) PD2(6) PD2(7) PD2(8) PD2(9) PD2(10) PD2(11) PD2(12) PD2(13) PD2(14) PD2(15)
#undef PD2
    return s; }
__device__ __forceinline__ void peer_axpy6(v6u_t w, float c, float (&acc)[32]) { const v32f_t f = __builtin_amdgcn_cvt_scalef32_pk32_f32_fp6(w, 1.0f);
#pragma unroll
    for (int i = 0; i < 32; ++i) acc[i] += c * f[i]; }
__device__ __forceinline__ void peer_axpy6v(v6u_t w, float c, v32f_t& acc) { const v32f_t f = __builtin_amdgcn_cvt_scalef32_pk32_f32_fp6(w, 1.0f); acc = acc + f * c; }
__device__ __forceinline__ void peer_compute(const PeerBuf& B, const u32 (&xr)[16], float (&acc)[32], float rn, int ivA, int ivB, float gvA, float gvB, int k0, int l) {
    const float gv = (k0 & 64) ? gvB : gvA; const int kk = k0 & 63;
    const float d0 = peer_dot6(B.u0, xr); __builtin_amdgcn_sched_barrier(0);
    const float d1 = peer_dot6(B.u1, xr); __builtin_amdgcn_sched_barrier(0);
    const bool o1 = l & 1;
    float t = (o1 ? d1 : d0) + __shfl_xor(o1 ? d0 : d1, 1);
#pragma unroll
    for (int o = 2; o < 64; o <<= 1) t += __shfl_xor(t, o);
    const float g0 = __uint_as_float(__builtin_amdgcn_readlane(__float_as_uint(gv), kk)), g1 = __uint_as_float(__builtin_amdgcn_readlane(__float_as_uint(gv), kk + 1));
    const float su = __uint_as_float(o1 ? B.sc1.x : B.sc0.x), sv = __uint_as_float(o1 ? B.sc1.y : B.sc0.y), gg = o1 ? g1 : g0;
    const float cf = gg * gelu_tanh(t * su * rn) * sv;
    const float c0 = __uint_as_float(__builtin_amdgcn_readlane(__float_as_uint(cf), 0)), c1 = __uint_as_float(__builtin_amdgcn_readlane(__float_as_uint(cf), 1));
    __builtin_amdgcn_sched_barrier(0);
    peer_axpy6(B.v0, c0, acc); __builtin_amdgcn_sched_barrier(0);
    peer_axpy6(B.v1, c1, acc); __builtin_amdgcn_sched_barrier(0);
}
#define XB_TMO      128
#define XB_XCNT(j)  (256  + 64 * (j))
#define XB_XSUB(j)  (1280 + 64 * (j))
#define XB_XGEN(j)  (2304 + 64 * (j))
#define XB_TOP      3328
#define XB_TOPGEN   3392
#define XCD_BAR_WORDS 3456
#define XB_SPIN_CAP (1u << 20)
__device__ __forceinline__ unsigned xb_ld(unsigned* p)              { return __hip_atomic_load(p, __ATOMIC_RELAXED, __HIP_MEMORY_SCOPE_AGENT); }
__device__ __forceinline__ unsigned xb_add(unsigned* p, unsigned v) { return __hip_atomic_fetch_add(p, v, __ATOMIC_RELAXED, __HIP_MEMORY_SCOPE_AGENT); }
__device__ __forceinline__ unsigned xb_xcc_id() { return (unsigned)__builtin_amdgcn_s_getreg((3 << 11) | 20) & 0xFu; }
#define XB_SPIN(cond, bar) do { unsigned _sp = 0; while (cond) { __builtin_amdgcn_s_sleep(1); \
    if ((++_sp & 255u) == 0u) { if (xb_ld(&(bar)[XB_TMO])) break; if (_sp > XB_SPIN_CAP) { atomicAdd(&(bar)[XB_TMO], 1u); break; } } } } while (0)
struct XcdBarrier { unsigned* bar; unsigned x; volatile LAS unsigned* st; };
__device__ __forceinline__ XcdBarrier xcd_barrier_post(unsigned* bar, volatile LAS unsigned* st) {
    XcdBarrier b; b.bar = bar; b.x = xb_xcc_id(); b.st = st;
    if (threadIdx.x == 0) (void)xb_add(&bar[XB_XCNT(b.x)], 1u);
    return b;
}
__device__ __forceinline__ void xcd_barrier_complete(unsigned* bar, unsigned x, unsigned& nloc, unsigned& nx) {
    const unsigned G = gridDim.x * gridDim.y * gridDim.z;
    unsigned sum, cnt, mine, sp = 0u;
    for (;;) {
        sum = 0u; cnt = 0u; mine = 0u;
#pragma unroll
        for (unsigned j = 0; j < 16; ++j) { const unsigned c = xb_ld(&bar[XB_XCNT(j)]); sum += c; cnt += (c > 0u) ? 1u : 0u; mine = (j == x) ? c : mine; }
        if (sum == G) break;
        __builtin_amdgcn_s_sleep(1);
        if ((++sp & 255u) == 0u) { if (xb_ld(&bar[XB_TMO])) break; if (sp > XB_SPIN_CAP) { atomicAdd(&bar[XB_TMO], 1u); break; } }
    }
    nloc = mine > 0u ? mine : 1u; nx = cnt > 0u ? cnt : 1u;
}
__device__ __forceinline__ void xcd_barrier(const XcdBarrier& b) {
    asm volatile("s_waitcnt vmcnt(0)" ::: "memory");
    __syncthreads();
    if (threadIdx.x == 0) {
        unsigned* bar = b.bar;
        __builtin_amdgcn_s_waitcnt(0);
        unsigned nloc = b.st[0], nx = b.st[1];
        if (nloc == 0u) { xcd_barrier_complete(bar, b.x, nloc, nx); b.st[0] = nloc; b.st[1] = nx; }
        const unsigned old = xb_add(&bar[XB_XSUB(b.x)], 1u);
        const unsigned gen = old / nloc;
        if (old + 1u == (gen + 1u) * nloc) {
            __builtin_amdgcn_fence(__ATOMIC_RELEASE, "agent");
            asm volatile("s_waitcnt vmcnt(0)" ::: "memory");
            const unsigned og = xb_add(&bar[XB_TOP], 1u);
            const unsigned tg = og / nx;
            if (og + 1u == (tg + 1u) * nx) xb_add(&bar[XB_TOPGEN], 1u);
            else XB_SPIN(xb_ld(&bar[XB_TOPGEN]) == tg, bar);
            __builtin_amdgcn_fence(__ATOMIC_ACQUIRE, "agent");
            xb_add(&bar[XB_XGEN(b.x)], 1u);
            asm volatile("s_waitcnt vmcnt(0)" ::: "memory");
        } else {
            XB_SPIN(xb_ld(&bar[XB_XGEN(b.x)]) == gen, bar);
            __builtin_amdgcn_fence(__ATOMIC_ACQUIRE, "agent");
            asm volatile("s_waitcnt vmcnt(0)" ::: "memory");
        }
    }
    __syncthreads();
}

template <int CTRL> __device__ __forceinline__ float dpp_f(float v) { return __int_as_float(__builtin_amdgcn_update_dpp(0, __float_as_int(v), CTRL, 0xF, 0xF, true)); }
__device__ __forceinline__ float row16_reduce8(const float (&d)[8], int ch) {
    const bool b0 = ch & 1, b1 = ch & 2;
    float e[4], f[2];
#pragma unroll
    for (int j = 0; j < 4; ++j) { const float keep = b0 ? d[2 * j + 1] : d[2 * j], give = b0 ? d[2 * j] : d[2 * j + 1]; e[j] = keep + dpp_f<0xB1>(give); }
#pragma unroll
    for (int m = 0; m < 2; ++m) { const float keep = b1 ? e[2 * m + 1] : e[2 * m], give = b1 ? e[2 * m] : e[2 * m + 1]; f[m] = keep + dpp_f<0x4E>(give); }
#pragma unroll
    for (int m = 0; m < 2; ++m) { f[m] += dpp_f<0x128>(f[m]); f[m] += dpp_f<0x124>(f[m]); }
    return (ch & 4) ? f[1] : f[0];
}
struct PeerHalf { v6u_t w0, w1, w2, w3, w4, w5, w6, w7; };
__device__ __forceinline__ void peer_q_ids(int (&el)[8], const int* p  ) {
#pragma unroll
    for (int st = 0; st < 8; ++st) el[st] = p[4 * st];
}
template <class RS> __device__ __forceinline__ void peer_q_issue(PeerHalf& B, const RS& rs, const int (&el)[8], int ch) {
#define PH_LD(st) ({ const int vo_ = el[st] * PEER_SROW; \
        const u32x4 a_ = __builtin_bit_cast(u32x4, __builtin_amdgcn_raw_buffer_load_b128(rs, vo_ + 16 * ch, 0, 0)); const u32x2 b_ = __builtin_bit_cast(u32x2, __builtin_amdgcn_raw_buffer_load_b64(rs, vo_ + 256 + 8 * ch, 0, 0)); \
        (v6u_t){a_.x, a_.y, a_.z, a_.w, b_.x, b_.y}; })
    B.w0 = PH_LD(0); B.w1 = PH_LD(1); B.w2 = PH_LD(2); B.w3 = PH_LD(3); B.w4 = PH_LD(4); B.w5 = PH_LD(5); B.w6 = PH_LD(6); B.w7 = PH_LD(7);
#undef PH_LD
}
__device__ __forceinline__ void peer_q_dots(const PeerHalf& B, const u32 (&xs)[16], LAS float* pd  , int ch) {
    float d[8], old[8];
#pragma unroll
    for (int st = 0; st < 8; ++st) old[st] = pd[4 * st];
    d[0] = peer_dot6(B.w0, xs); __builtin_amdgcn_sched_barrier(0); d[1] = peer_dot6(B.w1, xs); __builtin_amdgcn_sched_barrier(0);
    d[2] = peer_dot6(B.w2, xs); __builtin_amdgcn_sched_barrier(0); d[3] = peer_dot6(B.w3, xs); __builtin_amdgcn_sched_barrier(0);
    d[4] = peer_dot6(B.w4, xs); __builtin_amdgcn_sched_barrier(0); d[5] = peer_dot6(B.w5, xs); __builtin_amdgcn_sched_barrier(0);
    d[6] = peer_dot6(B.w6, xs); __builtin_amdgcn_sched_barrier(0); d[7] = peer_dot6(B.w7, xs); __builtin_amdgcn_sched_barrier(0);
#pragma unroll
    for (int o = 1; o < 16; o <<= 1)
#pragma unroll
        for (int st = 0; st < 8; ++st) d[st] += __shfl_xor(d[st], o);
    if (ch == 0) {
#pragma unroll
        for (int st = 0; st < 8; ++st) pd[4 * st] = old[st] + d[st];
    }
}
__device__ __forceinline__ void peer_q_axpy(const PeerHalf& B, const LAS float* pd  , v32f_t& acc) {
    float cf[8];
#pragma unroll
    for (int st = 0; st < 8; ++st) cf[st] = pd[4 * st];
    peer_axpy6v(B.w0, cf[0], acc); __builtin_amdgcn_sched_barrier(0); peer_axpy6v(B.w1, cf[1], acc); __builtin_amdgcn_sched_barrier(0);
    peer_axpy6v(B.w2, cf[2], acc); __builtin_amdgcn_sched_barrier(0); peer_axpy6v(B.w3, cf[3], acc); __builtin_amdgcn_sched_barrier(0);
    peer_axpy6v(B.w4, cf[4], acc); __builtin_amdgcn_sched_barrier(0); peer_axpy6v(B.w5, cf[5], acc); __builtin_amdgcn_sched_barrier(0);
    peer_axpy6v(B.w6, cf[6], acc); __builtin_amdgcn_sched_barrier(0); peer_axpy6v(B.w7, cf[7], acc); __builtin_amdgcn_sched_barrier(0);
}
#define PH_LD1(st) ({ const int vo_ = el[st] * PEER_SROW; \
        const u32x4 a_ = __builtin_bit_cast(u32x4, __builtin_amdgcn_raw_buffer_load_b128(rs, vo_ + 16 * ch, 0, 0)); const u32x2 b_ = __builtin_bit_cast(u32x2, __builtin_amdgcn_raw_buffer_load_b64(rs, vo_ + 256 + 8 * ch, 0, 0)); \
        (v6u_t){a_.x, a_.y, a_.z, a_.w, b_.x, b_.y}; })
template <class RS> __device__ __forceinline__ void peer_q_issue_dots(PeerHalf& N, const RS& rs, const int (&el)[8], const PeerHalf& B, const u32 (&xs)[16], LAS float* pd, int ch) {
    float d[8];
    const float old = pd[4 * (ch & 7)];
    N.w0 = PH_LD1(0); d[0] = peer_dot6(B.w0, xs); __builtin_amdgcn_sched_barrier(0); N.w1 = PH_LD1(1); d[1] = peer_dot6(B.w1, xs); __builtin_amdgcn_sched_barrier(0);
    N.w2 = PH_LD1(2); d[2] = peer_dot6(B.w2, xs); __builtin_amdgcn_sched_barrier(0); N.w3 = PH_LD1(3); d[3] = peer_dot6(B.w3, xs); __builtin_amdgcn_sched_barrier(0);
    N.w4 = PH_LD1(4); d[4] = peer_dot6(B.w4, xs); __builtin_amdgcn_sched_barrier(0); N.w5 = PH_LD1(5); d[5] = peer_dot6(B.w5, xs); __builtin_amdgcn_sched_barrier(0);
    N.w6 = PH_LD1(6); d[6] = peer_dot6(B.w6, xs); __builtin_amdgcn_sched_barrier(0); N.w7 = PH_LD1(7); d[7] = peer_dot6(B.w7, xs); __builtin_amdgcn_sched_barrier(0);
    const float tot = row16_reduce8(d, ch);
    if (ch < 8) pd[4 * ch] = old + tot;
}
template <class RS> __device__ __forceinline__ void peer_q_issue_axpy(PeerHalf& N, const RS& rs, const int (&el)[8], int ch, const PeerHalf& B, const LAS float* pd, v32f_t& acc) {
    float cf[8];
#pragma unroll
    for (int st = 0; st < 8; ++st) cf[st] = pd[4 * st];
    N.w0 = PH_LD1(0); peer_axpy6v(B.w0, cf[0], acc); __builtin_amdgcn_sched_barrier(0); N.w1 = PH_LD1(1); peer_axpy6v(B.w1, cf[1], acc); __builtin_amdgcn_sched_barrier(0);
    N.w2 = PH_LD1(2); peer_axpy6v(B.w2, cf[2], acc); __builtin_amdgcn_sched_barrier(0); N.w3 = PH_LD1(3); peer_axpy6v(B.w3, cf[3], acc); __builtin_amdgcn_sched_barrier(0);
    N.w4 = PH_LD1(4); peer_axpy6v(B.w4, cf[4], acc); __builtin_amdgcn_sched_barrier(0); N.w5 = PH_LD1(5); peer_axpy6v(B.w5, cf[5], acc); __builtin_amdgcn_sched_barrier(0);
    N.w6 = PH_LD1(6); peer_axpy6v(B.w6, cf[6], acc); __builtin_amdgcn_sched_barrier(0); N.w7 = PH_LD1(7); peer_axpy6v(B.w7, cf[7], acc); __builtin_amdgcn_sched_barrier(0);
}
#undef PH_LD1
__device__ __forceinline__ void phase_peer(const Ptrs& P, LAS unsigned char* lds, int G, const XcdBarrier* bar) {
    const int tid = threadIdx.x, l = tid & 63, w = __builtin_amdgcn_readfirstlane(tid >> 6);
    unsigned char* ws = P.ws;
    const bf16* HN = (const bf16*)(ws + WS_HN); const float* SUV = (const float*)(ws + WS_PEER_SU);
    const int* TI = (const int*)(ws + WS_TK_IDX); const float* TG = (const float*)(ws + WS_TK_G); float* out = P.out; const float* gfin = P.in[27]; const float* PS = (const float*)(ws + WS_PS);
    LAS float* PD = (LAS float*)(lds + w * 8192);
    LAS float* SS = (LAS float*)(lds + 65536 + w * 64);
    const int es = l >> 4, ch = l & 15, stride = G * NWAVES, tok0 = blockIdx.x * NWAVES + w;
    (void)bar;
    if (l < 16) SS[l] = 0.f;
#pragma unroll
    for (int q = 0; q < 8; ++q) *(LAS f32x4*)(PD + 4 * l + 256 * q) = (f32x4){0.f, 0.f, 0.f, 0.f};
#pragma unroll 1
    for (int s = 0; s < 4; ++s) {
        const auto rsU = __builtin_amdgcn_make_buffer_rsrc((void*)(ws + WS_PEER_U + (size_t)s * PEER_SLICE_BYTES), 0, (int)PEER_SLICE_BYTES, 0x00020000);
        PeerHalf A, B;
        int elA[8], elB[8];
        u32 xs[16];
#pragma unroll
        for (int q = 0; q < 8; ++q) { const u32x2 a = *(const u32x2*)(HN + (size_t)tok0 * DM + 512 * s + 64 * q + 4 * ch); xs[2 * q] = a.x; xs[2 * q + 1] = a.y; }
        peer_q_ids(elA, TI + (size_t)tok0 * 128 + es); peer_q_ids(elB, TI + (size_t)tok0 * 128 + 32 + es);
        peer_q_issue(A, rsU, elA, ch);
#pragma unroll 1
        for (int i = 0; i < 16; ++i) {
            const size_t tok = (size_t)(tok0 + i * stride), ntok = (size_t)(tok0 + (i < 15 ? i + 1 : i) * stride);
            u32 nxs[16];
#pragma unroll
            for (int q = 0; q < 8; ++q) { const u32x2 a = *(const u32x2*)(HN + ntok * DM + 512 * s + 64 * q + 4 * ch); nxs[2 * q] = a.x; nxs[2 * q + 1] = a.y; }
            peer_q_ids(elA, TI + tok * 128 + 64 + es);   __builtin_amdgcn_sched_barrier(0);   peer_q_issue_dots(B, rsU, elB, A, xs, PD + i * 128 + es, ch);
            peer_q_ids(elB, TI + tok * 128 + 96 + es);   __builtin_amdgcn_sched_barrier(0);   peer_q_issue_dots(A, rsU, elA, B, xs, PD + i * 128 + 32 + es, ch);
            peer_q_ids(elA, TI + ntok * 128 + es);   __builtin_amdgcn_sched_barrier(0);   peer_q_issue_dots(B, rsU, elB, A, xs, PD + i * 128 + 64 + es, ch);
            peer_q_ids(elB, TI + ntok * 128 + 32 + es);   __builtin_amdgcn_sched_barrier(0);   peer_q_issue_dots(A, rsU, elA, B, xs, PD + i * 128 + 96 + es, ch);
#pragma unroll
            for (int q = 0; q < 16; ++q) xs[q] = nxs[q];
        }
    }
#pragma unroll 1
    for (int hb = 0; hb < 2; ++hb) {
        int ce[8][2]; float cg[8][2], cps[8];
#pragma unroll
        for (int j = 0; j < 8; ++j) { const size_t tok = (size_t)(tok0 + (8 * hb + j) * stride);
            cps[j] = l < 32 ? PS[tok * 32 + l] : 0.f;
            ce[j][0] = TI[tok * 128 + l]; ce[j][1] = TI[tok * 128 + 64 + l]; cg[j][0] = TG[tok * 128 + l]; cg[j][1] = TG[tok * 128 + 64 + l]; }
        f32x2 csc[8][2];
#pragma unroll
        for (int j = 0; j < 8; ++j) { csc[j][0] = *(const f32x2*)(SUV + 2 * ce[j][0]); csc[j][1] = *(const f32x2*)(SUV + 2 * ce[j][1]); }
#pragma unroll
        for (int j = 0; j < 8; ++j) { const int i = 8 * hb + j;
            const float rn = __builtin_amdgcn_rsqf(wave_sum(cps[j]) * (1.0f / 2048.0f) + NORM_EPS);
#pragma unroll
            for (int hh = 0; hh < 2; ++hh) { const int k = 64 * hh + l; PD[i * 128 + k] = cg[j][hh] * gelu_tanh(PD[i * 128 + k] * csc[j][hh].x * rn) * csc[j][hh].y; } }
    }
#pragma unroll 1
    for (int s = 0; s < 4; ++s) {
        const auto rsV = __builtin_amdgcn_make_buffer_rsrc((void*)(ws + WS_PEER_V + (size_t)s * PEER_SLICE_BYTES), 0, (int)PEER_SLICE_BYTES, 0x00020000);
        PeerHalf A, B;
        int elA[8], elB[8];
        peer_q_ids(elA, TI + (size_t)tok0 * 128 + es); peer_q_ids(elB, TI + (size_t)tok0 * 128 + 32 + es);
        peer_q_issue(A, rsV, elA, ch);
#pragma unroll 1
        for (int i = 0; i < 16; ++i) {
            const size_t tok = (size_t)(tok0 + i * stride), ntok = (size_t)(tok0 + (i < 15 ? i + 1 : i) * stride);
            u32x2 hw[2];
#pragma unroll
            for (int j = 0; j < 2; ++j) hw[j] = *(const u32x2*)(HN + tok * DM + 512 * s + 64 * (2 * es + j) + 4 * ch);
            v32f_t acc;
#pragma unroll
            for (int c = 0; c < 32; ++c) acc[c] = 0.f;
            peer_q_ids(elA, TI + tok * 128 + 64 + es);   __builtin_amdgcn_sched_barrier(0);   peer_q_issue_axpy(B, rsV, elB, ch, A, PD + i * 128 + es, acc);
            peer_q_ids(elB, TI + tok * 128 + 96 + es);   __builtin_amdgcn_sched_barrier(0);   peer_q_issue_axpy(A, rsV, elA, ch, B, PD + i * 128 + 32 + es, acc);
            peer_q_ids(elA, TI + ntok * 128 + es);   __builtin_amdgcn_sched_barrier(0);   peer_q_issue_axpy(B, rsV, elB, ch, A, PD + i * 128 + 64 + es, acc);
            peer_q_ids(elB, TI + ntok * 128 + 32 + es);   __builtin_amdgcn_sched_barrier(0);   peer_q_issue_axpy(A, rsV, elA, ch, B, PD + i * 128 + 96 + es, acc);
            float r1[16], r2[8];
#pragma unroll
            for (int c = 0; c < 16; ++c) { const auto pp = __builtin_amdgcn_permlane32_swap(__float_as_uint(acc[c]), __float_as_uint(acc[c + 16]), false, false); r1[c] = __uint_as_float(pp[0]) + __uint_as_float(pp[1]); }
#pragma unroll
            for (int c = 0; c < 8; ++c) { const auto pp = __builtin_amdgcn_permlane16_swap(__float_as_uint(r1[c]), __float_as_uint(r1[c + 8]), false, false); r2[c] = __uint_as_float(pp[0]) + __uint_as_float(pp[1]); }
            float ss = 0.f;
            {
                float* op = out + tok * DM + 512 * s + 128 * es + 4 * ch;
#pragma unroll
                for (int j = 0; j < 2; ++j) {
                    const f32x4 o0 = {r2[4 * j] + bflo(hw[j].x), r2[4 * j + 1] + bfhi(hw[j].x), r2[4 * j + 2] + bflo(hw[j].y), r2[4 * j + 3] + bfhi(hw[j].y)};
                    ss += (o0[0] * o0[0] + o0[1] * o0[1]) + (o0[2] * o0[2] + o0[3] * o0[3]);
                    *(f32x4*)(op + 64 * j) = o0; }
            }
            ss = wave_sum(ss);
            if (l == 0) SS[i] += ss;
        }
    }
    asm volatile("s_waitcnt vmcnt(0) lgkmcnt(0)" ::: "memory");
    {
        f32x4 ga[8], cur[8];
#pragma unroll
        for (int j = 0; j < 8; ++j) { ga[j] = ((const f32x4*)gfin)[l + 64 * j]; cur[j] = ((const f32x4*)(out + (size_t)tok0 * DM))[l + 64 * j]; }
#pragma unroll 1
        for (int i = 0; i < 16; ++i) {
            const size_t tok = (size_t)(tok0 + i * stride), ntok = (size_t)(tok0 + (i < 15 ? i + 1 : i) * stride);
            f32x4 nxt[8];
#pragma unroll
            for (int j = 0; j < 8; ++j) nxt[j] = ((const f32x4*)(out + ntok * DM))[l + 64 * j];
            const float r = rsqrtf(SS[i] * (1.f / DM) + NORM_EPS);
            f32x4* op = (f32x4*)(out + tok * DM);
            if (i == 15) asm volatile("s_waitcnt vmcnt(0)" ::: "memory");
#pragma unroll
            for (int j = 0; j < 8; ++j) { const f32x4 o = cur[j]; op[l + 64 * j] = (f32x4){o.x * r * ga[j].x, o.y * r * ga[j].y, o.z * r * ga[j].z, o.w * r * ga[j].w}; }
#pragma unroll
            for (int j = 0; j < 8; ++j) cur[j] = nxt[j];
        }
    }
}

struct Params { const float* in[28]; float* out; unsigned char* ws; int ph_lo, ph_hi; };
constexpr int N_PHASES = 13;
#ifndef STOP_AFTER
#define STOP_AFTER 12
#endif

__global__ void __launch_bounds__(NTHREADS, 2) mega(Params prm) {
    extern __shared__ __attribute__((aligned(16))) unsigned char lds_raw[];
    LAS unsigned char* lds = (LAS unsigned char*)lds_raw;
    const int G = gridDim.x;
    Ptrs P;
#pragma unroll
    for (int i = 0; i < 28; ++i) P.in[i] = prm.in[i];
    P.out = prm.out; P.ws = prm.ws;
    unsigned char* ws = prm.ws;
    const int lo = prm.ph_lo, hi = prm.ph_hi;
#ifndef PHMASK
#define PHMASK 0x1fff
#endif
#define IN(k) (((PHMASK >> (k)) & 1) && lo <= (k) && (k) < hi)
#if ONE_LAUNCH
    volatile LAS unsigned* bst = (volatile LAS unsigned*)(lds + LDS_BYTES - 64);
    if (threadIdx.x == 0) { bst[0] = 0u; bst[1] = 0u; }
    __syncthreads();
    const XcdBarrier bar = xcd_barrier_post((unsigned*)(ws + WS_CTL), bst);
#define SEAM(k) do { if (IN(k) && IN((k) + 1)) xcd_barrier(bar); } while (0)
#ifndef PEER_SYNC
#define PEER_SYNC 0
#endif
#define PEER_BAR (PEER_SYNC ? &bar : (const XcdBarrier*)nullptr)
#else
#define SEAM(k) do { } while (0)
#define PEER_BAR ((const XcdBarrier*)nullptr)
#endif
    bf16* HN = (bf16*)(ws + WS_HN);
    if (IN(0)) { phase_prologue(P, lds, G); }
    SEAM(0);
    if (IN(1)) {
        __syncthreads();
        { pg8::Gemm g{HN, (const bf16*)(ws + WS_W_IN_T), NTOK, 2560, 2048}; pg8::StaticOrder S; S.init(NTOK, 2560, G, (int)blockIdx.x);
          pg8::EpiInProj E{(bf16*)(ws + WS_U), (bf16*)(ws + WS_Q), (bf16*)(ws + WS_K), (bf16*)(ws + WS_V)};
          pg8::gemm_phase<pg8::EpiInProj, pg8::StaticOrder, PG8_ALIGN, PG8_SP2>(lds, g, S, E); }
        __syncthreads();
        { pg8::Gemm g{(const bf16*)(ws + WS_MEM_N), (const bf16*)(ws + WS_W_CKV_T), 2048, 1024, 2048}; pg8::StaticOrder S; S.init(2048, 1024, G, (int)blockIdx.x);
          pg8::EpiBf16Plain E{(bf16*)(ws + WS_KV_C), 1024};
          pg8::gemm_phase<pg8::EpiBf16Plain, pg8::StaticOrder, PG8_ALIGN, PG8_SP2>(lds, g, S, E); }
        __syncthreads();
        {
            const int wv = __builtin_amdgcn_readfirstlane(threadIdx.x >> 6), ln = threadIdx.x & 63;
            constexpr int R1 = 32768;
            if (blockIdx.x >= 32) peer_quant_rows(P, lds, wv, ln, ((int)blockIdx.x - 32) * NWAVES + wv, (G - 32) * NWAVES, R1);
            else peer_quant_rows(P, lds, wv, ln, R1 + (int)blockIdx.x * NWAVES + wv, 32 * NWAVES, 32768);
        }
    }
    SEAM(1);
    if (IN(2)) {
#ifndef NO_S5
        __syncthreads(); phase_s5(P, lds, G);
#endif
#ifndef NO_SWA
        __syncthreads(); phase_swa(P, lds, G);
#endif
    }
    SEAM(2);
    if (IN(3)) {
        __syncthreads();
        pg8::Gemm g{(const bf16*)(ws + WS_YPRE), (const bf16*)(ws + WS_W_GLU_T), NTOK, 1024, 1024}; pg8::StaticOrder S; S.init(NTOK, 1024, G, (int)blockIdx.x);
        pg8::EpiGlu E{(bf16*)(ws + WS_YMIX), 2048, (const bf16*)(ws + WS_YPRE), 1024, P.in[14]};
        pg8::gemm_phase<pg8::EpiGlu, pg8::StaticOrder, PG8_ALIGN, PG8_SP2>(lds, g, S, E);
    }
    SEAM(3);
    if (IN(4)) {
        __syncthreads();
        pg8::Gemm g{(const bf16*)(ws + WS_YMIX), (const bf16*)(ws + WS_W_OUT_T), NTOK, 2048, 2048}; pg8::StaticOrder S; S.init(NTOK, 2048, G, (int)blockIdx.x);
        pg8::EpiResBf16<false> E{HN, P.in[0], (float*)(ws + WS_PS)};
        pg8::gemm_phase<pg8::EpiResBf16<false>, pg8::StaticOrder, PG8_ALIGN, PG8_SP2>(lds, g, S, E);
    }
    SEAM(4);
    if (IN(6)) {
        __syncthreads();
        pg8::Gemm g{HN, (const bf16*)(ws + WS_W_CQ_T), NTOK, 512, 2048}; pg8::StaticOrder S; S.init(NTOK, 512, G, (int)blockIdx.x);
        pg8::EpiBf16RowScale E{(bf16*)(ws + WS_QC), 512, (const float*)(ws + WS_PS)};
        pg8::gemm_phase<pg8::EpiBf16RowScale, pg8::StaticOrder, PG8_ALIGN, PG8_SP2>(lds, g, S, E);
    }
    SEAM(6);
    if (IN(7)) { __syncthreads(); phase_cross(P, lds, G); }
    SEAM(7);
    if (IN(8)) {
        __syncthreads();
        pg8::Gemm g{(const bf16*)(ws + WS_OC), (const bf16*)(ws + WS_W_CO_T), NTOK, 2048, 512}; pg8::StaticOrder S; S.init(NTOK, 2048, G, (int)blockIdx.x);
        pg8::EpiResBf16<true> E{HN, HN, (float*)(ws + WS_PS)};
        pg8::gemm_phase<pg8::EpiResBf16<true>, pg8::StaticOrder, PG8_ALIGN, PG8_SP2>(lds, g, S, E);
    }
    SEAM(8);
    if (IN(10)) {
        __syncthreads();
        pg8::Gemm g{HN, (const bf16*)(ws + WS_W_S_T), NTOK, 2048, 2048}; pg8::StaticOrder S; S.init(NTOK, 2048, G, (int)blockIdx.x);
        EpiTopk E{(const float*)(ws + WS_PS), (int*)(ws + WS_TK_IDX), (float*)(ws + WS_TK_G)};
        for (int i = 0; ; ++i) { pg8::Unit uu; if (!S.next(i, uu)) break; pg8::OneUnit O1{uu}; pg8::gemm_phase<EpiTopk, pg8::OneUnit, false, false>(lds, g, O1, E); }
    }
    SEAM(11);
    if (IN(12)) { __syncthreads(); phase_peer(P, lds, G, PEER_BAR); }
    if (lo <= 13 && 13 < hi) {
        const int lane = threadIdx.x & 63, wave = threadIdx.x >> 6;
        for (int m = blockIdx.x * NWAVES + wave; m < NTOK; m += G * NWAVES) {
            f32x4* xr = (f32x4*)(P.out + (size_t)m * DM) + lane; const f32x4* gr = (const f32x4*)P.in[27] + lane;
            f32x4 v[8]; float ss = 0.f;
#pragma unroll
            for (int j = 0; j < 8; ++j) { v[j] = xr[64 * j]; ss += (v[j].x * v[j].x + v[j].y * v[j].y) + (v[j].z * v[j].z + v[j].w * v[j].w); }
            const float r = rsqrtf(wave_sum(ss) * (1.f / DM) + NORM_EPS);
#pragma unroll
            for (int j = 0; j < 8; ++j) { const f32x4 g = gr[64 * j]; xr[64 * j] = (f32x4){v[j].x * r * g.x, v[j].y * r * g.y, v[j].z * r * g.z, v[j].w * r * g.w}; }
        }
    }
}

extern "C" void kernel_launch(void* const* d_in, const int* in_sizes, int n_in, void* d_out, int out_size, void* d_ws, size_t ws_size, hipStream_t stream) {
    static int grid = 0;
    if (!grid) {
        int dev = 0, cus = 0, per_cu = 0;
        if (hipGetDevice(&dev) != hipSuccess || hipDeviceGetAttribute(&cus, hipDeviceAttributeMultiprocessorCount, dev) != hipSuccess) { fprintf(stderr, "kernel_launch: device query failed\n"); return; }
        if (hipFuncSetAttribute((const void*)mega, hipFuncAttributeMaxDynamicSharedMemorySize, LDS_BYTES) != hipSuccess) { fprintf(stderr, "kernel_launch: hipFuncSetAttribute failed\n"); return; }
        if (hipOccupancyMaxActiveBlocksPerMultiprocessor(&per_cu, (const void*)mega, NTHREADS, LDS_BYTES) != hipSuccess || per_cu < 1) { fprintf(stderr, "kernel_launch: occupancy query says %d\n", per_cu); per_cu = 1; }
        grid = 256;
        if (cus != 256) fprintf(stderr, "kernel_launch: built for 256 CUs, device reports %d\n", cus);
        if (ws_size < WS_END || n_in != 28) fprintf(stderr, "kernel_launch: unexpected ws_size %zu / n_in %d\n", ws_size, n_in);
    }
    Params p{};
    for (int i = 0; i < 28; ++i) p.in[i] = (const float*)d_in[i];
    p.out = (float*)d_out; p.ws = (unsigned char*)d_ws;
#if ONE_LAUNCH
    p.ph_lo = 0; p.ph_hi = N_PHASES;
    if (hipMemsetAsync((char*)d_ws + WS_CTL, 0, CTL_ZERO_BYTES, stream) != hipSuccess) { fprintf(stderr, "kernel_launch: memset of the barrier words failed\n"); return; }
    hipLaunchKernelGGL(mega, dim3(grid), dim3(NTHREADS), LDS_BYTES, stream, p);
#else
#ifndef REPEAT_MASK
#define REPEAT_MASK 0
#endif
    for (int ph = 0; ph <= STOP_AFTER; ++ph) { p.ph_lo = ph; p.ph_hi = ph + 1;
        for (int rep = 0; rep < (((REPEAT_MASK >> ph) & 1) ? 2 : 1); ++rep) hipLaunchKernelGGL(mega, dim3(grid), dim3(NTHREADS), LDS_BYTES, stream, p); }
    if (STOP_AFTER < 12) { p.ph_lo = 13; p.ph_hi = 14; hipLaunchKernelGGL(mega, dim3(grid), dim3(NTHREADS), LDS_BYTES, stream, p); }
#endif
}
```

```cpp
#include <hip/hip_runtime.h>
#include <cstdio>
#include <cstdint>
#ifndef ONE_LAUNCH
#define ONE_LAUNCH 1
#endif
#define SN_HD __host__ __device__ __forceinline__
#ifndef SN_HD
#define SN_HD __host__ __device__ __forceinline__
#endif
typedef unsigned int u32;
SN_HD u32 sn_max(u32 a, u32 b) { return a > b ? a : b; }
SN_HD u32 sn_min(u32 a, u32 b) { return a < b ? a : b; }
SN_HD u32 f2key(float f) { u32 u = __builtin_bit_cast(u32, f); return (u & 0x80000000u) ? ~u : (u | 0x80000000u); }
SN_HD float key2f(u32 k) { u32 u = (k & 0x80000000u) ? (k & 0x7fffffffu) : ~k; return __builtin_bit_cast(float, u); }
template <int BASE> SN_HD void bitonic_merge16_desc(u32 (&v)[64]) {
#pragma unroll
    for (int j = 8; j > 0; j >>= 1) {
#pragma unroll
        for (int i = 0; i < 16; ++i) { const int l = i ^ j; if (l > i) { const u32 a = v[BASE + i], b = v[BASE + l]; v[BASE + i] = sn_max(a, b); v[BASE + l] = sn_min(a, b); } }
    }
}
template <int BASE> SN_HD void bitonic_sort16_desc(u32 (&v)[64]) {
#pragma unroll
    for (int k = 2; k <= 16; k <<= 1) {
#pragma unroll
        for (int j = k >> 1; j > 0; j >>= 1) {
#pragma unroll
            for (int i = 0; i < 16; ++i) { const int l = i ^ j; if (l > i) { const u32 a = v[BASE + i], b = v[BASE + l]; const bool desc = ((i & k) == 0);
                v[BASE + i] = desc ? sn_max(a, b) : sn_min(a, b); v[BASE + l] = desc ? sn_min(a, b) : sn_max(a, b); } }
        }
    }
}
template <int A, int B> SN_HD void merge_top16(u32 (&v)[64]) {
#pragma unroll
    for (int i = 0; i < 16; ++i) v[A + i] = sn_max(v[A + i], v[B + 15 - i]);
    bitonic_merge16_desc<A>(v);
}
SN_HD void top16_of_64(u32 (&v)[64]) {
    bitonic_sort16_desc<0>(v); bitonic_sort16_desc<16>(v); bitonic_sort16_desc<32>(v); bitonic_sort16_desc<48>(v);
    merge_top16<0, 16>(v); merge_top16<32, 48>(v); merge_top16<0, 32>(v);
}

SN_HD void merge_sorted16_desc(u32 (&a)[16]) {
#pragma unroll
    for (int j = 8; j > 0; j >>= 1) {
#pragma unroll
        for (int i = 0; i < 16; ++i) { const int l = i ^ j; if (l > i) { const u32 x = a[i], y = a[l]; a[i] = sn_max(x, y); a[l] = sn_min(x, y); } }
    }
}
SN_HD void sort16_desc(u32 (&a)[16]) {
#pragma unroll
    for (int k = 2; k <= 16; k <<= 1) {
#pragma unroll
        for (int j = k >> 1; j > 0; j >>= 1) {
#pragma unroll
            for (int i = 0; i < 16; ++i) { const int l = i ^ j; if (l > i) { const u32 x = a[i], y = a[l]; const bool desc = ((i & k) == 0);
                a[i] = desc ? sn_max(x, y) : sn_min(x, y); a[l] = desc ? sn_min(x, y) : sn_max(x, y); } }
        }
    }
}
SN_HD void merge_top16_desc(u32 (&a)[16], const u32 (&b)[16]) {
#pragma unroll
    for (int i = 0; i < 16; ++i) a[i] = sn_max(a[i], b[15 - i]);
    merge_sorted16_desc(a);
}
SN_HD void insert_top16_desc(u32 (&a)[16], u32 x) {
#pragma unroll
    for (int k = 15; k > 0; --k) a[k] = sn_max(a[k], sn_min(a[k - 1], x));
    a[0] = sn_max(a[0], x);
}
namespace pg8 {
#define PG8_LAS __attribute__((address_space(3)))
typedef unsigned short bf16_t;
typedef short bf16x8 __attribute__((ext_vector_type(8)));
typedef float f32x4 __attribute__((ext_vector_type(4)));
typedef unsigned u32x4 __attribute__((ext_vector_type(4)));
constexpr int BM = 256, BK = 64, HALF = 128, HTB = HALF * BK * 2  , STAGE_BYTES = 8 * HTB, NXCD = 8, WGM = 4;

__host__ __device__ __forceinline__ int lds_byte(int r, int c) { const int st = (r >> 4) * 2 + (c >> 5), rr = r & 15, cc = c & 31, ob = rr * 64 + cc * 2; return st * 1024 + (ob ^ (((ob >> 9) & 1) << 5)); }
__host__ __device__ __forceinline__ void stage_rc(int b, int& R, int& C) { const int st = b / 1024, sb = b % 1024, swz = sb ^ (((sb >> 9) & 1) << 5); R = (st >> 1) * 16 + swz / 64; C = (st & 1) * 32 + (swz % 64) / 2; }
__host__ __device__ __forceinline__ int perm32(int rho) { const int n = rho >> 4, i = rho & 15; return 8 * (i >> 2) + 4 * n + (i & 3); }

struct Unit { int pm, pn; };
struct Gemm { const bf16_t* A; const bf16_t* Bt; int M, N, K; };

struct StaticOrder {
    int nM, nN, nwg, G, c;
    __host__ __device__ void init(int M, int N, int G_, int c_) { nM = M / BM; nN = N / BM; nwg = nM * nN; G = G_; c = c_; }
    __host__ __device__ bool next(int i, Unit& u) const {
        const long L = (long)i * G + c; if (L >= nwg) return false;
        int wgid = (int)L; { const int q = nwg / NXCD, r = nwg % NXCD, xcd = wgid % NXCD, off = wgid / NXCD; wgid = (xcd < r ? xcd * (q + 1) : r * (q + 1) + (xcd - r) * q) + off; }
        const int nig = WGM * nN, gid = wgid / nig, fm = gid * WGM, gsz = (nM - fm) < WGM ? (nM - fm) : WGM;
        u.pm = fm + ((wgid % nig) % gsz); u.pn = (wgid % nig) / gsz; return true;
    }
    __device__ __forceinline__ void a_ready(const Unit&) const {}
    __device__ __forceinline__ void done(const Unit&) const {}
};

typedef float f32x2_t __attribute__((ext_vector_type(2)));
typedef __bf16 bf16x2_t __attribute__((ext_vector_type(2)));
struct OneUnit { Unit u;
    __device__ __forceinline__ bool next(int i, Unit& o) const { if (i) return false; o = u; return true; }
    __device__ __forceinline__ void a_ready(const Unit&) const {}
    __device__ __forceinline__ void done(const Unit&) const {} };

__device__ __forceinline__ unsigned cvt_pk_bf16(float lo, float hi) { const f32x2_t f = {lo, hi}; const bf16x2_t b = __builtin_convertvector(f, bf16x2_t); return __builtin_bit_cast(unsigned, b); }


template <class Epi, class Sched, bool ALIGN_EPI = false, bool SP2 = false>
__device__ __forceinline__ void gemm_phase(PG8_LAS unsigned char* lds, const Gemm g, const Sched& S, const Epi& E) {
    const int tid = threadIdx.x, wid = __builtin_amdgcn_readfirstlane(tid >> 6), lane = tid & 63, wr = wid >> 2, wc = wid & 3, fr = lane & 15, fq = lane >> 4;
    const int K = g.K, nt = K / BK;
    unsigned voffA[2], voffB[2];
#pragma unroll
    for (int i = 0; i < 2; ++i) { int R, C; stage_rc(tid * 16 + i * 8192, R, C); const int Rb = Epi::PERM ? ((R & ~31) + perm32(R & 31)) : R;
        voffA[i] = (unsigned)(R * K + C) * 2u; voffB[i] = (unsigned)(Rb * K + C) * 2u; }
    const size_t kstep = (size_t)(BK * 2);
    const size_t hstep = (size_t)HALF * K * 2;
    const size_t tstep = 2 * hstep;
    const unsigned ldsw = (unsigned)wid * 1024u;
    const int aoff = lds_byte(wr * 64 + fr, fq * 8), boff = lds_byte(wc * 32 + fr, fq * 8);
#define PG8_SA(b, h) (((b) * 2 + (h)) * HTB)
#define PG8_SB(b, h) ((4 + (b) * 2 + (h)) * HTB)
#define PG8_STAGE(bufoff, gbase, voff) do { _Pragma("unroll") for (int _i = 0; _i < 2; ++_i) \
        __builtin_amdgcn_global_load_lds((const unsigned*)((const char*)(gbase) + (voff)[_i]), (PG8_LAS unsigned*)(lds + (bufoff) + ldsw + _i * 8192), 16, 0, 0); } while (0)
#define PG8_LDA(dst, b, h) do { _Pragma("unroll") for (int m = 0; m < 4; ++m) _Pragma("unroll") for (int k = 0; k < 2; ++k) dst[m][k] = *(const PG8_LAS bf16x8*)(lds + PG8_SA(b, h) + aoff + m * 2048 + k * 1024); } while (0)
#define PG8_LDB(dst, b, h) do { _Pragma("unroll") for (int n = 0; n < 2; ++n) _Pragma("unroll") for (int k = 0; k < 2; ++k) dst[n][k] = *(const PG8_LAS bf16x8*)(lds + PG8_SB(b, h) + boff + n * 2048 + k * 1024); } while (0)
#define PG8_MMA(ai, bj, At, Bt) do { __builtin_amdgcn_s_setprio(1); _Pragma("unroll") for (int m = 0; m < 4; ++m) _Pragma("unroll") for (int n = 0; n < 2; ++n) _Pragma("unroll") for (int k = 0; k < 2; ++k) \
        acc[ai][bj][m][n] = __builtin_amdgcn_mfma_f32_16x16x32_bf16(Bt[n][k], At[m][k], acc[ai][bj][m][n], 0, 0, 0); __builtin_amdgcn_s_setprio(0); } while (0)
#define PG8_WAIT_V(n) asm volatile("s_waitcnt vmcnt(" #n ")" ::: "memory")
#define PG8_WAIT_L(n) asm volatile("s_waitcnt lgkmcnt(" #n ")" ::: "memory")
#define PG8_BAR __builtin_amdgcn_s_barrier()
#define PG8_SCHED __builtin_amdgcn_sched_barrier(0)
    Unit cur, nxt; int ui = 0;
    if (!S.next(0, cur)) return;
    f32x4 acc[2][2][4][2];
#pragma unroll
    for (int a = 0; a < 2; ++a)
#pragma unroll
        for (int b = 0; b < 2; ++b)
#pragma unroll
            for (int m = 0; m < 4; ++m)
#pragma unroll
                for (int n = 0; n < 2; ++n) acc[a][b][m][n] = (f32x4){0.f, 0.f, 0.f, 0.f};
    bf16x8 At[4][2], B0[2][2], B1[2][2];
    const char* cA = (const char*)g.A + (size_t)cur.pm * tstep; const char* cB = (const char*)g.Bt + (size_t)cur.pn * tstep;
    S.a_ready(cur);
    if constexpr (SP2) {
        PG8_STAGE(PG8_SB(0, 0), cB, voffB); PG8_STAGE(PG8_SB(0, 1), cB + hstep, voffB); PG8_STAGE(PG8_SA(0, 0), cA, voffA); PG8_STAGE(PG8_SA(0, 1), cA + hstep, voffA);
        if (wr == 1) PG8_BAR;
        PG8_WAIT_V(2); PG8_BAR;
        PG8_STAGE(PG8_SB(1, 0), cB + kstep, voffB); PG8_STAGE(PG8_SA(1, 0), cA + kstep, voffA); PG8_STAGE(PG8_SB(1, 1), cB + hstep + kstep, voffB);
        PG8_WAIT_V(6); PG8_BAR;
    } else {
        PG8_STAGE(PG8_SB(0, 0), cB, voffB); PG8_STAGE(PG8_SA(0, 0), cA, voffA); PG8_STAGE(PG8_SB(0, 1), cB + hstep, voffB); PG8_STAGE(PG8_SA(0, 1), cA + hstep, voffA);
        if (wr == 1) PG8_BAR;
        PG8_WAIT_V(4); PG8_BAR;
        PG8_STAGE(PG8_SB(1, 0), cB + kstep, voffB); PG8_STAGE(PG8_SA(1, 0), cA + kstep, voffA); PG8_STAGE(PG8_SB(1, 1), cB + hstep + kstep, voffB);
        PG8_WAIT_V(6); PG8_BAR;
    }
    for (;;) {
        const bool has_next = S.next(ui + 1, nxt);
        const char* nA = has_next ? (const char*)g.A + (size_t)nxt.pm * tstep : cA; const char* nB = has_next ? (const char*)g.Bt + (size_t)nxt.pn * tstep : cB;
        for (int t = 0; t < nt; t += 2) {
            const bool last = (t == nt - 2);
            const char* a1 = cA + (size_t)(t + 1) * kstep;
            const char* a2 = last ? nA : cA + (size_t)(t + 2) * kstep; const char* b2 = last ? nB : cB + (size_t)(t + 2) * kstep;
            const char* a3 = a2 + kstep; const char* b3 = b2 + kstep;
            if (last && has_next) S.a_ready(nxt);
            if constexpr (SP2) {
            PG8_LDB(B0, 0, 0); PG8_LDB(B1, 0, 1); PG8_SCHED; PG8_LDA(At, 0, 0); PG8_STAGE(PG8_SA(1, 1), a1 + hstep, voffA);
            PG8_WAIT_V(8); PG8_WAIT_L(0); PG8_BAR; PG8_MMA(0, 0, At, B0); PG8_MMA(0, 1, At, B1); PG8_BAR; PG8_SCHED;
            PG8_LDA(At, 0, 1); PG8_STAGE(PG8_SB(0, 0), b2, voffB); PG8_STAGE(PG8_SB(0, 1), b2 + hstep, voffB); PG8_STAGE(PG8_SA(0, 0), a2, voffA);
            PG8_WAIT_V(8); PG8_WAIT_L(0); PG8_BAR; PG8_MMA(1, 0, At, B0); PG8_MMA(1, 1, At, B1); PG8_BAR; PG8_SCHED;
            PG8_LDB(B0, 1, 0); PG8_LDB(B1, 1, 1); PG8_SCHED; PG8_LDA(At, 1, 0); PG8_STAGE(PG8_SA(0, 1), a2 + hstep, voffA);
            PG8_WAIT_V(8); PG8_WAIT_L(0); PG8_BAR; PG8_MMA(0, 0, At, B0); PG8_MMA(0, 1, At, B1); PG8_BAR; PG8_SCHED;
            PG8_LDA(At, 1, 1); PG8_STAGE(PG8_SB(1, 0), b3, voffB); PG8_STAGE(PG8_SB(1, 1), b3 + hstep, voffB); PG8_STAGE(PG8_SA(1, 0), a3, voffA);
            PG8_WAIT_V(8); PG8_WAIT_L(0); PG8_BAR; PG8_MMA(1, 0, At, B0); PG8_MMA(1, 1, At, B1); PG8_BAR; PG8_SCHED;
            } else {
            PG8_LDB(B0, 0, 0); PG8_SCHED; PG8_LDA(At, 0, 0); PG8_STAGE(PG8_SA(1, 1), a1 + hstep, voffA);
            PG8_WAIT_L(8); PG8_BAR; PG8_WAIT_L(0); PG8_MMA(0, 0, At, B0); PG8_BAR; PG8_SCHED;
            PG8_LDB(B1, 0, 1); PG8_STAGE(PG8_SB(0, 0), b2, voffB);
            PG8_BAR; PG8_WAIT_L(0); PG8_MMA(0, 1, At, B1); PG8_BAR;
            PG8_LDA(At, 0, 1); PG8_STAGE(PG8_SA(0, 0), a2, voffA);
            PG8_BAR; PG8_WAIT_L(0); PG8_MMA(1, 0, At, B0); PG8_BAR; PG8_SCHED;
            PG8_STAGE(PG8_SB(0, 1), b2 + hstep, voffB);
            PG8_WAIT_V(6); PG8_BAR; PG8_MMA(1, 1, At, B1); PG8_BAR;
            PG8_LDB(B0, 1, 0); PG8_SCHED; PG8_LDA(At, 1, 0); PG8_STAGE(PG8_SA(0, 1), a2 + hstep, voffA);
            PG8_WAIT_L(8); PG8_BAR; PG8_WAIT_L(0); PG8_MMA(0, 0, At, B0); PG8_BAR; PG8_SCHED;
            PG8_LDB(B1, 1, 1); PG8_STAGE(PG8_SB(1, 0), b3, voffB);
            PG8_BAR; PG8_WAIT_L(0); PG8_MMA(0, 1, At, B1); PG8_BAR;
            PG8_LDA(At, 1, 1); PG8_STAGE(PG8_SA(1, 0), a3, voffA);
            PG8_BAR; PG8_WAIT_L(0); PG8_MMA(1, 0, At, B0); PG8_BAR; PG8_SCHED;
            PG8_STAGE(PG8_SB(1, 1), b3 + hstep, voffB);
            PG8_WAIT_V(6); PG8_BAR; PG8_MMA(1, 1, At, B1); PG8_BAR;
            }
        }
        if constexpr (ALIGN_EPI) { if (wr == 0) PG8_BAR; }
        if constexpr (!Epi::AFTER_DRAIN) { E(acc, cur, wr, wc, fr, fq); S.done(cur); }
        if (!has_next) break;
#pragma unroll
        for (int a = 0; a < 2; ++a)
#pragma unroll
            for (int b = 0; b < 2; ++b)
#pragma unroll
                for (int m = 0; m < 4; ++m)
#pragma unroll
                    for (int n = 0; n < 2; ++n) acc[a][b][m][n] = (f32x4){0.f, 0.f, 0.f, 0.f};
        cur = nxt; cA = nA; cB = nB; ++ui;
        if constexpr (ALIGN_EPI) { if (wr == 1) PG8_BAR; }
    }
    PG8_WAIT_V(0);
    if constexpr (!ALIGN_EPI) { if (wr == 0) PG8_BAR; }
    PG8_BAR;
    if constexpr (Epi::AFTER_DRAIN) { E.fused(acc, cur, wr, wc, fr, fq, lds, wid, lane); S.done(cur); }
#undef PG8_SA
#undef PG8_SB
#undef PG8_STAGE
#undef PG8_LDA
#undef PG8_LDB
#undef PG8_MMA
#undef PG8_WAIT_V
#undef PG8_WAIT_L
#undef PG8_BAR
#undef PG8_SCHED
}

struct EpiInProj {
    static constexpr bool PERM = true, AFTER_DRAIN = false;
    bf16_t *U, *Q, *Kb, *Vb;
    __device__ __forceinline__ void operator()(const f32x4 (&acc)[2][2][4][2], const Unit& u, int wr, int wc, int fr, int fq) const {
        const int row0 = u.pm * BM + wr * 64 + fr;
        if (u.pn < 4) {
            const int col0 = u.pn * BM + wc * 32 + 8 * fq;
#pragma unroll
            for (int ai = 0; ai < 2; ++ai)
#pragma unroll
                for (int m = 0; m < 4; ++m) { const int row = row0 + ai * HALF + m * 16, b = row >> 12, t = row & 4095;
#pragma unroll
                    for (int bj = 0; bj < 2; ++bj) { const int col = col0 + bj * HALF; const f32x4 v0 = acc[ai][bj][m][0], v1 = acc[ai][bj][m][1];
                        u32x4 w; w.x = cvt_pk_bf16(v0[0], v0[1]); w.y = cvt_pk_bf16(v0[2], v0[3]); w.z = cvt_pk_bf16(v1[0], v1[1]); w.w = cvt_pk_bf16(v1[2], v1[3]);
                        *(u32x4*)(U + (((size_t)(b * 64 + (col >> 4)) * 4096 + t) * 16 + (col & 8))) = w; } }
            return;
        }
        bf16_t* base; int ldc, colt;
        if (u.pn < 8) { base = Q; ldc = 1024; colt = (u.pn - 4) * BM; } else if (u.pn == 8) { base = Kb; ldc = 256; colt = 0; } else { base = Vb; ldc = 256; colt = 0; }
        const int col0 = colt + wc * 32 + 8 * fq;
#pragma unroll
        for (int ai = 0; ai < 2; ++ai)
#pragma unroll
            for (int m = 0; m < 4; ++m) { bf16_t* rowp = base + (size_t)(row0 + ai * HALF + m * 16) * ldc + col0;
#pragma unroll
                for (int bj = 0; bj < 2; ++bj) { const f32x4 v0 = acc[ai][bj][m][0], v1 = acc[ai][bj][m][1];
                    u32x4 w; w.x = cvt_pk_bf16(v0[0], v0[1]); w.y = cvt_pk_bf16(v0[2], v0[3]); w.z = cvt_pk_bf16(v1[0], v1[1]); w.w = cvt_pk_bf16(v1[2], v1[3]);
                    *(u32x4*)(rowp + bj * HALF) = w; } }
    }
};
struct EpiBf16Plain {
    static constexpr bool PERM = true, AFTER_DRAIN = false;
    bf16_t* O; int ldc;
    __device__ __forceinline__ void operator()(const f32x4 (&acc)[2][2][4][2], const Unit& u, int wr, int wc, int fr, int fq) const {
        const int row0 = u.pm * BM + wr * 64 + fr, col0 = u.pn * BM + wc * 32 + 8 * fq;
#pragma unroll
        for (int ai = 0; ai < 2; ++ai)
#pragma unroll
            for (int m = 0; m < 4; ++m) { bf16_t* rowp = O + (size_t)(row0 + ai * HALF + m * 16) * ldc + col0;
#pragma unroll
                for (int bj = 0; bj < 2; ++bj) { const f32x4 v0 = acc[ai][bj][m][0], v1 = acc[ai][bj][m][1];
                    u32x4 w; w.x = cvt_pk_bf16(v0[0], v0[1]); w.y = cvt_pk_bf16(v0[2], v0[3]); w.z = cvt_pk_bf16(v1[0], v1[1]); w.w = cvt_pk_bf16(v1[2], v1[3]);
                    *(u32x4*)(rowp + bj * HALF) = w; } }
    }
};
struct EpiGlu {
    static constexpr bool PERM = true, AFTER_DRAIN = false;
    bf16_t* O; int ldo; const bf16_t* Y; int ldy; const float* bias;
    __device__ __forceinline__ void operator()(const f32x4 (&acc)[2][2][4][2], const Unit& u, int wr, int wc, int fr, int fq) const {
        const int row0 = u.pm * BM + wr * 64 + fr, col0 = u.pn * BM + wc * 32 + 8 * fq;
        f32x4 bv[2][2];
#pragma unroll
        for (int bj = 0; bj < 2; ++bj)
#pragma unroll
            for (int n = 0; n < 2; ++n) bv[bj][n] = *(const f32x4*)(bias + col0 + bj * HALF + 4 * n);
#pragma unroll
        for (int ai = 0; ai < 2; ++ai)
#pragma unroll
            for (int m = 0; m < 4; ++m) { const size_t row = (size_t)(row0 + ai * HALF + m * 16);
#pragma unroll
                for (int bj = 0; bj < 2; ++bj) {
                    const u32x4 yw = *(const u32x4*)(Y + row * ldy + col0 + bj * HALF);
                    float o[8];
#pragma unroll
                    for (int e = 0; e < 8; ++e) { const float a = acc[ai][bj][m][e >> 2][e & 3] + bv[bj][e >> 2][e & 3];
                        const unsigned yy = yw[e >> 1]; const float y = __uint_as_float((e & 1) ? (yy & 0xffff0000u) : (yy << 16));
                        o[e] = y / (1.0f + __expf(-a)); }
                    u32x4 w; w.x = cvt_pk_bf16(o[0], o[1]); w.y = cvt_pk_bf16(o[2], o[3]); w.z = cvt_pk_bf16(o[4], o[5]); w.w = cvt_pk_bf16(o[6], o[7]);
                    *(u32x4*)(O + row * ldo + col0 + bj * HALF) = w; } }
    }
};
struct EpiResF32 {
    static constexpr bool PERM = false, AFTER_DRAIN = false;
    float* C; const float* R; int ldc;
    __device__ __forceinline__ void operator()(const f32x4 (&acc)[2][2][4][2], const Unit& u, int wr, int wc, int fr, int fq) const {
        const int row0 = u.pm * BM + wr * 64 + fr, col0 = u.pn * BM + wc * 32 + 4 * fq;
#pragma unroll
        for (int ai = 0; ai < 2; ++ai)
#pragma unroll
            for (int m = 0; m < 4; ++m) { const size_t off = (size_t)(row0 + ai * HALF + m * 16) * ldc + col0;
#pragma unroll
                for (int bj = 0; bj < 2; ++bj)
#pragma unroll
                    for (int n = 0; n < 2; ++n) { f32x4 v = acc[ai][bj][m][n]; if (R) v = v + *(const f32x4*)(R + off + bj * HALF + n * 16); *(f32x4*)(C + off + bj * HALF + n * 16) = v; } }
    }
};
__device__ __forceinline__ float row_rnorm(const float* PS, size_t row) {
    const f32x4* p = (const f32x4*)(PS + row * 32); float s = 0.f;
#pragma unroll
    for (int i = 0; i < 8; ++i) { const f32x4 v = p[i]; s += (v[0] + v[1]) + (v[2] + v[3]); }
    return __builtin_amdgcn_rsqf(s * (1.0f / 2048.0f) + 1e-6f);
}
template <bool RBF16> struct EpiResBf16 {
    static constexpr bool PERM = true, AFTER_DRAIN = false;
    bf16_t* H; const void* R; float* PS;
    __device__ __forceinline__ void operator()(const f32x4 (&acc)[2][2][4][2], const Unit& u, int wr, int wc, int fr, int fq) const {
        const int row0 = u.pm * BM + wr * 64 + fr, col0 = u.pn * BM + wc * 32 + 8 * fq;
#pragma unroll
        for (int ai = 0; ai < 2; ++ai)
#pragma unroll
            for (int m = 0; m < 4; ++m) { const size_t row = (size_t)(row0 + ai * HALF + m * 16), off = row * 2048 + col0; float ss = 0.f;
#pragma unroll
                for (int bj = 0; bj < 2; ++bj) {
                    f32x4 r0, r1;
                    if (RBF16) { const u32x4 rw = *(const u32x4*)((const bf16_t*)R + off + bj * HALF);
                        r0 = (f32x4){__uint_as_float(rw.x << 16), __uint_as_float(rw.x & 0xffff0000u), __uint_as_float(rw.y << 16), __uint_as_float(rw.y & 0xffff0000u)};
                        r1 = (f32x4){__uint_as_float(rw.z << 16), __uint_as_float(rw.z & 0xffff0000u), __uint_as_float(rw.w << 16), __uint_as_float(rw.w & 0xffff0000u)}; }
                    else { r0 = *(const f32x4*)((const float*)R + off + bj * HALF); r1 = *(const f32x4*)((const float*)R + off + bj * HALF + 4); }
                    const f32x4 v0 = acc[ai][bj][m][0] + r0, v1 = acc[ai][bj][m][1] + r1;
                    ss += ((v0[0] * v0[0] + v0[1] * v0[1]) + (v0[2] * v0[2] + v0[3] * v0[3])) + ((v1[0] * v1[0] + v1[1] * v1[1]) + (v1[2] * v1[2] + v1[3] * v1[3]));
                    u32x4 w; w.x = cvt_pk_bf16(v0[0], v0[1]); w.y = cvt_pk_bf16(v0[2], v0[3]); w.z = cvt_pk_bf16(v1[0], v1[1]); w.w = cvt_pk_bf16(v1[2], v1[3]);
                    *(u32x4*)(H + off + bj * HALF) = w; }
                ss += __shfl_xor(ss, 16); ss += __shfl_xor(ss, 32);
                if (fq == 0) PS[row * 32 + u.pn * 4 + wc] = ss; }
    }
};
struct EpiBf16RowScale {
    static constexpr bool PERM = true, AFTER_DRAIN = false;
    bf16_t* O; int ldc; const float* PS;
    __device__ __forceinline__ void operator()(const f32x4 (&acc)[2][2][4][2], const Unit& u, int wr, int wc, int fr, int fq) const {
        const int row0 = u.pm * BM + wr * 64 + fr, col0 = u.pn * BM + wc * 32 + 8 * fq;
#pragma unroll
        for (int ai = 0; ai < 2; ++ai)
#pragma unroll
            for (int m = 0; m < 4; ++m) { const size_t row = (size_t)(row0 + ai * HALF + m * 16); const float r = row_rnorm(PS, row); bf16_t* rowp = O + row * ldc + col0;
#pragma unroll
                for (int bj = 0; bj < 2; ++bj) { const f32x4 v0 = acc[ai][bj][m][0] * r, v1 = acc[ai][bj][m][1] * r;
                    u32x4 w; w.x = cvt_pk_bf16(v0[0], v0[1]); w.y = cvt_pk_bf16(v0[2], v0[3]); w.z = cvt_pk_bf16(v1[0], v1[1]); w.w = cvt_pk_bf16(v1[2], v1[3]);
                    *(u32x4*)(rowp + bj * HALF) = w; } }
    }
};
struct EpiF32RowScale {
    static constexpr bool PERM = true, AFTER_DRAIN = false;
    float* C; int ldc; const float* PS;
    __device__ __forceinline__ void operator()(const f32x4 (&acc)[2][2][4][2], const Unit& u, int wr, int wc, int fr, int fq) const {
        const int row0 = u.pm * BM + wr * 64 + fr, col0 = u.pn * BM + wc * 32 + 8 * fq;
#pragma unroll
        for (int ai = 0; ai < 2; ++ai)
#pragma unroll
            for (int m = 0; m < 4; ++m) { const size_t row = (size_t)(row0 + ai * HALF + m * 16); const float r = row_rnorm(PS, row); const size_t off = row * ldc + col0;
#pragma unroll
                for (int bj = 0; bj < 2; ++bj) { *(f32x4*)(C + off + bj * HALF) = acc[ai][bj][m][0] * r; *(f32x4*)(C + off + bj * HALF + 4) = acc[ai][bj][m][1] * r; } }
    }
};
}

#ifndef PG8_SP2
#define PG8_SP2 false
#endif
#ifndef PG8_ALIGN
#define PG8_ALIGN true
#endif
constexpr int NTOK = 32768, DM = 2048, SEQ = 4096, NB = 8;
constexpr int NWAVES = 8, NTHREADS = 512;
constexpr int LDS_BYTES = 147456;
constexpr float NORM_EPS = 1e-6f;

#define LAS __attribute__((address_space(3)))
typedef unsigned short bf16;
typedef unsigned u32;
typedef short bf16x8 __attribute__((ext_vector_type(8)));
typedef short s16x4 __attribute__((ext_vector_type(4)));
typedef float f32x4 __attribute__((ext_vector_type(4)));
typedef float f32x16 __attribute__((ext_vector_type(16)));
typedef unsigned u32x4 __attribute__((ext_vector_type(4)));
typedef unsigned u32x2 __attribute__((ext_vector_type(2)));

constexpr size_t MiB = 1u << 20;
constexpr size_t WS_CTL = 0, CTL_ZERO_BYTES = 64 * 1024;
constexpr size_t WS_W_IN_T = 1 * MiB, WS_W_GLU_T = 11 * MiB, WS_W_OUT_T = 13 * MiB, WS_W_CQ_T = 21 * MiB, WS_W_CKV_T = 23 * MiB, WS_W_CO_T = 27 * MiB, WS_W_S_T = 29 * MiB;
constexpr size_t WS_S5_WIN = 37 * MiB, WS_S5_WOUT = 41 * MiB, WS_S5_K = 45 * MiB, WS_S5_LAM = 46 * MiB, WS_BIAS_TAB = 46 * MiB + 512 * 1024;
constexpr size_t WS_MEM_N = 47 * MiB, WS_KV_C = 55 * MiB, WS_PS = 59 * MiB;
#ifndef FP6_PACK_INTERLEAVED
#define FP6_PACK_INTERLEAVED 1
#endif
typedef unsigned v6u_t __attribute__((ext_vector_type(6)));
constexpr int PEER_ROW_BYTES = 1536;
constexpr int PEER_SROW = 384;
constexpr size_t PEER_SLICE_BYTES = (size_t)16384 * PEER_SROW;
constexpr size_t WS_PEER_U = 64 * MiB, WS_PEER_V = 96 * MiB;
constexpr size_t WS_PEER_SU = 128 * MiB, WS_PEER_SV = 128 * MiB + 65536;
constexpr size_t WS_HN = 192 * MiB;
constexpr size_t WS_U = 320 * MiB, WS_Q = 384 * MiB, WS_K = 448 * MiB, WS_V = 464 * MiB, WS_YPRE = 480 * MiB, WS_YMIX = 544 * MiB;
constexpr size_t WS_OB = 320 * MiB;
constexpr size_t WS_SCORES = 320 * MiB;
constexpr size_t WS_QC = 672 * MiB, WS_OC = 704 * MiB, WS_TK_IDX = 736 * MiB, WS_TK_G = 752 * MiB, WS_END = 768 * MiB;

__device__ __forceinline__ unsigned f2bf(float f) { unsigned u = __float_as_uint(f); return (u + 0x7fffu + ((u >> 16) & 1u)) >> 16; }
__device__ __forceinline__ unsigned pk2(float lo, float hi) { return pg8::cvt_pk_bf16(lo, hi); }
__device__ __forceinline__ unsigned cvtpk(float lo, float hi) { return pg8::cvt_pk_bf16(lo, hi); }
__device__ __forceinline__ float bflo(unsigned w) { return __uint_as_float(w << 16); }
__device__ __forceinline__ float bfhi(unsigned w) { return __uint_as_float(w & 0xffff0000u); }
__device__ __forceinline__ float wave_sum(float v) {
#pragma unroll
    for (int o = 1; o < 64; o <<= 1) v += __shfl_xor(v, o);
    return v;
}
__device__ __forceinline__ float gelu_tanh(float x) { const float z = 0.7978845608028654f * (x + 0.044715f * x * x * x); return x / (1.0f + __expf(-2.0f * z)); }
#define LDS_WAIT() asm volatile("s_waitcnt lgkmcnt(0)" ::: "memory")
#define MFMA16(a, b, c) __builtin_amdgcn_mfma_f32_16x16x32_bf16((a), (b), (c), 0, 0, 0)
#define MFMA32(a, b, c) __builtin_amdgcn_mfma_f32_32x32x16_bf16((a), (b), (c), 0, 0, 0)

__device__ __forceinline__ void p0_transpose_item(const float* W, int K, int N, bf16* WT, LAS float* scr, int item, int lane, const float* kgain = nullptr) {
    const int nblk = N / 32, kb = item / nblk, nb = item % nblk, k0 = 64 * kb, n0 = 32 * nb;
    f32x4 v[8];
#pragma unroll
    for (int i = 0; i < 8; ++i) v[i] = *(const f32x4*)(W + (size_t)(k0 + 8 * i + (lane >> 3)) * N + n0 + 4 * (lane & 7));
#pragma unroll
    for (int i = 0; i < 8; ++i) { const int kk = 8 * i + (lane >> 3); f32x4 x = v[i]; if (kgain) x = x * kgain[k0 + kk];
#pragma unroll
        for (int c = 0; c < 4; ++c) scr[kk * 33 + 4 * (lane & 7) + c] = x[c]; }
    LDS_WAIT(); asm volatile("" ::: "memory");
    const int c = lane & 7;
#pragma unroll
    for (int j = 0; j < 4; ++j) { const int n = (lane >> 3) + 8 * j; const LAS float* s = scr + (8 * c) * 33 + n;
        u32x4 o; o.x = pk2(s[0 * 33], s[1 * 33]); o.y = pk2(s[2 * 33], s[3 * 33]); o.z = pk2(s[4 * 33], s[5 * 33]); o.w = pk2(s[6 * 33], s[7 * 33]);
        *(u32x4*)(WT + (size_t)(n0 + n) * K + k0 + 8 * c) = o; }
    LDS_WAIT(); asm volatile("" ::: "memory");
}
__device__ __forceinline__ void rms_row_to_bf16(const float* xrow, const float* gain, bf16* orow, int lane) {
    const f32x4* xr = (const f32x4*)xrow + lane; const f32x4* gr = (const f32x4*)gain + lane;
    f32x4 v[8]; float s = 0.f;
#pragma unroll
    for (int j = 0; j < 8; ++j) { v[j] = xr[64 * j]; s += (v[j].x * v[j].x + v[j].y * v[j].y) + (v[j].z * v[j].z + v[j].w * v[j].w); }
    const float r = rsqrtf(wave_sum(s) * (1.f / DM) + NORM_EPS);
    u32x2* o8 = (u32x2*)orow + lane;
#pragma unroll
    for (int j = 0; j < 8; ++j) { const f32x4 g = gr[64 * j]; u32x2 w; w.x = pk2(v[j].x * r * g.x, v[j].y * r * g.y); w.y = pk2(v[j].z * r * g.z, v[j].w * r * g.w); o8[64 * j] = w; }
}

struct Ptrs {
    const float* in[28]; float* out; unsigned char* ws;
};

__device__ __forceinline__ void phase_prologue(const Ptrs& P, LAS unsigned char* lds, int G) {
    const int tid = threadIdx.x, lane = tid & 63, wave = __builtin_amdgcn_readfirstlane(tid >> 6);
    unsigned char* ws = P.ws;
    {
        const float* wq = P.in[23]; const float* sk = P.in[24]; bf16* WsT = (bf16*)(ws + WS_W_S_T);
        LAS float* wq_l = (LAS float*)lds;
        LAS float* sk_l = wq_l + 64 * 129;
        for (int it = blockIdx.x; it < 512; it += G) {
            const int hc = it >> 5, d0 = (it & 31) * 64;
            __syncthreads();
#pragma unroll
            for (int i = 0; i < 4; ++i) { const int e = tid + 512 * i, dl = e >> 5, j4 = (e & 31) * 4; f32x4 v = *(const f32x4*)(wq + (size_t)(d0 + dl) * 2048 + hc * 128 + j4); v = v * P.in[22][d0 + dl];
#pragma unroll
                for (int c = 0; c < 4; ++c) wq_l[dl * 129 + j4 + c] = v[c]; }
#pragma unroll
            for (int i = 0; i < 8; ++i) { const int e = tid + 512 * i, kk = e >> 5, j4 = (e & 31) * 4; const f32x4 v = *(const f32x4*)(sk + ((size_t)hc * 128 + kk) * 128 + j4);
#pragma unroll
                for (int c = 0; c < 4; ++c) sk_l[kk * 129 + j4 + c] = v[c]; }
            __syncthreads();
            const int kb = wave & 3, db = wave >> 2;
            const LAS float* ap = sk_l + (32 * kb + (lane & 31)) * 129 + (lane >> 5); const LAS float* bp = wq_l + (32 * db + (lane & 31)) * 129 + (lane >> 5);
            f32x16 acc;
#pragma unroll
            for (int i = 0; i < 16; ++i) acc[i] = 0.f;
#pragma unroll 16
            for (int st = 0; st < 64; ++st) acc = __builtin_amdgcn_mfma_f32_32x32x2f32(ap[2 * st], bp[2 * st], acc, 0, 0, 0);
#pragma unroll
            for (int r = 0; r < 16; ++r) { const int key = (r & 3) + 8 * (r >> 2) + 4 * (lane >> 5);
                WsT[(size_t)(hc * 128 + 32 * kb + key) * 2048 + d0 + 32 * db + (lane & 31)] = (bf16)f2bf(acc[r]); }
        }
        __syncthreads();
    }
    {
        const float *lam_re = P.in[5], *lam_im = P.in[6], *b_re = P.in[7], *b_im = P.in[8], *c_re = P.in[9], *c_im = P.in[10], *dd = P.in[11], *log_dt = P.in[12];
        LAS float* pwr = (LAS float*)lds;
        LAS float* bbar = pwr + 17 * 64 * 2;
        LAS float* cc = bbar + 64 * 16 * 2;
        for (int gi = blockIdx.x; gi < 256; gi += G) {
            const int g = gi >> 2, qt = gi & 3;
            __syncthreads();
            if (tid < 64) {
                const int p = tid; const float lre = lam_re[g * 64 + p], lim = lam_im[g * 64 + p], dt = expf(log_dt[g]);
                const float er = expf(lre * dt); float sn, cs; sincosf(lim * dt, &sn, &cs);
                const float lbr = er * cs, lbi = er * sn;
                const float nr = lbr - 1.0f, ni = lbi, den = lre * lre + lim * lim;
                const float fr = (nr * lre + ni * lim) / den, fi = (ni * lre - nr * lim) / den;
#pragma unroll
                for (int h = 0; h < 16; ++h) { const float br = b_re[(g * 64 + p) * 16 + h], bi = b_im[(g * 64 + p) * 16 + h];
                    bbar[(p * 16 + h) * 2] = fr * br - fi * bi; bbar[(p * 16 + h) * 2 + 1] = fr * bi + fi * br; }
                float pr = 1.f, pi = 0.f;
                for (int j = 0; j <= 16; ++j) { pwr[(j * 64 + p) * 2] = pr; pwr[(j * 64 + p) * 2 + 1] = pi; const float t = pr * lbr - pi * lbi; pi = pr * lbi + pi * lbr; pr = t; }
            }
            for (int e = tid; e < 1024; e += NTHREADS) { cc[e * 2] = c_re[g * 1024 + e]; cc[e * 2 + 1] = c_im[g * 1024 + e]; }
            __syncthreads();
            bf16* Win = (bf16*)(ws + WS_S5_WIN) + (size_t)g * 32768; bf16* Wout = (bf16*)(ws + WS_S5_WOUT) + (size_t)g * 32768; bf16* Kt = (bf16*)(ws + WS_S5_K) + (size_t)g * 4096;
            for (int e = qt * 8192 + tid; e < (qt + 1) * 8192; e += NTHREADS) {
                const int m = e >> 8, kk = e & 255, p = m & 63, ri = m >> 6, sg = kk >> 4, hp = kk & 15;
                const float ar = pwr[((15 - sg) * 64 + p) * 2], ai = pwr[((15 - sg) * 64 + p) * 2 + 1], xr = bbar[(p * 16 + hp) * 2], xi = bbar[(p * 16 + hp) * 2 + 1];
                Win[e] = (bf16)f2bf(ri ? (ar * xi + ai * xr) : (ar * xr - ai * xi));
            }
            for (int e = qt * 8192 + tid; e < (qt + 1) * 8192; e += NTHREADS) {
                const int mm = e >> 7, m = e & 127, tau = mm >> 4, h = mm & 15, p = m & 63, ri = m >> 6;
                const float ar = pwr[((tau + 1) * 64 + p) * 2], ai = pwr[((tau + 1) * 64 + p) * 2 + 1], cr = cc[(h * 64 + p) * 2], ci = cc[(h * 64 + p) * 2 + 1];
                Wout[e] = (bf16)f2bf(ri ? -(cr * ai + ci * ar) : (cr * ar - ci * ai));
            }
            for (int e = qt * 1024 + tid; e < (qt + 1) * 1024; e += NTHREADS) {
                const int j = e >> 8, h = (e >> 4) & 15, hp = e & 15; float s = 0.f;
                for (int p = 0; p < 64; ++p) { const float ar = pwr[(j * 64 + p) * 2], ai = pwr[(j * 64 + p) * 2 + 1], cr = cc[(h * 64 + p) * 2], ci = cc[(h * 64 + p) * 2 + 1];
                    const float wr = cr * ar - ci * ai, wi = cr * ai + ci * ar; s += wr * bbar[(p * 16 + hp) * 2] - wi * bbar[(p * 16 + hp) * 2 + 1]; }
                if (j == 0 && h == hp) s += dd[g * 16 + h];
                Kt[e] = (bf16)f2bf(s);
            }
            if (tid < 64 && qt == 0) { float* lamq = (float*)(ws + WS_S5_LAM) + g * 128; lamq[2 * tid] = pwr[(16 * 64 + tid) * 2]; lamq[2 * tid + 1] = pwr[(16 * 64 + tid) * 2 + 1]; }
        }
        __syncthreads();
    }
    {
        const float* rel_bias = P.in[2]; float* bt = (float*)(ws + WS_BIAS_TAB);
        for (int e = blockIdx.x * NTHREADS + tid; e < 2048; e += G * NTHREADS) {
            const int hq = e >> 7, dist = e & 127; int bucket = dist;
            if (dist >= 16) { int lg = 16 + (int)(logf((float)dist / 16.0f) / logf(8.0f) * 16.0f); bucket = lg < 31 ? lg : 31; }
            bt[e] = rel_bias[bucket * 16 + hq];
        }
    }
    {
        LAS float* scr = (LAS float*)(lds + wave * 16384);
        const int gw = blockIdx.x * NWAVES + wave, NGW = G * NWAVES;
        constexpr int I0 = 32 * 80, I1 = 16 * 32, I2 = 32 * 64, I3 = 32 * 16, I4 = 32 * 32, I5 = 8 * 64;
        for (int it = gw; it < I0 + I1 + I2 + I3 + I4 + I5; it += NGW) {
            int r = it;
            if (r < I0) { p0_transpose_item(P.in[4], 2048, 2560, (bf16*)(ws + WS_W_IN_T), scr, r, lane); continue; } r -= I0;
            if (r < I1) { p0_transpose_item(P.in[13], 1024, 1024, (bf16*)(ws + WS_W_GLU_T), scr, r, lane); continue; } r -= I1;
            if (r < I2) { p0_transpose_item(P.in[16], 2048, 2048, (bf16*)(ws + WS_W_OUT_T), scr, r, lane); continue; } r -= I2;
            if (r < I3) { p0_transpose_item(P.in[19], 2048, 512, (bf16*)(ws + WS_W_CQ_T), scr, r, lane, P.in[17]); continue; } r -= I3;
            if (r < I4) { p0_transpose_item(P.in[20], 2048, 1024, (bf16*)(ws + WS_W_CKV_T), scr, r, lane); continue; } r -= I4;
            p0_transpose_item(P.in[21], 512, 2048, (bf16*)(ws + WS_W_CO_T), scr, r, lane);
        }
        {
            f32x4 a[8], b[8];
#pragma unroll
            for (int j = 0; j < 8; ++j) { a[j] = ((const f32x4*)(P.in[0] + (size_t)gw * DM))[lane + 64 * j]; b[j] = ((const f32x4*)(P.in[0] + (size_t)(gw + NGW) * DM))[lane + 64 * j]; }
#pragma unroll 1
            for (int m = gw; m < NTOK; m += 2 * NGW) {
                const int mn = (m + 2 * NGW < NTOK) ? m + 2 * NGW : m;
                f32x4 na[8], nb[8];
#pragma unroll
                for (int j = 0; j < 8; ++j) { na[j] = ((const f32x4*)(P.in[0] + (size_t)mn * DM))[lane + 64 * j]; nb[j] = ((const f32x4*)(P.in[0] + (size_t)(mn + NGW) * DM))[lane + 64 * j]; }
                float s0 = 0.f, s1 = 0.f;
#pragma unroll
                for (int j = 0; j < 8; ++j) { s0 += (a[j].x * a[j].x + a[j].y * a[j].y) + (a[j].z * a[j].z + a[j].w * a[j].w); s1 += (b[j].x * b[j].x + b[j].y * b[j].y) + (b[j].z * b[j].z + b[j].w * b[j].w); }
                const float r0 = rsqrtf(wave_sum(s0) * (1.f / DM) + NORM_EPS), r1 = rsqrtf(wave_sum(s1) * (1.f / DM) + NORM_EPS);
                u32x2* o0 = (u32x2*)((bf16*)(ws + WS_HN) + (size_t)m * DM) + lane; u32x2* o1 = (u32x2*)((bf16*)(ws + WS_HN) + (size_t)(m + NGW) * DM) + lane;
#pragma unroll
                for (int j = 0; j < 8; ++j) { const f32x4 g = ((const f32x4*)P.in[3])[lane + 64 * j];
                    u32x2 w0, w1; w0.x = pk2(a[j].x * r0 * g.x, a[j].y * r0 * g.y); w0.y = pk2(a[j].z * r0 * g.z, a[j].w * r0 * g.w); w1.x = pk2(b[j].x * r1 * g.x, b[j].y * r1 * g.y); w1.y = pk2(b[j].z * r1 * g.z, b[j].w * r1 * g.w);
                    o0[64 * j] = w0; o1[64 * j] = w1; }
#pragma unroll
                for (int j = 0; j < 8; ++j) { a[j] = na[j]; b[j] = nb[j]; }
            }
        }
        for (int m = gw; m < 2048; m += NGW) rms_row_to_bf16(P.in[1] + (size_t)m * DM, P.in[18], (bf16*)(ws + WS_MEM_N) + (size_t)m * DM, lane);
    }
}

__device__ __forceinline__ void peer_quant_rows(const Ptrs& P, LAS unsigned char* lds, int wave, int lane, int first, int step, int r_hi) {
    unsigned char* ws = P.ws; (void)lds; (void)wave;
    if (first >= r_hi) return;
    typedef float v16f_t __attribute__((ext_vector_type(16)));
    const int lo4 = 128 * (lane >> 4) + (lane & 15);
#define PQ_SRC(r) (((r) >> 14) ? P.in[26] : P.in[25]) + (size_t)((r) & 16383) * DM
#define PQ_LOAD(V, r) { const f32x4* s4_ = (const f32x4*)(PQ_SRC(r)) + lo4; _Pragma("unroll") for (int q = 0; q < 8; ++q) V[q] = s4_[16 * q]; }
#define PQ_ROW(V, r) { const int t_ = (r) >> 14, e_ = (r) & 16383; float mx = 0.f; \
        if (t_ == 0) { _Pragma("unroll") for (int q = 0; q < 8; ++q) V[q] = V[q] * ((const f32x4*)P.in[22])[lo4 + 16 * q]; } \
        _Pragma("unroll") for (int q = 0; q < 8; ++q) mx = fmaxf(mx, fmaxf(fmaxf(fabsf(V[q].x), fabsf(V[q].y)), fmaxf(fabsf(V[q].z), fabsf(V[q].w)))); \
        _Pragma("unroll") for (int o = 1; o < 64; o <<= 1) mx = fmaxf(mx, __shfl_xor(mx, o)); \
        const float sc = mx > 0.f ? mx * (1.0f / 7.5f) : 1.0f, inv = 1.0f / sc; \
        v16f_t lo16, hi16; \
        _Pragma("unroll") for (int q = 0; q < 8; ++q) { lo16[2 * q] = V[q].x * inv; hi16[2 * q] = V[q].y * inv; lo16[2 * q + 1] = V[q].z * inv; hi16[2 * q + 1] = V[q].w * inv; } \
        const v6u_t wq = __builtin_amdgcn_cvt_scalef32_2xpk16_fp6_f32(lo16, hi16, 1.0f);        \
        unsigned char* dst = ws + (t_ ? WS_PEER_V : WS_PEER_U) + (size_t)(lane >> 4) * PEER_SLICE_BYTES + (size_t)e_ * PEER_SROW; \
          \
        *(u32x4*)(dst + 16 * (lane & 15)) = (u32x4){wq[0], wq[1], wq[2], wq[3]}; *(u32x2*)(dst + 256 + 8 * (lane & 15)) = (u32x2){wq[4], wq[5]}; \
        if (lane == 0) ((float*)(ws + WS_PEER_SU))[2 * e_ + t_] = sc;        }
    f32x4 va[8], vb[8];
    { const int r1 = first + step < r_hi ? first + step : first; PQ_LOAD(va, first) PQ_LOAD(vb, r1) }
#pragma unroll 1
    for (int rr = first; rr < r_hi; rr += 2 * step) {
        const bool two = rr + step < r_hi;
        const int n0 = rr + 2 * step < r_hi ? rr + 2 * step : rr, n1 = rr + 3 * step < r_hi ? rr + 3 * step : n0;
        f32x4 na[8], nb[8];
        PQ_LOAD(na, n0) PQ_LOAD(nb, n1)
        PQ_ROW(va, rr)
        if (two) PQ_ROW(vb, rr + step)
#pragma unroll
        for (int q = 0; q < 8; ++q) { va[q] = na[q]; vb[q] = nb[q]; }
    }
#undef PQ_SRC
#undef PQ_LOAD
#undef PQ_ROW
}

__device__ __forceinline__ void phase_norm(const float* h, const float* gain, bf16* hn, int G) {
    const int lane = threadIdx.x & 63, wave = __builtin_amdgcn_readfirstlane(threadIdx.x >> 6);
    for (int m = blockIdx.x * NWAVES + wave; m < NTOK; m += G * NWAVES) rms_row_to_bf16(h + (size_t)m * DM, gain, hn + (size_t)m * DM, lane);
}

__device__ __forceinline__ void phase_s5(const Ptrs& P, LAS unsigned char* lds, int G) {
    const int tid = threadIdx.x, l = tid & 63, w = __builtin_amdgcn_readfirstlane(tid >> 6);
    unsigned char* ws = P.ws;
    const bf16* U = (const bf16*)(ws + WS_U); bf16* Y = (bf16*)(ws + WS_YPRE);
    LAS unsigned char* U_l = lds;
    LAS float* S_l = (LAS float*)(lds + 33792);
    LAS bf16* Xs_l = (LAS bf16*)(lds + 33792 + 33280);
    LAS float* Eseg = (LAS float*)(lds + 33792 + 33280 + 17408);
    LAS float* Gcar = (LAS float*)(lds + 33792 + 33280 + 17408 + 4096);
    const int l15 = l & 15, l4 = l >> 4;
    const int uoff = l15 * 528 + (l >> 5) * 32 + (l4 & 1) * 16;
    for (int it = blockIdx.x; it < 512; it += G) {
        const int b = it >> 6, g = it & 63;
        const bf16* Win = (const bf16*)(ws + WS_S5_WIN) + (size_t)g * 32768; const bf16* Wout = (const bf16*)(ws + WS_S5_WOUT) + (size_t)g * 32768; const bf16* Kt = (const bf16*)(ws + WS_S5_K) + (size_t)g * 4096;
        const float* lamq = (const float*)(ws + WS_S5_LAM) + g * 128;
        const bf16* Ug = U + (size_t)(b * 64 + g) * 65536;
        const int p = tid & 63, seg = tid >> 6;
        const float lqr = lamq[2 * p], lqi = lamq[2 * p + 1];
        float l8r = lqr, l8i = lqi;
#pragma unroll
        for (int i = 0; i < 3; ++i) { const float t = l8r * l8r - l8i * l8i; l8i = 2.f * l8r * l8i; l8r = t; }
        __syncthreads();
        if (tid < 64) { Gcar[2 * tid] = 0.f; Gcar[2 * tid + 1] = 0.f; }
#pragma unroll 1
        for (int ps = 0; ps < 4; ++ps) {
#pragma unroll
            for (int i = 0; i < 4; ++i) { const int e = tid + 512 * i, t = e >> 1;
                *(LAS u32x4*)(U_l + (t >> 4) * 528 + (t & 15) * 32 + (e & 1) * 16) = *(const u32x4*)(Ug + (size_t)ps * 16384 + e * 8); }
            bf16x8 Aw[8];
#pragma unroll
            for (int ks = 0; ks < 8; ++ks) Aw[ks] = *(const bf16x8*)(Win + (16 * w + l15) * 256 + 32 * ks + 8 * l4);
            __syncthreads();
#pragma unroll
            for (int cb = 0; cb < 4; ++cb) {
                f32x4 acc = (f32x4){0.f, 0.f, 0.f, 0.f};
#pragma unroll
                for (int ks = 0; ks < 8; ++ks) { const bf16x8 Bf = *(const LAS bf16x8*)(U_l + cb * 8448 + uoff + 64 * ks); acc = MFMA16(Aw[ks], Bf, acc); }
#pragma unroll
                for (int r = 0; r < 4; ++r) S_l[(16 * w + 4 * l4 + r) * 65 + cb * 16 + l15] = acc[r];
            }
            __syncthreads();
            {
                float er = 0.f, ei = 0.f; const int c0 = seg * 8;
#pragma unroll
                for (int i = 0; i < 8; ++i) { const int c = c0 + i; const float sr = S_l[p * 65 + c], si = S_l[(64 + p) * 65 + c];
                    const float t = lqr * er - lqi * ei + sr; ei = lqr * ei + lqi * er + si; er = t; S_l[p * 65 + c] = er; S_l[(64 + p) * 65 + c] = ei; }
                Eseg[(seg * 64 + p) * 2] = er; Eseg[(seg * 64 + p) * 2 + 1] = ei;
                __syncthreads();
                float gr = Gcar[((ps & 1) * 64 + p) * 2], gi = Gcar[((ps & 1) * 64 + p) * 2 + 1];
                for (int s = 0; s < seg; ++s) { const float t = l8r * gr - l8i * gi + Eseg[(s * 64 + p) * 2]; gi = l8r * gi + l8i * gr + Eseg[(s * 64 + p) * 2 + 1]; gr = t; }
                if (seg == 7) { Gcar[(((ps + 1) & 1) * 64 + p) * 2] = l8r * gr - l8i * gi + er; Gcar[(((ps + 1) & 1) * 64 + p) * 2 + 1] = l8r * gi + l8i * gr + ei; }
                float pr = 1.f, pi = 0.f;
#pragma unroll
                for (int i = 0; i < 8; ++i) { const int c = c0 + i;
                    float xr = pr * gr - pi * gi, xi = pr * gi + pi * gr;
                    if (i > 0) { xr += S_l[p * 65 + c - 1]; xi += S_l[(64 + p) * 65 + c - 1]; }
                    Xs_l[c * 136 + p] = (bf16)f2bf(xr); Xs_l[c * 136 + 64 + p] = (bf16)f2bf(xi);
                    const float t = pr * lqr - pi * lqi; pi = pr * lqi + pi * lqr; pr = t; }
            }
            __syncthreads();
#pragma unroll 1
            for (int tt = 0; tt < 2; ++tt) {
                const int tau = tt ? 15 - w : w;
                bf16x8 Tf[8], Wo[4];
#pragma unroll
                for (int ks = 0; ks < 8; ++ks) { const int lag = tau - (2 * ks + (l >> 5));
                    bf16x8 z = (bf16x8){0, 0, 0, 0, 0, 0, 0, 0};
                    if (lag >= 0) z = *(const bf16x8*)(Kt + (lag * 16 + l15) * 16 + 8 * (l4 & 1));
                    Tf[ks] = z; }
#pragma unroll
                for (int k2 = 0; k2 < 4; ++k2) Wo[k2] = *(const bf16x8*)(Wout + (tau * 16 + l15) * 128 + 32 * k2 + 8 * l4);
#pragma unroll
                for (int cb = 0; cb < 4; ++cb) {
                    f32x4 acc = (f32x4){0.f, 0.f, 0.f, 0.f};
#pragma unroll
                    for (int ks = 0; ks < 8; ++ks) if (2 * ks <= tau) { const bf16x8 Bf = *(const LAS bf16x8*)(U_l + cb * 8448 + uoff + 64 * ks); acc = MFMA16(Tf[ks], Bf, acc); }
#pragma unroll
                    for (int k2 = 0; k2 < 4; ++k2) { const bf16x8 Bx = *(const LAS bf16x8*)(Xs_l + (cb * 16 + l15) * 136 + 32 * k2 + 8 * l4); acc = MFMA16(Wo[k2], Bx, acc); }
                    u32x2 o; o.x = pk2(gelu_tanh(acc[0]), gelu_tanh(acc[1])); o.y = pk2(gelu_tanh(acc[2]), gelu_tanh(acc[3]));
                    const size_t tok = (size_t)b * SEQ + 16 * (ps * 64 + cb * 16 + l15) + tau;
                    *(u32x2*)(Y + tok * 1024 + 16 * g + 4 * l4) = o;
                }
            }
            __syncthreads();
        }
    }
}

template <int D, int NKB, bool SWA>
__device__ __forceinline__ void attn_task(const bf16* qrow, const LAS unsigned char* Kl, int kstrideB, const LAS unsigned char* Vl, int vstrideB, int kb0,
                                          const LAS float* biasr, int qloc, bool first_blk, float sink, float scale, bf16* orow, int l) {
    const int r32 = l & 31, h = l >> 5;
    bf16x8 qf[D / 16];
#pragma unroll
    for (int s = 0; s < D / 16; ++s) qf[s] = *(const bf16x8*)(qrow + 16 * s + 8 * h);
    f32x16 x[NKB];
#pragma unroll
    for (int kbi = 0; kbi < NKB; ++kbi) {
#pragma unroll
        for (int i = 0; i < 16; ++i) x[kbi][i] = 0.f;
#pragma unroll
        for (int s = 0; s < D / 16; ++s) { const bf16x8 a = *(const LAS bf16x8*)(Kl + ((kb0 + kbi) * 32 + r32) * kstrideB + (16 * s + 8 * h) * 2); x[kbi] = MFMA32(a, qf[s], x[kbi]); }
    }
    float m = -INFINITY;
#pragma unroll
    for (int kbi = 0; kbi < NKB; ++kbi)
#pragma unroll
        for (int i = 0; i < 16; ++i) {
            float s = x[kbi][i] * scale;
            if (SWA) { const int kloc = (kb0 + kbi) * 32 + (i & 3) + 8 * (i >> 2) + 4 * h, dist = qloc - kloc;
                const bool valid = (dist >= 0) && (dist < 128) && (!first_blk || kloc >= 128);
                const int dcl = dist < 0 ? 0 : (dist > 127 ? 127 : dist);
                s = valid ? s + biasr[dcl] : -INFINITY; }
            x[kbi][i] = s; m = fmaxf(m, s);
        }
    m = fmaxf(m, __shfl_xor(m, 32)); if (SWA) m = fmaxf(m, sink);
    float sum = 0.f;
    u32 pk[NKB][8];
#pragma unroll
    for (int kbi = 0; kbi < NKB; ++kbi)
#pragma unroll
        for (int i = 0; i < 16; i += 2) { const float e0 = __expf(x[kbi][i] - m), e1 = __expf(x[kbi][i + 1] - m); sum += e0 + e1; pk[kbi][i >> 1] = cvtpk(e0, e1); }
    sum += __shfl_xor(sum, 32); if (SWA) sum += __expf(sink - m);
    const float inv = 1.0f / sum;
    f32x16 o[D / 32];
#pragma unroll
    for (int db = 0; db < D / 32; ++db)
#pragma unroll
        for (int i = 0; i < 16; ++i) o[db][i] = 0.f;
#pragma unroll
    for (int kbi = 0; kbi < NKB; ++kbi)
#pragma unroll
        for (int s2 = 0; s2 < 2; ++s2) {
            u32x4 pw; pw.x = pk[kbi][4 * s2]; pw.y = pk[kbi][4 * s2 + 1]; pw.z = pk[kbi][4 * s2 + 2]; pw.w = pk[kbi][4 * s2 + 3];
            const bf16x8 pb = __builtin_bit_cast(bf16x8, pw);
#pragma unroll
            for (int db = 0; db < D / 32; ++db) {
                const LAS unsigned char* vp = Vl + (db * 32 + r32) * vstrideB + ((kb0 + kbi) * 32 + 16 * s2 + 4 * h) * 2;
                const s16x4 lo = *(const LAS s16x4*)vp, hi = *(const LAS s16x4*)(vp + 16);
                const bf16x8 a = __builtin_shufflevector(lo, hi, 0, 1, 2, 3, 4, 5, 6, 7);
                o[db] = MFMA32(a, pb, o[db]);
            }
        }
#pragma unroll
    for (int db = 0; db < D / 32; ++db)
#pragma unroll
        for (int g4 = 0; g4 < 4; ++g4) { u32x2 wv; wv.x = cvtpk(o[db][4 * g4] * inv, o[db][4 * g4 + 1] * inv); wv.y = cvtpk(o[db][4 * g4 + 2] * inv, o[db][4 * g4 + 3] * inv);
            *(u32x2*)(orow + db * 32 + 8 * g4 + 4 * h) = wv; }
}

__device__ __forceinline__ void phase_swa(const Ptrs& P, LAS unsigned char* lds, int G) {
    const int tid = threadIdx.x, l = tid & 63, w = __builtin_amdgcn_readfirstlane(tid >> 6);
    unsigned char* ws = P.ws;
    const bf16* Qb = (const bf16*)(ws + WS_Q); const bf16* Kb = (const bf16*)(ws + WS_K); const bf16* Vb = (const bf16*)(ws + WS_V); bf16* Ym = (bf16*)(ws + WS_YMIX);
    const float* bt = (const float*)(ws + WS_BIAS_TAB); const float* sinks = P.in[15];
    LAS unsigned char* Kl = lds;
    LAS unsigned char* Vl = lds + 36864;
    LAS float* bias_l = (LAS float*)(lds + 36864 + 33280);
    for (int it = blockIdx.x; it < 1024; it += G) {
        const int g = it & 3, n = (it >> 2) & 31, b = it >> 7;
        __syncthreads();
#pragma unroll
        for (int i = 0; i < 4; ++i) { const int e = tid + 512 * i, key = e >> 3, part = e & 7; const int kpos = n * 128 - 128 + key;
            u32x4 v = (u32x4){0u, 0u, 0u, 0u};
            if (kpos >= 0) v = *(const u32x4*)(Kb + ((size_t)b * SEQ + kpos) * 256 + g * 64 + part * 8);
            *(LAS u32x4*)(Kl + key * 144 + part * 16) = v; }
#pragma unroll
        for (int i = 0; i < 4; ++i) { const int e = tid + 512 * i, key = e & 255, part = e >> 8; const int kpos = n * 128 - 128 + key;
            u32x4 v = (u32x4){0u, 0u, 0u, 0u};
            if (kpos >= 0) v = *(const u32x4*)(Vb + ((size_t)b * SEQ + kpos) * 256 + g * 64 + part * 8);
#pragma unroll
            for (int jj = 0; jj < 8; ++jj) { const unsigned wv = v[jj >> 1]; *(LAS bf16*)(Vl + (part * 8 + jj) * 520 + key * 2) = (bf16)((jj & 1) ? (wv >> 16) : (wv & 0xffffu)); } }
        bias_l[tid] = bt[(4 * g + (tid >> 7)) * 128 + (tid & 127)];
        __syncthreads();
        const int r = w >> 1, hq = 4 * g + r; const float sink = sinks[hq];
#pragma unroll 1
        for (int t = 0; t < 2; ++t) {
            const int qq = 2 * (w & 1) + t, r32 = l & 31;
            const size_t qtok = (size_t)b * SEQ + n * 128 + 32 * qq + r32;
            attn_task<64, 5, true>(Qb + qtok * 1024 + hq * 64, Kl, 144, Vl, 520, qq, bias_l + r * 128, 128 + 32 * qq + r32, n == 0, sink, 0.125f,
                                   Ym + qtok * 2048 + 1024 + hq * 64, l);
        }
    }
}

__device__ __forceinline__ void phase_cross(const Ptrs& P, LAS unsigned char* lds, int G) {
    const int tid = threadIdx.x, l = tid & 63, w = __builtin_amdgcn_readfirstlane(tid >> 6);
    unsigned char* ws = P.ws;
    const bf16* Qc = (const bf16*)(ws + WS_QC); const bf16* KV = (const bf16*)(ws + WS_KV_C); bf16* Oc = (bf16*)(ws + WS_OC);
    LAS unsigned char* Kl = lds;
    LAS unsigned char* Vl = lds + 69632;
    int prev = -1;
    for (int it = blockIdx.x; it < 512; it += G) {
        const int qb = it & 15, hd = (it >> 4) & 3, b = it >> 6;
        if ((it >> 4) != prev) {
            prev = it >> 4;
            __syncthreads();
#pragma unroll
            for (int i = 0; i < 8; ++i) { const int e = tid + 512 * i, key = e >> 4, part = e & 15;
                *(LAS u32x4*)(Kl + key * 272 + part * 16) = *(const u32x4*)(KV + ((size_t)b * 256 + key) * 1024 + hd * 128 + part * 8); }
#pragma unroll
            for (int i = 0; i < 8; ++i) { const int e = tid + 512 * i, key = e & 255, part = e >> 8;
                const u32x4 v = *(const u32x4*)(KV + ((size_t)b * 256 + key) * 1024 + 512 + hd * 128 + part * 8);
#pragma unroll
                for (int jj = 0; jj < 8; ++jj) { const unsigned wv = v[jj >> 1]; *(LAS bf16*)(Vl + (part * 8 + jj) * 520 + key * 2) = (bf16)((jj & 1) ? (wv >> 16) : (wv & 0xffffu)); } }
            __syncthreads();
        }
        const size_t qtok = (size_t)b * SEQ + qb * 256 + 32 * w + (l & 31);
        attn_task<128, 8, false>(Qc + qtok * 512 + hd * 128, Kl, 272, Vl, 520, 0, (const LAS float*)lds, 0, false, 0.f, 0.08838834764831845f, Oc + qtok * 512 + hd * 128, l);
    }
}
__device__ __forceinline__ void topk_wave32(LAS unsigned char* wb, int l, int* TI, float* TG, size_t obase, size_t ostride) {
    const int j = l >> 1, half = l & 1, sw = 2 * (j & 7);
    u32 v[16];
#pragma unroll
    for (int gq = 0; gq < 4; ++gq) {
        u32 t[16];
#pragma unroll
        for (int i4 = 0; i4 < 4; ++i4) { const int i = 4 * gq + i4, ci = 2 * i + half, phys = ci ^ sw; const f32x4 f = *(const LAS f32x4*)(wb + j * 512 + phys * 16);
#pragma unroll
            for (int e = 0; e < 4; ++e) t[4 * i4 + e] = (f2key(f[e]) & ~0x7Fu) | (u32)(127 - (8 * i + 4 * half + e)); }
        sort16_desc(t);
        if (gq == 0) {
#pragma unroll
            for (int i = 0; i < 16; ++i) v[i] = t[i];
        } else merge_top16_desc(v, t);
    }
    LDS_WAIT(); asm volatile("" ::: "memory");
    {
        u32 o[16];
#pragma unroll
        for (int i = 0; i < 16; ++i) o[i] = (u32)__shfl_xor((int)v[i], 1);
        merge_top16_desc(v, o);
    }
    LAS u32* lut = (LAS u32*)wb;
#pragma unroll
    for (int i = 0; i < 16; ++i) lut[l * 16 + i] = v[i];
    float va[16], vb[16];
    {
        const bool c1 = (l >> 1) & 1;
#pragma unroll
        for (int i = 0; i < 16; ++i) { const u32 o = (u32)__shfl_xor((int)v[i], 2); const u32 a = c1 ? o : v[i], b = c1 ? v[i] : o; va[i] = key2f(a & ~0x7Fu); vb[i] = key2f(b & ~0x7Fu); }
    }
#define CAND(i, q) ((f2key(va[i] + vb[q]) & ~0xFFu) | (u32)(255 - (16 * (i) + (q))))
    u32 c[16];
    {
        u32 t[16];
#pragma unroll
        for (int q = 0; q < 16; ++q) c[q] = CAND(0, q);
        sort16_desc(c);
#pragma unroll
        for (int q = 0; q < 8; ++q) t[q] = CAND(1, q);
#pragma unroll
        for (int q = 0; q < 5; ++q) t[8 + q] = CAND(2, q);
        t[13] = CAND(3, 0); t[14] = CAND(3, 1); t[15] = CAND(3, 2);
        sort16_desc(t); merge_top16_desc(c, t);
        t[0] = CAND(3, 3); t[1] = CAND(4, 0); t[2] = CAND(4, 1); t[3] = CAND(4, 2); t[4] = CAND(5, 0); t[5] = CAND(5, 1); t[6] = CAND(6, 0); t[7] = CAND(6, 1);
        t[8] = CAND(7, 0); t[9] = CAND(7, 1); t[10] = CAND(8, 0); t[11] = CAND(9, 0); t[12] = CAND(10, 0); t[13] = CAND(11, 0); t[14] = CAND(12, 0); t[15] = CAND(13, 0);
        sort16_desc(t); merge_top16_desc(c, t);
        insert_top16_desc(c, CAND(14, 0)); insert_top16_desc(c, CAND(15, 0));
    }
#undef CAND
    LDS_WAIT(); asm volatile("" ::: "memory");
    float best[16]; int eidx[16];
    const int la = (l & ~2) * 16, lb = (l | 2) * 16;
#pragma unroll
    for (int r = 0; r < 16; ++r) { const u32 key = c[r]; const int pos = 255 - (int)(key & 0xFFu); best[r] = key2f(key & ~0xFFu);
        const int k0 = 127 - (int)(lut[la + (pos >> 4)] & 0x7Fu), k1 = 127 - (int)(lut[lb + (pos & 15)] & 0x7Fu); eidx[r] = k0 * 128 + k1; }
    float s = 0.f;
#pragma unroll
    for (int r = 0; r < 16; ++r) { best[r] = __expf(best[r] - key2f(c[0] & ~0xFFu)); s += best[r]; }
    const float inv = 1.0f / s;
    if ((l & 3) == 0) {
        const size_t o = obase + (size_t)(l >> 2) * ostride;
#pragma unroll
        for (int r4 = 0; r4 < 4; ++r4) { *(int4*)(TI + o + 4 * r4) = make_int4(eidx[4 * r4], eidx[4 * r4 + 1], eidx[4 * r4 + 2], eidx[4 * r4 + 3]);
            *(f32x4*)(TG + o + 4 * r4) = (f32x4){best[4 * r4] * inv, best[4 * r4 + 1] * inv, best[4 * r4 + 2] * inv, best[4 * r4 + 3] * inv}; }
    }
    LDS_WAIT(); asm volatile("" ::: "memory");
}
struct EpiTopk {
    static constexpr bool PERM = true, AFTER_DRAIN = true;
    const float* PS; int* TI; float* TG;
    __device__ __forceinline__ void fused(const pg8::f32x4 (&acc)[2][2][4][2], const pg8::Unit& u, int wr, int wc, int fr, int fq, LAS unsigned char* lds, int wid, int lane) const {
        const int cb0 = (8 * wc + 2 * fq) ^ (4 * (fr & 3));
        LAS unsigned char* wq0 = lds + (4 * wr) * 16384 + (2 * fr) * 512 + cb0 * 16;
        LAS unsigned char* wq1 = lds + (4 * wr) * 16384 + (2 * fr + 1) * 512 + (cb0 ^ 2) * 16;
#pragma unroll
        for (int ai = 0; ai < 2; ++ai) {
#pragma unroll
            for (int m = 0; m < 4; ++m) { const size_t row = (size_t)(u.pm * 256 + ai * 128 + wr * 64 + m * 16 + fr); const float r = pg8::row_rnorm(PS, row);
#pragma unroll
                for (int n = 0; n < 2; ++n) { *(LAS f32x4*)(wq0 + m * 16384 + n * 16) = acc[ai][0][m][n] * r; *(LAS f32x4*)(wq1 + m * 16384 + n * 16) = acc[ai][1][m][n] * r; } }
            __syncthreads();
            topk_wave32(lds + wid * 16384, lane, TI, TG, ((size_t)(u.pm * 256 + ai * 128 + 16 * wid) * 8 + u.pn) * 16, 128);
            __syncthreads();
        }
    }
};

typedef float f32x2 __attribute__((ext_vector_type(2)));

typedef float v32f_t __attribute__((ext_vector_type(32)));
struct PeerBuf { v6u_t u0, u1, v0, v1; u32x2 sc0, sc1; };
#define PEER_LD6(rs, so) ({ const u32x4 a_ = __builtin_bit_cast(u32x4, __builtin_amdgcn_raw_buffer_load_b128(rs, 16 * l, so, 0)); const u32x2 b_ = __builtin_bit_cast(u32x2, __builtin_amdgcn_raw_buffer_load_b64(rs, 1024 + 8 * l, so, 0)); (v6u_t){a_.x, a_.y, a_.z, a_.w, b_.x, b_.y}; })
template <class RS> __device__ __forceinline__ void peer_issue(PeerBuf& B, const RS& rsU, const RS& rsV, const RS& rsS, int ivA, int ivB, int k0, int l) {
    const int iv = (k0 & 64) ? ivB : ivA;
    const int e0 = __builtin_amdgcn_readlane(iv, (k0 & 63)), e1 = __builtin_amdgcn_readlane(iv, (k0 & 63) + 1);
    B.sc0 = __builtin_bit_cast(u32x2, __builtin_amdgcn_raw_buffer_load_b64(rsS, 0, e0 * 8, 0)); B.sc1 = __builtin_bit_cast(u32x2, __builtin_amdgcn_raw_buffer_load_b64(rsS, 0, e1 * 8, 0));
    B.u0 = PEER_LD6(rsU, e0 * PEER_ROW_BYTES); B.u1 = PEER_LD6(rsU, e1 * PEER_ROW_BYTES); B.v0 = PEER_LD6(rsV, e0 * PEER_ROW_BYTES); B.v1 = PEER_LD6(rsV, e1 * PEER_ROW_BYTES);
}
typedef __bf16 v32bf_t __attribute__((ext_vector_type(32)));
typedef __bf16 bf16x2v __attribute__((ext_vector_type(2)));
__device__ __forceinline__ float peer_dot6(v6u_t w, const u32 (&xp)[16]) { const v32bf_t f = __builtin_amdgcn_cvt_scalef32_pk32_bf16_fp6(w, 1.0f); float s = 0.f;
#define PD2(pp) s = __builtin_amdgcn_fdot2_f32_bf16(__builtin_bit_cast(bf16x2v, xp[pp]), __builtin_shufflevector(f, f, 2 * (pp), 2 * (pp) + 1), s, false);
    PD2(0) PD2(1) PD2(2) PD2(3) PD2(4) PD2(5) PD2(6) PD2(7) PD2(8) PD2(9) PD2(10) PD2(11) PD2(12) PD2(13) PD2(14) PD2(15)
#undef PD2
    return s; }
__device__ __forceinline__ void peer_axpy6(v6u_t w, float c, float (&acc)[32]) { const v32f_t f = __builtin_amdgcn_cvt_scalef32_pk32_f32_fp6(w, 1.0f);
#pragma unroll
    for (int i = 0; i < 32; ++i) acc[i] += c * f[i]; }
__device__ __forceinline__ void peer_axpy6v(v6u_t w, float c, v32f_t& acc) { const v32f_t f = __builtin_amdgcn_cvt_scalef32_pk32_f32_fp6(w, 1.0f); acc = acc + f * c; }
__device__ __forceinline__ void peer_compute(const PeerBuf& B, const u32 (&xr)[16], float (&acc)[32], float rn, int ivA, int ivB, float gvA, float gvB, int k0, int l) {
    const float gv = (k0 & 64) ? gvB : gvA; const int kk = k0 & 63;
    const float d0 = peer_dot6(B.u0, xr); __builtin_amdgcn_sched_barrier(0);
    const float d1 = peer_dot6(B.u1, xr); __builtin_amdgcn_sched_barrier(0);
    const bool o1 = l & 1;
    float t = (o1 ? d1 : d0) + __shfl_xor(o1 ? d0 : d1, 1);
#pragma unroll
    for (int o = 2; o < 64; o <<= 1) t += __shfl_xor(t, o);
    const float g0 = __uint_as_float(__builtin_amdgcn_readlane(__float_as_uint(gv), kk)), g1 = __uint_as_float(__builtin_amdgcn_readlane(__float_as_uint(gv), kk + 1));
    const float su = __uint_as_float(o1 ? B.sc1.x : B.sc0.x), sv = __uint_as_float(o1 ? B.sc1.y : B.sc0.y), gg = o1 ? g1 : g0;
    const float cf = gg * gelu_tanh(t * su * rn) * sv;
    const float c0 = __uint_as_float(__builtin_amdgcn_readlane(__float_as_uint(cf), 0)), c1 = __uint_as_float(__builtin_amdgcn_readlane(__float_as_uint(cf), 1));
    __builtin_amdgcn_sched_barrier(0);
    peer_axpy6(B.v0, c0, acc); __builtin_amdgcn_sched_barrier(0);
    peer_axpy6(B.v1, c1, acc); __builtin_amdgcn_sched_barrier(0);
}
#define XB_TMO      128
#define XB_XCNT(j)  (256  + 64 * (j))
#define XB_XSUB(j)  (1280 + 64 * (j))
#define XB_XGEN(j)  (2304 + 64 * (j))
#define XB_TOP      3328
#define XB_TOPGEN   3392
#define XCD_BAR_WORDS 3456
#define XB_SPIN_CAP (1u << 20)
__device__ __forceinline__ unsigned xb_ld(unsigned* p)              { return __hip_atomic_load(p, __ATOMIC_RELAXED, __HIP_MEMORY_SCOPE_AGENT); }
__device__ __forceinline__ unsigned xb_add(unsigned* p, unsigned v) { return __hip_atomic_fetch_add(p, v, __ATOMIC_RELAXED, __HIP_MEMORY_SCOPE_AGENT); }
__device__ __forceinline__ unsigned xb_xcc_id() { return (unsigned)__builtin_amdgcn_s_getreg((3 << 11) | 20) & 0xFu; }
#define XB_SPIN(cond, bar) do { unsigned _sp = 0; while (cond) { __builtin_amdgcn_s_sleep(1); \
    if ((++_sp & 255u) == 0u) { if (xb_ld(&(bar)[XB_TMO])) break; if (_sp > XB_SPIN_CAP) { atomicAdd(&(bar)[XB_TMO], 1u); break; } } } } while (0)
struct XcdBarrier { unsigned* bar; unsigned x; volatile LAS unsigned* st; };
__device__ __forceinline__ XcdBarrier xcd_barrier_post(unsigned* bar, volatile LAS unsigned* st) {
    XcdBarrier b; b.bar = bar; b.x = xb_xcc_id(); b.st = st;
    if (threadIdx.x == 0) (void)xb_add(&bar[XB_XCNT(b.x)], 1u);
    return b;
}
__device__ __forceinline__ void xcd_barrier_complete(unsigned* bar, unsigned x, unsigned& nloc, unsigned& nx) {
    const unsigned G = gridDim.x * gridDim.y * gridDim.z;
    unsigned sum, cnt, mine, sp = 0u;
    for (;;) {
        sum = 0u; cnt = 0u; mine = 0u;
#pragma unroll
        for (unsigned j = 0; j < 16; ++j) { const unsigned c = xb_ld(&bar[XB_XCNT(j)]); sum += c; cnt += (c > 0u) ? 1u : 0u; mine = (j == x) ? c : mine; }
        if (sum == G) break;
        __builtin_amdgcn_s_sleep(1);
        if ((++sp & 255u) == 0u) { if (xb_ld(&bar[XB_TMO])) break; if (sp > XB_SPIN_CAP) { atomicAdd(&bar[XB_TMO], 1u); break; } }
    }
    nloc = mine > 0u ? mine : 1u; nx = cnt > 0u ? cnt : 1u;
}
__device__ __forceinline__ void xcd_barrier(const XcdBarrier& b) {
    asm volatile("s_waitcnt vmcnt(0)" ::: "memory");
    __syncthreads();
    if (threadIdx.x == 0) {
        unsigned* bar = b.bar;
        __builtin_amdgcn_s_waitcnt(0);
        unsigned nloc = b.st[0], nx = b.st[1];
        if (nloc == 0u) { xcd_barrier_complete(bar, b.x, nloc, nx); b.st[0] = nloc; b.st[1] = nx; }
        const unsigned old = xb_add(&bar[XB_XSUB(b.x)], 1u);
        const unsigned gen = old / nloc;
        if (old + 1u == (gen + 1u) * nloc) {
            __builtin_amdgcn_fence(__ATOMIC_RELEASE, "agent");
            asm volatile("s_waitcnt vmcnt(0)" ::: "memory");
            const unsigned og = xb_add(&bar[XB_TOP], 1u);
            const unsigned tg = og / nx;
            if (og + 1u == (tg + 1u) * nx) xb_add(&bar[XB_TOPGEN], 1u);
            else XB_SPIN(xb_ld(&bar[XB_TOPGEN]) == tg, bar);
            __builtin_amdgcn_fence(__ATOMIC_ACQUIRE, "agent");
            xb_add(&bar[XB_XGEN(b.x)], 1u);
            asm volatile("s_waitcnt vmcnt(0)" ::: "memory");
        } else {
            XB_SPIN(xb_ld(&bar[XB_XGEN(b.x)]) == gen, bar);
            __builtin_amdgcn_fence(__ATOMIC_ACQUIRE, "agent");
            asm volatile("s_waitcnt vmcnt(0)" ::: "memory");
        }
    }
    __syncthreads();
}

template <int CTRL> __device__ __forceinline__ float dpp_f(float v) { return __int_as_float(__builtin_amdgcn_update_dpp(0, __float_as_int(v), CTRL, 0xF, 0xF, true)); }
__device__ __forceinline__ float row16_reduce8(const float (&d)[8], int ch) {
    const bool b0 = ch & 1, b1 = ch & 2;
    float e[4], f[2];
#pragma unroll
    for (int j = 0; j < 4; ++j) { const float keep = b0 ? d[2 * j + 1] : d[2 * j], give = b0 ? d[2 * j] : d[2 * j + 1]; e[j] = keep + dpp_f<0xB1>(give); }
#pragma unroll
    for (int m = 0; m < 2; ++m) { const float keep = b1 ? e[2 * m + 1] : e[2 * m], give = b1 ? e[2 * m] : e[2 * m + 1]; f[m] = keep + dpp_f<0x4E>(give); }
#pragma unroll
    for (int m = 0; m < 2; ++m) { f[m] += dpp_f<0x128>(f[m]); f[m] += dpp_f<0x124>(f[m]); }
    return (ch & 4) ? f[1] : f[0];
}
struct PeerHalf { v6u_t w0, w1, w2, w3, w4, w5, w6, w7; };
__device__ __forceinline__ void peer_q_ids(int (&el)[8], const int* p  ) {
#pragma unroll
    for (int st = 0; st < 8; st += 4) { const int4 t = *(const int4*)(p + st); el[st] = t.x; el[st + 1] = t.y; el[st + 2] = t.z; el[st + 3] = t.w; }
}
template <class RS> __device__ __forceinline__ void peer_q_issue(PeerHalf& B, const RS& rs, const int (&el)[8], int ch) {
#define PH_LD(st) ({ const int vo_ = el[st] * PEER_SROW; \
        const u32x4 a_ = __builtin_bit_cast(u32x4, __builtin_amdgcn_raw_buffer_load_b128(rs, vo_ + 16 * ch, 0, 0)); const u32x2 b_ = __builtin_bit_cast(u32x2, __builtin_amdgcn_raw_buffer_load_b64(rs, vo_ + 256 + 8 * ch, 0, 0)); \
        (v6u_t){a_.x, a_.y, a_.z, a_.w, b_.x, b_.y}; })
    B.w0 = PH_LD(0); B.w1 = PH_LD(1); B.w2 = PH_LD(2); B.w3 = PH_LD(3); B.w4 = PH_LD(4); B.w5 = PH_LD(5); B.w6 = PH_LD(6); B.w7 = PH_LD(7);
#undef PH_LD
}
__device__ __forceinline__ void peer_q_dots(const PeerHalf& B, const u32 (&xs)[16], LAS float* pd  , int ch) {
    float d[8], old[8];
#pragma unroll
    for (int st = 0; st < 8; ++st) old[st] = pd[st];
    d[0] = peer_dot6(B.w0, xs); __builtin_amdgcn_sched_barrier(0); d[1] = peer_dot6(B.w1, xs); __builtin_amdgcn_sched_barrier(0);
    d[2] = peer_dot6(B.w2, xs); __builtin_amdgcn_sched_barrier(0); d[3] = peer_dot6(B.w3, xs); __builtin_amdgcn_sched_barrier(0);
    d[4] = peer_dot6(B.w4, xs); __builtin_amdgcn_sched_barrier(0); d[5] = peer_dot6(B.w5, xs); __builtin_amdgcn_sched_barrier(0);
    d[6] = peer_dot6(B.w6, xs); __builtin_amdgcn_sched_barrier(0); d[7] = peer_dot6(B.w7, xs); __builtin_amdgcn_sched_barrier(0);
#pragma unroll
    for (int o = 1; o < 16; o <<= 1)
#pragma unroll
        for (int st = 0; st < 8; ++st) d[st] += __shfl_xor(d[st], o);
    if (ch == 0) {
#pragma unroll
        for (int st = 0; st < 8; ++st) pd[st] = old[st] + d[st];
    }
}
__device__ __forceinline__ void peer_q_axpy(const PeerHalf& B, const LAS float* pd  , v32f_t& acc) {
    float cf[8];
#pragma unroll
    for (int st = 0; st < 8; ++st) cf[st] = pd[st];
    peer_axpy6v(B.w0, cf[0], acc); __builtin_amdgcn_sched_barrier(0); peer_axpy6v(B.w1, cf[1], acc); __builtin_amdgcn_sched_barrier(0);
    peer_axpy6v(B.w2, cf[2], acc); __builtin_amdgcn_sched_barrier(0); peer_axpy6v(B.w3, cf[3], acc); __builtin_amdgcn_sched_barrier(0);
    peer_axpy6v(B.w4, cf[4], acc); __builtin_amdgcn_sched_barrier(0); peer_axpy6v(B.w5, cf[5], acc); __builtin_amdgcn_sched_barrier(0);
    peer_axpy6v(B.w6, cf[6], acc); __builtin_amdgcn_sched_barrier(0); peer_axpy6v(B.w7, cf[7], acc); __builtin_amdgcn_sched_barrier(0);
}
#define PH_LD1(st) ({ const int vo_ = el[st] * PEER_SROW; \
        const u32x4 a_ = __builtin_bit_cast(u32x4, __builtin_amdgcn_raw_buffer_load_b128(rs, vo_ + 16 * ch, 0, 0)); const u32x2 b_ = __builtin_bit_cast(u32x2, __builtin_amdgcn_raw_buffer_load_b64(rs, vo_ + 256 + 8 * ch, 0, 0)); \
        (v6u_t){a_.x, a_.y, a_.z, a_.w, b_.x, b_.y}; })
template <class RS> __device__ __forceinline__ void peer_q_issue_dots(PeerHalf& N, const RS& rs, const int (&el)[8], const PeerHalf& B, const u32 (&xs)[16], LAS float* pd, int ch) {
    float d[8];
    const float old = pd[ch & 7];
    N.w0 = PH_LD1(0); d[0] = peer_dot6(B.w0, xs); __builtin_amdgcn_sched_barrier(0); N.w1 = PH_LD1(1); d[1] = peer_dot6(B.w1, xs); __builtin_amdgcn_sched_barrier(0);
    N.w2 = PH_LD1(2); d[2] = peer_dot6(B.w2, xs); __builtin_amdgcn_sched_barrier(0); N.w3 = PH_LD1(3); d[3] = peer_dot6(B.w3, xs); __builtin_amdgcn_sched_barrier(0);
    N.w4 = PH_LD1(4); d[4] = peer_dot6(B.w4, xs); __builtin_amdgcn_sched_barrier(0); N.w5 = PH_LD1(5); d[5] = peer_dot6(B.w5, xs); __builtin_amdgcn_sched_barrier(0);
    N.w6 = PH_LD1(6); d[6] = peer_dot6(B.w6, xs); __builtin_amdgcn_sched_barrier(0); N.w7 = PH_LD1(7); d[7] = peer_dot6(B.w7, xs); __builtin_amdgcn_sched_barrier(0);
    const float tot = row16_reduce8(d, ch);
    if (ch < 8) pd[ch] = old + tot;
}
template <class RS> __device__ __forceinline__ void peer_q_issue_axpy(PeerHalf& N, const RS& rs, const int (&el)[8], int ch, const PeerHalf& B, const LAS float* pd, v32f_t& acc) {
    float cf[8];
#pragma unroll
    for (int st = 0; st < 8; ++st) cf[st] = pd[st];
    N.w0 = PH_LD1(0); peer_axpy6v(B.w0, cf[0], acc); __builtin_amdgcn_sched_barrier(0); N.w1 = PH_LD1(1); peer_axpy6v(B.w1, cf[1], acc); __builtin_amdgcn_sched_barrier(0);
    N.w2 = PH_LD1(2); peer_axpy6v(B.w2, cf[2], acc); __builtin_amdgcn_sched_barrier(0); N.w3 = PH_LD1(3); peer_axpy6v(B.w3, cf[3], acc); __builtin_amdgcn_sched_barrier(0);
    N.w4 = PH_LD1(4); peer_axpy6v(B.w4, cf[4], acc); __builtin_amdgcn_sched_barrier(0); N.w5 = PH_LD1(5); peer_axpy6v(B.w5, cf[5], acc); __builtin_amdgcn_sched_barrier(0);
    N.w6 = PH_LD1(6); peer_axpy6v(B.w6, cf[6], acc); __builtin_amdgcn_sched_barrier(0); N.w7 = PH_LD1(7); peer_axpy6v(B.w7, cf[7], acc); __builtin_amdgcn_sched_barrier(0);
}
#undef PH_LD1
__device__ __forceinline__ void phase_peer(const Ptrs& P, LAS unsigned char* lds, int G, const XcdBarrier* bar) {
    const int tid = threadIdx.x, l = tid & 63, w = __builtin_amdgcn_readfirstlane(tid >> 6);
    unsigned char* ws = P.ws;
    const bf16* HN = (const bf16*)(ws + WS_HN); const float* SUV = (const float*)(ws + WS_PEER_SU);
    const int* TI = (const int*)(ws + WS_TK_IDX); const float* TG = (const float*)(ws + WS_TK_G); float* out = P.out; bf16* OB = (bf16*)(ws + WS_OB); const float* gfin = P.in[27]; const float* PS = (const float*)(ws + WS_PS);
    LAS float* PD = (LAS float*)(lds + w * 8192);
    LAS float* SS = (LAS float*)(lds + 65536 + w * 64);
    const int es = l >> 4, ch = l & 15, stride = G * NWAVES, tok0 = blockIdx.x * NWAVES + w;
    (void)bar;
    if (l < 16) SS[l] = 0.f;
#pragma unroll
    for (int q = 0; q < 8; ++q) *(LAS f32x4*)(PD + 4 * l + 256 * q) = (f32x4){0.f, 0.f, 0.f, 0.f};
#pragma unroll 1
    for (int s = 0; s < 4; ++s) {
        const auto rsU = __builtin_amdgcn_make_buffer_rsrc((void*)(ws + WS_PEER_U + (size_t)s * PEER_SLICE_BYTES), 0, (int)PEER_SLICE_BYTES, 0x00020000);
        PeerHalf A, B;
        int elA[8], elB[8];
        u32 xs[16];
#pragma unroll
        for (int q = 0; q < 8; ++q) { const u32x2 a = *(const u32x2*)(HN + (size_t)tok0 * DM + 512 * s + 64 * q + 4 * ch); xs[2 * q] = a.x; xs[2 * q + 1] = a.y; }
        peer_q_ids(elA, TI + (size_t)tok0 * 128 + 8 * es); peer_q_ids(elB, TI + (size_t)tok0 * 128 + 32 + 8 * es);
        peer_q_issue(A, rsU, elA, ch);
#pragma unroll 1
        for (int i = 0; i < 16; ++i) {
            const size_t tok = (size_t)(tok0 + i * stride), ntok = (size_t)(tok0 + (i < 15 ? i + 1 : i) * stride);
            u32 nxs[16];
#pragma unroll
            for (int q = 0; q < 8; ++q) { const u32x2 a = *(const u32x2*)(HN + ntok * DM + 512 * s + 64 * q + 4 * ch); nxs[2 * q] = a.x; nxs[2 * q + 1] = a.y; }
            peer_q_ids(elA, TI + tok * 128 + 64 + 8 * es);   __builtin_amdgcn_sched_barrier(0);   peer_q_issue_dots(B, rsU, elB, A, xs, PD + i * 128 + 8 * es, ch);
            peer_q_ids(elB, TI + tok * 128 + 96 + 8 * es);   __builtin_amdgcn_sched_barrier(0);   peer_q_issue_dots(A, rsU, elA, B, xs, PD + i * 128 + 32 + 8 * es, ch);
            peer_q_ids(elA, TI + ntok * 128 + 8 * es);   __builtin_amdgcn_sched_barrier(0);   peer_q_issue_dots(B, rsU, elB, A, xs, PD + i * 128 + 64 + 8 * es, ch);
            peer_q_ids(elB, TI + ntok * 128 + 32 + 8 * es);   __builtin_amdgcn_sched_barrier(0);   peer_q_issue_dots(A, rsU, elA, B, xs, PD + i * 128 + 96 + 8 * es, ch);
#pragma unroll
            for (int q = 0; q < 16; ++q) xs[q] = nxs[q];
        }
    }
#pragma unroll 1
    for (int hb = 0; hb < 2; ++hb) {
        int ce[8][2]; float cg[8][2], cps[8];
#pragma unroll
        for (int j = 0; j < 8; ++j) { const size_t tok = (size_t)(tok0 + (8 * hb + j) * stride);
            cps[j] = l < 32 ? PS[tok * 32 + l] : 0.f;
            ce[j][0] = TI[tok * 128 + l]; ce[j][1] = TI[tok * 128 + 64 + l]; cg[j][0] = TG[tok * 128 + l]; cg[j][1] = TG[tok * 128 + 64 + l]; }
        f32x2 csc[8][2];
#pragma unroll
        for (int j = 0; j < 8; ++j) { csc[j][0] = *(const f32x2*)(SUV + 2 * ce[j][0]); csc[j][1] = *(const f32x2*)(SUV + 2 * ce[j][1]); }
#pragma unroll
        for (int j = 0; j < 8; ++j) { const int i = 8 * hb + j;
            const float rn = __builtin_amdgcn_rsqf(wave_sum(cps[j]) * (1.0f / 2048.0f) + NORM_EPS);
#pragma unroll
            for (int hh = 0; hh < 2; ++hh) { const int k = 64 * hh + l; PD[i * 128 + k] = cg[j][hh] * gelu_tanh(PD[i * 128 + k] * csc[j][hh].x * rn) * csc[j][hh].y; } }
    }
#pragma unroll 1
    for (int s = 0; s < 4; ++s) {
        const auto rsV = __builtin_amdgcn_make_buffer_rsrc((void*)(ws + WS_PEER_V + (size_t)s * PEER_SLICE_BYTES), 0, (int)PEER_SLICE_BYTES, 0x00020000);
        PeerHalf A, B;
        int elA[8], elB[8];
        peer_q_ids(elA, TI + (size_t)tok0 * 128 + 8 * es); peer_q_ids(elB, TI + (size_t)tok0 * 128 + 32 + 8 * es);
        peer_q_issue(A, rsV, elA, ch);
#pragma unroll 1
        for (int i = 0; i < 16; ++i) {
            const size_t tok = (size_t)(tok0 + i * stride), ntok = (size_t)(tok0 + (i < 15 ? i + 1 : i) * stride);
            u32x2 hw[2];
#pragma unroll
            for (int j = 0; j < 2; ++j) hw[j] = *(const u32x2*)(HN + tok * DM + 512 * s + 64 * (2 * es + j) + 4 * ch);
            v32f_t acc;
#pragma unroll
            for (int c = 0; c < 32; ++c) acc[c] = 0.f;
            peer_q_ids(elA, TI + tok * 128 + 64 + 8 * es);   __builtin_amdgcn_sched_barrier(0);   peer_q_issue_axpy(B, rsV, elB, ch, A, PD + i * 128 + 8 * es, acc);
            peer_q_ids(elB, TI + tok * 128 + 96 + 8 * es);   __builtin_amdgcn_sched_barrier(0);   peer_q_issue_axpy(A, rsV, elA, ch, B, PD + i * 128 + 32 + 8 * es, acc);
            peer_q_ids(elA, TI + ntok * 128 + 8 * es);   __builtin_amdgcn_sched_barrier(0);   peer_q_issue_axpy(B, rsV, elB, ch, A, PD + i * 128 + 64 + 8 * es, acc);
            peer_q_ids(elB, TI + ntok * 128 + 32 + 8 * es);   __builtin_amdgcn_sched_barrier(0);   peer_q_issue_axpy(A, rsV, elA, ch, B, PD + i * 128 + 96 + 8 * es, acc);
            float r1[16], r2[8];
#pragma unroll
            for (int c = 0; c < 16; ++c) { const auto pp = __builtin_amdgcn_permlane32_swap(__float_as_uint(acc[c]), __float_as_uint(acc[c + 16]), false, false); r1[c] = __uint_as_float(pp[0]) + __uint_as_float(pp[1]); }
#pragma unroll
            for (int c = 0; c < 8; ++c) { const auto pp = __builtin_amdgcn_permlane16_swap(__float_as_uint(r1[c]), __float_as_uint(r1[c + 8]), false, false); r2[c] = __uint_as_float(pp[0]) + __uint_as_float(pp[1]); }
            float ss = 0.f;
            {
                bf16* op = OB + tok * DM + 512 * s + 128 * es + 4 * ch;
#pragma unroll
                for (int j = 0; j < 2; ++j) {
                    const f32x4 o0 = {r2[4 * j] + bflo(hw[j].x), r2[4 * j + 1] + bfhi(hw[j].x), r2[4 * j + 2] + bflo(hw[j].y), r2[4 * j + 3] + bfhi(hw[j].y)};
                    ss += (o0[0] * o0[0] + o0[1] * o0[1]) + (o0[2] * o0[2] + o0[3] * o0[3]);
                    *(u32x2*)(op + 64 * j) = (u32x2){pk2(o0[0], o0[1]), pk2(o0[2], o0[3])}; }
            }
            ss = wave_sum(ss);
            if (l == 0) SS[i] += ss;
        }
    }
    asm volatile("s_waitcnt vmcnt(0) lgkmcnt(0)" ::: "memory");
    {
        f32x4 ga[8]; u32x2 cur[8];
#pragma unroll
        for (int j = 0; j < 8; ++j) { ga[j] = ((const f32x4*)gfin)[l + 64 * j]; cur[j] = ((const u32x2*)(OB + (size_t)tok0 * DM))[l + 64 * j]; }
#pragma unroll 1
        for (int i = 0; i < 16; ++i) {
            const size_t tok = (size_t)(tok0 + i * stride), ntok = (size_t)(tok0 + (i < 15 ? i + 1 : i) * stride);
            u32x2 nxt[8];
#pragma unroll
            for (int j = 0; j < 8; ++j) nxt[j] = ((const u32x2*)(OB + ntok * DM))[l + 64 * j];
            const float r = rsqrtf(SS[i] * (1.f / DM) + NORM_EPS);
            f32x4* op = (f32x4*)(out + tok * DM);
#pragma unroll
            for (int j = 0; j < 8; ++j) { const u32x2 o = cur[j]; op[l + 64 * j] = (f32x4){bflo(o.x) * r * ga[j].x, bfhi(o.x) * r * ga[j].y, bflo(o.y) * r * ga[j].z, bfhi(o.y) * r * ga[j].w}; }
#pragma unroll
            for (int j = 0; j < 8; ++j) cur[j] = nxt[j];
        }
    }
}

struct Params { const float* in[28]; float* out; unsigned char* ws; int ph_lo, ph_hi; };
constexpr int N_PHASES = 13;
#ifndef STOP_AFTER
#define STOP_AFTER 12
#endif

__global__ void __launch_bounds__(NTHREADS, 2) mega(Params prm) {
    extern __shared__ __attribute__((aligned(16))) unsigned char lds_raw[];
    LAS unsigned char* lds = (LAS unsigned char*)lds_raw;
    const int G = gridDim.x;
    Ptrs P;
#pragma unroll
    for (int i = 0; i < 28; ++i) P.in[i] = prm.in[i];
    P.out = prm.out; P.ws = prm.ws;
    unsigned char* ws = prm.ws;
    const int lo = prm.ph_lo, hi = prm.ph_hi;
#ifndef PHMASK
#define PHMASK 0x1fff
#endif
#define IN(k) (((PHMASK >> (k)) & 1) && lo <= (k) && (k) < hi)
#if ONE_LAUNCH
    volatile LAS unsigned* bst = (volatile LAS unsigned*)(lds + LDS_BYTES - 64);
    if (threadIdx.x == 0) { bst[0] = 0u; bst[1] = 0u; }
    __syncthreads();
    const XcdBarrier bar = xcd_barrier_post((unsigned*)(ws + WS_CTL), bst);
#define SEAM(k) do { if (IN(k) && IN((k) + 1)) xcd_barrier(bar); } while (0)
#ifndef PEER_SYNC
#define PEER_SYNC 0
#endif
#define PEER_BAR (PEER_SYNC ? &bar : (const XcdBarrier*)nullptr)
#else
#define SEAM(k) do { } while (0)
#define PEER_BAR ((const XcdBarrier*)nullptr)
#endif
    bf16* HN = (bf16*)(ws + WS_HN);
    if (IN(0)) { phase_prologue(P, lds, G); }
    SEAM(0);
    if (IN(1)) {
        __syncthreads();
        { pg8::Gemm g{HN, (const bf16*)(ws + WS_W_IN_T), NTOK, 2560, 2048}; pg8::StaticOrder S; S.init(NTOK, 2560, G, (int)blockIdx.x);
          pg8::EpiInProj E{(bf16*)(ws + WS_U), (bf16*)(ws + WS_Q), (bf16*)(ws + WS_K), (bf16*)(ws + WS_V)};
          pg8::gemm_phase<pg8::EpiInProj, pg8::StaticOrder, PG8_ALIGN, PG8_SP2>(lds, g, S, E); }
        __syncthreads();
        { pg8::Gemm g{(const bf16*)(ws + WS_MEM_N), (const bf16*)(ws + WS_W_CKV_T), 2048, 1024, 2048}; pg8::StaticOrder S; S.init(2048, 1024, G, (int)blockIdx.x);
          pg8::EpiBf16Plain E{(bf16*)(ws + WS_KV_C), 1024};
          pg8::gemm_phase<pg8::EpiBf16Plain, pg8::StaticOrder, PG8_ALIGN, PG8_SP2>(lds, g, S, E); }
        __syncthreads();
        {
            const int wv = __builtin_amdgcn_readfirstlane(threadIdx.x >> 6), ln = threadIdx.x & 63;
            constexpr int R1 = 32768;
            if (blockIdx.x >= 32) peer_quant_rows(P, lds, wv, ln, ((int)blockIdx.x - 32) * NWAVES + wv, (G - 32) * NWAVES, R1);
            else peer_quant_rows(P, lds, wv, ln, R1 + (int)blockIdx.x * NWAVES + wv, 32 * NWAVES, 32768);
        }
    }
    SEAM(1);
    if (IN(2)) {
#ifndef NO_S5
        __syncthreads(); phase_s5(P, lds, G);
#endif
#ifndef NO_SWA
        __syncthreads(); phase_swa(P, lds, G);
#endif
    }
    SEAM(2);
    if (IN(3)) {
        __syncthreads();
        pg8::Gemm g{(const bf16*)(ws + WS_YPRE), (const bf16*)(ws + WS_W_GLU_T), NTOK, 1024, 1024}; pg8::StaticOrder S; S.init(NTOK, 1024, G, (int)blockIdx.x);
        pg8::EpiGlu E{(bf16*)(ws + WS_YMIX), 2048, (const bf16*)(ws + WS_YPRE), 1024, P.in[14]};
        pg8::gemm_phase<pg8::EpiGlu, pg8::StaticOrder, PG8_ALIGN, PG8_SP2>(lds, g, S, E);
    }
    SEAM(3);
    if (IN(4)) {
        __syncthreads();
        pg8::Gemm g{(const bf16*)(ws + WS_YMIX), (const bf16*)(ws + WS_W_OUT_T), NTOK, 2048, 2048}; pg8::StaticOrder S; S.init(NTOK, 2048, G, (int)blockIdx.x);
        pg8::EpiResBf16<false> E{HN, P.in[0], (float*)(ws + WS_PS)};
        pg8::gemm_phase<pg8::EpiResBf16<false>, pg8::StaticOrder, PG8_ALIGN, PG8_SP2>(lds, g, S, E);
    }
    SEAM(4);
    if (IN(6)) {
        __syncthreads();
        pg8::Gemm g{HN, (const bf16*)(ws + WS_W_CQ_T), NTOK, 512, 2048}; pg8::StaticOrder S; S.init(NTOK, 512, G, (int)blockIdx.x);
        pg8::EpiBf16RowScale E{(bf16*)(ws + WS_QC), 512, (const float*)(ws + WS_PS)};
        pg8::gemm_phase<pg8::EpiBf16RowScale, pg8::StaticOrder, PG8_ALIGN, PG8_SP2>(lds, g, S, E);
    }
    SEAM(6);
    if (IN(7)) { __syncthreads(); phase_cross(P, lds, G); }
    SEAM(7);
    if (IN(8)) {
        __syncthreads();
        pg8::Gemm g{(const bf16*)(ws + WS_OC), (const bf16*)(ws + WS_W_CO_T), NTOK, 2048, 512}; pg8::StaticOrder S; S.init(NTOK, 2048, G, (int)blockIdx.x);
        pg8::EpiResBf16<true> E{HN, HN, (float*)(ws + WS_PS)};
        pg8::gemm_phase<pg8::EpiResBf16<true>, pg8::StaticOrder, PG8_ALIGN, PG8_SP2>(lds, g, S, E);
    }
    SEAM(8);
    if (IN(10)) {
        __syncthreads();
        pg8::Gemm g{HN, (const bf16*)(ws + WS_W_S_T), NTOK, 2048, 2048}; pg8::StaticOrder S; S.init(NTOK, 2048, G, (int)blockIdx.x);
        EpiTopk E{(const float*)(ws + WS_PS), (int*)(ws + WS_TK_IDX), (float*)(ws + WS_TK_G)};
        for (int i = 0; ; ++i) { pg8::Unit uu; if (!S.next(i, uu)) break; pg8::OneUnit O1{uu}; pg8::gemm_phase<EpiTopk, pg8::OneUnit, false, false>(lds, g, O1, E); }
    }
    SEAM(11);
    if (IN(12)) { __syncthreads(); phase_peer(P, lds, G, PEER_BAR); }
    if (lo <= 13 && 13 < hi) {
        const int lane = threadIdx.x & 63, wave = threadIdx.x >> 6;
        for (int m = blockIdx.x * NWAVES + wave; m < NTOK; m += G * NWAVES) {
            f32x4* xr = (f32x4*)(P.out + (size_t)m * DM) + lane; const f32x4* gr = (const f32x4*)P.in[27] + lane;
            f32x4 v[8]; float ss = 0.f;
#pragma unroll
            for (int j = 0; j < 8; ++j) { v[j] = xr[64 * j]; ss += (v[j].x * v[j].x + v[j].y * v[j].y) + (v[j].z * v[j].z + v[j].w * v[j].w); }
            const float r = rsqrtf(wave_sum(ss) * (1.f / DM) + NORM_EPS);
#pragma unroll
            for (int j = 0; j < 8; ++j) { const f32x4 g = gr[64 * j]; xr[64 * j] = (f32x4){v[j].x * r * g.x, v[j].y * r * g.y, v[j].z * r * g.z, v[j].w * r * g.w}; }
        }
    }
}

extern "C" void kernel_launch(void* const* d_in, const int* in_sizes, int n_in, void* d_out, int out_size, void* d_ws, size_t ws_size, hipStream_t stream) {
    static int grid = 0;
    if (!grid) {
        int dev = 0, cus = 0, per_cu = 0;
        if (hipGetDevice(&dev) != hipSuccess || hipDeviceGetAttribute(&cus, hipDeviceAttributeMultiprocessorCount, dev) != hipSuccess) { fprintf(stderr, "kernel_launch: device query failed\n"); return; }
        if (hipFuncSetAttribute((const void*)mega, hipFuncAttributeMaxDynamicSharedMemorySize, LDS_BYTES) != hipSuccess) { fprintf(stderr, "kernel_launch: hipFuncSetAttribute failed\n"); return; }
        if (hipOccupancyMaxActiveBlocksPerMultiprocessor(&per_cu, (const void*)mega, NTHREADS, LDS_BYTES) != hipSuccess || per_cu < 1) { fprintf(stderr, "kernel_launch: occupancy query says %d\n", per_cu); per_cu = 1; }
        grid = 256;
        if (cus != 256) fprintf(stderr, "kernel_launch: built for 256 CUs, device reports %d\n", cus);
        if (ws_size < WS_END || n_in != 28) fprintf(stderr, "kernel_launch: unexpected ws_size %zu / n_in %d\n", ws_size, n_in);
    }
    Params p{};
    for (int i = 0; i < 28; ++i) p.in[i] = (const float*)d_in[i];
    p.out = (float*)d_out; p.ws = (unsigned char*)d_ws;
#if ONE_LAUNCH
    p.ph_lo = 0; p.ph_hi = N_PHASES;
    if (hipMemsetAsync((char*)d_ws + WS_CTL, 0, CTL_ZERO_BYTES, stream) != hipSuccess) { fprintf(stderr, "kernel_launch: memset of the barrier words failed\n"); return; }
    hipLaunchKernelGGL(mega, dim3(grid), dim3(NTHREADS), LDS_BYTES, stream, p);
#else
#ifndef REPEAT_MASK
#define REPEAT_MASK 0
#endif
    for (int ph = 0; ph <= STOP_AFTER; ++ph) { p.ph_lo = ph; p.ph_hi = ph + 1;
        for (int rep = 0; rep < (((REPEAT_MASK >> ph) & 1) ? 2 : 1); ++rep) hipLaunchKernelGGL(mega, dim3(grid), dim3(NTHREADS), LDS_BYTES, stream, p); }
    if (STOP_AFTER < 12) { p.ph_lo = 13; p.ph_hi = 14; hipLaunchKernelGGL(mega, dim3(grid), dim3(NTHREADS), LDS_BYTES, stream, p); }
#endif
}
```

```cpp
#include <hip/hip_runtime.h>
#include <cstdio>
#include <cstdint>
#ifndef ONE_LAUNCH
#define ONE_LAUNCH 1
#endif
#define SN_HD __host__ __device__ __forceinline__
#ifndef SN_HD
#define SN_HD __host__ __device__ __forceinline__
#endif
typedef unsigned int u32;
SN_HD u32 sn_max(u32 a, u32 b) { return a > b ? a : b; }
SN_HD u32 sn_min(u32 a, u32 b) { return a < b ? a : b; }
SN_HD u32 f2key(float f) { u32 u = __builtin_bit_cast(u32, f); return (u & 0x80000000u) ? ~u : (u | 0x80000000u); }
SN_HD float key2f(u32 k) { u32 u = (k & 0x80000000u) ? (k & 0x7fffffffu) : ~k; return __builtin_bit_cast(float, u); }
template <int BASE> SN_HD void bitonic_merge16_desc(u32 (&v)[64]) {
#pragma unroll
    for (int j = 8; j > 0; j >>= 1) {
#pragma unroll
        for (int i = 0; i < 16; ++i) { const int l = i ^ j; if (l > i) { const u32 a = v[BASE + i], b = v[BASE + l]; v[BASE + i] = sn_max(a, b); v[BASE + l] = sn_min(a, b); } }
    }
}
template <int BASE> SN_HD void bitonic_sort16_desc(u32 (&v)[64]) {
#pragma unroll
    for (int k = 2; k <= 16; k <<= 1) {
#pragma unroll
        for (int j = k >> 1; j > 0; j >>= 1) {
#pragma unroll
            for (int i = 0; i < 16; ++i) { const int l = i ^ j; if (l > i) { const u32 a = v[BASE + i], b = v[BASE + l]; const bool desc = ((i & k) == 0);
                v[BASE + i] = desc ? sn_max(a, b) : sn_min(a, b); v[BASE + l] = desc ? sn_min(a, b) : sn_max(a, b); } }
        }
    }
}
template <int A, int B> SN_HD void merge_top16(u32 (&v)[64]) {
#pragma unroll
    for (int i = 0; i < 16; ++i) v[A + i] = sn_max(v[A + i], v[B + 15 - i]);
    bitonic_merge16_desc<A>(v);
}
SN_HD void top16_of_64(u32 (&v)[64]) {
    bitonic_sort16_desc<0>(v); bitonic_sort16_desc<16>(v); bitonic_sort16_desc<32>(v); bitonic_sort16_desc<48>(v);
    merge_top16<0, 16>(v); merge_top16<32, 48>(v); merge_top16<0, 32>(v);
}

SN_HD void merge_sorted16_desc(u32 (&a)[16]) {
#pragma unroll
    for (int j = 8; j > 0; j >>= 1) {
#pragma unroll
        for (int i = 0; i < 16; ++i) { const int l = i ^ j; if (l > i) { const u32 x = a[i], y = a[l]; a[i] = sn_max(x, y); a[l] = sn_min(x, y); } }
    }
}
SN_HD void sort16_desc(u32 (&a)[16]) {
#pragma unroll
    for (int k = 2; k <= 16; k <<= 1) {
#pragma unroll
        for (int j = k >> 1; j > 0; j >>= 1) {
#pragma unroll
            for (int i = 0; i < 16; ++i) { const int l = i ^ j; if (l > i) { const u32 x = a[i], y = a[l]; const bool desc = ((i & k) == 0);
                a[i] = desc ? sn_max(x, y) : sn_min(x, y); a[l] = desc ? sn_min(x, y) : sn_max(x, y); } }
        }
    }
}
SN_HD void merge_top16_desc(u32 (&a)[16], const u32 (&b)[16]) {
#pragma unroll
    for (int i = 0; i < 16; ++i) a[i] = sn_max(a[i], b[15 - i]);
    merge_sorted16_desc(a);
}
SN_HD void insert_top16_desc(u32 (&a)[16], u32 x) {
#pragma unroll
    for (int k = 15; k > 0; --k) a[k] = sn_max(a[k], sn_min(a[k - 1], x));
    a[0] = sn_max(a[0], x);
}
namespace pg8 {
#define PG8_LAS __attribute__((address_space(3)))
typedef unsigned short bf16_t;
typedef short bf16x8 __attribute__((ext_vector_type(8)));
typedef float f32x4 __attribute__((ext_vector_type(4)));
typedef unsigned u32x4 __attribute__((ext_vector_type(4)));
constexpr int BM = 256, BK = 64, HALF = 128, HTB = HALF * BK * 2  , STAGE_BYTES = 8 * HTB, NXCD = 8, WGM = 4;

__host__ __device__ __forceinline__ int lds_byte(int r, int c) { const int st = (r >> 4) * 2 + (c >> 5), rr = r & 15, cc = c & 31, ob = rr * 64 + cc * 2; return st * 1024 + (ob ^ (((ob >> 9) & 1) << 5)); }
__host__ __device__ __forceinline__ void stage_rc(int b, int& R, int& C) { const int st = b / 1024, sb = b % 1024, swz = sb ^ (((sb >> 9) & 1) << 5); R = (st >> 1) * 16 + swz / 64; C = (st & 1) * 32 + (swz % 64) / 2; }
__host__ __device__ __forceinline__ int perm32(int rho) { const int n = rho >> 4, i = rho & 15; return 8 * (i >> 2) + 4 * n + (i & 3); }

struct Unit { int pm, pn; };
struct Gemm { const bf16_t* A; const bf16_t* Bt; int M, N, K; };

struct StaticOrder {
    int nM, nN, nwg, G, c;
    __host__ __device__ void init(int M, int N, int G_, int c_) { nM = M / BM; nN = N / BM; nwg = nM * nN; G = G_; c = c_; }
    __host__ __device__ bool next(int i, Unit& u) const {
        const long L = (long)i * G + c; if (L >= nwg) return false;
        int wgid = (int)L; { const int q = nwg / NXCD, r = nwg % NXCD, xcd = wgid % NXCD, off = wgid / NXCD; wgid = (xcd < r ? xcd * (q + 1) : r * (q + 1) + (xcd - r) * q) + off; }
        const int nig = WGM * nN, gid = wgid / nig, fm = gid * WGM, gsz = (nM - fm) < WGM ? (nM - fm) : WGM;
        u.pm = fm + ((wgid % nig) % gsz); u.pn = (wgid % nig) / gsz; return true;
    }
    __device__ __forceinline__ void a_ready(const Unit&) const {}
    __device__ __forceinline__ void done(const Unit&) const {}
};

typedef float f32x2_t __attribute__((ext_vector_type(2)));
typedef __bf16 bf16x2_t __attribute__((ext_vector_type(2)));
struct OneUnit { Unit u;
    __device__ __forceinline__ bool next(int i, Unit& o) const { if (i) return false; o = u; return true; }
    __device__ __forceinline__ void a_ready(const Unit&) const {}
    __device__ __forceinline__ void done(const Unit&) const {} };

__device__ __forceinline__ unsigned cvt_pk_bf16(float lo, float hi) { const f32x2_t f = {lo, hi}; const bf16x2_t b = __builtin_convertvector(f, bf16x2_t); return __builtin_bit_cast(unsigned, b); }


template <class Epi, class Sched, bool ALIGN_EPI = false, bool SP2 = false>
__device__ __forceinline__ void gemm_phase(PG8_LAS unsigned char* lds, const Gemm g, const Sched& S, const Epi& E) {
    const int tid = threadIdx.x, wid = __builtin_amdgcn_readfirstlane(tid >> 6), lane = tid & 63, wr = wid >> 2, wc = wid & 3, fr = lane & 15, fq = lane >> 4;
    const int K = g.K, nt = K / BK;
    unsigned voffA[2], voffB[2];
#pragma unroll
    for (int i = 0; i < 2; ++i) { int R, C; stage_rc(tid * 16 + i * 8192, R, C); const int Rb = Epi::PERM ? ((R & ~31) + perm32(R & 31)) : R;
        voffA[i] = (unsigned)(R * K + C) * 2u; voffB[i] = (unsigned)(Rb * K + C) * 2u; }
    const size_t kstep = (size_t)(BK * 2);
    const size_t hstep = (size_t)HALF * K * 2;
    const size_t tstep = 2 * hstep;
    const unsigned ldsw = (unsigned)wid * 1024u;
    const int aoff = lds_byte(wr * 64 + fr, fq * 8), boff = lds_byte(wc * 32 + fr, fq * 8);
#define PG8_SA(b, h) (((b) * 2 + (h)) * HTB)
#define PG8_SB(b, h) ((4 + (b) * 2 + (h)) * HTB)
#define PG8_STAGE(bufoff, gbase, voff) do { _Pragma("unroll") for (int _i = 0; _i < 2; ++_i) \
        __builtin_amdgcn_global_load_lds((const unsigned*)((const char*)(gbase) + (voff)[_i]), (PG8_LAS unsigned*)(lds + (bufoff) + ldsw + _i * 8192), 16, 0, 0); } while (0)
#define PG8_LDA(dst, b, h) do { _Pragma("unroll") for (int m = 0; m < 4; ++m) _Pragma("unroll") for (int k = 0; k < 2; ++k) dst[m][k] = *(const PG8_LAS bf16x8*)(lds + PG8_SA(b, h) + aoff + m * 2048 + k * 1024); } while (0)
#define PG8_LDB(dst, b, h) do { _Pragma("unroll") for (int n = 0; n < 2; ++n) _Pragma("unroll") for (int k = 0; k < 2; ++k) dst[n][k] = *(const PG8_LAS bf16x8*)(lds + PG8_SB(b, h) + boff + n * 2048 + k * 1024); } while (0)
#define PG8_MMA(ai, bj, At, Bt) do { __builtin_amdgcn_s_setprio(1); _Pragma("unroll") for (int m = 0; m < 4; ++m) _Pragma("unroll") for (int n = 0; n < 2; ++n) _Pragma("unroll") for (int k = 0; k < 2; ++k) \
        acc[ai][bj][m][n] = __builtin_amdgcn_mfma_f32_16x16x32_bf16(Bt[n][k], At[m][k], acc[ai][bj][m][n], 0, 0, 0); __builtin_amdgcn_s_setprio(0); } while (0)
#define PG8_WAIT_V(n) asm volatile("s_waitcnt vmcnt(" #n ")" ::: "memory")
#define PG8_WAIT_L(n) asm volatile("s_waitcnt lgkmcnt(" #n ")" ::: "memory")
#define PG8_BAR __builtin_amdgcn_s_barrier()
#define PG8_SCHED __builtin_amdgcn_sched_barrier(0)
    Unit cur, nxt; int ui = 0;
    if (!S.next(0, cur)) return;
    f32x4 acc[2][2][4][2];
#pragma unroll
    for (int a = 0; a < 2; ++a)
#pragma unroll
        for (int b = 0; b < 2; ++b)
#pragma unroll
            for (int m = 0; m < 4; ++m)
#pragma unroll
                for (int n = 0; n < 2; ++n) acc[a][b][m][n] = (f32x4){0.f, 0.f, 0.f, 0.f};
    bf16x8 At[4][2], B0[2][2], B1[2][2];
    const char* cA = (const char*)g.A + (size_t)cur.pm * tstep; const char* cB = (const char*)g.Bt + (size_t)cur.pn * tstep;
    S.a_ready(cur);
    if constexpr (SP2) {
        PG8_STAGE(PG8_SB(0, 0), cB, voffB); PG8_STAGE(PG8_SB(0, 1), cB + hstep, voffB); PG8_STAGE(PG8_SA(0, 0), cA, voffA); PG8_STAGE(PG8_SA(0, 1), cA + hstep, voffA);
        if (wr == 1) PG8_BAR;
        PG8_WAIT_V(2); PG8_BAR;
        PG8_STAGE(PG8_SB(1, 0), cB + kstep, voffB); PG8_STAGE(PG8_SA(1, 0), cA + kstep, voffA); PG8_STAGE(PG8_SB(1, 1), cB + hstep + kstep, voffB);
        PG8_WAIT_V(6); PG8_BAR;
    } else {
        PG8_STAGE(PG8_SB(0, 0), cB, voffB); PG8_STAGE(PG8_SA(0, 0), cA, voffA); PG8_STAGE(PG8_SB(0, 1), cB + hstep, voffB); PG8_STAGE(PG8_SA(0, 1), cA + hstep, voffA);
        if (wr == 1) PG8_BAR;
        PG8_WAIT_V(4); PG8_BAR;
        PG8_STAGE(PG8_SB(1, 0), cB + kstep, voffB); PG8_STAGE(PG8_SA(1, 0), cA + kstep, voffA); PG8_STAGE(PG8_SB(1, 1), cB + hstep + kstep, voffB);
        PG8_WAIT_V(6); PG8_BAR;
    }
    for (;;) {
        const bool has_next = S.next(ui + 1, nxt);
        const char* nA = has_next ? (const char*)g.A + (size_t)nxt.pm * tstep : cA; const char* nB = has_next ? (const char*)g.Bt + (size_t)nxt.pn * tstep : cB;
        for (int t = 0; t < nt; t += 2) {
            const bool last = (t == nt - 2);
            const char* a1 = cA + (size_t)(t + 1) * kstep;
            const char* a2 = last ? nA : cA + (size_t)(t + 2) * kstep; const char* b2 = last ? nB : cB + (size_t)(t + 2) * kstep;
            const char* a3 = a2 + kstep; const char* b3 = b2 + kstep;
            if (last && has_next) S.a_ready(nxt);
            if constexpr (SP2) {
            PG8_LDB(B0, 0, 0); PG8_LDB(B1, 0, 1); PG8_SCHED; PG8_LDA(At, 0, 0); PG8_STAGE(PG8_SA(1, 1), a1 + hstep, voffA);
            PG8_WAIT_V(8); PG8_WAIT_L(0); PG8_BAR; PG8_MMA(0, 0, At, B0); PG8_MMA(0, 1, At, B1); PG8_BAR; PG8_SCHED;
            PG8_LDA(At, 0, 1); PG8_STAGE(PG8_SB(0, 0), b2, voffB); PG8_STAGE(PG8_SB(0, 1), b2 + hstep, voffB); PG8_STAGE(PG8_SA(0, 0), a2, voffA);
            PG8_WAIT_V(8); PG8_WAIT_L(0); PG8_BAR; PG8_MMA(1, 0, At, B0); PG8_MMA(1, 1, At, B1); PG8_BAR; PG8_SCHED;
            PG8_LDB(B0, 1, 0); PG8_LDB(B1, 1, 1); PG8_SCHED; PG8_LDA(At, 1, 0); PG8_STAGE(PG8_SA(0, 1), a2 + hstep, voffA);
            PG8_WAIT_V(8); PG8_WAIT_L(0); PG8_BAR; PG8_MMA(0, 0, At, B0); PG8_MMA(0, 1, At, B1); PG8_BAR; PG8_SCHED;
            PG8_LDA(At, 1, 1); PG8_STAGE(PG8_SB(1, 0), b3, voffB); PG8_STAGE(PG8_SB(1, 1), b3 + hstep, voffB); PG8_STAGE(PG8_SA(1, 0), a3, voffA);
            PG8_WAIT_V(8); PG8_WAIT_L(0); PG8_BAR; PG8_MMA(1, 0, At, B0); PG8_MMA(1, 1, At, B1); PG8_BAR; PG8_SCHED;
            } else {
            PG8_LDB(B0, 0, 0); PG8_SCHED; PG8_LDA(At, 0, 0); PG8_STAGE(PG8_SA(1, 1), a1 + hstep, voffA);
            PG8_WAIT_L(8); PG8_BAR; PG8_WAIT_L(0); PG8_MMA(0, 0, At, B0); PG8_BAR; PG8_SCHED;
            PG8_LDB(B1, 0, 1); PG8_STAGE(PG8_SB(0, 0), b2, voffB);
            PG8_BAR; PG8_WAIT_L(0); PG8_MMA(0, 1, At, B1); PG8_BAR;
            PG8_LDA(At, 0, 1); PG8_STAGE(PG8_SA(0, 0), a2, voffA);
            PG8_BAR; PG8_WAIT_L(0); PG8_MMA(1, 0, At, B0); PG8_BAR; PG8_SCHED;
            PG8_STAGE(PG8_SB(0, 1), b2 + hstep, voffB);
            PG8_WAIT_V(6); PG8_BAR; PG8_MMA(1, 1, At, B1); PG8_BAR;
            PG8_LDB(B0, 1, 0); PG8_SCHED; PG8_LDA(At, 1, 0); PG8_STAGE(PG8_SA(0, 1), a2 + hstep, voffA);
            PG8_WAIT_L(8); PG8_BAR; PG8_WAIT_L(0); PG8_MMA(0, 0, At, B0); PG8_BAR; PG8_SCHED;
            PG8_LDB(B1, 1, 1); PG8_STAGE(PG8_SB(1, 0), b3, voffB);
            PG8_BAR; PG8_WAIT_L(0); PG8_MMA(0, 1, At, B1); PG8_BAR;
            PG8_LDA(At, 1, 1); PG8_STAGE(PG8_SA(1, 0), a3, voffA);
            PG8_BAR; PG8_WAIT_L(0); PG8_MMA(1, 0, At, B0); PG8_BAR; PG8_SCHED;
            PG8_STAGE(PG8_SB(1, 1), b3 + hstep, voffB);
            PG8_WAIT_V(6); PG8_BAR; PG8_MMA(1, 1, At, B1); PG8_BAR;
            }
        }
        if constexpr (ALIGN_EPI) { if (wr == 0) PG8_BAR; }
        if constexpr (!Epi::AFTER_DRAIN) { E(acc, cur, wr, wc, fr, fq); S.done(cur); }
        if (!has_next) break;
#pragma unroll
        for (int a = 0; a < 2; ++a)
#pragma unroll
            for (int b = 0; b < 2; ++b)
#pragma unroll
                for (int m = 0; m < 4; ++m)
#pragma unroll
                    for (int n = 0; n < 2; ++n) acc[a][b][m][n] = (f32x4){0.f, 0.f, 0.f, 0.f};
        cur = nxt; cA = nA; cB = nB; ++ui;
        if constexpr (ALIGN_EPI) { if (wr == 1) PG8_BAR; }
    }
    PG8_WAIT_V(0);
    if constexpr (!ALIGN_EPI) { if (wr == 0) PG8_BAR; }
    PG8_BAR;
    if constexpr (Epi::AFTER_DRAIN) { E.fused(acc, cur, wr, wc, fr, fq, lds, wid, lane); S.done(cur); }
#undef PG8_SA
#undef PG8_SB
#undef PG8_STAGE
#undef PG8_LDA
#undef PG8_LDB
#undef PG8_MMA
#undef PG8_WAIT_V
#undef PG8_WAIT_L
#undef PG8_BAR
#undef PG8_SCHED
}

struct EpiInProj {
    static constexpr bool PERM = true, AFTER_DRAIN = false;
    bf16_t *U, *Q, *Kb, *Vb;
    __device__ __forceinline__ void operator()(const f32x4 (&acc)[2][2][4][2], const Unit& u, int wr, int wc, int fr, int fq) const {
        const int row0 = u.pm * BM + wr * 64 + fr;
        if (u.pn < 4) {
            const int col0 = u.pn * BM + wc * 32 + 8 * fq;
#pragma unroll
            for (int ai = 0; ai < 2; ++ai)
#pragma unroll
                for (int m = 0; m < 4; ++m) { const int row = row0 + ai * HALF + m * 16, b = row >> 12, t = row & 4095;
#pragma unroll
                    for (int bj = 0; bj < 2; ++bj) { const int col = col0 + bj * HALF; const f32x4 v0 = acc[ai][bj][m][0], v1 = acc[ai][bj][m][1];
                        u32x4 w; w.x = cvt_pk_bf16(v0[0], v0[1]); w.y = cvt_pk_bf16(v0[2], v0[3]); w.z = cvt_pk_bf16(v1[0], v1[1]); w.w = cvt_pk_bf16(v1[2], v1[3]);
                        *(u32x4*)(U + (((size_t)(b * 64 + (col >> 4)) * 4096 + t) * 16 + (col & 8))) = w; } }
            return;
        }
        bf16_t* base; int ldc, colt;
        if (u.pn < 8) { base = Q; ldc = 1024; colt = (u.pn - 4) * BM; } else if (u.pn == 8) { base = Kb; ldc = 256; colt = 0; } else { base = Vb; ldc = 256; colt = 0; }
        const int col0 = colt + wc * 32 + 8 * fq;
#pragma unroll
        for (int ai = 0; ai < 2; ++ai)
#pragma unroll
            for (int m = 0; m < 4; ++m) { bf16_t* rowp = base + (size_t)(row0 + ai * HALF + m * 16) * ldc + col0;
#pragma unroll
                for (int bj = 0; bj < 2; ++bj) { const f32x4 v0 = acc[ai][bj][m][0], v1 = acc[ai][bj][m][1];
                    u32x4 w; w.x = cvt_pk_bf16(v0[0], v0[1]); w.y = cvt_pk_bf16(v0[2], v0[3]); w.z = cvt_pk_bf16(v1[0], v1[1]); w.w = cvt_pk_bf16(v1[2], v1[3]);
                    *(u32x4*)(rowp + bj * HALF) = w; } }
    }
};
struct EpiBf16Plain {
    static constexpr bool PERM = true, AFTER_DRAIN = false;
    bf16_t* O; int ldc;
    __device__ __forceinline__ void operator()(const f32x4 (&acc)[2][2][4][2], const Unit& u, int wr, int wc, int fr, int fq) const {
        const int row0 = u.pm * BM + wr * 64 + fr, col0 = u.pn * BM + wc * 32 + 8 * fq;
#pragma unroll
        for (int ai = 0; ai < 2; ++ai)
#pragma unroll
            for (int m = 0; m < 4; ++m) { bf16_t* rowp = O + (size_t)(row0 + ai * HALF + m * 16) * ldc + col0;
#pragma unroll
                for (int bj = 0; bj < 2; ++bj) { const f32x4 v0 = acc[ai][bj][m][0], v1 = acc[ai][bj][m][1];
                    u32x4 w; w.x = cvt_pk_bf16(v0[0], v0[1]); w.y = cvt_pk_bf16(v0[2], v0[3]); w.z = cvt_pk_bf16(v1[0], v1[1]); w.w = cvt_pk_bf16(v1[2], v1[3]);
                    *(u32x4*)(rowp + bj * HALF) = w; } }
    }
};
struct EpiGlu {
    static constexpr bool PERM = true, AFTER_DRAIN = false;
    bf16_t* O; int ldo; const bf16_t* Y; int ldy; const float* bias;
    __device__ __forceinline__ void operator()(const f32x4 (&acc)[2][2][4][2], const Unit& u, int wr, int wc, int fr, int fq) const {
        const int row0 = u.pm * BM + wr * 64 + fr, col0 = u.pn * BM + wc * 32 + 8 * fq;
        f32x4 bv[2][2];
#pragma unroll
        for (int bj = 0; bj < 2; ++bj)
#pragma unroll
            for (int n = 0; n < 2; ++n) bv[bj][n] = *(const f32x4*)(bias + col0 + bj * HALF + 4 * n);
#pragma unroll
        for (int ai = 0; ai < 2; ++ai)
#pragma unroll
            for (int m = 0; m < 4; ++m) { const size_t row = (size_t)(row0 + ai * HALF + m * 16);
#pragma unroll
                for (int bj = 0; bj < 2; ++bj) {
                    const u32x4 yw = *(const u32x4*)(Y + row * ldy + col0 + bj * HALF);
                    float o[8];
#pragma unroll
                    for (int e = 0; e < 8; ++e) { const float a = acc[ai][bj][m][e >> 2][e & 3] + bv[bj][e >> 2][e & 3];
                        const unsigned yy = yw[e >> 1]; const float y = __uint_as_float((e & 1) ? (yy & 0xffff0000u) : (yy << 16));
                        o[e] = y / (1.0f + __expf(-a)); }
                    u32x4 w; w.x = cvt_pk_bf16(o[0], o[1]); w.y = cvt_pk_bf16(o[2], o[3]); w.z = cvt_pk_bf16(o[4], o[5]); w.w = cvt_pk_bf16(o[6], o[7]);
                    *(u32x4*)(O + row * ldo + col0 + bj * HALF) = w; } }
    }
};
struct EpiResF32 {
    static constexpr bool PERM = false, AFTER_DRAIN = false;
    float* C; const float* R; int ldc;
    __device__ __forceinline__ void operator()(const f32x4 (&acc)[2][2][4][2], const Unit& u, int wr, int wc, int fr, int fq) const {
        const int row0 = u.pm * BM + wr * 64 + fr, col0 = u.pn * BM + wc * 32 + 4 * fq;
#pragma unroll
        for (int ai = 0; ai < 2; ++ai)
#pragma unroll
            for (int m = 0; m < 4; ++m) { const size_t off = (size_t)(row0 + ai * HALF + m * 16) * ldc + col0;
#pragma unroll
                for (int bj = 0; bj < 2; ++bj)
#pragma unroll
                    for (int n = 0; n < 2; ++n) { f32x4 v = acc[ai][bj][m][n]; if (R) v = v + *(const f32x4*)(R + off + bj * HALF + n * 16); *(f32x4*)(C + off + bj * HALF + n * 16) = v; } }
    }
};
__device__ __forceinline__ float row_rnorm(const float* PS, size_t row) {
    const f32x4* p = (const f32x4*)(PS + row * 32); float s = 0.f;
#pragma unroll
    for (int i = 0; i < 8; ++i) { const f32x4 v = p[i]; s += (v[0] + v[1]) + (v[2] + v[3]); }
    return __builtin_amdgcn_rsqf(s * (1.0f / 2048.0f) + 1e-6f);
}
template <bool RBF16> struct EpiResBf16 {
    static constexpr bool PERM = true, AFTER_DRAIN = false;
    bf16_t* H; const void* R; float* PS;
    __device__ __forceinline__ void operator()(const f32x4 (&acc)[2][2][4][2], const Unit& u, int wr, int wc, int fr, int fq) const {
        const int row0 = u.pm * BM + wr * 64 + fr, col0 = u.pn * BM + wc * 32 + 8 * fq;
#pragma unroll
        for (int ai = 0; ai < 2; ++ai)
#pragma unroll
            for (int m = 0; m < 4; ++m) { const size_t row = (size_t)(row0 + ai * HALF + m * 16), off = row * 2048 + col0; float ss = 0.f;
#pragma unroll
                for (int bj = 0; bj < 2; ++bj) {
                    f32x4 r0, r1;
                    if (RBF16) { const u32x4 rw = *(const u32x4*)((const bf16_t*)R + off + bj * HALF);
                        r0 = (f32x4){__uint_as_float(rw.x << 16), __uint_as_float(rw.x & 0xffff0000u), __uint_as_float(rw.y << 16), __uint_as_float(rw.y & 0xffff0000u)};
                        r1 = (f32x4){__uint_as_float(rw.z << 16), __uint_as_float(rw.z & 0xffff0000u), __uint_as_float(rw.w << 16), __uint_as_float(rw.w & 0xffff0000u)}; }
                    else { r0 = *(const f32x4*)((const float*)R + off + bj * HALF); r1 = *(const f32x4*)((const float*)R + off + bj * HALF + 4); }
                    const f32x4 v0 = acc[ai][bj][m][0] + r0, v1 = acc[ai][bj][m][1] + r1;
                    ss += ((v0[0] * v0[0] + v0[1] * v0[1]) + (v0[2] * v0[2] + v0[3] * v0[3])) + ((v1[0] * v1[0] + v1[1] * v1[1]) + (v1[2] * v1[2] + v1[3] * v1[3]));
                    u32x4 w; w.x = cvt_pk_bf16(v0[0], v0[1]); w.y = cvt_pk_bf16(v0[2], v0[3]); w.z = cvt_pk_bf16(v1[0], v1[1]); w.w = cvt_pk_bf16(v1[2], v1[3]);
                    *(u32x4*)(H + off + bj * HALF) = w; }
                ss += __shfl_xor(ss, 16); ss += __shfl_xor(ss, 32);
                if (fq == 0) PS[row * 32 + u.pn * 4 + wc] = ss; }
    }
};
struct EpiBf16RowScale {
    static constexpr bool PERM = true, AFTER_DRAIN = false;
    bf16_t* O; int ldc; const float* PS;
    __device__ __forceinline__ void operator()(const f32x4 (&acc)[2][2][4][2], const Unit& u, int wr, int wc, int fr, int fq) const {
        const int row0 = u.pm * BM + wr * 64 + fr, col0 = u.pn * BM + wc * 32 + 8 * fq;
#pragma unroll
        for (int ai = 0; ai < 2; ++ai)
#pragma unroll
            for (int m = 0; m < 4; ++m) { const size_t row = (size_t)(row0 + ai * HALF + m * 16); const float r = row_rnorm(PS, row); bf16_t* rowp = O + row * ldc + col0;
#pragma unroll
                for (int bj = 0; bj < 2; ++bj) { const f32x4 v0 = acc[ai][bj][m][0] * r, v1 = acc[ai][bj][m][1] * r;
                    u32x4 w; w.x = cvt_pk_bf16(v0[0], v0[1]); w.y = cvt_pk_bf16(v0[2], v0[3]); w.z = cvt_pk_bf16(v1[0], v1[1]); w.w = cvt_pk_bf16(v1[2], v1[3]);
                    *(u32x4*)(rowp + bj * HALF) = w; } }
    }
};
struct EpiF32RowScale {
    static constexpr bool PERM = true, AFTER_DRAIN = false;
    float* C; int ldc; const float* PS;
    __device__ __forceinline__ void operator()(const f32x4 (&acc)[2][2][4][2], const Unit& u, int wr, int wc, int fr, int fq) const {
        const int row0 = u.pm * BM + wr * 64 + fr, col0 = u.pn * BM + wc * 32 + 8 * fq;
#pragma unroll
        for (int ai = 0; ai < 2; ++ai)
#pragma unroll
            for (int m = 0; m < 4; ++m) { const size_t row = (size_t)(row0 + ai * HALF + m * 16); const float r = row_rnorm(PS, row); const size_t off = row * ldc + col0;
#pragma unroll
                for (int bj = 0; bj < 2; ++bj) { *(f32x4*)(C + off + bj * HALF) = acc[ai][bj][m][0] * r; *(f32x4*)(C + off + bj * HALF + 4) = acc[ai][bj][m][1] * r; } }
    }
};
}

#ifndef PG8_SP2
#define PG8_SP2 false
#endif
#ifndef PG8_ALIGN
#define PG8_ALIGN true
#endif
constexpr int NTOK = 32768, DM = 2048, SEQ = 4096, NB = 8;
constexpr int NWAVES = 8, NTHREADS = 512;
constexpr int LDS_BYTES = 147456;
constexpr float NORM_EPS = 1e-6f;

#define LAS __attribute__((address_space(3)))
typedef unsigned short bf16;
typedef unsigned u32;
typedef short bf16x8 __attribute__((ext_vector_type(8)));
typedef short s16x4 __attribute__((ext_vector_type(4)));
typedef float f32x4 __attribute__((ext_vector_type(4)));
typedef float f32x16 __attribute__((ext_vector_type(16)));
typedef unsigned u32x4 __attribute__((ext_vector_type(4)));
typedef unsigned u32x2 __attribute__((ext_vector_type(2)));

constexpr size_t MiB = 1u << 20;
constexpr size_t WS_CTL = 0, CTL_ZERO_BYTES = 64 * 1024;
constexpr size_t WS_W_IN_T = 1 * MiB, WS_W_GLU_T = 11 * MiB, WS_W_OUT_T = 13 * MiB, WS_W_CQ_T = 21 * MiB, WS_W_CKV_T = 23 * MiB, WS_W_CO_T = 27 * MiB, WS_W_S_T = 29 * MiB;
constexpr size_t WS_S5_WIN = 37 * MiB, WS_S5_WOUT = 41 * MiB, WS_S5_K = 45 * MiB, WS_S5_LAM = 46 * MiB, WS_BIAS_TAB = 46 * MiB + 512 * 1024;
constexpr size_t WS_MEM_N = 47 * MiB, WS_KV_C = 55 * MiB, WS_PS = 59 * MiB;
#ifndef FP6_PACK_INTERLEAVED
#define FP6_PACK_INTERLEAVED 1
#endif
typedef unsigned v6u_t __attribute__((ext_vector_type(6)));
constexpr int PEER_ROW_BYTES = 1536;
constexpr int PEER_SROW = 384;
constexpr size_t PEER_SLICE_BYTES = (size_t)16384 * PEER_SROW;
constexpr size_t WS_PEER_U = 64 * MiB, WS_PEER_V = 96 * MiB;
constexpr size_t WS_PEER_SU = 128 * MiB, WS_PEER_SV = 128 * MiB + 65536;
constexpr size_t WS_HN = 192 * MiB;
constexpr size_t WS_U = 320 * MiB, WS_Q = 384 * MiB, WS_K = 448 * MiB, WS_V = 464 * MiB, WS_YPRE = 480 * MiB, WS_YMIX = 544 * MiB;
constexpr size_t WS_OB = 320 * MiB;
constexpr size_t WS_SCORES = 320 * MiB;
constexpr size_t WS_QC = 672 * MiB, WS_OC = 704 * MiB, WS_TK_IDX = 736 * MiB, WS_TK_G = 752 * MiB, WS_END = 768 * MiB;

__device__ __forceinline__ unsigned f2bf(float f) { unsigned u = __float_as_uint(f); return (u + 0x7fffu + ((u >> 16) & 1u)) >> 16; }
__device__ __forceinline__ unsigned pk2(float lo, float hi) { return pg8::cvt_pk_bf16(lo, hi); }
__device__ __forceinline__ unsigned cvtpk(float lo, float hi) { return pg8::cvt_pk_bf16(lo, hi); }
__device__ __forceinline__ float bflo(unsigned w) { return __uint_as_float(w << 16); }
__device__ __forceinline__ float bfhi(unsigned w) { return __uint_as_float(w & 0xffff0000u); }
__device__ __forceinline__ float wave_sum(float v) {
#pragma unroll
    for (int o = 1; o < 64; o <<= 1) v += __shfl_xor(v, o);
    return v;
}
__device__ __forceinline__ float gelu_tanh(float x) { const float z = 0.7978845608028654f * (x + 0.044715f * x * x * x); return x / (1.0f + __expf(-2.0f * z)); }
#define LDS_WAIT() asm volatile("s_waitcnt lgkmcnt(0)" ::: "memory")
#define MFMA16(a, b, c) __builtin_amdgcn_mfma_f32_16x16x32_bf16((a), (b), (c), 0, 0, 0)
#define MFMA32(a, b, c) __builtin_amdgcn_mfma_f32_32x32x16_bf16((a), (b), (c), 0, 0, 0)

__device__ __forceinline__ void p0_transpose_item(const float* W, int K, int N, bf16* WT, LAS float* scr, int item, int lane, const float* kgain = nullptr) {
    const int nblk = N / 32, kb = item / nblk, nb = item % nblk, k0 = 64 * kb, n0 = 32 * nb;
    f32x4 v[8];
#pragma unroll
    for (int i = 0; i < 8; ++i) v[i] = *(const f32x4*)(W + (size_t)(k0 + 8 * i + (lane >> 3)) * N + n0 + 4 * (lane & 7));
#pragma unroll
    for (int i = 0; i < 8; ++i) { const int kk = 8 * i + (lane >> 3); f32x4 x = v[i]; if (kgain) x = x * kgain[k0 + kk];
#pragma unroll
        for (int c = 0; c < 4; ++c) scr[kk * 33 + 4 * (lane & 7) + c] = x[c]; }
    LDS_WAIT(); asm volatile("" ::: "memory");
    const int c = lane & 7;
#pragma unroll
    for (int j = 0; j < 4; ++j) { const int n = (lane >> 3) + 8 * j; const LAS float* s = scr + (8 * c) * 33 + n;
        u32x4 o; o.x = pk2(s[0 * 33], s[1 * 33]); o.y = pk2(s[2 * 33], s[3 * 33]); o.z = pk2(s[4 * 33], s[5 * 33]); o.w = pk2(s[6 * 33], s[7 * 33]);
        *(u32x4*)(WT + (size_t)(n0 + n) * K + k0 + 8 * c) = o; }
    LDS_WAIT(); asm volatile("" ::: "memory");
}
__device__ __forceinline__ void rms_row_to_bf16(const float* xrow, const float* gain, bf16* orow, int lane) {
    const f32x4* xr = (const f32x4*)xrow + lane; const f32x4* gr = (const f32x4*)gain + lane;
    f32x4 v[8]; float s = 0.f;
#pragma unroll
    for (int j = 0; j < 8; ++j) { v[j] = xr[64 * j]; s += (v[j].x * v[j].x + v[j].y * v[j].y) + (v[j].z * v[j].z + v[j].w * v[j].w); }
    const float r = rsqrtf(wave_sum(s) * (1.f / DM) + NORM_EPS);
    u32x2* o8 = (u32x2*)orow + lane;
#pragma unroll
    for (int j = 0; j < 8; ++j) { const f32x4 g = gr[64 * j]; u32x2 w; w.x = pk2(v[j].x * r * g.x, v[j].y * r * g.y); w.y = pk2(v[j].z * r * g.z, v[j].w * r * g.w); o8[64 * j] = w; }
}

struct Ptrs {
    const float* in[28]; float* out; unsigned char* ws;
};

__device__ __forceinline__ void phase_prologue(const Ptrs& P, LAS unsigned char* lds, int G) {
    const int tid = threadIdx.x, lane = tid & 63, wave = __builtin_amdgcn_readfirstlane(tid >> 6);
    unsigned char* ws = P.ws;
    {
        const float* wq = P.in[23]; const float* sk = P.in[24]; bf16* WsT = (bf16*)(ws + WS_W_S_T);
        LAS float* wq_l = (LAS float*)lds;
        LAS float* sk_l = wq_l + 64 * 129;
        for (int it = blockIdx.x; it < 512; it += G) {
            const int hc = it >> 5, d0 = (it & 31) * 64;
            __syncthreads();
#pragma unroll
            for (int i = 0; i < 4; ++i) { const int e = tid + 512 * i, dl = e >> 5, j4 = (e & 31) * 4; f32x4 v = *(const f32x4*)(wq + (size_t)(d0 + dl) * 2048 + hc * 128 + j4); v = v * P.in[22][d0 + dl];
#pragma unroll
                for (int c = 0; c < 4; ++c) wq_l[dl * 129 + j4 + c] = v[c]; }
#pragma unroll
            for (int i = 0; i < 8; ++i) { const int e = tid + 512 * i, kk = e >> 5, j4 = (e & 31) * 4; const f32x4 v = *(const f32x4*)(sk + ((size_t)hc * 128 + kk) * 128 + j4);
#pragma unroll
                for (int c = 0; c < 4; ++c) sk_l[kk * 129 + j4 + c] = v[c]; }
            __syncthreads();
            const int kb = wave & 3, db = wave >> 2;
            const LAS float* ap = sk_l + (32 * kb + (lane & 31)) * 129 + (lane >> 5); const LAS float* bp = wq_l + (32 * db + (lane & 31)) * 129 + (lane >> 5);
            f32x16 acc;
#pragma unroll
            for (int i = 0; i < 16; ++i) acc[i] = 0.f;
#pragma unroll 16
            for (int st = 0; st < 64; ++st) acc = __builtin_amdgcn_mfma_f32_32x32x2f32(ap[2 * st], bp[2 * st], acc, 0, 0, 0);
#pragma unroll
            for (int r = 0; r < 16; ++r) { const int key = (r & 3) + 8 * (r >> 2) + 4 * (lane >> 5);
                WsT[(size_t)(hc * 128 + 32 * kb + key) * 2048 + d0 + 32 * db + (lane & 31)] = (bf16)f2bf(acc[r]); }
        }
        __syncthreads();
    }
    {
        const float *lam_re = P.in[5], *lam_im = P.in[6], *b_re = P.in[7], *b_im = P.in[8], *c_re = P.in[9], *c_im = P.in[10], *dd = P.in[11], *log_dt = P.in[12];
        LAS float* pwr = (LAS float*)lds;
        LAS float* bbar = pwr + 17 * 64 * 2;
        LAS float* cc = bbar + 64 * 16 * 2;
        for (int gi = blockIdx.x; gi < 256; gi += G) {
            const int g = gi >> 2, qt = gi & 3;
            __syncthreads();
            if (tid < 64) {
                const int p = tid; const float lre = lam_re[g * 64 + p], lim = lam_im[g * 64 + p], dt = expf(log_dt[g]);
                const float er = expf(lre * dt); float sn, cs; sincosf(lim * dt, &sn, &cs);
                const float lbr = er * cs, lbi = er * sn;
                const float nr = lbr - 1.0f, ni = lbi, den = lre * lre + lim * lim;
                const float fr = (nr * lre + ni * lim) / den, fi = (ni * lre - nr * lim) / den;
#pragma unroll
                for (int h = 0; h < 16; ++h) { const float br = b_re[(g * 64 + p) * 16 + h], bi = b_im[(g * 64 + p) * 16 + h];
                    bbar[(p * 16 + h) * 2] = fr * br - fi * bi; bbar[(p * 16 + h) * 2 + 1] = fr * bi + fi * br; }
                float pr = 1.f, pi = 0.f;
                for (int j = 0; j <= 16; ++j) { pwr[(j * 64 + p) * 2] = pr; pwr[(j * 64 + p) * 2 + 1] = pi; const float t = pr * lbr - pi * lbi; pi = pr * lbi + pi * lbr; pr = t; }
            }
            for (int e = tid; e < 1024; e += NTHREADS) { cc[e * 2] = c_re[g * 1024 + e]; cc[e * 2 + 1] = c_im[g * 1024 + e]; }
            __syncthreads();
            bf16* Win = (bf16*)(ws + WS_S5_WIN) + (size_t)g * 32768; bf16* Wout = (bf16*)(ws + WS_S5_WOUT) + (size_t)g * 32768; bf16* Kt = (bf16*)(ws + WS_S5_K) + (size_t)g * 4096;
            for (int e = qt * 8192 + tid; e < (qt + 1) * 8192; e += NTHREADS) {
                const int m = e >> 8, kk = e & 255, p = m & 63, ri = m >> 6, sg = kk >> 4, hp = kk & 15;
                const float ar = pwr[((15 - sg) * 64 + p) * 2], ai = pwr[((15 - sg) * 64 + p) * 2 + 1], xr = bbar[(p * 16 + hp) * 2], xi = bbar[(p * 16 + hp) * 2 + 1];
                Win[e] = (bf16)f2bf(ri ? (ar * xi + ai * xr) : (ar * xr - ai * xi));
            }
            for (int e = qt * 8192 + tid; e < (qt + 1) * 8192; e += NTHREADS) {
                const int mm = e >> 7, m = e & 127, tau = mm >> 4, h = mm & 15, p = m & 63, ri = m >> 6;
                const float ar = pwr[((tau + 1) * 64 + p) * 2], ai = pwr[((tau + 1) * 64 + p) * 2 + 1], cr = cc[(h * 64 + p) * 2], ci = cc[(h * 64 + p) * 2 + 1];
                Wout[e] = (bf16)f2bf(ri ? -(cr * ai + ci * ar) : (cr * ar - ci * ai));
            }
            for (int e = qt * 1024 + tid; e < (qt + 1) * 1024; e += NTHREADS) {
                const int j = e >> 8, h = (e >> 4) & 15, hp = e & 15; float s = 0.f;
                for (int p = 0; p < 64; ++p) { const float ar = pwr[(j * 64 + p) * 2], ai = pwr[(j * 64 + p) * 2 + 1], cr = cc[(h * 64 + p) * 2], ci = cc[(h * 64 + p) * 2 + 1];
                    const float wr = cr * ar - ci * ai, wi = cr * ai + ci * ar; s += wr * bbar[(p * 16 + hp) * 2] - wi * bbar[(p * 16 + hp) * 2 + 1]; }
                if (j == 0 && h == hp) s += dd[g * 16 + h];
                Kt[e] = (bf16)f2bf(s);
            }
            if (tid < 64 && qt == 0) { float* lamq = (float*)(ws + WS_S5_LAM) + g * 128; lamq[2 * tid] = pwr[(16 * 64 + tid) * 2]; lamq[2 * tid + 1] = pwr[(16 * 64 + tid) * 2 + 1]; }
        }
        __syncthreads();
    }
    {
        const float* rel_bias = P.in[2]; float* bt = (float*)(ws + WS_BIAS_TAB);
        for (int e = blockIdx.x * NTHREADS + tid; e < 2048; e += G * NTHREADS) {
            const int hq = e >> 7, dist = e & 127; int bucket = dist;
            if (dist >= 16) { int lg = 16 + (int)(logf((float)dist / 16.0f) / logf(8.0f) * 16.0f); bucket = lg < 31 ? lg : 31; }
            bt[e] = rel_bias[bucket * 16 + hq];
        }
    }
    {
        LAS float* scr = (LAS float*)(lds + wave * 16384);
        const int gw = blockIdx.x * NWAVES + wave, NGW = G * NWAVES;
        constexpr int I0 = 32 * 80, I1 = 16 * 32, I2 = 32 * 64, I3 = 32 * 16, I4 = 32 * 32, I5 = 8 * 64;
        for (int it = gw; it < I0 + I1 + I2 + I3 + I4 + I5; it += NGW) {
            int r = it;
            if (r < I0) { p0_transpose_item(P.in[4], 2048, 2560, (bf16*)(ws + WS_W_IN_T), scr, r, lane); continue; } r -= I0;
            if (r < I1) { p0_transpose_item(P.in[13], 1024, 1024, (bf16*)(ws + WS_W_GLU_T), scr, r, lane); continue; } r -= I1;
            if (r < I2) { p0_transpose_item(P.in[16], 2048, 2048, (bf16*)(ws + WS_W_OUT_T), scr, r, lane); continue; } r -= I2;
            if (r < I3) { p0_transpose_item(P.in[19], 2048, 512, (bf16*)(ws + WS_W_CQ_T), scr, r, lane, P.in[17]); continue; } r -= I3;
            if (r < I4) { p0_transpose_item(P.in[20], 2048, 1024, (bf16*)(ws + WS_W_CKV_T), scr, r, lane); continue; } r -= I4;
            p0_transpose_item(P.in[21], 512, 2048, (bf16*)(ws + WS_W_CO_T), scr, r, lane);
        }
        {
            f32x4 a[8], b[8];
#pragma unroll
            for (int j = 0; j < 8; ++j) { a[j] = ((const f32x4*)(P.in[0] + (size_t)gw * DM))[lane + 64 * j]; b[j] = ((const f32x4*)(P.in[0] + (size_t)(gw + NGW) * DM))[lane + 64 * j]; }
#pragma unroll 1
            for (int m = gw; m < NTOK; m += 2 * NGW) {
                const int mn = (m + 2 * NGW < NTOK) ? m + 2 * NGW : m;
                f32x4 na[8], nb[8];
#pragma unroll
                for (int j = 0; j < 8; ++j) { na[j] = ((const f32x4*)(P.in[0] + (size_t)mn * DM))[lane + 64 * j]; nb[j] = ((const f32x4*)(P.in[0] + (size_t)(mn + NGW) * DM))[lane + 64 * j]; }
                float s0 = 0.f, s1 = 0.f;
#pragma unroll
                for (int j = 0; j < 8; ++j) { s0 += (a[j].x * a[j].x + a[j].y * a[j].y) + (a[j].z * a[j].z + a[j].w * a[j].w); s1 += (b[j].x * b[j].x + b[j].y * b[j].y) + (b[j].z * b[j].z + b[j].w * b[j].w); }
                const float r0 = rsqrtf(wave_sum(s0) * (1.f / DM) + NORM_EPS), r1 = rsqrtf(wave_sum(s1) * (1.f / DM) + NORM_EPS);
                u32x2* o0 = (u32x2*)((bf16*)(ws + WS_HN) + (size_t)m * DM) + lane; u32x2* o1 = (u32x2*)((bf16*)(ws + WS_HN) + (size_t)(m + NGW) * DM) + lane;
#pragma unroll
                for (int j = 0; j < 8; ++j) { const f32x4 g = ((const f32x4*)P.in[3])[lane + 64 * j];
                    u32x2 w0, w1; w0.x = pk2(a[j].x * r0 * g.x, a[j].y * r0 * g.y); w0.y = pk2(a[j].z * r0 * g.z, a[j].w * r0 * g.w); w1.x = pk2(b[j].x * r1 * g.x, b[j].y * r1 * g.y); w1.y = pk2(b[j].z * r1 * g.z, b[j].w * r1 * g.w);
                    o0[64 * j] = w0; o1[64 * j] = w1; }
#pragma unroll
                for (int j = 0; j < 8; ++j) { a[j] = na[j]; b[j] = nb[j]; }
            }
        }
        for (int m = gw; m < 2048; m += NGW) rms_row_to_bf16(P.in[1] + (size_t)m * DM, P.in[18], (bf16*)(ws + WS_MEM_N) + (size_t)m * DM, lane);
    }
}

__device__ __forceinline__ void peer_quant_rows(const Ptrs& P, LAS unsigned char* lds, int wave, int lane, int first, int step, int r_hi) {
    unsigned char* ws = P.ws; (void)lds; (void)wave;
    if (first >= r_hi) return;
    typedef float v16f_t __attribute__((ext_vector_type(16)));
    const int lo4 = 128 * (lane >> 4) + (lane & 15);
#define PQ_SRC(r) (((r) >> 14) ? P.in[26] : P.in[25]) + (size_t)((r) & 16383) * DM
#define PQ_LOAD(V, r) { const f32x4* s4_ = (const f32x4*)(PQ_SRC(r)) + lo4; _Pragma("unroll") for (int q = 0; q < 8; ++q) V[q] = s4_[16 * q]; }
#define PQ_ROW(V, r) { const int t_ = (r) >> 14, e_ = (r) & 16383; float mx = 0.f; \
        if (t_ == 0) { _Pragma("unroll") for (int q = 0; q < 8; ++q) V[q] = V[q] * ((const f32x4*)P.in[22])[lo4 + 16 * q]; } \
        _Pragma("unroll") for (int q = 0; q < 8; ++q) mx = fmaxf(mx, fmaxf(fmaxf(fabsf(V[q].x), fabsf(V[q].y)), fmaxf(fabsf(V[q].z), fabsf(V[q].w)))); \
        _Pragma("unroll") for (int o = 1; o < 64; o <<= 1) mx = fmaxf(mx, __shfl_xor(mx, o)); \
        const float sc = mx > 0.f ? mx * (1.0f / 7.5f) : 1.0f, inv = 1.0f / sc; \
        v16f_t lo16, hi16; \
        _Pragma("unroll") for (int q = 0; q < 8; ++q) { lo16[2 * q] = V[q].x * inv; hi16[2 * q] = V[q].y * inv; lo16[2 * q + 1] = V[q].z * inv; hi16[2 * q + 1] = V[q].w * inv; } \
        const v6u_t wq = __builtin_amdgcn_cvt_scalef32_2xpk16_fp6_f32(lo16, hi16, 1.0f);        \
        unsigned char* dst = ws + (t_ ? WS_PEER_V : WS_PEER_U) + (size_t)(lane >> 4) * PEER_SLICE_BYTES + (size_t)e_ * PEER_SROW; \
          \
        *(u32x4*)(dst + 16 * (lane & 15)) = (u32x4){wq[0], wq[1], wq[2], wq[3]}; *(u32x2*)(dst + 256 + 8 * (lane & 15)) = (u32x2){wq[4], wq[5]}; \
        if (lane == 0) ((float*)(ws + WS_PEER_SU))[2 * e_ + t_] = sc;        }
    f32x4 va[8], vb[8];
    { const int r1 = first + step < r_hi ? first + step : first; PQ_LOAD(va, first) PQ_LOAD(vb, r1) }
#pragma unroll 1
    for (int rr = first; rr < r_hi; rr += 2 * step) {
        const bool two = rr + step < r_hi;
        const int n0 = rr + 2 * step < r_hi ? rr + 2 * step : rr, n1 = rr + 3 * step < r_hi ? rr + 3 * step : n0;
        f32x4 na[8], nb[8];
        PQ_LOAD(na, n0) PQ_LOAD(nb, n1)
        PQ_ROW(va, rr)
        if (two) PQ_ROW(vb, rr + step)
#pragma unroll
        for (int q = 0; q < 8; ++q) { va[q] = na[q]; vb[q] = nb[q]; }
    }
#undef PQ_SRC
#undef PQ_LOAD
#undef PQ_ROW
}

__device__ __forceinline__ void phase_norm(const float* h, const float* gain, bf16* hn, int G) {
    const int lane = threadIdx.x & 63, wave = __builtin_amdgcn_readfirstlane(threadIdx.x >> 6);
    for (int m = blockIdx.x * NWAVES + wave; m < NTOK; m += G * NWAVES) rms_row_to_bf16(h + (size_t)m * DM, gain, hn + (size_t)m * DM, lane);
}

__device__ __forceinline__ void phase_s5(const Ptrs& P, LAS unsigned char* lds, int G) {
    const int tid = threadIdx.x, l = tid & 63, w = __builtin_amdgcn_readfirstlane(tid >> 6);
    unsigned char* ws = P.ws;
    const bf16* U = (const bf16*)(ws + WS_U); bf16* Y = (bf16*)(ws + WS_YPRE);
    LAS unsigned char* U_l = lds;
    LAS float* S_l = (LAS float*)(lds + 33792);
    LAS bf16* Xs_l = (LAS bf16*)(lds + 33792 + 33280);
    LAS float* Eseg = (LAS float*)(lds + 33792 + 33280 + 17408);
    LAS float* Gcar = (LAS float*)(lds + 33792 + 33280 + 17408 + 4096);
    const int l15 = l & 15, l4 = l >> 4;
    const int uoff = l15 * 528 + (l >> 5) * 32 + (l4 & 1) * 16;
    for (int it = blockIdx.x; it < 512; it += G) {
        const int b = it >> 6, g = it & 63;
        const bf16* Win = (const bf16*)(ws + WS_S5_WIN) + (size_t)g * 32768; const bf16* Wout = (const bf16*)(ws + WS_S5_WOUT) + (size_t)g * 32768; const bf16* Kt = (const bf16*)(ws + WS_S5_K) + (size_t)g * 4096;
        const float* lamq = (const float*)(ws + WS_S5_LAM) + g * 128;
        const bf16* Ug = U + (size_t)(b * 64 + g) * 65536;
        const int p = tid & 63, seg = tid >> 6;
        const float lqr = lamq[2 * p], lqi = lamq[2 * p + 1];
        float l8r = lqr, l8i = lqi;
#pragma unroll
        for (int i = 0; i < 3; ++i) { const float t = l8r * l8r - l8i * l8i; l8i = 2.f * l8r * l8i; l8r = t; }
        __syncthreads();
        if (tid < 64) { Gcar[2 * tid] = 0.f; Gcar[2 * tid + 1] = 0.f; }
#pragma unroll 1
        for (int ps = 0; ps < 4; ++ps) {
#pragma unroll
            for (int i = 0; i < 4; ++i) { const int e = tid + 512 * i, t = e >> 1;
                *(LAS u32x4*)(U_l + (t >> 4) * 528 + (t & 15) * 32 + (e & 1) * 16) = *(const u32x4*)(Ug + (size_t)ps * 16384 + e * 8); }
            bf16x8 Aw[8];
#pragma unroll
            for (int ks = 0; ks < 8; ++ks) Aw[ks] = *(const bf16x8*)(Win + (16 * w + l15) * 256 + 32 * ks + 8 * l4);
            __syncthreads();
#pragma unroll
            for (int cb = 0; cb < 4; ++cb) {
                f32x4 acc = (f32x4){0.f, 0.f, 0.f, 0.f};
#pragma unroll
                for (int ks = 0; ks < 8; ++ks) { const bf16x8 Bf = *(const LAS bf16x8*)(U_l + cb * 8448 + uoff + 64 * ks); acc = MFMA16(Aw[ks], Bf, acc); }
#pragma unroll
                for (int r = 0; r < 4; ++r) S_l[(16 * w + 4 * l4 + r) * 65 + cb * 16 + l15] = acc[r];
            }
            __syncthreads();
            {
                float er = 0.f, ei = 0.f; const int c0 = seg * 8;
#pragma unroll
                for (int i = 0; i < 8; ++i) { const int c = c0 + i; const float sr = S_l[p * 65 + c], si = S_l[(64 + p) * 65 + c];
                    const float t = lqr * er - lqi * ei + sr; ei = lqr * ei + lqi * er + si; er = t; S_l[p * 65 + c] = er; S_l[(64 + p) * 65 + c] = ei; }
                Eseg[(seg * 64 + p) * 2] = er; Eseg[(seg * 64 + p) * 2 + 1] = ei;
                __syncthreads();
                float gr = Gcar[((ps & 1) * 64 + p) * 2], gi = Gcar[((ps & 1) * 64 + p) * 2 + 1];
                for (int s = 0; s < seg; ++s) { const float t = l8r * gr - l8i * gi + Eseg[(s * 64 + p) * 2]; gi = l8r * gi + l8i * gr + Eseg[(s * 64 + p) * 2 + 1]; gr = t; }
                if (seg == 7) { Gcar[(((ps + 1) & 1) * 64 + p) * 2] = l8r * gr - l8i * gi + er; Gcar[(((ps + 1) & 1) * 64 + p) * 2 + 1] = l8r * gi + l8i * gr + ei; }
                float pr = 1.f, pi = 0.f;
#pragma unroll
                for (int i = 0; i < 8; ++i) { const int c = c0 + i;
                    float xr = pr * gr - pi * gi, xi = pr * gi + pi * gr;
                    if (i > 0) { xr += S_l[p * 65 + c - 1]; xi += S_l[(64 + p) * 65 + c - 1]; }
                    Xs_l[c * 136 + p] = (bf16)f2bf(xr); Xs_l[c * 136 + 64 + p] = (bf16)f2bf(xi);
                    const float t = pr * lqr - pi * lqi; pi = pr * lqi + pi * lqr; pr = t; }
            }
            __syncthreads();
#pragma unroll 1
            for (int tt = 0; tt < 2; ++tt) {
                const int tau = tt ? 15 - w : w;
                bf16x8 Tf[8], Wo[4];
#pragma unroll
                for (int ks = 0; ks < 8; ++ks) { const int lag = tau - (2 * ks + (l >> 5));
                    bf16x8 z = (bf16x8){0, 0, 0, 0, 0, 0, 0, 0};
                    if (lag >= 0) z = *(const bf16x8*)(Kt + (lag * 16 + l15) * 16 + 8 * (l4 & 1));
                    Tf[ks] = z; }
#pragma unroll
                for (int k2 = 0; k2 < 4; ++k2) Wo[k2] = *(const bf16x8*)(Wout + (tau * 16 + l15) * 128 + 32 * k2 + 8 * l4);
#pragma unroll
                for (int cb = 0; cb < 4; ++cb) {
                    f32x4 acc = (f32x4){0.f, 0.f, 0.f, 0.f};
#pragma unroll
                    for (int ks = 0; ks < 8; ++ks) if (2 * ks <= tau) { const bf16x8 Bf = *(const LAS bf16x8*)(U_l + cb * 8448 + uoff + 64 * ks); acc = MFMA16(Tf[ks], Bf, acc); }
#pragma unroll
                    for (int k2 = 0; k2 < 4; ++k2) { const bf16x8 Bx = *(const LAS bf16x8*)(Xs_l + (cb * 16 + l15) * 136 + 32 * k2 + 8 * l4); acc = MFMA16(Wo[k2], Bx, acc); }
                    u32x2 o; o.x = pk2(gelu_tanh(acc[0]), gelu_tanh(acc[1])); o.y = pk2(gelu_tanh(acc[2]), gelu_tanh(acc[3]));
                    const size_t tok = (size_t)b * SEQ + 16 * (ps * 64 + cb * 16 + l15) + tau;
                    *(u32x2*)(Y + tok * 1024 + 16 * g + 4 * l4) = o;
                }
            }
            __syncthreads();
        }
    }
}

template <int D, int NKB, bool SWA>
__device__ __forceinline__ void attn_task(const bf16* qrow, const LAS unsigned char* Kl, int kstrideB, const LAS unsigned char* Vl, int vstrideB, int kb0,
                                          const LAS float* biasr, int qloc, bool first_blk, float sink, float scale, bf16* orow, int l) {
    const int r32 = l & 31, h = l >> 5;
    bf16x8 qf[D / 16];
#pragma unroll
    for (int s = 0; s < D / 16; ++s) qf[s] = *(const bf16x8*)(qrow + 16 * s + 8 * h);
    f32x16 x[NKB];
#pragma unroll
    for (int kbi = 0; kbi < NKB; ++kbi) {
#pragma unroll
        for (int i = 0; i < 16; ++i) x[kbi][i] = 0.f;
#pragma unroll
        for (int s = 0; s < D / 16; ++s) { const bf16x8 a = *(const LAS bf16x8*)(Kl + ((kb0 + kbi) * 32 + r32) * kstrideB + (16 * s + 8 * h) * 2); x[kbi] = MFMA32(a, qf[s], x[kbi]); }
    }
    float m = -INFINITY;
#pragma unroll
    for (int kbi = 0; kbi < NKB; ++kbi)
#pragma unroll
        for (int i = 0; i < 16; ++i) {
            float s = x[kbi][i] * scale;
            if (SWA) { const int kloc = (kb0 + kbi) * 32 + (i & 3) + 8 * (i >> 2) + 4 * h, dist = qloc - kloc;
                const bool valid = (dist >= 0) && (dist < 128) && (!first_blk || kloc >= 128);
                const int dcl = dist < 0 ? 0 : (dist > 127 ? 127 : dist);
                s = valid ? s + biasr[dcl] : -INFINITY; }
            x[kbi][i] = s; m = fmaxf(m, s);
        }
    m = fmaxf(m, __shfl_xor(m, 32)); if (SWA) m = fmaxf(m, sink);
    float sum = 0.f;
    u32 pk[NKB][8];
#pragma unroll
    for (int kbi = 0; kbi < NKB; ++kbi)
#pragma unroll
        for (int i = 0; i < 16; i += 2) { const float e0 = __expf(x[kbi][i] - m), e1 = __expf(x[kbi][i + 1] - m); sum += e0 + e1; pk[kbi][i >> 1] = cvtpk(e0, e1); }
    sum += __shfl_xor(sum, 32); if (SWA) sum += __expf(sink - m);
    const float inv = 1.0f / sum;
    f32x16 o[D / 32];
#pragma unroll
    for (int db = 0; db < D / 32; ++db)
#pragma unroll
        for (int i = 0; i < 16; ++i) o[db][i] = 0.f;
#pragma unroll
    for (int kbi = 0; kbi < NKB; ++kbi)
#pragma unroll
        for (int s2 = 0; s2 < 2; ++s2) {
            u32x4 pw; pw.x = pk[kbi][4 * s2]; pw.y = pk[kbi][4 * s2 + 1]; pw.z = pk[kbi][4 * s2 + 2]; pw.w = pk[kbi][4 * s2 + 3];
            const bf16x8 pb = __builtin_bit_cast(bf16x8, pw);
#pragma unroll
            for (int db = 0; db < D / 32; ++db) {
                const LAS unsigned char* vp = Vl + (db * 32 + r32) * vstrideB + ((kb0 + kbi) * 32 + 16 * s2 + 4 * h) * 2;
                const s16x4 lo = *(const LAS s16x4*)vp, hi = *(const LAS s16x4*)(vp + 16);
                const bf16x8 a = __builtin_shufflevector(lo, hi, 0, 1, 2, 3, 4, 5, 6, 7);
                o[db] = MFMA32(a, pb, o[db]);
            }
        }
#pragma unroll
    for (int db = 0; db < D / 32; ++db)
#pragma unroll
        for (int g4 = 0; g4 < 4; ++g4) { u32x2 wv; wv.x = cvtpk(o[db][4 * g4] * inv, o[db][4 * g4 + 1] * inv); wv.y = cvtpk(o[db][4 * g4 + 2] * inv, o[db][4 * g4 + 3] * inv);
            *(u32x2*)(orow + db * 32 + 8 * g4 + 4 * h) = wv; }
}

__device__ __forceinline__ void phase_swa(const Ptrs& P, LAS unsigned char* lds, int G) {
    const int tid = threadIdx.x, l = tid & 63, w = __builtin_amdgcn_readfirstlane(tid >> 6);
    unsigned char* ws = P.ws;
    const bf16* Qb = (const bf16*)(ws + WS_Q); const bf16* Kb = (const bf16*)(ws + WS_K); const bf16* Vb = (const bf16*)(ws + WS_V); bf16* Ym = (bf16*)(ws + WS_YMIX);
    const float* bt = (const float*)(ws + WS_BIAS_TAB); const float* sinks = P.in[15];
    LAS unsigned char* Kl = lds;
    LAS unsigned char* Vl = lds + 36864;
    LAS float* bias_l = (LAS float*)(lds + 36864 + 33280);
    for (int it = blockIdx.x; it < 1024; it += G) {
        const int g = it & 3, n = (it >> 2) & 31, b = it >> 7;
        __syncthreads();
#pragma unroll
        for (int i = 0; i < 4; ++i) { const int e = tid + 512 * i, key = e >> 3, part = e & 7; const int kpos = n * 128 - 128 + key;
            u32x4 v = (u32x4){0u, 0u, 0u, 0u};
            if (kpos >= 0) v = *(const u32x4*)(Kb + ((size_t)b * SEQ + kpos) * 256 + g * 64 + part * 8);
            *(LAS u32x4*)(Kl + key * 144 + part * 16) = v; }
#pragma unroll
        for (int i = 0; i < 4; ++i) { const int e = tid + 512 * i, key = e & 255, part = e >> 8; const int kpos = n * 128 - 128 + key;
            u32x4 v = (u32x4){0u, 0u, 0u, 0u};
            if (kpos >= 0) v = *(const u32x4*)(Vb + ((size_t)b * SEQ + kpos) * 256 + g * 64 + part * 8);
#pragma unroll
            for (int jj = 0; jj < 8; ++jj) { const unsigned wv = v[jj >> 1]; *(LAS bf16*)(Vl + (part * 8 + jj) * 520 + key * 2) = (bf16)((jj & 1) ? (wv >> 16) : (wv & 0xffffu)); } }
        bias_l[tid] = bt[(4 * g + (tid >> 7)) * 128 + (tid & 127)];
        __syncthreads();
        const int r = w >> 1, hq = 4 * g + r; const float sink = sinks[hq];
#pragma unroll 1
        for (int t = 0; t < 2; ++t) {
            const int qq = 2 * (w & 1) + t, r32 = l & 31;
            const size_t qtok = (size_t)b * SEQ + n * 128 + 32 * qq + r32;
            attn_task<64, 5, true>(Qb + qtok * 1024 + hq * 64, Kl, 144, Vl, 520, qq, bias_l + r * 128, 128 + 32 * qq + r32, n == 0, sink, 0.125f,
                                   Ym + qtok * 2048 + 1024 + hq * 64, l);
        }
    }
}

__device__ __forceinline__ void phase_cross(const Ptrs& P, LAS unsigned char* lds, int G) {
    const int tid = threadIdx.x, l = tid & 63, w = __builtin_amdgcn_readfirstlane(tid >> 6);
    unsigned char* ws = P.ws;
    const bf16* Qc = (const bf16*)(ws + WS_QC); const bf16* KV = (const bf16*)(ws + WS_KV_C); bf16* Oc = (bf16*)(ws + WS_OC);
    LAS unsigned char* Kl = lds;
    LAS unsigned char* Vl = lds + 69632;
    int prev = -1;
    for (int it = blockIdx.x; it < 512; it += G) {
        const int qb = it & 15, hd = (it >> 4) & 3, b = it >> 6;
        if ((it >> 4) != prev) {
            prev = it >> 4;
            __syncthreads();
#pragma unroll
            for (int i = 0; i < 8; ++i) { const int e = tid + 512 * i, key = e >> 4, part = e & 15;
                *(LAS u32x4*)(Kl + key * 272 + part * 16) = *(const u32x4*)(KV + ((size_t)b * 256 + key) * 1024 + hd * 128 + part * 8); }
#pragma unroll
            for (int i = 0; i < 8; ++i) { const int e = tid + 512 * i, key = e & 255, part = e >> 8;
                const u32x4 v = *(const u32x4*)(KV + ((size_t)b * 256 + key) * 1024 + 512 + hd * 128 + part * 8);
#pragma unroll
                for (int jj = 0; jj < 8; ++jj) { const unsigned wv = v[jj >> 1]; *(LAS bf16*)(Vl + (part * 8 + jj) * 520 + key * 2) = (bf16)((jj & 1) ? (wv >> 16) : (wv & 0xffffu)); } }
            __syncthreads();
        }
        const size_t qtok = (size_t)b * SEQ + qb * 256 + 32 * w + (l & 31);
        attn_task<128, 8, false>(Qc + qtok * 512 + hd * 128, Kl, 272, Vl, 520, 0, (const LAS float*)lds, 0, false, 0.f, 0.08838834764831845f, Oc + qtok * 512 + hd * 128, l);
    }
}
__device__ __forceinline__ void topk_stage1(LAS unsigned char* wb, int l, u32 (&v)[16]) {
    const int j = l >> 1, half = l & 1, sw = 2 * (j & 7);
#pragma unroll
    for (int gq = 0; gq < 4; ++gq) {
        u32 t[16];
#pragma unroll
        for (int i4 = 0; i4 < 4; ++i4) { const int i = 4 * gq + i4, ci = 2 * i + half, phys = ci ^ sw; const f32x4 f = *(const LAS f32x4*)(wb + j * 512 + phys * 16);
#pragma unroll
            for (int e = 0; e < 4; ++e) t[4 * i4 + e] = (f2key(f[e]) & ~0x7Fu) | (u32)(127 - (8 * i + 4 * half + e)); }
        sort16_desc(t);
        if (gq == 0) {
#pragma unroll
            for (int i = 0; i < 16; ++i) v[i] = t[i];
        } else merge_top16_desc(v, t);
    }
    LDS_WAIT(); asm volatile("" ::: "memory");
    {
        u32 o[16];
#pragma unroll
        for (int i = 0; i < 16; ++i) o[i] = (u32)__shfl_xor((int)v[i], 1);
        merge_top16_desc(v, o);
    }
}
__device__ __forceinline__ void topk_stage2(LAS unsigned char* wb, int l, const u32 (&v)[16], int* TI, float* TG, size_t obase, size_t ostride) {
    LAS u32* lut = (LAS u32*)wb;
#pragma unroll
    for (int i = 0; i < 16; ++i) lut[l * 16 + i] = v[i];
    float va[16], vb[16];
    {
        const bool c1 = (l >> 1) & 1;
#pragma unroll
        for (int i = 0; i < 16; ++i) { const u32 o = (u32)__shfl_xor((int)v[i], 2); const u32 a = c1 ? o : v[i], b = c1 ? v[i] : o; va[i] = key2f(a & ~0x7Fu); vb[i] = key2f(b & ~0x7Fu); }
    }
#define CAND(i, q) ((f2key(va[i] + vb[q]) & ~0xFFu) | (u32)(255 - (16 * (i) + (q))))
    u32 c[16];
    {
        u32 t[16];
#pragma unroll
        for (int q = 0; q < 16; ++q) c[q] = CAND(0, q);
        sort16_desc(c);
#pragma unroll
        for (int q = 0; q < 8; ++q) t[q] = CAND(1, q);
#pragma unroll
        for (int q = 0; q < 5; ++q) t[8 + q] = CAND(2, q);
        t[13] = CAND(3, 0); t[14] = CAND(3, 1); t[15] = CAND(3, 2);
        sort16_desc(t); merge_top16_desc(c, t);
        t[0] = CAND(3, 3); t[1] = CAND(4, 0); t[2] = CAND(4, 1); t[3] = CAND(4, 2); t[4] = CAND(5, 0); t[5] = CAND(5, 1); t[6] = CAND(6, 0); t[7] = CAND(6, 1);
        t[8] = CAND(7, 0); t[9] = CAND(7, 1); t[10] = CAND(8, 0); t[11] = CAND(9, 0); t[12] = CAND(10, 0); t[13] = CAND(11, 0); t[14] = CAND(12, 0); t[15] = CAND(13, 0);
        sort16_desc(t); merge_top16_desc(c, t);
        insert_top16_desc(c, CAND(14, 0)); insert_top16_desc(c, CAND(15, 0));
    }
#undef CAND
    LDS_WAIT(); asm volatile("" ::: "memory");
    float best[16]; int eidx[16];
    const int la = (l & ~2) * 16, lb = (l | 2) * 16;
#pragma unroll
    for (int r = 0; r < 16; ++r) { const u32 key = c[r]; const int pos = 255 - (int)(key & 0xFFu); best[r] = key2f(key & ~0xFFu);
        const int k0 = 127 - (int)(lut[la + (pos >> 4)] & 0x7Fu), k1 = 127 - (int)(lut[lb + (pos & 15)] & 0x7Fu); eidx[r] = k0 * 128 + k1; }
    float s = 0.f;
#pragma unroll
    for (int r = 0; r < 16; ++r) { best[r] = __expf(best[r] - key2f(c[0] & ~0xFFu)); s += best[r]; }
    const float inv = 1.0f / s;
    if ((l & 2) == 0) {
        const size_t o = obase + (size_t)(l >> 2) * ostride;
#pragma unroll
        for (int r4 = 0; r4 < 4; ++r4) { *(int4*)(TI + o + 4 * r4) = make_int4(eidx[4 * r4], eidx[4 * r4 + 1], eidx[4 * r4 + 2], eidx[4 * r4 + 3]);
            *(f32x4*)(TG + o + 4 * r4) = (f32x4){best[4 * r4] * inv, best[4 * r4 + 1] * inv, best[4 * r4 + 2] * inv, best[4 * r4 + 3] * inv}; }
    }
    LDS_WAIT(); asm volatile("" ::: "memory");
}
struct EpiTopk {
    static constexpr bool PERM = true, AFTER_DRAIN = true;
    const float* PS; int* TI; float* TG;
    __device__ __forceinline__ void fused(const pg8::f32x4 (&acc)[2][2][4][2], const pg8::Unit& u, int wr, int wc, int fr, int fq, LAS unsigned char* lds, int wid, int lane) const {
        const int cb0 = (8 * wc + 2 * fq) ^ (4 * (fr & 3));
        LAS unsigned char* wq0 = lds + (4 * wr) * 16384 + (2 * fr) * 512 + cb0 * 16;
        LAS unsigned char* wq1 = lds + (4 * wr) * 16384 + (2 * fr + 1) * 512 + (cb0 ^ 2) * 16;
        u32 v0[16];
#pragma unroll
        for (int ai = 0; ai < 2; ++ai) {
#pragma unroll
            for (int m = 0; m < 4; ++m) { const size_t row = (size_t)(u.pm * 256 + ai * 128 + wr * 64 + m * 16 + fr); const float r = pg8::row_rnorm(PS, row);
#pragma unroll
                for (int n = 0; n < 2; ++n) { *(LAS f32x4*)(wq0 + m * 16384 + n * 16) = acc[ai][0][m][n] * r; *(LAS f32x4*)(wq1 + m * 16384 + n * 16) = acc[ai][1][m][n] * r; } }
            __syncthreads();
            if (ai == 0) { topk_stage1(lds + wid * 16384, lane, v0); __syncthreads(); }
            else {
                u32 v1[16];
                topk_stage1(lds + wid * 16384, lane, v1);
#pragma unroll
                for (int i = 0; i < 16; ++i) v1[i] = (lane & 1) ? v1[i] : v0[i];
                LDS_WAIT(); asm volatile("" ::: "memory");
                topk_stage2(lds + wid * 16384, lane, v1, TI, TG, ((size_t)(u.pm * 256 + (lane & 1) * 128 + 16 * wid) * 8 + u.pn) * 16, 128);
                __syncthreads();
            }
        }
    }
};

typedef float f32x2 __attribute__((ext_vector_type(2)));

typedef float v32f_t __attribute__((ext_vector_type(32)));
struct PeerBuf { v6u_t u0, u1, v0, v1; u32x2 sc0, sc1; };
#define PEER_LD6(rs, so) ({ const u32x4 a_ = __builtin_bit_cast(u32x4, __builtin_amdgcn_raw_buffer_load_b128(rs, 16 * l, so, 0)); const u32x2 b_ = __builtin_bit_cast(u32x2, __builtin_amdgcn_raw_buffer_load_b64(rs, 1024 + 8 * l, so, 0)); (v6u_t){a_.x, a_.y, a_.z, a_.w, b_.x, b_.y}; })
template <class RS> __device__ __forceinline__ void peer_issue(PeerBuf& B, const RS& rsU, const RS& rsV, const RS& rsS, int ivA, int ivB, int k0, int l) {
    const int iv = (k0 & 64) ? ivB : ivA;
    const int e0 = __builtin_amdgcn_readlane(iv, (k0 & 63)), e1 = __builtin_amdgcn_readlane(iv, (k0 & 63) + 1);
    B.sc0 = __builtin_bit_cast(u32x2, __builtin_amdgcn_raw_buffer_load_b64(rsS, 0, e0 * 8, 0)); B.sc1 = __builtin_bit_cast(u32x2, __builtin_amdgcn_raw_buffer_load_b64(rsS, 0, e1 * 8, 0));
    B.u0 = PEER_LD6(rsU, e0 * PEER_ROW_BYTES); B.u1 = PEER_LD6(rsU, e1 * PEER_ROW_BYTES); B.v0 = PEER_LD6(rsV, e0 * PEER_ROW_BYTES); B.v1 = PEER_LD6(rsV, e1 * PEER_ROW_BYTES);
}
typedef __bf16 v32bf_t __attribute__((ext_vector_type(32)));
typedef __bf16 bf16x2v __attribute__((ext_vector_type(2)));
__device__ __forceinline__ float peer_dot6(v6u_t w, const u32 (&xp)[16]) { const v32bf_t f = __builtin_amdgcn_cvt_scalef32_pk32_bf16_fp6(w, 1.0f); float s = 0.f;
#define PD2(pp) s = __builtin_amdgcn_fdot2_f32_bf16(__builtin_bit_cast(bf16x2v, xp[pp]), __builtin_shufflevector(f, f, 2 * (pp), 2 * (pp) + 1), s, false);
    PD2(0) PD2(1) PD2(2) PD2(3) PD2(4) PD2(5) PD2(6) PD2(7) PD2(8) PD2(9) PD2(10) PD2(11) PD2(12) PD2(13) PD2(14) PD2(15)
#undef PD2
    return s; }
__device__ __forceinline__ void peer_axpy6(v6u_t w, float c, float (&acc)[32]) { const v32f_t f = __builtin_amdgcn_cvt_scalef32_pk32_f32_fp6(w, 1.0f);
#pragma unroll
    for (int i = 0; i < 32; ++i) acc[i] += c * f[i]; }
__device__ __forceinline__ void peer_axpy6v(v6u_t w, float c, v32f_t& acc) { const v32f_t f = __builtin_amdgcn_cvt_scalef32_pk32_f32_fp6(w, 1.0f); acc = acc + f * c; }
__device__ __forceinline__ void peer_compute(const PeerBuf& B, const u32 (&xr)[16], float (&acc)[32], float rn, int ivA, int ivB, float gvA, float gvB, int k0, int l) {
    const float gv = (k0 & 64) ? gvB : gvA; const int kk = k0 & 63;
    const float d0 = peer_dot6(B.u0, xr); __builtin_amdgcn_sched_barrier(0);
    const float d1 = peer_dot6(B.u1, xr); __builtin_amdgcn_sched_barrier(0);
    const bool o1 = l & 1;
    float t = (o1 ? d1 : d0) + __shfl_xor(o1 ? d0 : d1, 1);
#pragma unroll
    for (int o = 2; o < 64; o <<= 1) t += __shfl_xor(t, o);
    const float g0 = __uint_as_float(__builtin_amdgcn_readlane(__float_as_uint(gv), kk)), g1 = __uint_as_float(__builtin_amdgcn_readlane(__float_as_uint(gv), kk + 1));
    const float su = __uint_as_float(o1 ? B.sc1.x : B.sc0.x), sv = __uint_as_float(o1 ? B.sc1.y : B.sc0.y), gg = o1 ? g1 : g0;
    const float cf = gg * gelu_tanh(t * su * rn) * sv;
    const float c0 = __uint_as_float(__builtin_amdgcn_readlane(__float_as_uint(cf), 0)), c1 = __uint_as_float(__builtin_amdgcn_readlane(__float_as_uint(cf), 1));
    __builtin_amdgcn_sched_barrier(0);
    peer_axpy6(B.v0, c0, acc); __builtin_amdgcn_sched_barrier(0);
    peer_axpy6(B.v1, c1, acc); __builtin_amdgcn_sched_barrier(0);
}
#define XB_TMO      128
#define XB_XCNT(j)  (256  + 64 * (j))
#define XB_XSUB(j)  (1280 + 64 * (j))
#define XB_XGEN(j)  (2304 + 64 * (j))
#define XB_TOP      3328
#define XB_TOPGEN   3392
#define XCD_BAR_WORDS 3456
#define XB_SPIN_CAP (1u << 20)
__device__ __forceinline__ unsigned xb_ld(unsigned* p)              { return __hip_atomic_load(p, __ATOMIC_RELAXED, __HIP_MEMORY_SCOPE_AGENT); }
__device__ __forceinline__ unsigned xb_add(unsigned* p, unsigned v) { return __hip_atomic_fetch_add(p, v, __ATOMIC_RELAXED, __HIP_MEMORY_SCOPE_AGENT); }
__device__ __forceinline__ unsigned xb_xcc_id() { return (unsigned)__builtin_amdgcn_s_getreg((3 << 11) | 20) & 0xFu; }
#define XB_SPIN(cond, bar) do { unsigned _sp = 0; while (cond) { __builtin_amdgcn_s_sleep(1); \
    if ((++_sp & 255u) == 0u) { if (xb_ld(&(bar)[XB_TMO])) break; if (_sp > XB_SPIN_CAP) { atomicAdd(&(bar)[XB_TMO], 1u); break; } } } } while (0)
struct XcdBarrier { unsigned* bar; unsigned x; volatile LAS unsigned* st; };
__device__ __forceinline__ XcdBarrier xcd_barrier_post(unsigned* bar, volatile LAS unsigned* st) {
    XcdBarrier b; b.bar = bar; b.x = xb_xcc_id(); b.st = st;
    if (threadIdx.x == 0) (void)xb_add(&bar[XB_XCNT(b.x)], 1u);
    return b;
}
__device__ __forceinline__ void xcd_barrier_complete(unsigned* bar, unsigned x, unsigned& nloc, unsigned& nx) {
    const unsigned G = gridDim.x * gridDim.y * gridDim.z;
    unsigned sum, cnt, mine, sp = 0u;
    for (;;) {
        sum = 0u; cnt = 0u; mine = 0u;
#pragma unroll
        for (unsigned j = 0; j < 16; ++j) { const unsigned c = xb_ld(&bar[XB_XCNT(j)]); sum += c; cnt += (c > 0u) ? 1u : 0u; mine = (j == x) ? c : mine; }
        if (sum == G) break;
        __builtin_amdgcn_s_sleep(1);
        if ((++sp & 255u) == 0u) { if (xb_ld(&bar[XB_TMO])) break; if (sp > XB_SPIN_CAP) { atomicAdd(&bar[XB_TMO], 1u); break; } }
    }
    nloc = mine > 0u ? mine : 1u; nx = cnt > 0u ? cnt : 1u;
}
__device__ __forceinline__ void xcd_barrier(const XcdBarrier& b) {
    asm volatile("s_waitcnt vmcnt(0)" ::: "memory");
    __syncthreads();
    if (threadIdx.x == 0) {
        unsigned* bar = b.bar;
        __builtin_amdgcn_s_waitcnt(0);
        unsigned nloc = b.st[0], nx = b.st[1];
        if (nloc == 0u) { xcd_barrier_complete(bar, b.x, nloc, nx); b.st[0] = nloc; b.st[1] = nx; }
        const unsigned old = xb_add(&bar[XB_XSUB(b.x)], 1u);
        const unsigned gen = old / nloc;
        if (old + 1u == (gen + 1u) * nloc) {
            __builtin_amdgcn_fence(__ATOMIC_RELEASE, "agent");
            asm volatile("s_waitcnt vmcnt(0)" ::: "memory");
            const unsigned og = xb_add(&bar[XB_TOP], 1u);
            const unsigned tg = og / nx;
            if (og + 1u == (tg + 1u) * nx) xb_add(&bar[XB_TOPGEN], 1u);
            else XB_SPIN(xb_ld(&bar[XB_TOPGEN]) == tg, bar);
            __builtin_amdgcn_fence(__ATOMIC_ACQUIRE, "agent");
            xb_add(&bar[XB_XGEN(b.x)], 1u);
            asm volatile("s_waitcnt vmcnt(0)" ::: "memory");
        } else {
            XB_SPIN(xb_ld(&bar[XB_XGEN(b.x)]) == gen, bar);
            __builtin_amdgcn_fence(__ATOMIC_ACQUIRE, "agent");
            asm volatile("s_waitcnt vmcnt(0)" ::: "memory");
        }
    }
    __syncthreads();
}

template <int CTRL> __device__ __forceinline__ float dpp_f(float v) { return __int_as_float(__builtin_amdgcn_update_dpp(0, __float_as_int(v), CTRL, 0xF, 0xF, true)); }
__device__ __forceinline__ float row16_reduce8(const float (&d)[8], int ch) {
    const bool b0 = ch & 1, b1 = ch & 2;
    float e[4], f[2];
#pragma unroll
    for (int j = 0; j < 4; ++j) { const float keep = b0 ? d[2 * j + 1] : d[2 * j], give = b0 ? d[2 * j] : d[2 * j + 1]; e[j] = keep + dpp_f<0xB1>(give); }
#pragma unroll
    for (int m = 0; m < 2; ++m) { const float keep = b1 ? e[2 * m + 1] : e[2 * m], give = b1 ? e[2 * m] : e[2 * m + 1]; f[m] = keep + dpp_f<0x4E>(give); }
#pragma unroll
    for (int m = 0; m < 2; ++m) { f[m] += dpp_f<0x128>(f[m]); f[m] += dpp_f<0x124>(f[m]); }
    return (ch & 4) ? f[1] : f[0];
}
struct PeerHalf { v6u_t w0, w1, w2, w3, w4, w5, w6, w7; };
__device__ __forceinline__ void peer_q_ids(int (&el)[8], const int* p  ) {
#pragma unroll
    for (int st = 0; st < 8; st += 4) { const int4 t = *(const int4*)(p + st); el[st] = t.x; el[st + 1] = t.y; el[st + 2] = t.z; el[st + 3] = t.w; }
}
template <class RS> __device__ __forceinline__ void peer_q_issue(PeerHalf& B, const RS& rs, const int (&el)[8], int ch) {
#define PH_LD(st) ({ const int vo_ = el[st] * PEER_SROW; \
        const u32x4 a_ = __builtin_bit_cast(u32x4, __builtin_amdgcn_raw_buffer_load_b128(rs, vo_ + 16 * ch, 0, 0)); const u32x2 b_ = __builtin_bit_cast(u32x2, __builtin_amdgcn_raw_buffer_load_b64(rs, vo_ + 256 + 8 * ch, 0, 0)); \
        (v6u_t){a_.x, a_.y, a_.z, a_.w, b_.x, b_.y}; })
    B.w0 = PH_LD(0); B.w1 = PH_LD(1); B.w2 = PH_LD(2); B.w3 = PH_LD(3); B.w4 = PH_LD(4); B.w5 = PH_LD(5); B.w6 = PH_LD(6); B.w7 = PH_LD(7);
#undef PH_LD
}
__device__ __forceinline__ void peer_q_dots(const PeerHalf& B, const u32 (&xs)[16], LAS float* pd  , int ch) {
    float d[8], old[8];
#pragma unroll
    for (int st = 0; st < 8; ++st) old[st] = pd[st];
    d[0] = peer_dot6(B.w0, xs); __builtin_amdgcn_sched_barrier(0); d[1] = peer_dot6(B.w1, xs); __builtin_amdgcn_sched_barrier(0);
    d[2] = peer_dot6(B.w2, xs); __builtin_amdgcn_sched_barrier(0); d[3] = peer_dot6(B.w3, xs); __builtin_amdgcn_sched_barrier(0);
    d[4] = peer_dot6(B.w4, xs); __builtin_amdgcn_sched_barrier(0); d[5] = peer_dot6(B.w5, xs); __builtin_amdgcn_sched_barrier(0);
    d[6] = peer_dot6(B.w6, xs); __builtin_amdgcn_sched_barrier(0); d[7] = peer_dot6(B.w7, xs); __builtin_amdgcn_sched_barrier(0);
#pragma unroll
    for (int o = 1; o < 16; o <<= 1)
#pragma unroll
        for (int st = 0; st < 8; ++st) d[st] += __shfl_xor(d[st], o);
    if (ch == 0) {
#pragma unroll
        for (int st = 0; st < 8; ++st) pd[st] = old[st] + d[st];
    }
}
__device__ __forceinline__ void peer_q_axpy(const PeerHalf& B, const LAS float* pd  , v32f_t& acc) {
    float cf[8];
#pragma unroll
    for (int st = 0; st < 8; ++st) cf[st] = pd[st];
    peer_axpy6v(B.w0, cf[0], acc); __builtin_amdgcn_sched_barrier(0); peer_axpy6v(B.w1, cf[1], acc); __builtin_amdgcn_sched_barrier(0);
    peer_axpy6v(B.w2, cf[2], acc); __builtin_amdgcn_sched_barrier(0); peer_axpy6v(B.w3, cf[3], acc); __builtin_amdgcn_sched_barrier(0);
    peer_axpy6v(B.w4, cf[4], acc); __builtin_amdgcn_sched_barrier(0); peer_axpy6v(B.w5, cf[5], acc); __builtin_amdgcn_sched_barrier(0);
    peer_axpy6v(B.w6, cf[6], acc); __builtin_amdgcn_sched_barrier(0); peer_axpy6v(B.w7, cf[7], acc); __builtin_amdgcn_sched_barrier(0);
}
#define PH_LD1(st) ({ const int vo_ = el[st] * PEER_SROW; \
        const u32x4 a_ = __builtin_bit_cast(u32x4, __builtin_amdgcn_raw_buffer_load_b128(rs, vo_ + 16 * ch, 0, 0)); const u32x2 b_ = __builtin_bit_cast(u32x2, __builtin_amdgcn_raw_buffer_load_b64(rs, vo_ + 256 + 8 * ch, 0, 0)); \
        (v6u_t){a_.x, a_.y, a_.z, a_.w, b_.x, b_.y}; })
template <class RS> __device__ __forceinline__ void peer_q_issue_dots(PeerHalf& N, const RS& rs, const int (&el)[8], const PeerHalf& B, const u32 (&xs)[16], LAS float* pd, int ch) {
    float d[8];
    const float old = pd[ch & 7];
    N.w0 = PH_LD1(0); d[0] = peer_dot6(B.w0, xs); __builtin_amdgcn_sched_barrier(0); N.w1 = PH_LD1(1); d[1] = peer_dot6(B.w1, xs); __builtin_amdgcn_sched_barrier(0);
    N.w2 = PH_LD1(2); d[2] = peer_dot6(B.w2, xs); __builtin_amdgcn_sched_barrier(0); N.w3 = PH_LD1(3); d[3] = peer_dot6(B.w3, xs); __builtin_amdgcn_sched_barrier(0);
    N.w4 = PH_LD1(4); d[4] = peer_dot6(B.w4, xs); __builtin_amdgcn_sched_barrier(0); N.w5 = PH_LD1(5); d[5] = peer_dot6(B.w5, xs); __builtin_amdgcn_sched_barrier(0);
    N.w6 = PH_LD1(6); d[6] = peer_dot6(B.w6, xs); __builtin_amdgcn_sched_barrier(0); N.w7 = PH_LD1(7); d[7] = peer_dot6(B.w7, xs); __builtin_amdgcn_sched_barrier(0);
    const float tot = row16_reduce8(d, ch);
    if (ch < 8) pd[ch] = old + tot;
}
template <class RS> __device__ __forceinline__ void peer_q_issue_axpy(PeerHalf& N, const RS& rs, const int (&el)[8], int ch, const PeerHalf& B, const LAS float* pd, v32f_t& acc) {
    float cf[8];
#pragma unroll
    for (int st = 0; st < 8; ++st) cf[st] = pd[st];
    N.w0 = PH_LD1(0); peer_axpy6v(B.w0, cf[0], acc); __builtin_amdgcn_sched_barrier(0); N.w1 = PH_LD1(1); peer_axpy6v(B.w1, cf[1], acc); __builtin_amdgcn_sched_barrier(0);
    N.w2 = PH_LD1(2); peer_axpy6v(B.w2, cf[2], acc); __builtin_amdgcn_sched_barrier(0); N.w3 = PH_LD1(3); peer_axpy6v(B.w3, cf[3], acc); __builtin_amdgcn_sched_barrier(0);
    N.w4 = PH_LD1(4); peer_axpy6v(B.w4, cf[4], acc); __builtin_amdgcn_sched_barrier(0); N.w5 = PH_LD1(5); peer_axpy6v(B.w5, cf[5], acc); __builtin_amdgcn_sched_barrier(0);
    N.w6 = PH_LD1(6); peer_axpy6v(B.w6, cf[6], acc); __builtin_amdgcn_sched_barrier(0); N.w7 = PH_LD1(7); peer_axpy6v(B.w7, cf[7], acc); __builtin_amdgcn_sched_barrier(0);
}
#undef PH_LD1
__device__ __forceinline__ void phase_peer(const Ptrs& P, LAS unsigned char* lds, int G, const XcdBarrier* bar) {
    const int tid = threadIdx.x, l = tid & 63, w = __builtin_amdgcn_readfirstlane(tid >> 6);
    unsigned char* ws = P.ws;
    const bf16* HN = (const bf16*)(ws + WS_HN); const float* SUV = (const float*)(ws + WS_PEER_SU);
    const int* TI = (const int*)(ws + WS_TK_IDX); const float* TG = (const float*)(ws + WS_TK_G); float* out = P.out; bf16* OB = (bf16*)(ws + WS_OB); const float* gfin = P.in[27]; const float* PS = (const float*)(ws + WS_PS);
    LAS float* PD = (LAS float*)(lds + w * 8192);
    LAS float* SS = (LAS float*)(lds + 65536 + w * 64);
    const int es = l >> 4, ch = l & 15, stride = G * NWAVES, tok0 = blockIdx.x * NWAVES + w;
    (void)bar;
    if (l < 16) SS[l] = 0.f;
#pragma unroll
    for (int q = 0; q < 8; ++q) *(LAS f32x4*)(PD + 4 * l + 256 * q) = (f32x4){0.f, 0.f, 0.f, 0.f};
#pragma unroll 1
    for (int s = 0; s < 4; ++s) {
        const auto rsU = __builtin_amdgcn_make_buffer_rsrc((void*)(ws + WS_PEER_U + (size_t)s * PEER_SLICE_BYTES), 0, (int)PEER_SLICE_BYTES, 0x00020000);
        PeerHalf A, B;
        int elA[8], elB[8];
        u32 xs[16];
#pragma unroll
        for (int q = 0; q < 8; ++q) { const u32x2 a = *(const u32x2*)(HN + (size_t)tok0 * DM + 512 * s + 64 * q + 4 * ch); xs[2 * q] = a.x; xs[2 * q + 1] = a.y; }
        peer_q_ids(elA, TI + (size_t)tok0 * 128 + 8 * es); peer_q_ids(elB, TI + (size_t)tok0 * 128 + 32 + 8 * es);
        peer_q_issue(A, rsU, elA, ch);
#pragma unroll 1
        for (int i = 0; i < 16; ++i) {
            const size_t tok = (size_t)(tok0 + i * stride), ntok = (size_t)(tok0 + (i < 15 ? i + 1 : i) * stride);
            u32 nxs[16];
#pragma unroll
            for (int q = 0; q < 8; ++q) { const u32x2 a = *(const u32x2*)(HN + ntok * DM + 512 * s + 64 * q + 4 * ch); nxs[2 * q] = a.x; nxs[2 * q + 1] = a.y; }
            peer_q_ids(elA, TI + tok * 128 + 64 + 8 * es);   __builtin_amdgcn_sched_barrier(0);   peer_q_issue_dots(B, rsU, elB, A, xs, PD + i * 128 + 8 * es, ch);
            peer_q_ids(elB, TI + tok * 128 + 96 + 8 * es);   __builtin_amdgcn_sched_barrier(0);   peer_q_issue_dots(A, rsU, elA, B, xs, PD + i * 128 + 32 + 8 * es, ch);
            peer_q_ids(elA, TI + ntok * 128 + 8 * es);   __builtin_amdgcn_sched_barrier(0);   peer_q_issue_dots(B, rsU, elB, A, xs, PD + i * 128 + 64 + 8 * es, ch);
            peer_q_ids(elB, TI + ntok * 128 + 32 + 8 * es);   __builtin_amdgcn_sched_barrier(0);   peer_q_issue_dots(A, rsU, elA, B, xs, PD + i * 128 + 96 + 8 * es, ch);
#pragma unroll
            for (int q = 0; q < 16; ++q) xs[q] = nxs[q];
        }
    }
#pragma unroll 1
    for (int hb = 0; hb < 2; ++hb) {
        int ce[8][2]; float cg[8][2], cps[8];
#pragma unroll
        for (int j = 0; j < 8; ++j) { const size_t tok = (size_t)(tok0 + (8 * hb + j) * stride);
            cps[j] = l < 32 ? PS[tok * 32 + l] : 0.f;
            ce[j][0] = TI[tok * 128 + l]; ce[j][1] = TI[tok * 128 + 64 + l]; cg[j][0] = TG[tok * 128 + l]; cg[j][1] = TG[tok * 128 + 64 + l]; }
        f32x2 csc[8][2];
#pragma unroll
        for (int j = 0; j < 8; ++j) { csc[j][0] = *(const f32x2*)(SUV + 2 * ce[j][0]); csc[j][1] = *(const f32x2*)(SUV + 2 * ce[j][1]); }
#pragma unroll
        for (int j = 0; j < 8; ++j) { const int i = 8 * hb + j;
            const float rn = __builtin_amdgcn_rsqf(wave_sum(cps[j]) * (1.0f / 2048.0f) + NORM_EPS);
#pragma unroll
            for (int hh = 0; hh < 2; ++hh) { const int k = 64 * hh + l; PD[i * 128 + k] = cg[j][hh] * gelu_tanh(PD[i * 128 + k] * csc[j][hh].x * rn) * csc[j][hh].y; } }
    }
#pragma unroll 1
    for (int s = 0; s < 4; ++s) {
        const auto rsV = __builtin_amdgcn_make_buffer_rsrc((void*)(ws + WS_PEER_V + (size_t)s * PEER_SLICE_BYTES), 0, (int)PEER_SLICE_BYTES, 0x00020000);
        PeerHalf A, B;
        int elA[8], elB[8];
        peer_q_ids(elA, TI + (size_t)tok0 * 128 + 8 * es); peer_q_ids(elB, TI + (size_t)tok0 * 128 + 32 + 8 * es);
        peer_q_issue(A, rsV, elA, ch);
#pragma unroll 1
        for (int i = 0; i < 16; ++i) {
            const size_t tok = (size_t)(tok0 + i * stride), ntok = (size_t)(tok0 + (i < 15 ? i + 1 : i) * stride);
            u32x2 hw[2];
#pragma unroll
            for (int j = 0; j < 2; ++j) hw[j] = *(const u32x2*)(HN + tok * DM + 512 * s + 64 * (2 * es + j) + 4 * ch);
            v32f_t acc;
#pragma unroll
            for (int c = 0; c < 32; ++c) acc[c] = 0.f;
            peer_q_ids(elA, TI + tok * 128 + 64 + 8 * es);   __builtin_amdgcn_sched_barrier(0);   peer_q_issue_axpy(B, rsV, elB, ch, A, PD + i * 128 + 8 * es, acc);
            peer_q_ids(elB, TI + tok * 128 + 96 + 8 * es);   __builtin_amdgcn_sched_barrier(0);   peer_q_issue_axpy(A, rsV, elA, ch, B, PD + i * 128 + 32 + 8 * es, acc);
            peer_q_ids(elA, TI + ntok * 128 + 8 * es);   __builtin_amdgcn_sched_barrier(0);   peer_q_issue_axpy(B, rsV, elB, ch, A, PD + i * 128 + 64 + 8 * es, acc);
            peer_q_ids(elB, TI + ntok * 128 + 32 + 8 * es);   __builtin_amdgcn_sched_barrier(0);   peer_q_issue_axpy(A, rsV, elA, ch, B, PD + i * 128 + 96 + 8 * es, acc);
            float r1[16], r2[8];
#pragma unroll
            for (int c = 0; c < 16; ++c) { const auto pp = __builtin_amdgcn_permlane32_swap(__float_as_uint(acc[c]), __float_as_uint(acc[c + 16]), false, false); r1[c] = __uint_as_float(pp[0]) + __uint_as_float(pp[1]); }
#pragma unroll
            for (int c = 0; c < 8; ++c) { const auto pp = __builtin_amdgcn_permlane16_swap(__float_as_uint(r1[c]), __float_as_uint(r1[c + 8]), false, false); r2[c] = __uint_as_float(pp[0]) + __uint_as_float(pp[1]); }
            float ss = 0.f;
            {
                bf16* op = OB + tok * DM + 512 * s + 128 * es + 4 * ch;
#pragma unroll
                for (int j = 0; j < 2; ++j) {
                    const f32x4 o0 = {r2[4 * j] + bflo(hw[j].x), r2[4 * j + 1] + bfhi(hw[j].x), r2[4 * j + 2] + bflo(hw[j].y), r2[4 * j + 3] + bfhi(hw[j].y)};
                    ss += (o0[0] * o0[0] + o0[1] * o0[1]) + (o0[2] * o0[2] + o0[3] * o0[3]);
                    *(u32x2*)(op + 64 * j) = (u32x2){pk2(o0[0], o0[1]), pk2(o0[2], o0[3])}; }
            }
            ss = wave_sum(ss);
            if (l == 0) SS[i] += ss;
        }
    }
    asm volatile("s_waitcnt vmcnt(0) lgkmcnt(0)" ::: "memory");
    {
        f32x4 ga[8]; u32x2 cur[8];
#pragma unroll
        for (int j = 0; j < 8; ++j) { ga[j] = ((const f32x4*)gfin)[l + 64 * j]; cur[j] = ((const u32x2*)(OB + (size_t)tok0 * DM))[l + 64 * j]; }
#pragma unroll 1
        for (int i = 0; i < 16; ++i) {
            const size_t tok = (size_t)(tok0 + i * stride), ntok = (size_t)(tok0 + (i < 15 ? i + 1 : i) * stride);
            u32x2 nxt[8];
#pragma unroll
            for (int j = 0; j < 8; ++j) nxt[j] = ((const u32x2*)(OB + ntok * DM))[l + 64 * j];
            const float r = rsqrtf(SS[i] * (1.f / DM) + NORM_EPS);
            f32x4* op = (f32x4*)(out + tok * DM);
#pragma unroll
            for (int j = 0; j < 8; ++j) { const u32x2 o = cur[j]; op[l + 64 * j] = (f32x4){bflo(o.x) * r * ga[j].x, bfhi(o.x) * r * ga[j].y, bflo(o.y) * r * ga[j].z, bfhi(o.y) * r * ga[j].w}; }
#pragma unroll
            for (int j = 0; j < 8; ++j) cur[j] = nxt[j];
        }
    }
}

struct Params { const float* in[28]; float* out; unsigned char* ws; int ph_lo, ph_hi; };
constexpr int N_PHASES = 13;
#ifndef STOP_AFTER
#define STOP_AFTER 12
#endif

__global__ void __launch_bounds__(NTHREADS, 2) mega(Params prm) {
    extern __shared__ __attribute__((aligned(16))) unsigned char lds_raw[];
    LAS unsigned char* lds = (LAS unsigned char*)lds_raw;
    const int G = gridDim.x;
    Ptrs P;
#pragma unroll
    for (int i = 0; i < 28; ++i) P.in[i] = prm.in[i];
    P.out = prm.out; P.ws = prm.ws;
    unsigned char* ws = prm.ws;
    const int lo = prm.ph_lo, hi = prm.ph_hi;
#ifndef PHMASK
#define PHMASK 0x1fff
#endif
#define IN(k) (((PHMASK >> (k)) & 1) && lo <= (k) && (k) < hi)
#if ONE_LAUNCH
    volatile LAS unsigned* bst = (volatile LAS unsigned*)(lds + LDS_BYTES - 64);
    if (threadIdx.x == 0) { bst[0] = 0u; bst[1] = 0u; }
    __syncthreads();
    const XcdBarrier bar = xcd_barrier_post((unsigned*)(ws + WS_CTL), bst);
#define SEAM(k) do { if (IN(k) && IN((k) + 1)) xcd_barrier(bar); } while (0)
#ifndef PEER_SYNC
#define PEER_SYNC 0
#endif
#define PEER_BAR (PEER_SYNC ? &bar : (const XcdBarrier*)nullptr)
#else
#define SEAM(k) do { } while (0)
#define PEER_BAR ((const XcdBarrier*)nullptr)
#endif
    bf16* HN = (bf16*)(ws + WS_HN);
    if (IN(0)) { phase_prologue(P, lds, G); }
    SEAM(0);
    if (IN(1)) {
        __syncthreads();
        { pg8::Gemm g{HN, (const bf16*)(ws + WS_W_IN_T), NTOK, 2560, 2048}; pg8::StaticOrder S; S.init(NTOK, 2560, G, (int)blockIdx.x);
          pg8::EpiInProj E{(bf16*)(ws + WS_U), (bf16*)(ws + WS_Q), (bf16*)(ws + WS_K), (bf16*)(ws + WS_V)};
          pg8::gemm_phase<pg8::EpiInProj, pg8::StaticOrder, PG8_ALIGN, PG8_SP2>(lds, g, S, E); }
        __syncthreads();
        { pg8::Gemm g{(const bf16*)(ws + WS_MEM_N), (const bf16*)(ws + WS_W_CKV_T), 2048, 1024, 2048}; pg8::StaticOrder S; S.init(2048, 1024, G, (int)blockIdx.x);
          pg8::EpiBf16Plain E{(bf16*)(ws + WS_KV_C), 1024};
          pg8::gemm_phase<pg8::EpiBf16Plain, pg8::StaticOrder, PG8_ALIGN, PG8_SP2>(lds, g, S, E); }
        __syncthreads();
        {
            const int wv = __builtin_amdgcn_readfirstlane(threadIdx.x >> 6), ln = threadIdx.x & 63;
            constexpr int R1 = 32768;
            if (blockIdx.x >= 32) peer_quant_rows(P, lds, wv, ln, ((int)blockIdx.x - 32) * NWAVES + wv, (G - 32) * NWAVES, R1);
            else peer_quant_rows(P, lds, wv, ln, R1 + (int)blockIdx.x * NWAVES + wv, 32 * NWAVES, 32768);
        }
    }
    SEAM(1);
    if (IN(2)) {
#ifndef NO_S5
        __syncthreads(); phase_s5(P, lds, G);
#endif
#ifndef NO_SWA
        __syncthreads(); phase_swa(P, lds, G);
#endif
    }
    SEAM(2);
    if (IN(3)) {
        __syncthreads();
        pg8::Gemm g{(const bf16*)(ws + WS_YPRE), (const bf16*)(ws + WS_W_GLU_T), NTOK, 1024, 1024}; pg8::StaticOrder S; S.init(NTOK, 1024, G, (int)blockIdx.x);
        pg8::EpiGlu E{(bf16*)(ws + WS_YMIX), 2048, (const bf16*)(ws + WS_YPRE), 1024, P.in[14]};
        pg8::gemm_phase<pg8::EpiGlu, pg8::StaticOrder, PG8_ALIGN, PG8_SP2>(lds, g, S, E);
    }
    SEAM(3);
    if (IN(4)) {
        __syncthreads();
        pg8::Gemm g{(const bf16*)(ws + WS_YMIX), (const bf16*)(ws + WS_W_OUT_T), NTOK, 2048, 2048}; pg8::StaticOrder S; S.init(NTOK, 2048, G, (int)blockIdx.x);
        pg8::EpiResBf16<false> E{HN, P.in[0], (float*)(ws + WS_PS)};
        pg8::gemm_phase<pg8::EpiResBf16<false>, pg8::StaticOrder, PG8_ALIGN, PG8_SP2>(lds, g, S, E);
    }
    SEAM(4);
    if (IN(6)) {
        __syncthreads();
        pg8::Gemm g{HN, (const bf16*)(ws + WS_W_CQ_T), NTOK, 512, 2048}; pg8::StaticOrder S; S.init(NTOK, 512, G, (int)blockIdx.x);
        pg8::EpiBf16RowScale E{(bf16*)(ws + WS_QC), 512, (const float*)(ws + WS_PS)};
        pg8::gemm_phase<pg8::EpiBf16RowScale, pg8::StaticOrder, PG8_ALIGN, PG8_SP2>(lds, g, S, E);
    }
    SEAM(6);
    if (IN(7)) { __syncthreads(); phase_cross(P, lds, G); }
    SEAM(7);
    if (IN(8)) {
        __syncthreads();
        pg8::Gemm g{(const bf16*)(ws + WS_OC), (const bf16*)(ws + WS_W_CO_T), NTOK, 2048, 512}; pg8::StaticOrder S; S.init(NTOK, 2048, G, (int)blockIdx.x);
        pg8::EpiResBf16<true> E{HN, HN, (float*)(ws + WS_PS)};
        pg8::gemm_phase<pg8::EpiResBf16<true>, pg8::StaticOrder, PG8_ALIGN, PG8_SP2>(lds, g, S, E);
    }
    SEAM(8);
    if (IN(10)) {
        __syncthreads();
        pg8::Gemm g{HN, (const bf16*)(ws + WS_W_S_T), NTOK, 2048, 2048}; pg8::StaticOrder S; S.init(NTOK, 2048, G, (int)blockIdx.x);
        EpiTopk E{(const float*)(ws + WS_PS), (int*)(ws + WS_TK_IDX), (float*)(ws + WS_TK_G)};
        for (int i = 0; ; ++i) { pg8::Unit uu; if (!S.next(i, uu)) break; pg8::OneUnit O1{uu}; pg8::gemm_phase<EpiTopk, pg8::OneUnit, false, false>(lds, g, O1, E); }
    }
    SEAM(11);
    if (IN(12)) { __syncthreads(); phase_peer(P, lds, G, PEER_BAR); }
    if (lo <= 13 && 13 < hi) {
        const int lane = threadIdx.x & 63, wave = threadIdx.x >> 6;
        for (int m = blockIdx.x * NWAVES + wave; m < NTOK; m += G * NWAVES) {
            f32x4* xr = (f32x4*)(P.out + (size_t)m * DM) + lane; const f32x4* gr = (const f32x4*)P.in[27] + lane;
            f32x4 v[8]; float ss = 0.f;
#pragma unroll
            for (int j = 0; j < 8; ++j) { v[j] = xr[64 * j]; ss += (v[j].x * v[j].x + v[j].y * v[j].y) + (v[j].z * v[j].z + v[j].w * v[j].w); }
            const float r = rsqrtf(wave_sum(ss) * (1.f / DM) + NORM_EPS);
#pragma unroll
            for (int j = 0; j < 8; ++j) { const f32x4 g = gr[64 * j]; xr[64 * j] = (f32x4){v[j].x * r * g.x, v[j].y * r * g.y, v[j].z * r * g.z, v[j].w * r * g.w}; }
        }
    }
}

extern "C" void kernel_launch(void* const* d_in, const int* in_sizes, int n_in, void* d_out, int out_size, void* d_ws, size_t ws_size, hipStream_t stream) {
    static int grid = 0;
    if (!grid) {
        int dev = 0, cus = 0, per_cu = 0;
        if (hipGetDevice(&dev) != hipSuccess || hipDeviceGetAttribute(&cus, hipDeviceAttributeMultiprocessorCount, dev) != hipSuccess) { fprintf(stderr, "kernel_launch: device query failed\n"); return; }
        if (hipFuncSetAttribute((const void*)mega, hipFuncAttributeMaxDynamicSharedMemorySize, LDS_BYTES) != hipSuccess) { fprintf(stderr, "kernel_launch: hipFuncSetAttribute failed\n"); return; }
        if (hipOccupancyMaxActiveBlocksPerMultiprocessor(&per_cu, (const void*)mega, NTHREADS, LDS_BYTES) != hipSuccess || per_cu < 1) { fprintf(stderr, "kernel_launch: occupancy query says %d\n", per_cu); per_cu = 1; }
        grid = 256;
        if (cus != 256) fprintf(stderr, "kernel_launch: built for 256 CUs, device reports %d\n", cus);
        if (ws_size < WS_END || n_in != 28) fprintf(stderr, "kernel_launch: unexpected ws_size %zu / n_in %d\n", ws_size, n_in);
    }
    Params p{};
    for (int i = 0; i < 28; ++i) p.in[i] = (const float*)d_in[i];
    p.out = (float*)d_out; p.ws = (unsigned char*)d_ws;
#if ONE_LAUNCH
    p.ph_lo = 0; p.ph_hi = N_PHASES;
    if (hipMemsetAsync((char*)d_ws + WS_CTL, 0, CTL_ZERO_BYTES, stream) != hipSuccess) { fprintf(stderr, "kernel_launch: memset of the barrier words failed\n"); return; }
    hipLaunchKernelGGL(mega, dim3(grid), dim3(NTHREADS), LDS_BYTES, stream, p);
#else
#ifndef REPEAT_MASK
#define REPEAT_MASK 0
#endif
    for (int ph = 0; ph <= STOP_AFTER; ++ph) { p.ph_lo = ph; p.ph_hi = ph + 1;
        for (int rep = 0; rep < (((REPEAT_MASK >> ph) & 1) ? 2 : 1); ++rep) hipLaunchKernelGGL(mega, dim3(grid), dim3(NTHREADS), LDS_BYTES, stream, p); }
    if (STOP_AFTER < 12) { p.ph_lo = 13; p.ph_hi = 14; hipLaunchKernelGGL(mega, dim3(grid), dim3(NTHREADS), LDS_BYTES, stream, p); }
#endif
}
```

```cpp
#include <hip/hip_runtime.h>
#include <cstdio>
#include <cstdint>
#ifndef ONE_LAUNCH
#define ONE_LAUNCH 1
#endif
#define SN_HD __host__ __device__ __forceinline__
#ifndef SN_HD
#define SN_HD __host__ __device__ __forceinline__
#endif
typedef unsigned int u32;
SN_HD u32 sn_max(u32 a, u32 b) { return a > b ? a : b; }
SN_HD u32 sn_min(u32 a, u32 b) { return a < b ? a : b; }
SN_HD u32 f2key(float f) { u32 u = __builtin_bit_cast(u32, f); return (u & 0x80000000u) ? ~u : (u | 0x80000000u); }
SN_HD float key2f(u32 k) { u32 u = (k & 0x80000000u) ? (k & 0x7fffffffu) : ~k; return __builtin_bit_cast(float, u); }
template <int BASE> SN_HD void bitonic_merge16_desc(u32 (&v)[64]) {
#pragma unroll
    for (int j = 8; j > 0; j >>= 1) {
#pragma unroll
        for (int i = 0; i < 16; ++i) { const int l = i ^ j; if (l > i) { const u32 a = v[BASE + i], b = v[BASE + l]; v[BASE + i] = sn_max(a, b); v[BASE + l] = sn_min(a, b); } }
    }
}
template <int BASE> SN_HD void bitonic_sort16_desc(u32 (&v)[64]) {
#pragma unroll
    for (int k = 2; k <= 16; k <<= 1) {
#pragma unroll
        for (int j = k >> 1; j > 0; j >>= 1) {
#pragma unroll
            for (int i = 0; i < 16; ++i) { const int l = i ^ j; if (l > i) { const u32 a = v[BASE + i], b = v[BASE + l]; const bool desc = ((i & k) == 0);
                v[BASE + i] = desc ? sn_max(a, b) : sn_min(a, b); v[BASE + l] = desc ? sn_min(a, b) : sn_max(a, b); } }
        }
    }
}
template <int A, int B> SN_HD void merge_top16(u32 (&v)[64]) {
#pragma unroll
    for (int i = 0; i < 16; ++i) v[A + i] = sn_max(v[A + i], v[B + 15 - i]);
    bitonic_merge16_desc<A>(v);
}
SN_HD void top16_of_64(u32 (&v)[64]) {
    bitonic_sort16_desc<0>(v); bitonic_sort16_desc<16>(v); bitonic_sort16_desc<32>(v); bitonic_sort16_desc<48>(v);
    merge_top16<0, 16>(v); merge_top16<32, 48>(v); merge_top16<0, 32>(v);
}

SN_HD void merge_sorted16_desc(u32 (&a)[16]) {
#pragma unroll
    for (int j = 8; j > 0; j >>= 1) {
#pragma unroll
        for (int i = 0; i < 16; ++i) { const int l = i ^ j; if (l > i) { const u32 x = a[i], y = a[l]; a[i] = sn_max(x, y); a[l] = sn_min(x, y); } }
    }
}
SN_HD void sort16_desc(u32 (&a)[16]) {
#pragma unroll
    for (int k = 2; k <= 16; k <<= 1) {
#pragma unroll
        for (int j = k >> 1; j > 0; j >>= 1) {
#pragma unroll
            for (int i = 0; i < 16; ++i) { const int l = i ^ j; if (l > i) { const u32 x = a[i], y = a[l]; const bool desc = ((i & k) == 0);
                a[i] = desc ? sn_max(x, y) : sn_min(x, y); a[l] = desc ? sn_min(x, y) : sn_max(x, y); } }
        }
    }
}
SN_HD void merge_top16_desc(u32 (&a)[16], const u32 (&b)[16]) {
#pragma unroll
    for (int i = 0; i < 16; ++i) a[i] = sn_max(a[i], b[15 - i]);
    merge_sorted16_desc(a);
}
SN_HD void insert_top16_desc(u32 (&a)[16], u32 x) {
#pragma unroll
    for (int k = 15; k > 0; --k) a[k] = sn_max(a[k], sn_min(a[k - 1], x));
    a[0] = sn_max(a[0], x);
}
namespace pg8 {
#define PG8_LAS __attribute__((address_space(3)))
typedef unsigned short bf16_t;
typedef short bf16x8 __attribute__((ext_vector_type(8)));
typedef float f32x4 __attribute__((ext_vector_type(4)));
typedef unsigned u32x4 __attribute__((ext_vector_type(4)));
constexpr int BM = 256, BK = 64, HALF = 128, HTB = HALF * BK * 2  , STAGE_BYTES = 8 * HTB, NXCD = 8, WGM = 4;

__host__ __device__ __forceinline__ int lds_byte(int r, int c) { const int st = (r >> 4) * 2 + (c >> 5), rr = r & 15, cc = c & 31, ob = rr * 64 + cc * 2; return st * 1024 + (ob ^ (((ob >> 9) & 1) << 5)); }
__host__ __device__ __forceinline__ void stage_rc(int b, int& R, int& C) { const int st = b / 1024, sb = b % 1024, swz = sb ^ (((sb >> 9) & 1) << 5); R = (st >> 1) * 16 + swz / 64; C = (st & 1) * 32 + (swz % 64) / 2; }
__host__ __device__ __forceinline__ int perm32(int rho) { const int n = rho >> 4, i = rho & 15; return 8 * (i >> 2) + 4 * n + (i & 3); }

struct Unit { int pm, pn; };
struct Gemm { const bf16_t* A; const bf16_t* Bt; int M, N, K; };

struct StaticOrder {
    int nM, nN, nwg, G, c;
    __host__ __device__ void init(int M, int N, int G_, int c_) { nM = M / BM; nN = N / BM; nwg = nM * nN; G = G_; c = c_; }
    __host__ __device__ bool next(int i, Unit& u) const {
        const long L = (long)i * G + c; if (L >= nwg) return false;
        int wgid = (int)L; { const int q = nwg / NXCD, r = nwg % NXCD, xcd = wgid % NXCD, off = wgid / NXCD; wgid = (xcd < r ? xcd * (q + 1) : r * (q + 1) + (xcd - r) * q) + off; }
        const int nig = WGM * nN, gid = wgid / nig, fm = gid * WGM, gsz = (nM - fm) < WGM ? (nM - fm) : WGM;
        u.pm = fm + ((wgid % nig) % gsz); u.pn = (wgid % nig) / gsz; return true;
    }
    __device__ __forceinline__ void a_ready(const Unit&) const {}
    __device__ __forceinline__ void done(const Unit&) const {}
};

typedef float f32x2_t __attribute__((ext_vector_type(2)));
typedef __bf16 bf16x2_t __attribute__((ext_vector_type(2)));
struct OneUnit { Unit u;
    __device__ __forceinline__ bool next(int i, Unit& o) const { if (i) return false; o = u; return true; }
    __device__ __forceinline__ void a_ready(const Unit&) const {}
    __device__ __forceinline__ void done(const Unit&) const {} };

__device__ __forceinline__ unsigned cvt_pk_bf16(float lo, float hi) { const f32x2_t f = {lo, hi}; const bf16x2_t b = __builtin_convertvector(f, bf16x2_t); return __builtin_bit_cast(unsigned, b); }


template <class Epi, class Sched, bool ALIGN_EPI = false, bool SP2 = false>
__device__ __forceinline__ void gemm_phase(PG8_LAS unsigned char* lds, const Gemm g, const Sched& S, const Epi& E) {
    const int tid = threadIdx.x, wid = __builtin_amdgcn_readfirstlane(tid >> 6), lane = tid & 63, wr = wid >> 2, wc = wid & 3, fr = lane & 15, fq = lane >> 4;
    const int K = g.K, nt = K / BK;
    unsigned voffA[2], voffB[2];
#pragma unroll
    for (int i = 0; i < 2; ++i) { int R, C; stage_rc(tid * 16 + i * 8192, R, C); const int Rb = Epi::PERM ? ((R & ~31) + perm32(R & 31)) : R;
        voffA[i] = (unsigned)(R * K + C) * 2u; voffB[i] = (unsigned)(Rb * K + C) * 2u; }
    const size_t kstep = (size_t)(BK * 2);
    const size_t hstep = (size_t)HALF * K * 2;
    const size_t tstep = 2 * hstep;
    const unsigned ldsw = (unsigned)wid * 1024u;
    const int aoff = lds_byte(wr * 64 + fr, fq * 8), boff = lds_byte(wc * 32 + fr, fq * 8);
#define PG8_SA(b, h) (((b) * 2 + (h)) * HTB)
#define PG8_SB(b, h) ((4 + (b) * 2 + (h)) * HTB)
#define PG8_STAGE(bufoff, gbase, voff) do { _Pragma("unroll") for (int _i = 0; _i < 2; ++_i) \
        __builtin_amdgcn_global_load_lds((const unsigned*)((const char*)(gbase) + (voff)[_i]), (PG8_LAS unsigned*)(lds + (bufoff) + ldsw + _i * 8192), 16, 0, 0); } while (0)
#define PG8_LDA(dst, b, h) do { _Pragma("unroll") for (int m = 0; m < 4; ++m) _Pragma("unroll") for (int k = 0; k < 2; ++k) dst[m][k] = *(const PG8_LAS bf16x8*)(lds + PG8_SA(b, h) + aoff + m * 2048 + k * 1024); } while (0)
#define PG8_LDB(dst, b, h) do { _Pragma("unroll") for (int n = 0; n < 2; ++n) _Pragma("unroll") for (int k = 0; k < 2; ++k) dst[n][k] = *(const PG8_LAS bf16x8*)(lds + PG8_SB(b, h) + boff + n * 2048 + k * 1024); } while (0)
#define PG8_MMA(ai, bj, At, Bt) do { __builtin_amdgcn_s_setprio(1); _Pragma("unroll") for (int m = 0; m < 4; ++m) _Pragma("unroll") for (int n = 0; n < 2; ++n) _Pragma("unroll") for (int k = 0; k < 2; ++k) \
        acc[ai][bj][m][n] = __builtin_amdgcn_mfma_f32_16x16x32_bf16(Bt[n][k], At[m][k], acc[ai][bj][m][n], 0, 0, 0); __builtin_amdgcn_s_setprio(0); } while (0)
#define PG8_WAIT_V(n) asm volatile("s_waitcnt vmcnt(" #n ")" ::: "memory")
#define PG8_WAIT_L(n) asm volatile("s_waitcnt lgkmcnt(" #n ")" ::: "memory")
#define PG8_BAR __builtin_amdgcn_s_barrier()
#define PG8_SCHED __builtin_amdgcn_sched_barrier(0)
    Unit cur, nxt; int ui = 0;
    if (!S.next(0, cur)) return;
    f32x4 acc[2][2][4][2];
#pragma unroll
    for (int a = 0; a < 2; ++a)
#pragma unroll
        for (int b = 0; b < 2; ++b)
#pragma unroll
            for (int m = 0; m < 4; ++m)
#pragma unroll
                for (int n = 0; n < 2; ++n) acc[a][b][m][n] = (f32x4){0.f, 0.f, 0.f, 0.f};
    bf16x8 At[4][2], B0[2][2], B1[2][2];
    const char* cA = (const char*)g.A + (size_t)cur.pm * tstep; const char* cB = (const char*)g.Bt + (size_t)cur.pn * tstep;
    S.a_ready(cur);
    if constexpr (SP2) {
        PG8_STAGE(PG8_SB(0, 0), cB, voffB); PG8_STAGE(PG8_SB(0, 1), cB + hstep, voffB); PG8_STAGE(PG8_SA(0, 0), cA, voffA); PG8_STAGE(PG8_SA(0, 1), cA + hstep, voffA);
        if (wr == 1) PG8_BAR;
        PG8_WAIT_V(2); PG8_BAR;
        PG8_STAGE(PG8_SB(1, 0), cB + kstep, voffB); PG8_STAGE(PG8_SA(1, 0), cA + kstep, voffA); PG8_STAGE(PG8_SB(1, 1), cB + hstep + kstep, voffB);
        PG8_WAIT_V(6); PG8_BAR;
    } else {
        PG8_STAGE(PG8_SB(0, 0), cB, voffB); PG8_STAGE(PG8_SA(0, 0), cA, voffA); PG8_STAGE(PG8_SB(0, 1), cB + hstep, voffB); PG8_STAGE(PG8_SA(0, 1), cA + hstep, voffA);
        if (wr == 1) PG8_BAR;
        PG8_WAIT_V(4); PG8_BAR;
        PG8_STAGE(PG8_SB(1, 0), cB + kstep, voffB); PG8_STAGE(PG8_SA(1, 0), cA + kstep, voffA); PG8_STAGE(PG8_SB(1, 1), cB + hstep + kstep, voffB);
        PG8_WAIT_V(6); PG8_BAR;
    }
    for (;;) {
        const bool has_next = S.next(ui + 1, nxt);
        const char* nA = has_next ? (const char*)g.A + (size_t)nxt.pm * tstep : cA; const char* nB = has_next ? (const char*)g.Bt + (size_t)nxt.pn * tstep : cB;
        for (int t = 0; t < nt; t += 2) {
            const bool last = (t == nt - 2);
            const char* a1 = cA + (size_t)(t + 1) * kstep;
            const char* a2 = last ? nA : cA + (size_t)(t + 2) * kstep; const char* b2 = last ? nB : cB + (size_t)(t + 2) * kstep;
            const char* a3 = a2 + kstep; const char* b3 = b2 + kstep;
            if (last && has_next) S.a_ready(nxt);
            if constexpr (SP2) {
            PG8_LDB(B0, 0, 0); PG8_LDB(B1, 0, 1); PG8_SCHED; PG8_LDA(At, 0, 0); PG8_STAGE(PG8_SA(1, 1), a1 + hstep, voffA);
            PG8_WAIT_V(8); PG8_WAIT_L(0); PG8_BAR; PG8_MMA(0, 0, At, B0); PG8_MMA(0, 1, At, B1); PG8_BAR; PG8_SCHED;
            PG8_LDA(At, 0, 1); PG8_STAGE(PG8_SB(0, 0), b2, voffB); PG8_STAGE(PG8_SB(0, 1), b2 + hstep, voffB); PG8_STAGE(PG8_SA(0, 0), a2, voffA);
            PG8_WAIT_V(8); PG8_WAIT_L(0); PG8_BAR; PG8_MMA(1, 0, At, B0); PG8_MMA(1, 1, At, B1); PG8_BAR; PG8_SCHED;
            PG8_LDB(B0, 1, 0); PG8_LDB(B1, 1, 1); PG8_SCHED; PG8_LDA(At, 1, 0); PG8_STAGE(PG8_SA(0, 1), a2 + hstep, voffA);
            PG8_WAIT_V(8); PG8_WAIT_L(0); PG8_BAR; PG8_MMA(0, 0, At, B0); PG8_MMA(0, 1, At, B1); PG8_BAR; PG8_SCHED;
            PG8_LDA(At, 1, 1); PG8_STAGE(PG8_SB(1, 0), b3, voffB); PG8_STAGE(PG8_SB(1, 1), b3 + hstep, voffB); PG8_STAGE(PG8_SA(1, 0), a3, voffA);
            PG8_WAIT_V(8); PG8_WAIT_L(0); PG8_BAR; PG8_MMA(1, 0, At, B0); PG8_MMA(1, 1, At, B1); PG8_BAR; PG8_SCHED;
            } else {
            PG8_LDB(B0, 0, 0); PG8_SCHED; PG8_LDA(At, 0, 0); PG8_STAGE(PG8_SA(1, 1), a1 + hstep, voffA);
            PG8_WAIT_L(8); PG8_BAR; PG8_WAIT_L(0); PG8_MMA(0, 0, At, B0); PG8_BAR; PG8_SCHED;
            PG8_LDB(B1, 0, 1); PG8_STAGE(PG8_SB(0, 0), b2, voffB);
            PG8_BAR; PG8_WAIT_L(0); PG8_MMA(0, 1, At, B1); PG8_BAR;
            PG8_LDA(At, 0, 1); PG8_STAGE(PG8_SA(0, 0), a2, voffA);
            PG8_BAR; PG8_WAIT_L(0); PG8_MMA(1, 0, At, B0); PG8_BAR; PG8_SCHED;
            PG8_STAGE(PG8_SB(0, 1), b2 + hstep, voffB);
            PG8_WAIT_V(6); PG8_BAR; PG8_MMA(1, 1, At, B1); PG8_BAR;
            PG8_LDB(B0, 1, 0); PG8_SCHED; PG8_LDA(At, 1, 0); PG8_STAGE(PG8_SA(0, 1), a2 + hstep, voffA);
            PG8_WAIT_L(8); PG8_BAR; PG8_WAIT_L(0); PG8_MMA(0, 0, At, B0); PG8_BAR; PG8_SCHED;
            PG8_LDB(B1, 1, 1); PG8_STAGE(PG8_SB(1, 0), b3, voffB);
            PG8_BAR; PG8_WAIT_L(0); PG8_MMA(0, 1, At, B1); PG8_BAR;
            PG8_LDA(At, 1, 1); PG8_STAGE(PG8_SA(1, 0), a3, voffA);
            PG8_BAR; PG8_WAIT_L(0); PG8_MMA(1, 0, At, B0); PG8_BAR; PG8_SCHED;
            PG8_STAGE(PG8_SB(1, 1), b3 + hstep, voffB);
            PG8_WAIT_V(6); PG8_BAR; PG8_MMA(1, 1, At, B1); PG8_BAR;
            }
        }
        if constexpr (ALIGN_EPI) { if (wr == 0) PG8_BAR; }
        if constexpr (!Epi::AFTER_DRAIN) { E(acc, cur, wr, wc, fr, fq); S.done(cur); }
        if (!has_next) break;
#pragma unroll
        for (int a = 0; a < 2; ++a)
#pragma unroll
            for (int b = 0; b < 2; ++b)
#pragma unroll
                for (int m = 0; m < 4; ++m)
#pragma unroll
                    for (int n = 0; n < 2; ++n) acc[a][b][m][n] = (f32x4){0.f, 0.f, 0.f, 0.f};
        cur = nxt; cA = nA; cB = nB; ++ui;
        if constexpr (ALIGN_EPI) { if (wr == 1) PG8_BAR; }
    }
    PG8_WAIT_V(0);
    if constexpr (!ALIGN_EPI) { if (wr == 0) PG8_BAR; }
    PG8_BAR;
    if constexpr (Epi::AFTER_DRAIN) { E.fused(acc, cur, wr, wc, fr, fq, lds, wid, lane); S.done(cur); }
#undef PG8_SA
#undef PG8_SB
#undef PG8_STAGE
#undef PG8_LDA
#undef PG8_LDB
#undef PG8_MMA
#undef PG8_WAIT_V
#undef PG8_WAIT_L
#undef PG8_BAR
#undef PG8_SCHED
}

struct EpiInProj {
    static constexpr bool PERM = true, AFTER_DRAIN = false;
    bf16_t *U, *Q, *Kb, *Vb;
    __device__ __forceinline__ void operator()(const f32x4 (&acc)[2][2][4][2], const Unit& u, int wr, int wc, int fr, int fq) const {
        const int row0 = u.pm * BM + wr * 64 + fr;
        if (u.pn < 4) {
            const int col0 = u.pn * BM + wc * 32 + 8 * fq;
#pragma unroll
            for (int ai = 0; ai < 2; ++ai)
#pragma unroll
                for (int m = 0; m < 4; ++m) { const int row = row0 + ai * HALF + m * 16, b = row >> 12, t = row & 4095;
#pragma unroll
                    for (int bj = 0; bj < 2; ++bj) { const int col = col0 + bj * HALF; const f32x4 v0 = acc[ai][bj][m][0], v1 = acc[ai][bj][m][1];
                        u32x4 w; w.x = cvt_pk_bf16(v0[0], v0[1]); w.y = cvt_pk_bf16(v0[2], v0[3]); w.z = cvt_pk_bf16(v1[0], v1[1]); w.w = cvt_pk_bf16(v1[2], v1[3]);
                        *(u32x4*)(U + (((size_t)(b * 64 + (col >> 4)) * 4096 + t) * 16 + (col & 8))) = w; } }
            return;
        }
        bf16_t* base; int ldc, colt;
        if (u.pn < 8) { base = Q; ldc = 1024; colt = (u.pn - 4) * BM; } else if (u.pn == 8) { base = Kb; ldc = 256; colt = 0; } else { base = Vb; ldc = 256; colt = 0; }
        const int col0 = colt + wc * 32 + 8 * fq;
#pragma unroll
        for (int ai = 0; ai < 2; ++ai)
#pragma unroll
            for (int m = 0; m < 4; ++m) { bf16_t* rowp = base + (size_t)(row0 + ai * HALF + m * 16) * ldc + col0;
#pragma unroll
                for (int bj = 0; bj < 2; ++bj) { const f32x4 v0 = acc[ai][bj][m][0], v1 = acc[ai][bj][m][1];
                    u32x4 w; w.x = cvt_pk_bf16(v0[0], v0[1]); w.y = cvt_pk_bf16(v0[2], v0[3]); w.z = cvt_pk_bf16(v1[0], v1[1]); w.w = cvt_pk_bf16(v1[2], v1[3]);
                    *(u32x4*)(rowp + bj * HALF) = w; } }
    }
};
struct EpiBf16Plain {
    static constexpr bool PERM = true, AFTER_DRAIN = false;
    bf16_t* O; int ldc;
    __device__ __forceinline__ void operator()(const f32x4 (&acc)[2][2][4][2], const Unit& u, int wr, int wc, int fr, int fq) const {
        const int row0 = u.pm * BM + wr * 64 + fr, col0 = u.pn * BM + wc * 32 + 8 * fq;
#pragma unroll
        for (int ai = 0; ai < 2; ++ai)
#pragma unroll
            for (int m = 0; m < 4; ++m) { bf16_t* rowp = O + (size_t)(row0 + ai * HALF + m * 16) * ldc + col0;
#pragma unroll
                for (int bj = 0; bj < 2; ++bj) { const f32x4 v0 = acc[ai][bj][m][0], v1 = acc[ai][bj][m][1];
                    u32x4 w; w.x = cvt_pk_bf16(v0[0], v0[1]); w.y = cvt_pk_bf16(v0[2], v0[3]); w.z = cvt_pk_bf16(v1[0], v1[1]); w.w = cvt_pk_bf16(v1[2], v1[3]);
                    *(u32x4*)(rowp + bj * HALF) = w; } }
    }
};
struct EpiGlu {
    static constexpr bool PERM = true, AFTER_DRAIN = false;
    bf16_t* O; int ldo; const bf16_t* Y; int ldy; const float* bias;
    __device__ __forceinline__ void operator()(const f32x4 (&acc)[2][2][4][2], const Unit& u, int wr, int wc, int fr, int fq) const {
        const int row0 = u.pm * BM + wr * 64 + fr, col0 = u.pn * BM + wc * 32 + 8 * fq;
        f32x4 bv[2][2];
#pragma unroll
        for (int bj = 0; bj < 2; ++bj)
#pragma unroll
            for (int n = 0; n < 2; ++n) bv[bj][n] = *(const f32x4*)(bias + col0 + bj * HALF + 4 * n);
#pragma unroll
        for (int ai = 0; ai < 2; ++ai)
#pragma unroll
            for (int m = 0; m < 4; ++m) { const size_t row = (size_t)(row0 + ai * HALF + m * 16);
#pragma unroll
                for (int bj = 0; bj < 2; ++bj) {
                    const u32x4 yw = *(const u32x4*)(Y + row * ldy + col0 + bj * HALF);
                    float o[8];
#pragma unroll
                    for (int e = 0; e < 8; ++e) { const float a = acc[ai][bj][m][e >> 2][e & 3] + bv[bj][e >> 2][e & 3];
                        const unsigned yy = yw[e >> 1]; const float y = __uint_as_float((e & 1) ? (yy & 0xffff0000u) : (yy << 16));
                        o[e] = y / (1.0f + __expf(-a)); }
                    u32x4 w; w.x = cvt_pk_bf16(o[0], o[1]); w.y = cvt_pk_bf16(o[2], o[3]); w.z = cvt_pk_bf16(o[4], o[5]); w.w = cvt_pk_bf16(o[6], o[7]);
                    *(u32x4*)(O + row * ldo + col0 + bj * HALF) = w; } }
    }
};
struct EpiResF32 {
    static constexpr bool PERM = false, AFTER_DRAIN = false;
    float* C; const float* R; int ldc;
    __device__ __forceinline__ void operator()(const f32x4 (&acc)[2][2][4][2], const Unit& u, int wr, int wc, int fr, int fq) const {
        const int row0 = u.pm * BM + wr * 64 + fr, col0 = u.pn * BM + wc * 32 + 4 * fq;
#pragma unroll
        for (int ai = 0; ai < 2; ++ai)
#pragma unroll
            for (int m = 0; m < 4; ++m) { const size_t off = (size_t)(row0 + ai * HALF + m * 16) * ldc + col0;
#pragma unroll
                for (int bj = 0; bj < 2; ++bj)
#pragma unroll
                    for (int n = 0; n < 2; ++n) { f32x4 v = acc[ai][bj][m][n]; if (R) v = v + *(const f32x4*)(R + off + bj * HALF + n * 16); *(f32x4*)(C + off + bj * HALF + n * 16) = v; } }
    }
};
__device__ __forceinline__ float row_rnorm(const float* PS, size_t row) {
    const f32x4* p = (const f32x4*)(PS + row * 32); float s = 0.f;
#pragma unroll
    for (int i = 0; i < 8; ++i) { const f32x4 v = p[i]; s += (v[0] + v[1]) + (v[2] + v[3]); }
    return __builtin_amdgcn_rsqf(s * (1.0f / 2048.0f) + 1e-6f);
}
template <bool RBF16> struct EpiResBf16 {
    static constexpr bool PERM = true, AFTER_DRAIN = false;
    bf16_t* H; const void* R; float* PS;
    __device__ __forceinline__ void operator()(const f32x4 (&acc)[2][2][4][2], const Unit& u, int wr, int wc, int fr, int fq) const {
        const int row0 = u.pm * BM + wr * 64 + fr, col0 = u.pn * BM + wc * 32 + 8 * fq;
#pragma unroll
        for (int ai = 0; ai < 2; ++ai)
#pragma unroll
            for (int m = 0; m < 4; ++m) { const size_t row = (size_t)(row0 + ai * HALF + m * 16), off = row * 2048 + col0; float ss = 0.f;
#pragma unroll
                for (int bj = 0; bj < 2; ++bj) {
                    f32x4 r0, r1;
                    if (RBF16) { const u32x4 rw = *(const u32x4*)((const bf16_t*)R + off + bj * HALF);
                        r0 = (f32x4){__uint_as_float(rw.x << 16), __uint_as_float(rw.x & 0xffff0000u), __uint_as_float(rw.y << 16), __uint_as_float(rw.y & 0xffff0000u)};
                        r1 = (f32x4){__uint_as_float(rw.z << 16), __uint_as_float(rw.z & 0xffff0000u), __uint_as_float(rw.w << 16), __uint_as_float(rw.w & 0xffff0000u)}; }
                    else { r0 = *(const f32x4*)((const float*)R + off + bj * HALF); r1 = *(const f32x4*)((const float*)R + off + bj * HALF + 4); }
                    const f32x4 v0 = acc[ai][bj][m][0] + r0, v1 = acc[ai][bj][m][1] + r1;
                    ss += ((v0[0] * v0[0] + v0[1] * v0[1]) + (v0[2] * v0[2] + v0[3] * v0[3])) + ((v1[0] * v1[0] + v1[1] * v1[1]) + (v1[2] * v1[2] + v1[3] * v1[3]));
                    u32x4 w; w.x = cvt_pk_bf16(v0[0], v0[1]); w.y = cvt_pk_bf16(v0[2], v0[3]); w.z = cvt_pk_bf16(v1[0], v1[1]); w.w = cvt_pk_bf16(v1[2], v1[3]);
                    *(u32x4*)(H + off + bj * HALF) = w; }
                ss += __shfl_xor(ss, 16); ss += __shfl_xor(ss, 32);
                if (fq == 0) PS[row * 32 + u.pn * 4 + wc] = ss; }
    }
};
struct EpiBf16RowScale {
    static constexpr bool PERM = true, AFTER_DRAIN = false;
    bf16_t* O; int ldc; const float* PS;
    __device__ __forceinline__ void operator()(const f32x4 (&acc)[2][2][4][2], const Unit& u, int wr, int wc, int fr, int fq) const {
        const int row0 = u.pm * BM + wr * 64 + fr, col0 = u.pn * BM + wc * 32 + 8 * fq;
#pragma unroll
        for (int ai = 0; ai < 2; ++ai)
#pragma unroll
            for (int m = 0; m < 4; ++m) { const size_t row = (size_t)(row0 + ai * HALF + m * 16); const float r = row_rnorm(PS, row); bf16_t* rowp = O + row * ldc + col0;
#pragma unroll
                for (int bj = 0; bj < 2; ++bj) { const f32x4 v0 = acc[ai][bj][m][0] * r, v1 = acc[ai][bj][m][1] * r;
                    u32x4 w; w.x = cvt_pk_bf16(v0[0], v0[1]); w.y = cvt_pk_bf16(v0[2], v0[3]); w.z = cvt_pk_bf16(v1[0], v1[1]); w.w = cvt_pk_bf16(v1[2], v1[3]);
                    *(u32x4*)(rowp + bj * HALF) = w; } }
    }
};
struct EpiF32RowScale {
    static constexpr bool PERM = true, AFTER_DRAIN = false;
    float* C; int ldc; const float* PS;
    __device__ __forceinline__ void operator()(const f32x4 (&acc)[2][2][4][2], const Unit& u, int wr, int wc, int fr, int fq) const {
        const int row0 = u.pm * BM + wr * 64 + fr, col0 = u.pn * BM + wc * 32 + 8 * fq;
#pragma unroll
        for (int ai = 0; ai < 2; ++ai)
#pragma unroll
            for (int m = 0; m < 4; ++m) { const size_t row = (size_t)(row0 + ai * HALF + m * 16); const float r = row_rnorm(PS, row); const size_t off = row * ldc + col0;
#pragma unroll
                for (int bj = 0; bj < 2; ++bj) { *(f32x4*)(C + off + bj * HALF) = acc[ai][bj][m][0] * r; *(f32x4*)(C + off + bj * HALF + 4) = acc[ai][bj][m][1] * r; } }
    }
};
}

#ifndef PG8_SP2
#define PG8_SP2 false
#endif
#ifndef PG8_ALIGN
#define PG8_ALIGN true
#endif
constexpr int NTOK = 32768, DM = 2048, SEQ = 4096, NB = 8;
constexpr int NWAVES = 8, NTHREADS = 512;
constexpr int LDS_BYTES = 147456;
constexpr float NORM_EPS = 1e-6f;

#define LAS __attribute__((address_space(3)))
typedef unsigned short bf16;
typedef unsigned u32;
typedef short bf16x8 __attribute__((ext_vector_type(8)));
typedef short s16x4 __attribute__((ext_vector_type(4)));
typedef float f32x4 __attribute__((ext_vector_type(4)));
typedef float f32x16 __attribute__((ext_vector_type(16)));
typedef unsigned u32x4 __attribute__((ext_vector_type(4)));
typedef unsigned u32x2 __attribute__((ext_vector_type(2)));

constexpr size_t MiB = 1u << 20;
constexpr size_t WS_CTL = 0, CTL_ZERO_BYTES = 64 * 1024;
constexpr size_t WS_W_IN_T = 1 * MiB, WS_W_GLU_T = 11 * MiB, WS_W_OUT_T = 13 * MiB, WS_W_CQ_T = 21 * MiB, WS_W_CKV_T = 23 * MiB, WS_W_CO_T = 27 * MiB, WS_W_S_T = 29 * MiB;
constexpr size_t WS_S5_WIN = 37 * MiB, WS_S5_WOUT = 41 * MiB, WS_S5_K = 45 * MiB, WS_S5_LAM = 46 * MiB, WS_BIAS_TAB = 46 * MiB + 512 * 1024;
constexpr size_t WS_MEM_N = 47 * MiB, WS_KV_C = 55 * MiB, WS_PS = 59 * MiB;
#ifndef FP6_PACK_INTERLEAVED
#define FP6_PACK_INTERLEAVED 1
#endif
typedef unsigned v6u_t __attribute__((ext_vector_type(6)));
constexpr int PEER_ROW_BYTES = 1536;
constexpr int PEER_SROW = 384;
constexpr size_t PEER_SLICE_BYTES = (size_t)16384 * PEER_SROW;
constexpr size_t WS_PEER_U = 64 * MiB, WS_PEER_V = 96 * MiB;
constexpr size_t WS_PEER_SU = 128 * MiB, WS_PEER_SV = 128 * MiB + 65536;
constexpr size_t WS_HN = 192 * MiB;
constexpr size_t WS_U = 320 * MiB, WS_Q = 384 * MiB, WS_K = 448 * MiB, WS_V = 464 * MiB, WS_YPRE = 480 * MiB, WS_YMIX = 544 * MiB;
constexpr size_t WS_OB = 320 * MiB;
constexpr size_t WS_SCORES = 320 * MiB;
constexpr size_t WS_QC = 672 * MiB, WS_OC = 704 * MiB, WS_TK_IDX = 736 * MiB, WS_TK_G = 752 * MiB, WS_END = 768 * MiB;

__device__ __forceinline__ unsigned f2bf(float f) { unsigned u = __float_as_uint(f); return (u + 0x7fffu + ((u >> 16) & 1u)) >> 16; }
__device__ __forceinline__ unsigned pk2(float lo, float hi) { return pg8::cvt_pk_bf16(lo, hi); }
__device__ __forceinline__ unsigned cvtpk(float lo, float hi) { return pg8::cvt_pk_bf16(lo, hi); }
__device__ __forceinline__ float bflo(unsigned w) { return __uint_as_float(w << 16); }
__device__ __forceinline__ float bfhi(unsigned w) { return __uint_as_float(w & 0xffff0000u); }
__device__ __forceinline__ float wave_sum(float v) {
#pragma unroll
    for (int o = 1; o < 64; o <<= 1) v += __shfl_xor(v, o);
    return v;
}
__device__ __forceinline__ float gelu_tanh(float x) { const float z = 0.7978845608028654f * (x + 0.044715f * x * x * x); return x / (1.0f + __expf(-2.0f * z)); }
#define LDS_WAIT() asm volatile("s_waitcnt lgkmcnt(0)" ::: "memory")
#define MFMA16(a, b, c) __builtin_amdgcn_mfma_f32_16x16x32_bf16((a), (b), (c), 0, 0, 0)
#define MFMA32(a, b, c) __builtin_amdgcn_mfma_f32_32x32x16_bf16((a), (b), (c), 0, 0, 0)

__device__ __forceinline__ void p0_transpose_item(const float* W, int K, int N, bf16* WT, LAS float* scr, int item, int lane, const float* kgain = nullptr) {
    const int nblk = N / 32, kb = item / nblk, nb = item % nblk, k0 = 64 * kb, n0 = 32 * nb;
    f32x4 v[8];
#pragma unroll
    for (int i = 0; i < 8; ++i) v[i] = *(const f32x4*)(W + (size_t)(k0 + 8 * i + (lane >> 3)) * N + n0 + 4 * (lane & 7));
#pragma unroll
    for (int i = 0; i < 8; ++i) { const int kk = 8 * i + (lane >> 3); f32x4 x = v[i]; if (kgain) x = x * kgain[k0 + kk];
#pragma unroll
        for (int c = 0; c < 4; ++c) scr[kk * 33 + 4 * (lane & 7) + c] = x[c]; }
    LDS_WAIT(); asm volatile("" ::: "memory");
    const int c = lane & 7;
#pragma unroll
    for (int j = 0; j < 4; ++j) { const int n = (lane >> 3) + 8 * j; const LAS float* s = scr + (8 * c) * 33 + n;
        u32x4 o; o.x = pk2(s[0 * 33], s[1 * 33]); o.y = pk2(s[2 * 33], s[3 * 33]); o.z = pk2(s[4 * 33], s[5 * 33]); o.w = pk2(s[6 * 33], s[7 * 33]);
        *(u32x4*)(WT + (size_t)(n0 + n) * K + k0 + 8 * c) = o; }
    LDS_WAIT(); asm volatile("" ::: "memory");
}
__device__ __forceinline__ void rms_row_to_bf16(const float* xrow, const float* gain, bf16* orow, int lane) {
    const f32x4* xr = (const f32x4*)xrow + lane; const f32x4* gr = (const f32x4*)gain + lane;
    f32x4 v[8]; float s = 0.f;
#pragma unroll
    for (int j = 0; j < 8; ++j) { v[j] = xr[64 * j]; s += (v[j].x * v[j].x + v[j].y * v[j].y) + (v[j].z * v[j].z + v[j].w * v[j].w); }
    const float r = rsqrtf(wave_sum(s) * (1.f / DM) + NORM_EPS);
    u32x2* o8 = (u32x2*)orow + lane;
#pragma unroll
    for (int j = 0; j < 8; ++j) { const f32x4 g = gr[64 * j]; u32x2 w; w.x = pk2(v[j].x * r * g.x, v[j].y * r * g.y); w.y = pk2(v[j].z * r * g.z, v[j].w * r * g.w); o8[64 * j] = w; }
}

struct Ptrs {
    const float* in[28]; float* out; unsigned char* ws;
};

__device__ __forceinline__ void phase_prologue(const Ptrs& P, LAS unsigned char* lds, int G) {
    const int tid = threadIdx.x, lane = tid & 63, wave = __builtin_amdgcn_readfirstlane(tid >> 6);
    unsigned char* ws = P.ws;
    {
        const float* wq = P.in[23]; const float* sk = P.in[24]; bf16* WsT = (bf16*)(ws + WS_W_S_T);
        LAS float* wq_l = (LAS float*)lds;
        LAS float* sk_l = wq_l + 64 * 129;
        for (int it = blockIdx.x; it < 512; it += G) {
            const int hc = it >> 5, d0 = (it & 31) * 64;
            __syncthreads();
#pragma unroll
            for (int i = 0; i < 4; ++i) { const int e = tid + 512 * i, dl = e >> 5, j4 = (e & 31) * 4; f32x4 v = *(const f32x4*)(wq + (size_t)(d0 + dl) * 2048 + hc * 128 + j4); v = v * P.in[22][d0 + dl];
#pragma unroll
                for (int c = 0; c < 4; ++c) wq_l[dl * 129 + j4 + c] = v[c]; }
#pragma unroll
            for (int i = 0; i < 8; ++i) { const int e = tid + 512 * i, kk = e >> 5, j4 = (e & 31) * 4; const f32x4 v = *(const f32x4*)(sk + ((size_t)hc * 128 + kk) * 128 + j4);
#pragma unroll
                for (int c = 0; c < 4; ++c) sk_l[kk * 129 + j4 + c] = v[c]; }
            __syncthreads();
            const int kb = wave & 3, db = wave >> 2;
            const LAS float* ap = sk_l + (32 * kb + (lane & 31)) * 129 + (lane >> 5); const LAS float* bp = wq_l + (32 * db + (lane & 31)) * 129 + (lane >> 5);
            f32x16 acc;
#pragma unroll
            for (int i = 0; i < 16; ++i) acc[i] = 0.f;
#pragma unroll 16
            for (int st = 0; st < 64; ++st) acc = __builtin_amdgcn_mfma_f32_32x32x2f32(ap[2 * st], bp[2 * st], acc, 0, 0, 0);
#pragma unroll
            for (int r = 0; r < 16; ++r) { const int key = (r & 3) + 8 * (r >> 2) + 4 * (lane >> 5);
                WsT[(size_t)(hc * 128 + 32 * kb + key) * 2048 + d0 + 32 * db + (lane & 31)] = (bf16)f2bf(acc[r]); }
        }
        __syncthreads();
    }
    {
        const float *lam_re = P.in[5], *lam_im = P.in[6], *b_re = P.in[7], *b_im = P.in[8], *c_re = P.in[9], *c_im = P.in[10], *dd = P.in[11], *log_dt = P.in[12];
        LAS float* pwr = (LAS float*)lds;
        LAS float* bbar = pwr + 17 * 64 * 2;
        LAS float* cc = bbar + 64 * 16 * 2;
        for (int gi = blockIdx.x; gi < 256; gi += G) {
            const int g = gi >> 2, qt = gi & 3;
            __syncthreads();
            if (tid < 64) {
                const int p = tid; const float lre = lam_re[g * 64 + p], lim = lam_im[g * 64 + p], dt = expf(log_dt[g]);
                const float er = expf(lre * dt); float sn, cs; sincosf(lim * dt, &sn, &cs);
                const float lbr = er * cs, lbi = er * sn;
                const float nr = lbr - 1.0f, ni = lbi, den = lre * lre + lim * lim;
                const float fr = (nr * lre + ni * lim) / den, fi = (ni * lre - nr * lim) / den;
#pragma unroll
                for (int h = 0; h < 16; ++h) { const float br = b_re[(g * 64 + p) * 16 + h], bi = b_im[(g * 64 + p) * 16 + h];
                    bbar[(p * 16 + h) * 2] = fr * br - fi * bi; bbar[(p * 16 + h) * 2 + 1] = fr * bi + fi * br; }
                float pr = 1.f, pi = 0.f;
                for (int j = 0; j <= 16; ++j) { pwr[(j * 64 + p) * 2] = pr; pwr[(j * 64 + p) * 2 + 1] = pi; const float t = pr * lbr - pi * lbi; pi = pr * lbi + pi * lbr; pr = t; }
            }
            for (int e = tid; e < 1024; e += NTHREADS) { cc[e * 2] = c_re[g * 1024 + e]; cc[e * 2 + 1] = c_im[g * 1024 + e]; }
            __syncthreads();
            bf16* Win = (bf16*)(ws + WS_S5_WIN) + (size_t)g * 32768; bf16* Wout = (bf16*)(ws + WS_S5_WOUT) + (size_t)g * 32768; bf16* Kt = (bf16*)(ws + WS_S5_K) + (size_t)g * 4096;
            for (int e = qt * 8192 + tid; e < (qt + 1) * 8192; e += NTHREADS) {
                const int m = e >> 8, kk = e & 255, p = m & 63, ri = m >> 6, sg = kk >> 4, hp = kk & 15;
                const float ar = pwr[((15 - sg) * 64 + p) * 2], ai = pwr[((15 - sg) * 64 + p) * 2 + 1], xr = bbar[(p * 16 + hp) * 2], xi = bbar[(p * 16 + hp) * 2 + 1];
                Win[e] = (bf16)f2bf(ri ? (ar * xi + ai * xr) : (ar * xr - ai * xi));
            }
            for (int e = qt * 8192 + tid; e < (qt + 1) * 8192; e += NTHREADS) {
                const int mm = e >> 7, m = e & 127, tau = mm >> 4, h = mm & 15, p = m & 63, ri = m >> 6;
                const float ar = pwr[((tau + 1) * 64 + p) * 2], ai = pwr[((tau + 1) * 64 + p) * 2 + 1], cr = cc[(h * 64 + p) * 2], ci = cc[(h * 64 + p) * 2 + 1];
                Wout[e] = (bf16)f2bf(ri ? -(cr * ai + ci * ar) : (cr * ar - ci * ai));
            }
            for (int e = qt * 1024 + tid; e < (qt + 1) * 1024; e += NTHREADS) {
                const int j = e >> 8, h = (e >> 4) & 15, hp = e & 15; float s = 0.f;
                for (int p = 0; p < 64; ++p) { const float ar = pwr[(j * 64 + p) * 2], ai = pwr[(j * 64 + p) * 2 + 1], cr = cc[(h * 64 + p) * 2], ci = cc[(h * 64 + p) * 2 + 1];
                    const float wr = cr * ar - ci * ai, wi = cr * ai + ci * ar; s += wr * bbar[(p * 16 + hp) * 2] - wi * bbar[(p * 16 + hp) * 2 + 1]; }
                if (j == 0 && h == hp) s += dd[g * 16 + h];
                Kt[e] = (bf16)f2bf(s);
            }
            if (tid < 64 && qt == 0) { float* lamq = (float*)(ws + WS_S5_LAM) + g * 128; lamq[2 * tid] = pwr[(16 * 64 + tid) * 2]; lamq[2 * tid + 1] = pwr[(16 * 64 + tid) * 2 + 1]; }
        }
        __syncthreads();
    }
    {
        const float* rel_bias = P.in[2]; float* bt = (float*)(ws + WS_BIAS_TAB);
        for (int e = blockIdx.x * NTHREADS + tid; e < 2048; e += G * NTHREADS) {
            const int hq = e >> 7, dist = e & 127; int bucket = dist;
            if (dist >= 16) { int lg = 16 + (int)(logf((float)dist / 16.0f) / logf(8.0f) * 16.0f); bucket = lg < 31 ? lg : 31; }
            bt[e] = rel_bias[bucket * 16 + hq];
        }
    }
    {
        LAS float* scr = (LAS float*)(lds + wave * 16384);
        const int gw = blockIdx.x * NWAVES + wave, NGW = G * NWAVES;
        constexpr int I0 = 32 * 80, I1 = 16 * 32, I2 = 32 * 64, I3 = 32 * 16, I4 = 32 * 32, I5 = 8 * 64;
        for (int it = gw; it < I0 + I1 + I2 + I3 + I4 + I5; it += NGW) {
            int r = it;
            if (r < I0) { p0_transpose_item(P.in[4], 2048, 2560, (bf16*)(ws + WS_W_IN_T), scr, r, lane); continue; } r -= I0;
            if (r < I1) { p0_transpose_item(P.in[13], 1024, 1024, (bf16*)(ws + WS_W_GLU_T), scr, r, lane); continue; } r -= I1;
            if (r < I2) { p0_transpose_item(P.in[16], 2048, 2048, (bf16*)(ws + WS_W_OUT_T), scr, r, lane); continue; } r -= I2;
            if (r < I3) { p0_transpose_item(P.in[19], 2048, 512, (bf16*)(ws + WS_W_CQ_T), scr, r, lane, P.in[17]); continue; } r -= I3;
            if (r < I4) { p0_transpose_item(P.in[20], 2048, 1024, (bf16*)(ws + WS_W_CKV_T), scr, r, lane); continue; } r -= I4;
            p0_transpose_item(P.in[21], 512, 2048, (bf16*)(ws + WS_W_CO_T), scr, r, lane);
        }
        {
            f32x4 a[8], b[8];
#pragma unroll
            for (int j = 0; j < 8; ++j) { a[j] = ((const f32x4*)(P.in[0] + (size_t)gw * DM))[lane + 64 * j]; b[j] = ((const f32x4*)(P.in[0] + (size_t)(gw + NGW) * DM))[lane + 64 * j]; }
#pragma unroll 1
            for (int m = gw; m < NTOK; m += 2 * NGW) {
                const int mn = (m + 2 * NGW < NTOK) ? m + 2 * NGW : m;
                f32x4 na[8], nb[8];
#pragma unroll
                for (int j = 0; j < 8; ++j) { na[j] = ((const f32x4*)(P.in[0] + (size_t)mn * DM))[lane + 64 * j]; nb[j] = ((const f32x4*)(P.in[0] + (size_t)(mn + NGW) * DM))[lane + 64 * j]; }
                float s0 = 0.f, s1 = 0.f;
#pragma unroll
                for (int j = 0; j < 8; ++j) { s0 += (a[j].x * a[j].x + a[j].y * a[j].y) + (a[j].z * a[j].z + a[j].w * a[j].w); s1 += (b[j].x * b[j].x + b[j].y * b[j].y) + (b[j].z * b[j].z + b[j].w * b[j].w); }
                const float r0 = rsqrtf(wave_sum(s0) * (1.f / DM) + NORM_EPS), r1 = rsqrtf(wave_sum(s1) * (1.f / DM) + NORM_EPS);
                u32x2* o0 = (u32x2*)((bf16*)(ws + WS_HN) + (size_t)m * DM) + lane; u32x2* o1 = (u32x2*)((bf16*)(ws + WS_HN) + (size_t)(m + NGW) * DM) + lane;
#pragma unroll
                for (int j = 0; j < 8; ++j) { const f32x4 g = ((const f32x4*)P.in[3])[lane + 64 * j];
                    u32x2 w0, w1; w0.x = pk2(a[j].x * r0 * g.x, a[j].y * r0 * g.y); w0.y = pk2(a[j].z * r0 * g.z, a[j].w * r0 * g.w); w1.x = pk2(b[j].x * r1 * g.x, b[j].y * r1 * g.y); w1.y = pk2(b[j].z * r1 * g.z, b[j].w * r1 * g.w);
                    o0[64 * j] = w0; o1[64 * j] = w1; }
#pragma unroll
                for (int j = 0; j < 8; ++j) { a[j] = na[j]; b[j] = nb[j]; }
            }
        }
        for (int m = gw; m < 2048; m += NGW) rms_row_to_bf16(P.in[1] + (size_t)m * DM, P.in[18], (bf16*)(ws + WS_MEM_N) + (size_t)m * DM, lane);
    }
}

__device__ __forceinline__ void peer_quant_rows(const Ptrs& P, LAS unsigned char* lds, int wave, int lane, int first, int step, int r_hi) {
    unsigned char* ws = P.ws; (void)lds; (void)wave;
    if (first >= r_hi) return;
    typedef float v16f_t __attribute__((ext_vector_type(16)));
    const int lo4 = 128 * (lane >> 4) + (lane & 15);
#define PQ_SRC(r) (((r) >> 14) ? P.in[26] : P.in[25]) + (size_t)((r) & 16383) * DM
#define PQ_LOAD(V, r) { const f32x4* s4_ = (const f32x4*)(PQ_SRC(r)) + lo4; _Pragma("unroll") for (int q = 0; q < 8; ++q) V[q] = s4_[16 * q]; }
#define PQ_ROW(V, r) { const int t_ = (r) >> 14, e_ = (r) & 16383; float mx = 0.f; \
        if (t_ == 0) { _Pragma("unroll") for (int q = 0; q < 8; ++q) V[q] = V[q] * ((const f32x4*)P.in[22])[lo4 + 16 * q]; } \
        _Pragma("unroll") for (int q = 0; q < 8; ++q) mx = fmaxf(mx, fmaxf(fmaxf(fabsf(V[q].x), fabsf(V[q].y)), fmaxf(fabsf(V[q].z), fabsf(V[q].w)))); \
        _Pragma("unroll") for (int o = 1; o < 64; o <<= 1) mx = fmaxf(mx, __shfl_xor(mx, o)); \
        const float sc = mx > 0.f ? mx * (1.0f / 7.5f) : 1.0f, inv = 1.0f / sc; \
        v16f_t lo16, hi16; \
        _Pragma("unroll") for (int q = 0; q < 8; ++q) { lo16[2 * q] = V[q].x * inv; hi16[2 * q] = V[q].y * inv; lo16[2 * q + 1] = V[q].z * inv; hi16[2 * q + 1] = V[q].w * inv; } \
        const v6u_t wq = __builtin_amdgcn_cvt_scalef32_2xpk16_fp6_f32(lo16, hi16, 1.0f);        \
        unsigned char* dst = ws + (t_ ? WS_PEER_V : WS_PEER_U) + (size_t)(lane >> 4) * PEER_SLICE_BYTES + (size_t)e_ * PEER_SROW; \
          \
        *(u32x4*)(dst + 16 * (lane & 15)) = (u32x4){wq[0], wq[1], wq[2], wq[3]}; *(u32x2*)(dst + 256 + 8 * (lane & 15)) = (u32x2){wq[4], wq[5]}; \
        if (lane == 0) ((float*)(ws + WS_PEER_SU))[2 * e_ + t_] = sc;        }
    f32x4 va[8], vb[8];
    { const int r1 = first + step < r_hi ? first + step : first; PQ_LOAD(va, first) PQ_LOAD(vb, r1) }
#pragma unroll 1
    for (int rr = first; rr < r_hi; rr += 2 * step) {
        const bool two = rr + step < r_hi;
        const int n0 = rr + 2 * step < r_hi ? rr + 2 * step : rr, n1 = rr + 3 * step < r_hi ? rr + 3 * step : n0;
        f32x4 na[8], nb[8];
        PQ_LOAD(na, n0) PQ_LOAD(nb, n1)
        PQ_ROW(va, rr)
        if (two) PQ_ROW(vb, rr + step)
#pragma unroll
        for (int q = 0; q < 8; ++q) { va[q] = na[q]; vb[q] = nb[q]; }
    }
#undef PQ_SRC
#undef PQ_LOAD
#undef PQ_ROW
}

__device__ __forceinline__ void phase_norm(const float* h, const float* gain, bf16* hn, int G) {
    const int lane = threadIdx.x & 63, wave = __builtin_amdgcn_readfirstlane(threadIdx.x >> 6);
    for (int m = blockIdx.x * NWAVES + wave; m < NTOK; m += G * NWAVES) rms_row_to_bf16(h + (size_t)m * DM, gain, hn + (size_t)m * DM, lane);
}

__device__ __forceinline__ void phase_s5(const Ptrs& P, LAS unsigned char* lds, int G) {
    const int tid = threadIdx.x, l = tid & 63, w = __builtin_amdgcn_readfirstlane(tid >> 6);
    unsigned char* ws = P.ws;
    const bf16* U = (const bf16*)(ws + WS_U); bf16* Y = (bf16*)(ws + WS_YPRE);
    LAS unsigned char* U_l = lds;
    LAS float* S_l = (LAS float*)(lds + 33792);
    LAS bf16* Xs_l = (LAS bf16*)(lds + 33792 + 33280);
    LAS float* Eseg = (LAS float*)(lds + 33792 + 33280 + 17408);
    LAS float* Gcar = (LAS float*)(lds + 33792 + 33280 + 17408 + 4096);
    const int l15 = l & 15, l4 = l >> 4;
    const int uoff = l15 * 528 + (l >> 5) * 32 + (l4 & 1) * 16;
    for (int it = blockIdx.x; it < 512; it += G) {
        const int b = it >> 6, g = it & 63;
        const bf16* Win = (const bf16*)(ws + WS_S5_WIN) + (size_t)g * 32768; const bf16* Wout = (const bf16*)(ws + WS_S5_WOUT) + (size_t)g * 32768; const bf16* Kt = (const bf16*)(ws + WS_S5_K) + (size_t)g * 4096;
        const float* lamq = (const float*)(ws + WS_S5_LAM) + g * 128;
        const bf16* Ug = U + (size_t)(b * 64 + g) * 65536;
        const int p = tid & 63, seg = tid >> 6;
        const float lqr = lamq[2 * p], lqi = lamq[2 * p + 1];
        float l8r = lqr, l8i = lqi;
#pragma unroll
        for (int i = 0; i < 3; ++i) { const float t = l8r * l8r - l8i * l8i; l8i = 2.f * l8r * l8i; l8r = t; }
        __syncthreads();
        if (tid < 64) { Gcar[2 * tid] = 0.f; Gcar[2 * tid + 1] = 0.f; }
#pragma unroll 1
        for (int ps = 0; ps < 4; ++ps) {
#pragma unroll
            for (int i = 0; i < 4; ++i) { const int e = tid + 512 * i, t = e >> 1;
                *(LAS u32x4*)(U_l + (t >> 4) * 528 + (t & 15) * 32 + (e & 1) * 16) = *(const u32x4*)(Ug + (size_t)ps * 16384 + e * 8); }
            bf16x8 Aw[8];
#pragma unroll
            for (int ks = 0; ks < 8; ++ks) Aw[ks] = *(const bf16x8*)(Win + (16 * w + l15) * 256 + 32 * ks + 8 * l4);
            __syncthreads();
#pragma unroll
            for (int cb = 0; cb < 4; ++cb) {
                f32x4 acc = (f32x4){0.f, 0.f, 0.f, 0.f};
#pragma unroll
                for (int ks = 0; ks < 8; ++ks) { const bf16x8 Bf = *(const LAS bf16x8*)(U_l + cb * 8448 + uoff + 64 * ks); acc = MFMA16(Aw[ks], Bf, acc); }
#pragma unroll
                for (int r = 0; r < 4; ++r) S_l[(16 * w + 4 * l4 + r) * 65 + cb * 16 + l15] = acc[r];
            }
            __syncthreads();
            {
                float er = 0.f, ei = 0.f; const int c0 = seg * 8;
#pragma unroll
                for (int i = 0; i < 8; ++i) { const int c = c0 + i; const float sr = S_l[p * 65 + c], si = S_l[(64 + p) * 65 + c];
                    const float t = lqr * er - lqi * ei + sr; ei = lqr * ei + lqi * er + si; er = t; S_l[p * 65 + c] = er; S_l[(64 + p) * 65 + c] = ei; }
                Eseg[(seg * 64 + p) * 2] = er; Eseg[(seg * 64 + p) * 2 + 1] = ei;
                __syncthreads();
                float gr = Gcar[((ps & 1) * 64 + p) * 2], gi = Gcar[((ps & 1) * 64 + p) * 2 + 1];
                for (int s = 0; s < seg; ++s) { const float t = l8r * gr - l8i * gi + Eseg[(s * 64 + p) * 2]; gi = l8r * gi + l8i * gr + Eseg[(s * 64 + p) * 2 + 1]; gr = t; }
                if (seg == 7) { Gcar[(((ps + 1) & 1) * 64 + p) * 2] = l8r * gr - l8i * gi + er; Gcar[(((ps + 1) & 1) * 64 + p) * 2 + 1] = l8r * gi + l8i * gr + ei; }
                float pr = 1.f, pi = 0.f;
#pragma unroll
                for (int i = 0; i < 8; ++i) { const int c = c0 + i;
                    float xr = pr * gr - pi * gi, xi = pr * gi + pi * gr;
                    if (i > 0) { xr += S_l[p * 65 + c - 1]; xi += S_l[(64 + p) * 65 + c - 1]; }
                    Xs_l[c * 136 + p] = (bf16)f2bf(xr); Xs_l[c * 136 + 64 + p] = (bf16)f2bf(xi);
                    const float t = pr * lqr - pi * lqi; pi = pr * lqi + pi * lqr; pr = t; }
            }
            __syncthreads();
#pragma unroll 1
            for (int tt = 0; tt < 2; ++tt) {
                const int tau = tt ? 15 - w : w;
                bf16x8 Tf[8], Wo[4];
#pragma unroll
                for (int ks = 0; ks < 8; ++ks) { const int lag = tau - (2 * ks + (l >> 5));
                    bf16x8 z = (bf16x8){0, 0, 0, 0, 0, 0, 0, 0};
                    if (lag >= 0) z = *(const bf16x8*)(Kt + (lag * 16 + l15) * 16 + 8 * (l4 & 1));
                    Tf[ks] = z; }
#pragma unroll
                for (int k2 = 0; k2 < 4; ++k2) Wo[k2] = *(const bf16x8*)(Wout + (tau * 16 + l15) * 128 + 32 * k2 + 8 * l4);
#pragma unroll
                for (int cb = 0; cb < 4; ++cb) {
                    f32x4 acc = (f32x4){0.f, 0.f, 0.f, 0.f};
#pragma unroll
                    for (int ks = 0; ks < 8; ++ks) if (2 * ks <= tau) { const bf16x8 Bf = *(const LAS bf16x8*)(U_l + cb * 8448 + uoff + 64 * ks); acc = MFMA16(Tf[ks], Bf, acc); }
#pragma unroll
                    for (int k2 = 0; k2 < 4; ++k2) { const bf16x8 Bx = *(const LAS bf16x8*)(Xs_l + (cb * 16 + l15) * 136 + 32 * k2 + 8 * l4); acc = MFMA16(Wo[k2], Bx, acc); }
                    u32x2 o; o.x = pk2(gelu_tanh(acc[0]), gelu_tanh(acc[1])); o.y = pk2(gelu_tanh(acc[2]), gelu_tanh(acc[3]));
                    const size_t tok = (size_t)b * SEQ + 16 * (ps * 64 + cb * 16 + l15) + tau;
                    *(u32x2*)(Y + tok * 1024 + 16 * g + 4 * l4) = o;
                }
            }
            __syncthreads();
        }
    }
}

template <int D, int NKB, bool SWA>
__device__ __forceinline__ void attn_task(const bf16* qrow, const LAS unsigned char* Kl, int kstrideB, const LAS unsigned char* Vl, int vstrideB, int kb0,
                                          const LAS float* biasr, int qloc, bool first_blk, float sink, float scale, bf16* orow, int l) {
    const int r32 = l & 31, h = l >> 5;
    bf16x8 qf[D / 16];
#pragma unroll
    for (int s = 0; s < D / 16; ++s) qf[s] = *(const bf16x8*)(qrow + 16 * s + 8 * h);
    f32x16 x[NKB];
#pragma unroll
    for (int kbi = 0; kbi < NKB; ++kbi) {
#pragma unroll
        for (int i = 0; i < 16; ++i) x[kbi][i] = 0.f;
#pragma unroll
        for (int s = 0; s < D / 16; ++s) { const bf16x8 a = *(const LAS bf16x8*)(Kl + ((kb0 + kbi) * 32 + r32) * kstrideB + (16 * s + 8 * h) * 2); x[kbi] = MFMA32(a, qf[s], x[kbi]); }
    }
    float m = -INFINITY;
#pragma unroll
    for (int kbi = 0; kbi < NKB; ++kbi)
#pragma unroll
        for (int i = 0; i < 16; ++i) {
            float s = x[kbi][i] * scale;
            if (SWA) { const int kloc = (kb0 + kbi) * 32 + (i & 3) + 8 * (i >> 2) + 4 * h, dist = qloc - kloc;
                const bool valid = (dist >= 0) && (dist < 128) && (!first_blk || kloc >= 128);
                const int dcl = dist < 0 ? 0 : (dist > 127 ? 127 : dist);
                s = valid ? s + biasr[dcl] : -INFINITY; }
            x[kbi][i] = s; m = fmaxf(m, s);
        }
    m = fmaxf(m, __shfl_xor(m, 32)); if (SWA) m = fmaxf(m, sink);
    float sum = 0.f;
    u32 pk[NKB][8];
#pragma unroll
    for (int kbi = 0; kbi < NKB; ++kbi)
#pragma unroll
        for (int i = 0; i < 16; i += 2) { const float e0 = __expf(x[kbi][i] - m), e1 = __expf(x[kbi][i + 1] - m); sum += e0 + e1; pk[kbi][i >> 1] = cvtpk(e0, e1); }
    sum += __shfl_xor(sum, 32); if (SWA) sum += __expf(sink - m);
    const float inv = 1.0f / sum;
    f32x16 o[D / 32];
#pragma unroll
    for (int db = 0; db < D / 32; ++db)
#pragma unroll
        for (int i = 0; i < 16; ++i) o[db][i] = 0.f;
#pragma unroll
    for (int kbi = 0; kbi < NKB; ++kbi)
#pragma unroll
        for (int s2 = 0; s2 < 2; ++s2) {
            u32x4 pw; pw.x = pk[kbi][4 * s2]; pw.y = pk[kbi][4 * s2 + 1]; pw.z = pk[kbi][4 * s2 + 2]; pw.w = pk[kbi][4 * s2 + 3];
            const bf16x8 pb = __builtin_bit_cast(bf16x8, pw);
#pragma unroll
            for (int db = 0; db < D / 32; ++db) {
                const LAS unsigned char* vp = Vl + (db * 32 + r32) * vstrideB + ((kb0 + kbi) * 32 + 16 * s2 + 4 * h) * 2;
                const s16x4 lo = *(const LAS s16x4*)vp, hi = *(const LAS s16x4*)(vp + 16);
                const bf16x8 a = __builtin_shufflevector(lo, hi, 0, 1, 2, 3, 4, 5, 6, 7);
                o[db] = MFMA32(a, pb, o[db]);
            }
        }
#pragma unroll
    for (int db = 0; db < D / 32; ++db)
#pragma unroll
        for (int g4 = 0; g4 < 4; ++g4) { u32x2 wv; wv.x = cvtpk(o[db][4 * g4] * inv, o[db][4 * g4 + 1] * inv); wv.y = cvtpk(o[db][4 * g4 + 2] * inv, o[db][4 * g4 + 3] * inv);
            *(u32x2*)(orow + db * 32 + 8 * g4 + 4 * h) = wv; }
}

__device__ __forceinline__ void phase_swa(const Ptrs& P, LAS unsigned char* lds, int G) {
    const int tid = threadIdx.x, l = tid & 63, w = __builtin_amdgcn_readfirstlane(tid >> 6);
    unsigned char* ws = P.ws;
    const bf16* Qb = (const bf16*)(ws + WS_Q); const bf16* Kb = (const bf16*)(ws + WS_K); const bf16* Vb = (const bf16*)(ws + WS_V); bf16* Ym = (bf16*)(ws + WS_YMIX);
    const float* bt = (const float*)(ws + WS_BIAS_TAB); const float* sinks = P.in[15];
    LAS unsigned char* Kl = lds;
    LAS unsigned char* Vl = lds + 36864;
    LAS float* bias_l = (LAS float*)(lds + 36864 + 33280);
    for (int it = blockIdx.x; it < 1024; it += G) {
        const int g = it & 3, n = (it >> 2) & 31, b = it >> 7;
        __syncthreads();
#pragma unroll
        for (int i = 0; i < 4; ++i) { const int e = tid + 512 * i, key = e >> 3, part = e & 7; const int kpos = n * 128 - 128 + key;
            u32x4 v = (u32x4){0u, 0u, 0u, 0u};
            if (kpos >= 0) v = *(const u32x4*)(Kb + ((size_t)b * SEQ + kpos) * 256 + g * 64 + part * 8);
            *(LAS u32x4*)(Kl + key * 144 + part * 16) = v; }
#pragma unroll
        for (int i = 0; i < 4; ++i) { const int e = tid + 512 * i, key = e & 255, part = e >> 8; const int kpos = n * 128 - 128 + key;
            u32x4 v = (u32x4){0u, 0u, 0u, 0u};
            if (kpos >= 0) v = *(const u32x4*)(Vb + ((size_t)b * SEQ + kpos) * 256 + g * 64 + part * 8);
#pragma unroll
            for (int jj = 0; jj < 8; ++jj) { const unsigned wv = v[jj >> 1]; *(LAS bf16*)(Vl + (part * 8 + jj) * 520 + key * 2) = (bf16)((jj & 1) ? (wv >> 16) : (wv & 0xffffu)); } }
        bias_l[tid] = bt[(4 * g + (tid >> 7)) * 128 + (tid & 127)];
        __syncthreads();
        const int r = w >> 1, hq = 4 * g + r; const float sink = sinks[hq];
#pragma unroll 1
        for (int t = 0; t < 2; ++t) {
            const int qq = 2 * (w & 1) + t, r32 = l & 31;
            const size_t qtok = (size_t)b * SEQ + n * 128 + 32 * qq + r32;
            attn_task<64, 5, true>(Qb + qtok * 1024 + hq * 64, Kl, 144, Vl, 520, qq, bias_l + r * 128, 128 + 32 * qq + r32, n == 0, sink, 0.125f,
                                   Ym + qtok * 2048 + 1024 + hq * 64, l);
        }
    }
}

__device__ __forceinline__ void phase_cross(const Ptrs& P, LAS unsigned char* lds, int G) {
    const int tid = threadIdx.x, l = tid & 63, w = __builtin_amdgcn_readfirstlane(tid >> 6);
    unsigned char* ws = P.ws;
    const bf16* Qc = (const bf16*)(ws + WS_QC); const bf16* KV = (const bf16*)(ws + WS_KV_C); bf16* Oc = (bf16*)(ws + WS_OC);
    LAS unsigned char* Kl = lds;
    LAS unsigned char* Vl = lds + 69632;
    int prev = -1;
    for (int it = blockIdx.x; it < 512; it += G) {
        const int qb = it & 15, hd = (it >> 4) & 3, b = it >> 6;
        if ((it >> 4) != prev) {
            prev = it >> 4;
            __syncthreads();
#pragma unroll
            for (int i = 0; i < 8; ++i) { const int e = tid + 512 * i, key = e >> 4, part = e & 15;
                *(LAS u32x4*)(Kl + key * 272 + part * 16) = *(const u32x4*)(KV + ((size_t)b * 256 + key) * 1024 + hd * 128 + part * 8); }
#pragma unroll
            for (int i = 0; i < 8; ++i) { const int e = tid + 512 * i, key = e & 255, part = e >> 8;
                const u32x4 v = *(const u32x4*)(KV + ((size_t)b * 256 + key) * 1024 + 512 + hd * 128 + part * 8);
#pragma unroll
                for (int jj = 0; jj < 8; ++jj) { const unsigned wv = v[jj >> 1]; *(LAS bf16*)(Vl + (part * 8 + jj) * 520 + key * 2) = (bf16)((jj & 1) ? (wv >> 16) : (wv & 0xffffu)); } }
            __syncthreads();
        }
        const size_t qtok = (size_t)b * SEQ + qb * 256 + 32 * w + (l & 31);
        attn_task<128, 8, false>(Qc + qtok * 512 + hd * 128, Kl, 272, Vl, 520, 0, (const LAS float*)lds, 0, false, 0.f, 0.08838834764831845f, Oc + qtok * 512 + hd * 128, l);
    }
}
__device__ __forceinline__ void topk_stage1(LAS unsigned char* wb, int l, u32 (&v)[16]) {
    const int j = l >> 1, half = l & 1, sw = 2 * (j & 7);
#pragma unroll
    for (int gq = 0; gq < 4; ++gq) {
        u32 t[16];
#pragma unroll
        for (int i4 = 0; i4 < 4; ++i4) { const int i = 4 * gq + i4, ci = 2 * i + half, phys = ci ^ sw; const f32x4 f = *(const LAS f32x4*)(wb + j * 512 + phys * 16);
#pragma unroll
            for (int e = 0; e < 4; ++e) t[4 * i4 + e] = (f2key(f[e]) & ~0x7Fu) | (u32)(127 - (8 * i + 4 * half + e)); }
        sort16_desc(t);
        if (gq == 0) {
#pragma unroll
            for (int i = 0; i < 16; ++i) v[i] = t[i];
        } else merge_top16_desc(v, t);
    }
    LDS_WAIT(); asm volatile("" ::: "memory");
    {
        u32 o[16];
#pragma unroll
        for (int i = 0; i < 16; ++i) o[i] = (u32)__shfl_xor((int)v[i], 1);
        merge_top16_desc(v, o);
    }
}
__device__ __forceinline__ void topk_stage2(LAS unsigned char* wb, int l, const u32 (&v)[16], int* TI, float* TG, size_t obase, size_t ostride) {
    LAS u32* lut = (LAS u32*)wb;
#pragma unroll
    for (int i = 0; i < 16; ++i) lut[l * 16 + i] = v[i];
    float va[16], vb[16];
    {
        const bool c1 = (l >> 1) & 1;
#pragma unroll
        for (int i = 0; i < 16; ++i) { const u32 o = (u32)__shfl_xor((int)v[i], 2); const u32 a = c1 ? o : v[i], b = c1 ? v[i] : o; va[i] = key2f(a & ~0x7Fu); vb[i] = key2f(b & ~0x7Fu); }
    }
#define CAND(i, q) ((f2key(va[i] + vb[q]) & ~0xFFu) | (u32)(255 - (16 * (i) + (q))))
    u32 c[16];
    {
        u32 t[16];
#pragma unroll
        for (int q = 0; q < 16; ++q) c[q] = CAND(0, q);
        sort16_desc(c);
#pragma unroll
        for (int q = 0; q < 8; ++q) t[q] = CAND(1, q);
#pragma unroll
        for (int q = 0; q < 5; ++q) t[8 + q] = CAND(2, q);
        t[13] = CAND(3, 0); t[14] = CAND(3, 1); t[15] = CAND(3, 2);
        sort16_desc(t); merge_top16_desc(c, t);
        t[0] = CAND(3, 3); t[1] = CAND(4, 0); t[2] = CAND(4, 1); t[3] = CAND(4, 2); t[4] = CAND(5, 0); t[5] = CAND(5, 1); t[6] = CAND(6, 0); t[7] = CAND(6, 1);
        t[8] = CAND(7, 0); t[9] = CAND(7, 1); t[10] = CAND(8, 0); t[11] = CAND(9, 0); t[12] = CAND(10, 0); t[13] = CAND(11, 0); t[14] = CAND(12, 0); t[15] = CAND(13, 0);
        sort16_desc(t); merge_top16_desc(c, t);
        insert_top16_desc(c, CAND(14, 0)); insert_top16_desc(c, CAND(15, 0));
    }
#undef CAND
    LDS_WAIT(); asm volatile("" ::: "memory");
    float best[16]; int eidx[16];
    const int la = (l & ~2) * 16, lb = (l | 2) * 16;
#pragma unroll
    for (int r = 0; r < 16; ++r) { const u32 key = c[r]; const int pos = 255 - (int)(key & 0xFFu); best[r] = key2f(key & ~0xFFu);
        const int k0 = 127 - (int)(lut[la + (pos >> 4)] & 0x7Fu), k1 = 127 - (int)(lut[lb + (pos & 15)] & 0x7Fu); eidx[r] = k0 * 128 + k1; }
    float s = 0.f;
#pragma unroll
    for (int r = 0; r < 16; ++r) { best[r] = __expf(best[r] - key2f(c[0] & ~0xFFu)); s += best[r]; }
    const float inv = 1.0f / s;
    if ((l & 2) == 0) {
        const size_t o = obase + (size_t)(l >> 2) * ostride;
#pragma unroll
        for (int r4 = 0; r4 < 4; ++r4) { *(int4*)(TI + o + 4 * r4) = make_int4(eidx[4 * r4], eidx[4 * r4 + 1], eidx[4 * r4 + 2], eidx[4 * r4 + 3]);
            *(f32x4*)(TG + o + 4 * r4) = (f32x4){best[4 * r4] * inv, best[4 * r4 + 1] * inv, best[4 * r4 + 2] * inv, best[4 * r4 + 3] * inv}; }
    }
    LDS_WAIT(); asm volatile("" ::: "memory");
}
struct EpiTopk {
    static constexpr bool PERM = true, AFTER_DRAIN = true;
    const float* PS; int* TI; float* TG;
    __device__ __forceinline__ void fused(const pg8::f32x4 (&acc)[2][2][4][2], const pg8::Unit& u, int wr, int wc, int fr, int fq, LAS unsigned char* lds, int wid, int lane) const {
        const int cb0 = (8 * wc + 2 * fq) ^ (4 * (fr & 3));
        LAS unsigned char* wq0 = lds + (4 * wr) * 16384 + (2 * fr) * 512 + cb0 * 16;
        LAS unsigned char* wq1 = lds + (4 * wr) * 16384 + (2 * fr + 1) * 512 + (cb0 ^ 2) * 16;
        u32 v0[16];
#pragma unroll
        for (int ai = 0; ai < 2; ++ai) {
#pragma unroll
            for (int m = 0; m < 4; ++m) { const size_t row = (size_t)(u.pm * 256 + ai * 128 + wr * 64 + m * 16 + fr); const float r = pg8::row_rnorm(PS, row);
#pragma unroll
                for (int n = 0; n < 2; ++n) { *(LAS f32x4*)(wq0 + m * 16384 + n * 16) = acc[ai][0][m][n] * r; *(LAS f32x4*)(wq1 + m * 16384 + n * 16) = acc[ai][1][m][n] * r; } }
            __syncthreads();
            if (ai == 0) { topk_stage1(lds + wid * 16384, lane, v0); __syncthreads(); }
            else {
                u32 v1[16];
                topk_stage1(lds + wid * 16384, lane, v1);
#pragma unroll
                for (int i = 0; i < 16; ++i) v1[i] = (lane & 1) ? v1[i] : v0[i];
                LDS_WAIT(); asm volatile("" ::: "memory");
                topk_stage2(lds + wid * 16384, lane, v1, TI, TG, ((size_t)(u.pm * 256 + (lane & 1) * 128 + 16 * wid) * 8 + u.pn) * 16, 128);
                __syncthreads();
            }
        }
    }
};

typedef float f32x2 __attribute__((ext_vector_type(2)));

typedef float v32f_t __attribute__((ext_vector_type(32)));
struct PeerBuf { v6u_t u0, u1, v0, v1; u32x2 sc0, sc1; };
#define PEER_LD6(rs, so) ({ const u32x4 a_ = __builtin_bit_cast(u32x4, __builtin_amdgcn_raw_buffer_load_b128(rs, 16 * l, so, 0)); const u32x2 b_ = __builtin_bit_cast(u32x2, __builtin_amdgcn_raw_buffer_load_b64(rs, 1024 + 8 * l, so, 0)); (v6u_t){a_.x, a_.y, a_.z, a_.w, b_.x, b_.y}; })
template <class RS> __device__ __forceinline__ void peer_issue(PeerBuf& B, const RS& rsU, const RS& rsV, const RS& rsS, int ivA, int ivB, int k0, int l) {
    const int iv = (k0 & 64) ? ivB : ivA;
    const int e0 = __builtin_amdgcn_readlane(iv, (k0 & 63)), e1 = __builtin_amdgcn_readlane(iv, (k0 & 63) + 1);
    B.sc0 = __builtin_bit_cast(u32x2, __builtin_amdgcn_raw_buffer_load_b64(rsS, 0, e0 * 8, 0)); B.sc1 = __builtin_bit_cast(u32x2, __builtin_amdgcn_raw_buffer_load_b64(rsS, 0, e1 * 8, 0));
    B.u0 = PEER_LD6(rsU, e0 * PEER_ROW_BYTES); B.u1 = PEER_LD6(rsU, e1 * PEER_ROW_BYTES); B.v0 = PEER_LD6(rsV, e0 * PEER_ROW_BYTES); B.v1 = PEER_LD6(rsV, e1 * PEER_ROW_BYTES);
}
typedef __bf16 v32bf_t __attribute__((ext_vector_type(32)));
typedef __bf16 bf16x2v __attribute__((ext_vector_type(2)));
__device__ __forceinline__ float peer_dot6(v6u_t w, const u32 (&xp)[16]) { const v32bf_t f = __builtin_amdgcn_cvt_scalef32_pk32_bf16_fp6(w, 1.0f); float s = 0.f;
#define PD2(pp) s = __builtin_amdgcn_fdot2_f32_bf16(__builtin_bit_cast(bf16x2v, xp[pp]), __builtin_shufflevector(f, f, 2 * (pp), 2 * (pp) + 1), s, false);
    PD2(0) PD2(1) PD2(2) PD2(3) PD2(4) PD2(5) PD2(6) PD2(7) PD2(8) PD2(9) PD2(10) PD2(11) PD2(12) PD2(13) PD2(14) PD2(15)
#undef PD2
    return s; }
__device__ __forceinline__ void peer_axpy6(v6u_t w, float c, float (&acc)[32]) { const v32f_t f = __builtin_amdgcn_cvt_scalef32_pk32_f32_fp6(w, 1.0f);
#pragma unroll
    for (int i = 0; i < 32; ++i) acc[i] += c * f[i]; }
__device__ __forceinline__ void peer_axpy6v(v6u_t w, float c, v32f_t& acc) { const v32f_t f = __builtin_amdgcn_cvt_scalef32_pk32_f32_fp6(w, 1.0f); acc = acc + f * c; }
__device__ __forceinline__ void peer_compute(const PeerBuf& B, const u32 (&xr)[16], float (&acc)[32], float rn, int ivA, int ivB, float gvA, float gvB, int k0, int l) {
    const float gv = (k0 & 64) ? gvB : gvA; const int kk = k0 & 63;
    const float d0 = peer_dot6(B.u0, xr); __builtin_amdgcn_sched_barrier(0);
    const float d1 = peer_dot6(B.u1, xr); __builtin_amdgcn_sched_barrier(0);
    const bool o1 = l & 1;
    float t = (o1 ? d1 : d0) + __shfl_xor(o1 ? d0 : d1, 1);
#pragma unroll
    for (int o = 2; o < 64; o <<= 1) t += __shfl_xor(t, o);
    const float g0 = __uint_as_float(__builtin_amdgcn_readlane(__float_as_uint(gv), kk)), g1 = __uint_as_float(__builtin_amdgcn_readlane(__float_as_uint(gv), kk + 1));
    const float su = __uint_as_float(o1 ? B.sc1.x : B.sc0.x), sv = __uint_as_float(o1 ? B.sc1.y : B.sc0.y), gg = o1 ? g1 : g0;
    const float cf = gg * gelu_tanh(t * su * rn) * sv;
    const float c0 = __uint_as_float(__builtin_amdgcn_readlane(__float_as_uint(cf), 0)), c1 = __uint_as_float(__builtin_amdgcn_readlane(__float_as_uint(cf), 1));
    __builtin_amdgcn_sched_barrier(0);
    peer_axpy6(B.v0, c0, acc); __builtin_amdgcn_sched_barrier(0);
    peer_axpy6(B.v1, c1, acc); __builtin_amdgcn_sched_barrier(0);
}
#define XB_TMO      128
#define XB_XCNT(j)  (256  + 64 * (j))
#define XB_XSUB(j)  (1280 + 64 * (j))
#define XB_XGEN(j)  (2304 + 64 * (j))
#define XB_TOP      3328
#define XB_TOPGEN   3392
#define XCD_BAR_WORDS 3456
#define XB_SPIN_CAP (1u << 20)
__device__ __forceinline__ unsigned xb_ld(unsigned* p)              { return __hip_atomic_load(p, __ATOMIC_RELAXED, __HIP_MEMORY_SCOPE_AGENT); }
__device__ __forceinline__ unsigned xb_add(unsigned* p, unsigned v) { return __hip_atomic_fetch_add(p, v, __ATOMIC_RELAXED, __HIP_MEMORY_SCOPE_AGENT); }
__device__ __forceinline__ unsigned xb_xcc_id() { return (unsigned)__builtin_amdgcn_s_getreg((3 << 11) | 20) & 0xFu; }
#define XB_SPIN(cond, bar) do { unsigned _sp = 0; while (cond) { __builtin_amdgcn_s_sleep(1); \
    if ((++_sp & 255u) == 0u) { if (xb_ld(&(bar)[XB_TMO])) break; if (_sp > XB_SPIN_CAP) { atomicAdd(&(bar)[XB_TMO], 1u); break; } } } } while (0)
struct XcdBarrier { unsigned* bar; unsigned x; volatile LAS unsigned* st; };
__device__ __forceinline__ XcdBarrier xcd_barrier_post(unsigned* bar, volatile LAS unsigned* st) {
    XcdBarrier b; b.bar = bar; b.x = xb_xcc_id(); b.st = st;
    if (threadIdx.x == 0) (void)xb_add(&bar[XB_XCNT(b.x)], 1u);
    return b;
}
__device__ __forceinline__ void xcd_barrier_complete(unsigned* bar, unsigned x, unsigned& nloc, unsigned& nx) {
    const unsigned G = gridDim.x * gridDim.y * gridDim.z;
    unsigned sum, cnt, mine, sp = 0u;
    for (;;) {
        sum = 0u; cnt = 0u; mine = 0u;
#pragma unroll
        for (unsigned j = 0; j < 16; ++j) { const unsigned c = xb_ld(&bar[XB_XCNT(j)]); sum += c; cnt += (c > 0u) ? 1u : 0u; mine = (j == x) ? c : mine; }
        if (sum == G) break;
        __builtin_amdgcn_s_sleep(1);
        if ((++sp & 255u) == 0u) { if (xb_ld(&bar[XB_TMO])) break; if (sp > XB_SPIN_CAP) { atomicAdd(&bar[XB_TMO], 1u); break; } }
    }
    nloc = mine > 0u ? mine : 1u; nx = cnt > 0u ? cnt : 1u;
}
__device__ __forceinline__ void xcd_barrier(const XcdBarrier& b) {
    asm volatile("s_waitcnt vmcnt(0)" ::: "memory");
    __syncthreads();
    if (threadIdx.x == 0) {
        unsigned* bar = b.bar;
        __builtin_amdgcn_s_waitcnt(0);
        unsigned nloc = b.st[0], nx = b.st[1];
        if (nloc == 0u) { xcd_barrier_complete(bar, b.x, nloc, nx); b.st[0] = nloc; b.st[1] = nx; }
        const unsigned old = xb_add(&bar[XB_XSUB(b.x)], 1u);
        const unsigned gen = old / nloc;
        if (old + 1u == (gen + 1u) * nloc) {
            __builtin_amdgcn_fence(__ATOMIC_RELEASE, "agent");
            asm volatile("s_waitcnt vmcnt(0)" ::: "memory");
            const unsigned og = xb_add(&bar[XB_TOP], 1u);
            const unsigned tg = og / nx;
            if (og + 1u == (tg + 1u) * nx) xb_add(&bar[XB_TOPGEN], 1u);
            else XB_SPIN(xb_ld(&bar[XB_TOPGEN]) == tg, bar);
            __builtin_amdgcn_fence(__ATOMIC_ACQUIRE, "agent");
            xb_add(&bar[XB_XGEN(b.x)], 1u);
            asm volatile("s_waitcnt vmcnt(0)" ::: "memory");
        } else {
            XB_SPIN(xb_ld(&bar[XB_XGEN(b.x)]) == gen, bar);
            __builtin_amdgcn_fence(__ATOMIC_ACQUIRE, "agent");
            asm volatile("s_waitcnt vmcnt(0)" ::: "memory");
        }
    }
    __syncthreads();
}

template <int CTRL> __device__ __forceinline__ float dpp_f(float v) { return __int_as_float(__builtin_amdgcn_update_dpp(0, __float_as_int(v), CTRL, 0xF, 0xF, true)); }
__device__ __forceinline__ float row16_reduce8(const float (&d)[8], int ch) {
    const bool b0 = ch & 1, b1 = ch & 2;
    float e[4], f[2];
#pragma unroll
    for (int j = 0; j < 4; ++j) { const float keep = b0 ? d[2 * j + 1] : d[2 * j], give = b0 ? d[2 * j] : d[2 * j + 1]; e[j] = keep + dpp_f<0xB1>(give); }
#pragma unroll
    for (int m = 0; m < 2; ++m) { const float keep = b1 ? e[2 * m + 1] : e[2 * m], give = b1 ? e[2 * m] : e[2 * m + 1]; f[m] = keep + dpp_f<0x4E>(give); }
#pragma unroll
    for (int m = 0; m < 2; ++m) { f[m] += dpp_f<0x128>(f[m]); f[m] += dpp_f<0x124>(f[m]); }
    return (ch & 4) ? f[1] : f[0];
}
struct PeerHalf { v6u_t w0, w1, w2, w3, w4, w5, w6, w7; };
__device__ __forceinline__ void peer_q_ids(int (&el)[8], const int* p  ) {
#pragma unroll
    for (int st = 0; st < 8; st += 4) { const int4 t = *(const int4*)(p + st); el[st] = t.x; el[st + 1] = t.y; el[st + 2] = t.z; el[st + 3] = t.w; }
}
template <class RS> __device__ __forceinline__ void peer_q_issue(PeerHalf& B, const RS& rs, const int (&el)[8], int ch) {
#define PH_LD(st) ({ const int vo_ = el[st] * PEER_SROW; \
        const u32x4 a_ = __builtin_bit_cast(u32x4, __builtin_amdgcn_raw_buffer_load_b128(rs, vo_ + 16 * ch, 0, 0)); const u32x2 b_ = __builtin_bit_cast(u32x2, __builtin_amdgcn_raw_buffer_load_b64(rs, vo_ + 256 + 8 * ch, 0, 0)); \
        (v6u_t){a_.x, a_.y, a_.z, a_.w, b_.x, b_.y}; })
    B.w0 = PH_LD(0); B.w1 = PH_LD(1); B.w2 = PH_LD(2); B.w3 = PH_LD(3); B.w4 = PH_LD(4); B.w5 = PH_LD(5); B.w6 = PH_LD(6); B.w7 = PH_LD(7);
#undef PH_LD
}
__device__ __forceinline__ void peer_q_dots(const PeerHalf& B, const u32 (&xs)[16], LAS float* pd  , int ch) {
    float d[8], old[8];
#pragma unroll
    for (int st = 0; st < 8; ++st) old[st] = pd[st];
    d[0] = peer_dot6(B.w0, xs); __builtin_amdgcn_sched_barrier(0); d[1] = peer_dot6(B.w1, xs); __builtin_amdgcn_sched_barrier(0);
    d[2] = peer_dot6(B.w2, xs); __builtin_amdgcn_sched_barrier(0); d[3] = peer_dot6(B.w3, xs); __builtin_amdgcn_sched_barrier(0);
    d[4] = peer_dot6(B.w4, xs); __builtin_amdgcn_sched_barrier(0); d[5] = peer_dot6(B.w5, xs); __builtin_amdgcn_sched_barrier(0);
    d[6] = peer_dot6(B.w6, xs); __builtin_amdgcn_sched_barrier(0); d[7] = peer_dot6(B.w7, xs); __builtin_amdgcn_sched_barrier(0);
#pragma unroll
    for (int o = 1; o < 16; o <<= 1)
#pragma unroll
        for (int st = 0; st < 8; ++st) d[st] += __shfl_xor(d[st], o);
    if (ch == 0) {
#pragma unroll
        for (int st = 0; st < 8; ++st) pd[st] = old[st] + d[st];
    }
}
__device__ __forceinline__ void peer_q_axpy(const PeerHalf& B, const LAS float* pd  , v32f_t& acc) {
    float cf[8];
#pragma unroll
    for (int st = 0; st < 8; ++st) cf[st] = pd[st];
    peer_axpy6v(B.w0, cf[0], acc); __builtin_amdgcn_sched_barrier(0); peer_axpy6v(B.w1, cf[1], acc); __builtin_amdgcn_sched_barrier(0);
    peer_axpy6v(B.w2, cf[2], acc); __builtin_amdgcn_sched_barrier(0); peer_axpy6v(B.w3, cf[3], acc); __builtin_amdgcn_sched_barrier(0);
    peer_axpy6v(B.w4, cf[4], acc); __builtin_amdgcn_sched_barrier(0); peer_axpy6v(B.w5, cf[5], acc); __builtin_amdgcn_sched_barrier(0);
    peer_axpy6v(B.w6, cf[6], acc); __builtin_amdgcn_sched_barrier(0); peer_axpy6v(B.w7, cf[7], acc); __builtin_amdgcn_sched_barrier(0);
}
#define PH_LD1(st) ({ const int vo_ = el[st] * PEER_SROW; \
        const u32x4 a_ = __builtin_bit_cast(u32x4, __builtin_amdgcn_raw_buffer_load_b128(rs, vo_ + 16 * ch, 0, 0)); const u32x2 b_ = __builtin_bit_cast(u32x2, __builtin_amdgcn_raw_buffer_load_b64(rs, vo_ + 256 + 8 * ch, 0, 0)); \
        (v6u_t){a_.x, a_.y, a_.z, a_.w, b_.x, b_.y}; })
template <class RS> __device__ __forceinline__ void peer_q_issue_dots(PeerHalf& N, const RS& rs, const int (&el)[8], const PeerHalf& B, const u32 (&xs)[16], LAS float* pd, int ch) {
    float d[8];
    const float old = pd[ch & 7];
    N.w0 = PH_LD1(0); d[0] = peer_dot6(B.w0, xs); __builtin_amdgcn_sched_barrier(0); N.w1 = PH_LD1(1); d[1] = peer_dot6(B.w1, xs); __builtin_amdgcn_sched_barrier(0);
    N.w2 = PH_LD1(2); d[2] = peer_dot6(B.w2, xs); __builtin_amdgcn_sched_barrier(0); N.w3 = PH_LD1(3); d[3] = peer_dot6(B.w3, xs); __builtin_amdgcn_sched_barrier(0);
    N.w4 = PH_LD1(4); d[4] = peer_dot6(B.w4, xs); __builtin_amdgcn_sched_barrier(0); N.w5 = PH_LD1(5); d[5] = peer_dot6(B.w5, xs); __builtin_amdgcn_sched_barrier(0);
    N.w6 = PH_LD1(6); d[6] = peer_dot6(B.w6, xs); __builtin_amdgcn_sched_barrier(0); N.w7 = PH_LD1(7); d[7] = peer_dot6(B.w7, xs); __builtin_amdgcn_sched_barrier(0);
    const float tot = row16_reduce8(d, ch);
    if (ch < 8) pd[ch] = old + tot;
}
template <class RS> __device__ __forceinline__ void peer_q_issue_axpy(PeerHalf& N, const RS& rs, const int (&el)[8], int ch, const PeerHalf& B, const LAS float* pd, v32f_t& acc) {
    float cf[8];
#pragma unroll
    for (int st = 0; st < 8; ++st) cf[st] = pd[st];
    N.w0 = PH_LD1(0); peer_axpy6v(B.w0, cf[0], acc); __builtin_amdgcn_sched_barrier(0); N.w1 = PH_LD1(1); peer_axpy6v(B.w1, cf[1], acc); __builtin_amdgcn_sched_barrier(0);
    N.w2 = PH_LD1(2); peer_axpy6v(B.w2, cf[2], acc); __builtin_amdgcn_sched_barrier(0); N.w3 = PH_LD1(3); peer_axpy6v(B.w3, cf[3], acc); __builtin_amdgcn_sched_barrier(0);
    N.w4 = PH_LD1(4); peer_axpy6v(B.w4, cf[4], acc); __builtin_amdgcn_sched_barrier(0); N.w5 = PH_LD1(5); peer_axpy6v(B.w5, cf[5], acc); __builtin_amdgcn_sched_barrier(0);
    N.w6 = PH_LD1(6); peer_axpy6v(B.w6, cf[6], acc); __builtin_amdgcn_sched_barrier(0); N.w7 = PH_LD1(7); peer_axpy6v(B.w7, cf[7], acc); __builtin_amdgcn_sched_barrier(0);
}
#undef PH_LD1
__device__ __forceinline__ void phase_peer(const Ptrs& P, LAS unsigned char* lds, int G, const XcdBarrier* bar) {
    const int tid = threadIdx.x, l = tid & 63, w = __builtin_amdgcn_readfirstlane(tid >> 6);
    unsigned char* ws = P.ws;
    const bf16* HN = (const bf16*)(ws + WS_HN); const float* SUV = (const float*)(ws + WS_PEER_SU);
    const int* TI = (const int*)(ws + WS_TK_IDX); const float* TG = (const float*)(ws + WS_TK_G); float* out = P.out; bf16* OB = (bf16*)(ws + WS_OB); const float* gfin = P.in[27]; const float* PS = (const float*)(ws + WS_PS);
    LAS float* PD = (LAS float*)(lds + w * 8192);
    LAS float* SS = (LAS float*)(lds + 65536 + w * 64);
    const int es = l >> 4, ch = l & 15, stride = G * NWAVES, tok0 = blockIdx.x * NWAVES + w;
    (void)bar;
    if (l < 16) SS[l] = 0.f;
#pragma unroll
    for (int q = 0; q < 8; ++q) *(LAS f32x4*)(PD + 4 * l + 256 * q) = (f32x4){0.f, 0.f, 0.f, 0.f};
    {
        int* TIw = (int*)(ws + WS_TK_IDX); float* TGw = (float*)(ws + WS_TK_G);
#pragma unroll 1
        for (int i = 0; i < 16; ++i) {
            const size_t tok = (size_t)(tok0 + i * stride);
            const int e0 = TIw[tok * 128 + l], e1 = TIw[tok * 128 + 64 + l]; const float g0 = TGw[tok * 128 + l], g1 = TGw[tok * 128 + 64 + l];
            const int k0 = (e0 << 7) | l, k1 = (e1 << 7) | (64 + l);
            int r0 = 0, r1 = 0;
#pragma unroll 8
            for (int j = 0; j < 64; ++j) { const int ka = __builtin_amdgcn_readlane(k0, j), kb = __builtin_amdgcn_readlane(k1, j);
                r0 += (ka < k0 ? 1 : 0) + (kb < k0 ? 1 : 0); r1 += (ka < k1 ? 1 : 0) + (kb < k1 ? 1 : 0); }
            TIw[tok * 128 + r0] = e0; TIw[tok * 128 + r1] = e1; TGw[tok * 128 + r0] = g0; TGw[tok * 128 + r1] = g1;
        }
        asm volatile("s_waitcnt vmcnt(0)" ::: "memory");
    }
#pragma unroll 1
    for (int s = 0; s < 4; ++s) {
        const auto rsU = __builtin_amdgcn_make_buffer_rsrc((void*)(ws + WS_PEER_U + (size_t)s * PEER_SLICE_BYTES), 0, (int)PEER_SLICE_BYTES, 0x00020000);
#pragma unroll 1
        for (int p = 0; p < 2; ++p) {
            PeerHalf A, B;
            int elA[8], elB[8];
            u32 xs[16];
#pragma unroll
            for (int q = 0; q < 8; ++q) { const u32x2 a = *(const u32x2*)(HN + (size_t)tok0 * DM + 512 * s + 64 * q + 4 * ch); xs[2 * q] = a.x; xs[2 * q + 1] = a.y; }
            peer_q_ids(elA, TI + (size_t)tok0 * 128 + 64 * p + 8 * es); peer_q_ids(elB, TI + (size_t)tok0 * 128 + 64 * p + 32 + 8 * es);
            peer_q_issue(A, rsU, elA, ch);
#pragma unroll 1
            for (int i = 0; i < 16; ++i) {
                const size_t ntok = (size_t)(tok0 + (i < 15 ? i + 1 : i) * stride);
                u32 nxs[16];
#pragma unroll
                for (int q = 0; q < 8; ++q) { const u32x2 a = *(const u32x2*)(HN + ntok * DM + 512 * s + 64 * q + 4 * ch); nxs[2 * q] = a.x; nxs[2 * q + 1] = a.y; }
                peer_q_ids(elA, TI + ntok * 128 + 64 * p + 8 * es);   __builtin_amdgcn_sched_barrier(0);   peer_q_issue_dots(B, rsU, elB, A, xs, PD + i * 128 + 64 * p + 8 * es, ch);
                peer_q_ids(elB, TI + ntok * 128 + 64 * p + 32 + 8 * es);   __builtin_amdgcn_sched_barrier(0);   peer_q_issue_dots(A, rsU, elA, B, xs, PD + i * 128 + 64 * p + 32 + 8 * es, ch);
#pragma unroll
                for (int q = 0; q < 16; ++q) xs[q] = nxs[q];
            }
        }
    }
#pragma unroll 1
    for (int hb = 0; hb < 2; ++hb) {
        int ce[8][2]; float cg[8][2], cps[8];
#pragma unroll
        for (int j = 0; j < 8; ++j) { const size_t tok = (size_t)(tok0 + (8 * hb + j) * stride);
            cps[j] = l < 32 ? PS[tok * 32 + l] : 0.f;
            ce[j][0] = TI[tok * 128 + l]; ce[j][1] = TI[tok * 128 + 64 + l]; cg[j][0] = TG[tok * 128 + l]; cg[j][1] = TG[tok * 128 + 64 + l]; }
        f32x2 csc[8][2];
#pragma unroll
        for (int j = 0; j < 8; ++j) { csc[j][0] = *(const f32x2*)(SUV + 2 * ce[j][0]); csc[j][1] = *(const f32x2*)(SUV + 2 * ce[j][1]); }
#pragma unroll
        for (int j = 0; j < 8; ++j) { const int i = 8 * hb + j;
            const float rn = __builtin_amdgcn_rsqf(wave_sum(cps[j]) * (1.0f / 2048.0f) + NORM_EPS);
#pragma unroll
            for (int hh = 0; hh < 2; ++hh) { const int k = 64 * hh + l; PD[i * 128 + k] = cg[j][hh] * gelu_tanh(PD[i * 128 + k] * csc[j][hh].x * rn) * csc[j][hh].y; } }
    }
#pragma unroll 1
    for (int s = 0; s < 4; ++s) {
        const auto rsV = __builtin_amdgcn_make_buffer_rsrc((void*)(ws + WS_PEER_V + (size_t)s * PEER_SLICE_BYTES), 0, (int)PEER_SLICE_BYTES, 0x00020000);
        PeerHalf A, B;
        int elA[8], elB[8];
        peer_q_ids(elA, TI + (size_t)tok0 * 128 + 8 * es); peer_q_ids(elB, TI + (size_t)tok0 * 128 + 32 + 8 * es);
        peer_q_issue(A, rsV, elA, ch);
#pragma unroll 1
        for (int i = 0; i < 16; ++i) {
            const size_t tok = (size_t)(tok0 + i * stride), ntok = (size_t)(tok0 + (i < 15 ? i + 1 : i) * stride);
            u32x2 hw[2];
#pragma unroll
            for (int j = 0; j < 2; ++j) hw[j] = *(const u32x2*)(HN + tok * DM + 512 * s + 64 * (2 * es + j) + 4 * ch);
            v32f_t acc;
#pragma unroll
            for (int c = 0; c < 32; ++c) acc[c] = 0.f;
            peer_q_ids(elA, TI + tok * 128 + 64 + 8 * es);   __builtin_amdgcn_sched_barrier(0);   peer_q_issue_axpy(B, rsV, elB, ch, A, PD + i * 128 + 8 * es, acc);
            peer_q_ids(elB, TI + tok * 128 + 96 + 8 * es);   __builtin_amdgcn_sched_barrier(0);   peer_q_issue_axpy(A, rsV, elA, ch, B, PD + i * 128 + 32 + 8 * es, acc);
            peer_q_ids(elA, TI + ntok * 128 + 8 * es);   __builtin_amdgcn_sched_barrier(0);   peer_q_issue_axpy(B, rsV, elB, ch, A, PD + i * 128 + 64 + 8 * es, acc);
            peer_q_ids(elB, TI + ntok * 128 + 32 + 8 * es);   __builtin_amdgcn_sched_barrier(0);   peer_q_issue_axpy(A, rsV, elA, ch, B, PD + i * 128 + 96 + 8 * es, acc);
            float r1[16], r2[8];
#pragma unroll
            for (int c = 0; c < 16; ++c) { const auto pp = __builtin_amdgcn_permlane32_swap(__float_as_uint(acc[c]), __float_as_uint(acc[c + 16]), false, false); r1[c] = __uint_as_float(pp[0]) + __uint_as_float(pp[1]); }
#pragma unroll
            for (int c = 0; c < 8; ++c) { const auto pp = __builtin_amdgcn_permlane16_swap(__float_as_uint(r1[c]), __float_as_uint(r1[c + 8]), false, false); r2[c] = __uint_as_float(pp[0]) + __uint_as_float(pp[1]); }
            float ss = 0.f;
            {
                bf16* op = OB + tok * DM + 512 * s + 128 * es + 4 * ch;
#pragma unroll
                for (int j = 0; j < 2; ++j) {
                    const f32x4 o0 = {r2[4 * j] + bflo(hw[j].x), r2[4 * j + 1] + bfhi(hw[j].x), r2[4 * j + 2] + bflo(hw[j].y), r2[4 * j + 3] + bfhi(hw[j].y)};
                    ss += (o0[0] * o0[0] + o0[1] * o0[1]) + (o0[2] * o0[2] + o0[3] * o0[3]);
                    *(u32x2*)(op + 64 * j) = (u32x2){pk2(o0[0], o0[1]), pk2(o0[2], o0[3])}; }
            }
            ss = wave_sum(ss);
            if (l == 0) SS[i] += ss;
        }
    }
    asm volatile("s_waitcnt vmcnt(0) lgkmcnt(0)" ::: "memory");
    {
        f32x4 ga[8]; u32x2 cur[8];
#pragma unroll
        for (int j = 0; j < 8; ++j) { ga[j] = ((const f32x4*)gfin)[l + 64 * j]; cur[j] = ((const u32x2*)(OB + (size_t)tok0 * DM))[l + 64 * j]; }
#pragma unroll 1
        for (int i = 0; i < 16; ++i) {
            const size_t tok = (size_t)(tok0 + i * stride), ntok = (size_t)(tok0 + (i < 15 ? i + 1 : i) * stride);
            u32x2 nxt[8];
#pragma unroll
            for (int j = 0; j < 8; ++j) nxt[j] = ((const u32x2*)(OB + ntok * DM))[l + 64 * j];
            const float r = rsqrtf(SS[i] * (1.f / DM) + NORM_EPS);
            f32x4* op = (f32x4*)(out + tok * DM);
#pragma unroll
            for (int j = 0; j < 8; ++j) { const u32x2 o = cur[j]; op[l + 64 * j] = (f32x4){bflo(o.x) * r * ga[j].x, bfhi(o.x) * r * ga[j].y, bflo(o.y) * r * ga[j].z, bfhi(o.y) * r * ga[j].w}; }
#pragma unroll
            for (int j = 0; j < 8; ++j) cur[j] = nxt[j];
        }
    }
}

struct Params { const float* in[28]; float* out; unsigned char* ws; int ph_lo, ph_hi; };
constexpr int N_PHASES = 13;
#ifndef STOP_AFTER
#define STOP_AFTER 12
#endif

__global__ void __launch_bounds__(NTHREADS, 2) mega(Params prm) {
    extern __shared__ __attribute__((aligned(16))) unsigned char lds_raw[];
    LAS unsigned char* lds = (LAS unsigned char*)lds_raw;
    const int G = gridDim.x;
    Ptrs P;
#pragma unroll
    for (int i = 0; i < 28; ++i) P.in[i] = prm.in[i];
    P.out = prm.out; P.ws = prm.ws;
    unsigned char* ws = prm.ws;
    const int lo = prm.ph_lo, hi = prm.ph_hi;
#ifndef PHMASK
#define PHMASK 0x1fff
#endif
#define IN(k) (((PHMASK >> (k)) & 1) && lo <= (k) && (k) < hi)
#if ONE_LAUNCH
    volatile LAS unsigned* bst = (volatile LAS unsigned*)(lds + LDS_BYTES - 64);
    if (threadIdx.x == 0) { bst[0] = 0u; bst[1] = 0u; }
    __syncthreads();
    const XcdBarrier bar = xcd_barrier_post((unsigned*)(ws + WS_CTL), bst);
#define SEAM(k) do { if (IN(k) && IN((k) + 1)) xcd_barrier(bar); } while (0)
#ifndef PEER_SYNC
#define PEER_SYNC 0
#endif
#define PEER_BAR (PEER_SYNC ? &bar : (const XcdBarrier*)nullptr)
#else
#define SEAM(k) do { } while (0)
#define PEER_BAR ((const XcdBarrier*)nullptr)
#endif
    bf16* HN = (bf16*)(ws + WS_HN);
    if (IN(0)) { phase_prologue(P, lds, G); }
    SEAM(0);
    if (IN(1)) {
        __syncthreads();
        { pg8::Gemm g{HN, (const bf16*)(ws + WS_W_IN_T), NTOK, 2560, 2048}; pg8::StaticOrder S; S.init(NTOK, 2560, G, (int)blockIdx.x);
          pg8::EpiInProj E{(bf16*)(ws + WS_U), (bf16*)(ws + WS_Q), (bf16*)(ws + WS_K), (bf16*)(ws + WS_V)};
          pg8::gemm_phase<pg8::EpiInProj, pg8::StaticOrder, PG8_ALIGN, PG8_SP2>(lds, g, S, E); }
        __syncthreads();
        { pg8::Gemm g{(const bf16*)(ws + WS_MEM_N), (const bf16*)(ws + WS_W_CKV_T), 2048, 1024, 2048}; pg8::StaticOrder S; S.init(2048, 1024, G, (int)blockIdx.x);
          pg8::EpiBf16Plain E{(bf16*)(ws + WS_KV_C), 1024};
          pg8::gemm_phase<pg8::EpiBf16Plain, pg8::StaticOrder, PG8_ALIGN, PG8_SP2>(lds, g, S, E); }
        __syncthreads();
        {
            const int wv = __builtin_amdgcn_readfirstlane(threadIdx.x >> 6), ln = threadIdx.x & 63;
            constexpr int R1 = 32768;
            if (blockIdx.x >= 32) peer_quant_rows(P, lds, wv, ln, ((int)blockIdx.x - 32) * NWAVES + wv, (G - 32) * NWAVES, R1);
            else peer_quant_rows(P, lds, wv, ln, R1 + (int)blockIdx.x * NWAVES + wv, 32 * NWAVES, 32768);
        }
    }
    SEAM(1);
    if (IN(2)) {
#ifndef NO_S5
        __syncthreads(); phase_s5(P, lds, G);
#endif
#ifndef NO_SWA
        __syncthreads(); phase_swa(P, lds, G);
#endif
    }
    SEAM(2);
    if (IN(3)) {
        __syncthreads();
        pg8::Gemm g{(const bf16*)(ws + WS_YPRE), (const bf16*)(ws + WS_W_GLU_T), NTOK, 1024, 1024}; pg8::StaticOrder S; S.init(NTOK, 1024, G, (int)blockIdx.x);
        pg8::EpiGlu E{(bf16*)(ws + WS_YMIX), 2048, (const bf16*)(ws + WS_YPRE), 1024, P.in[14]};
        pg8::gemm_phase<pg8::EpiGlu, pg8::StaticOrder, PG8_ALIGN, PG8_SP2>(lds, g, S, E);
    }
    SEAM(3);
    if (IN(4)) {
        __syncthreads();
        pg8::Gemm g{(const bf16*)(ws + WS_YMIX), (const bf16*)(ws + WS_W_OUT_T), NTOK, 2048, 2048}; pg8::StaticOrder S; S.init(NTOK, 2048, G, (int)blockIdx.x);
        pg8::EpiResBf16<false> E{HN, P.in[0], (float*)(ws + WS_PS)};
        pg8::gemm_phase<pg8::EpiResBf16<false>, pg8::StaticOrder, PG8_ALIGN, PG8_SP2>(lds, g, S, E);
    }
    SEAM(4);
    if (IN(6)) {
        __syncthreads();
        pg8::Gemm g{HN, (const bf16*)(ws + WS_W_CQ_T), NTOK, 512, 2048}; pg8::StaticOrder S; S.init(NTOK, 512, G, (int)blockIdx.x);
        pg8::EpiBf16RowScale E{(bf16*)(ws + WS_QC), 512, (const float*)(ws + WS_PS)};
        pg8::gemm_phase<pg8::EpiBf16RowScale, pg8::StaticOrder, PG8_ALIGN, PG8_SP2>(lds, g, S, E);
    }
    SEAM(6);
    if (IN(7)) { __syncthreads(); phase_cross(P, lds, G); }
    SEAM(7);
    if (IN(8)) {
        __syncthreads();
        pg8::Gemm g{(const bf16*)(ws + WS_OC), (const bf16*)(ws + WS_W_CO_T), NTOK, 2048, 512}; pg8::StaticOrder S; S.init(NTOK, 2048, G, (int)blockIdx.x);
        pg8::EpiResBf16<true> E{HN, HN, (float*)(ws + WS_PS)};
        pg8::gemm_phase<pg8::EpiResBf16<true>, pg8::StaticOrder, PG8_ALIGN, PG8_SP2>(lds, g, S, E);
    }
    SEAM(8);
    if (IN(10)) {
        __syncthreads();
        pg8::Gemm g{HN, (const bf16*)(ws + WS_W_S_T), NTOK, 2048, 2048}; pg8::StaticOrder S; S.init(NTOK, 2048, G, (int)blockIdx.x);
        EpiTopk E{(const float*)(ws + WS_PS), (int*)(ws + WS_TK_IDX), (float*)(ws + WS_TK_G)};
        for (int i = 0; ; ++i) { pg8::Unit uu; if (!S.next(i, uu)) break; pg8::OneUnit O1{uu}; pg8::gemm_phase<EpiTopk, pg8::OneUnit, false, false>(lds, g, O1, E); }
    }
    SEAM(11);
    if (IN(12)) { __syncthreads(); phase_peer(P, lds, G, PEER_BAR); }
    if (lo <= 13 && 13 < hi) {
        const int lane = threadIdx.x & 63, wave = threadIdx.x >> 6;
        for (int m = blockIdx.x * NWAVES + wave; m < NTOK; m += G * NWAVES) {
            f32x4* xr = (f32x4*)(P.out + (size_t)m * DM) + lane; const f32x4* gr = (const f32x4*)P.in[27] + lane;
            f32x4 v[8]; float ss = 0.f;
#pragma unroll
            for (int j = 0; j < 8; ++j) { v[j] = xr[64 * j]; ss += (v[j].x * v[j].x + v[j].y * v[j].y) + (v[j].z * v[j].z + v[j].w * v[j].w); }
            const float r = rsqrtf(wave_sum(ss) * (1.f / DM) + NORM_EPS);
#pragma unroll
            for (int j = 0; j < 8; ++j) { const f32x4 g = gr[64 * j]; xr[64 * j] = (f32x4){v[j].x * r * g.x, v[j].y * r * g.y, v[j].z * r * g.z, v[j].w * r * g.w}; }
        }
    }
}

extern "C" void kernel_launch(void* const* d_in, const int* in_sizes, int n_in, void* d_out, int out_size, void* d_ws, size_t ws_size, hipStream_t stream) {
    static int grid = 0;
    if (!grid) {
        int dev = 0, cus = 0, per_cu = 0;
        if (hipGetDevice(&dev) != hipSuccess || hipDeviceGetAttribute(&cus, hipDeviceAttributeMultiprocessorCount, dev) != hipSuccess) { fprintf(stderr, "kernel_launch: device query failed\n"); return; }
        if (hipFuncSetAttribute((const void*)mega, hipFuncAttributeMaxDynamicSharedMemorySize, LDS_BYTES) != hipSuccess) { fprintf(stderr, "kernel_launch: hipFuncSetAttribute failed\n"); return; }
        if (hipOccupancyMaxActiveBlocksPerMultiprocessor(&per_cu, (const void*)mega, NTHREADS, LDS_BYTES) != hipSuccess || per_cu < 1) { fprintf(stderr, "kernel_launch: occupancy query says %d\n", per_cu); per_cu = 1; }
        grid = 256;
        if (cus != 256) fprintf(stderr, "kernel_launch: built for 256 CUs, device reports %d\n", cus);
        if (ws_size < WS_END || n_in != 28) fprintf(stderr, "kernel_launch: unexpected ws_size %zu / n_in %d\n", ws_size, n_in);
    }
    Params p{};
    for (int i = 0; i < 28; ++i) p.in[i] = (const float*)d_in[i];
    p.out = (float*)d_out; p.ws = (unsigned char*)d_ws;
#if ONE_LAUNCH
    p.ph_lo = 0; p.ph_hi = N_PHASES;
    if (hipMemsetAsync((char*)d_ws + WS_CTL, 0, CTL_ZERO_BYTES, stream) != hipSuccess) { fprintf(stderr, "kernel_launch: memset of the barrier words failed\n"); return; }
    hipLaunchKernelGGL(mega, dim3(grid), dim3(NTHREADS), LDS_BYTES, stream, p);
#else
#ifndef REPEAT_MASK
#define REPEAT_MASK 0
#endif
    for (int ph = 0; ph <= STOP_AFTER; ++ph) { p.ph_lo = ph; p.ph_hi = ph + 1;
        for (int rep = 0; rep < (((REPEAT_MASK >> ph) & 1) ? 2 : 1); ++rep) hipLaunchKernelGGL(mega, dim3(grid), dim3(NTHREADS), LDS_BYTES, stream, p); }
    if (STOP_AFTER < 12) { p.ph_lo = 13; p.ph_hi = 14; hipLaunchKernelGGL(mega, dim3(grid), dim3(NTHREADS), LDS_BYTES, stream, p); }
#endif
}
```

```cpp
#include <hip/hip_runtime.h>
#include <cstdio>
#include <cstdint>
#ifndef ONE_LAUNCH
#define ONE_LAUNCH 1
#endif
#define SN_HD __host__ __device__ __forceinline__
#ifndef SN_HD
#define SN_HD __host__ __device__ __forceinline__
#endif
typedef unsigned int u32;
SN_HD u32 sn_max(u32 a, u32 b) { return a > b ? a : b; }
SN_HD u32 sn_min(u32 a, u32 b) { return a < b ? a : b; }
SN_HD u32 f2key(float f) { u32 u = __builtin_bit_cast(u32, f); return (u & 0x80000000u) ? ~u : (u | 0x80000000u); }
SN_HD float key2f(u32 k) { u32 u = (k & 0x80000000u) ? (k & 0x7fffffffu) : ~k; return __builtin_bit_cast(float, u); }
template <int BASE> SN_HD void bitonic_merge16_desc(u32 (&v)[64]) {
#pragma unroll
    for (int j = 8; j > 0; j >>= 1) {
#pragma unroll
        for (int i = 0; i < 16; ++i) { const int l = i ^ j; if (l > i) { const u32 a = v[BASE + i], b = v[BASE + l]; v[BASE + i] = sn_max(a, b); v[BASE + l] = sn_min(a, b); } }
    }
}
template <int BASE> SN_HD void bitonic_sort16_desc(u32 (&v)[64]) {
#pragma unroll
    for (int k = 2; k <= 16; k <<= 1) {
#pragma unroll
        for (int j = k >> 1; j > 0; j >>= 1) {
#pragma unroll
            for (int i = 0; i < 16; ++i) { const int l = i ^ j; if (l > i) { const u32 a = v[BASE + i], b = v[BASE + l]; const bool desc = ((i & k) == 0);
                v[BASE + i] = desc ? sn_max(a, b) : sn_min(a, b); v[BASE + l] = desc ? sn_min(a, b) : sn_max(a, b); } }
        }
    }
}
template <int A, int B> SN_HD void merge_top16(u32 (&v)[64]) {
#pragma unroll
    for (int i = 0; i < 16; ++i) v[A + i] = sn_max(v[A + i], v[B + 15 - i]);
    bitonic_merge16_desc<A>(v);
}
SN_HD void top16_of_64(u32 (&v)[64]) {
    bitonic_sort16_desc<0>(v); bitonic_sort16_desc<16>(v); bitonic_sort16_desc<32>(v); bitonic_sort16_desc<48>(v);
    merge_top16<0, 16>(v); merge_top16<32, 48>(v); merge_top16<0, 32>(v);
}

SN_HD void merge_sorted16_desc(u32 (&a)[16]) {
#pragma unroll
    for (int j = 8; j > 0; j >>= 1) {
#pragma unroll
        for (int i = 0; i < 16; ++i) { const int l = i ^ j; if (l > i) { const u32 x = a[i], y = a[l]; a[i] = sn_max(x, y); a[l] = sn_min(x, y); } }
    }
}
SN_HD void sort16_desc(u32 (&a)[16]) {
#pragma unroll
    for (int k = 2; k <= 16; k <<= 1) {
#pragma unroll
        for (int j = k >> 1; j > 0; j >>= 1) {
#pragma unroll
            for (int i = 0; i < 16; ++i) { const int l = i ^ j; if (l > i) { const u32 x = a[i], y = a[l]; const bool desc = ((i & k) == 0);
                a[i] = desc ? sn_max(x, y) : sn_min(x, y); a[l] = desc ? sn_min(x, y) : sn_max(x, y); } }
        }
    }
}
SN_HD void merge_top16_desc(u32 (&a)[16], const u32 (&b)[16]) {
#pragma unroll
    for (int i = 0; i < 16; ++i) a[i] = sn_max(a[i], b[15 - i]);
    merge_sorted16_desc(a);
}
SN_HD void insert_top16_desc(u32 (&a)[16], u32 x) {
#pragma unroll
    for (int k = 15; k > 0; --k) a[k] = sn_max(a[k], sn_min(a[k - 1], x));
    a[0] = sn_max(a[0], x);
}
namespace pg8 {
#define PG8_LAS __attribute__((address_space(3)))
typedef unsigned short bf16_t;
typedef short bf16x8 __attribute__((ext_vector_type(8)));
typedef float f32x4 __attribute__((ext_vector_type(4)));
typedef unsigned u32x4 __attribute__((ext_vector_type(4)));
constexpr int BM = 256, BK = 64, HALF = 128, HTB = HALF * BK * 2  , STAGE_BYTES = 8 * HTB, NXCD = 8, WGM = 4;

__host__ __device__ __forceinline__ int lds_byte(int r, int c) { const int st = (r >> 4) * 2 + (c >> 5), rr = r & 15, cc = c & 31, ob = rr * 64 + cc * 2; return st * 1024 + (ob ^ (((ob >> 9) & 1) << 5)); }
__host__ __device__ __forceinline__ void stage_rc(int b, int& R, int& C) { const int st = b / 1024, sb = b % 1024, swz = sb ^ (((sb >> 9) & 1) << 5); R = (st >> 1) * 16 + swz / 64; C = (st & 1) * 32 + (swz % 64) / 2; }
__host__ __device__ __forceinline__ int perm32(int rho) { const int n = rho >> 4, i = rho & 15; return 8 * (i >> 2) + 4 * n + (i & 3); }

struct Unit { int pm, pn; };
struct Gemm { const bf16_t* A; const bf16_t* Bt; int M, N, K; };

struct StaticOrder {
    int nM, nN, nwg, G, c;
    __host__ __device__ void init(int M, int N, int G_, int c_) { nM = M / BM; nN = N / BM; nwg = nM * nN; G = G_; c = c_; }
    __host__ __device__ bool next(int i, Unit& u) const {
        const long L = (long)i * G + c; if (L >= nwg) return false;
        int wgid = (int)L; { const int q = nwg / NXCD, r = nwg % NXCD, xcd = wgid % NXCD, off = wgid / NXCD; wgid = (xcd < r ? xcd * (q + 1) : r * (q + 1) + (xcd - r) * q) + off; }
        const int nig = WGM * nN, gid = wgid / nig, fm = gid * WGM, gsz = (nM - fm) < WGM ? (nM - fm) : WGM;
        u.pm = fm + ((wgid % nig) % gsz); u.pn = (wgid % nig) / gsz; return true;
    }
    __device__ __forceinline__ void a_ready(const Unit&) const {}
    __device__ __forceinline__ void done(const Unit&) const {}
};

typedef float f32x2_t __attribute__((ext_vector_type(2)));
typedef __bf16 bf16x2_t __attribute__((ext_vector_type(2)));
struct OneUnit { Unit u;
    __device__ __forceinline__ bool next(int i, Unit& o) const { if (i) return false; o = u; return true; }
    __device__ __forceinline__ void a_ready(const Unit&) const {}
    __device__ __forceinline__ void done(const Unit&) const {} };

__device__ __forceinline__ unsigned cvt_pk_bf16(float lo, float hi) { const f32x2_t f = {lo, hi}; const bf16x2_t b = __builtin_convertvector(f, bf16x2_t); return __builtin_bit_cast(unsigned, b); }


template <class Epi, class Sched, bool ALIGN_EPI = false, bool SP2 = false>
__device__ __forceinline__ void gemm_phase(PG8_LAS unsigned char* lds, const Gemm g, const Sched& S, const Epi& E) {
    const int tid = threadIdx.x, wid = __builtin_amdgcn_readfirstlane(tid >> 6), lane = tid & 63, wr = wid >> 2, wc = wid & 3, fr = lane & 15, fq = lane >> 4;
    const int K = g.K, nt = K / BK;
    unsigned voffA[2], voffB[2];
#pragma unroll
    for (int i = 0; i < 2; ++i) { int R, C; stage_rc(tid * 16 + i * 8192, R, C); const int Rb = Epi::PERM ? ((R & ~31) + perm32(R & 31)) : R;
        voffA[i] = (unsigned)(R * K + C) * 2u; voffB[i] = (unsigned)(Rb * K + C) * 2u; }
    const size_t kstep = (size_t)(BK * 2);
    const size_t hstep = (size_t)HALF * K * 2;
    const size_t tstep = 2 * hstep;
    const unsigned ldsw = (unsigned)wid * 1024u;
    const int aoff = lds_byte(wr * 64 + fr, fq * 8), boff = lds_byte(wc * 32 + fr, fq * 8);
#define PG8_SA(b, h) (((b) * 2 + (h)) * HTB)
#define PG8_SB(b, h) ((4 + (b) * 2 + (h)) * HTB)
#define PG8_STAGE(bufoff, gbase, voff) do { _Pragma("unroll") for (int _i = 0; _i < 2; ++_i) \
        __builtin_amdgcn_global_load_lds((const unsigned*)((const char*)(gbase) + (voff)[_i]), (PG8_LAS unsigned*)(lds + (bufoff) + ldsw + _i * 8192), 16, 0, 0); } while (0)
#define PG8_LDA(dst, b, h) do { _Pragma("unroll") for (int m = 0; m < 4; ++m) _Pragma("unroll") for (int k = 0; k < 2; ++k) dst[m][k] = *(const PG8_LAS bf16x8*)(lds + PG8_SA(b, h) + aoff + m * 2048 + k * 1024); } while (0)
#define PG8_LDB(dst, b, h) do { _Pragma("unroll") for (int n = 0; n < 2; ++n) _Pragma("unroll") for (int k = 0; k < 2; ++k) dst[n][k] = *(const PG8_LAS bf16x8*)(lds + PG8_SB(b, h) + boff + n * 2048 + k * 1024); } while (0)
#define PG8_MMA(ai, bj, At, Bt) do { __builtin_amdgcn_s_setprio(1); _Pragma("unroll") for (int m = 0; m < 4; ++m) _Pragma("unroll") for (int n = 0; n < 2; ++n) _Pragma("unroll") for (int k = 0; k < 2; ++k) \
        acc[ai][bj][m][n] = __builtin_amdgcn_mfma_f32_16x16x32_bf16(Bt[n][k], At[m][k], acc[ai][bj][m][n], 0, 0, 0); __builtin_amdgcn_s_setprio(0); } while (0)
#define PG8_WAIT_V(n) asm volatile("s_waitcnt vmcnt(" #n ")" ::: "memory")
#define PG8_WAIT_L(n) asm volatile("s_waitcnt lgkmcnt(" #n ")" ::: "memory")
#define PG8_BAR __builtin_amdgcn_s_barrier()
#define PG8_SCHED __builtin_amdgcn_sched_barrier(0)
    Unit cur, nxt; int ui = 0;
    if (!S.next(0, cur)) return;
    f32x4 acc[2][2][4][2];
#pragma unroll
    for (int a = 0; a < 2; ++a)
#pragma unroll
        for (int b = 0; b < 2; ++b)
#pragma unroll
            for (int m = 0; m < 4; ++m)
#pragma unroll
                for (int n = 0; n < 2; ++n) acc[a][b][m][n] = (f32x4){0.f, 0.f, 0.f, 0.f};
    bf16x8 At[4][2], B0[2][2], B1[2][2];
    const char* cA = (const char*)g.A + (size_t)cur.pm * tstep; const char* cB = (const char*)g.Bt + (size_t)cur.pn * tstep;
    S.a_ready(cur);
    if constexpr (SP2) {
        PG8_STAGE(PG8_SB(0, 0), cB, voffB); PG8_STAGE(PG8_SB(0, 1), cB + hstep, voffB); PG8_STAGE(PG8_SA(0, 0), cA, voffA); PG8_STAGE(PG8_SA(0, 1), cA + hstep, voffA);
        if (wr == 1) PG8_BAR;
        PG8_WAIT_V(2); PG8_BAR;
        PG8_STAGE(PG8_SB(1, 0), cB + kstep, voffB); PG8_STAGE(PG8_SA(1, 0), cA + kstep, voffA); PG8_STAGE(PG8_SB(1, 1), cB + hstep + kstep, voffB);
        PG8_WAIT_V(6); PG8_BAR;
    } else {
        PG8_STAGE(PG8_SB(0, 0), cB, voffB); PG8_STAGE(PG8_SA(0, 0), cA, voffA); PG8_STAGE(PG8_SB(0, 1), cB + hstep, voffB); PG8_STAGE(PG8_SA(0, 1), cA + hstep, voffA);
        if (wr == 1) PG8_BAR;
        PG8_WAIT_V(4); PG8_BAR;
        PG8_STAGE(PG8_SB(1, 0), cB + kstep, voffB); PG8_STAGE(PG8_SA(1, 0), cA + kstep, voffA); PG8_STAGE(PG8_SB(1, 1), cB + hstep + kstep, voffB);
        PG8_WAIT_V(6); PG8_BAR;
    }
    for (;;) {
        const bool has_next = S.next(ui + 1, nxt);
        const char* nA = has_next ? (const char*)g.A + (size_t)nxt.pm * tstep : cA; const char* nB = has_next ? (const char*)g.Bt + (size_t)nxt.pn * tstep : cB;
        for (int t = 0; t < nt; t += 2) {
            const bool last = (t == nt - 2);
            const char* a1 = cA + (size_t)(t + 1) * kstep;
            const char* a2 = last ? nA : cA + (size_t)(t + 2) * kstep; const char* b2 = last ? nB : cB + (size_t)(t + 2) * kstep;
            const char* a3 = a2 + kstep; const char* b3 = b2 + kstep;
            if (last && has_next) S.a_ready(nxt);
            if constexpr (SP2) {
            PG8_LDB(B0, 0, 0); PG8_LDB(B1, 0, 1); PG8_SCHED; PG8_LDA(At, 0, 0); PG8_STAGE(PG8_SA(1, 1), a1 + hstep, voffA);
            PG8_WAIT_V(8); PG8_WAIT_L(0); PG8_BAR; PG8_MMA(0, 0, At, B0); PG8_MMA(0, 1, At, B1); PG8_BAR; PG8_SCHED;
            PG8_LDA(At, 0, 1); PG8_STAGE(PG8_SB(0, 0), b2, voffB); PG8_STAGE(PG8_SB(0, 1), b2 + hstep, voffB); PG8_STAGE(PG8_SA(0, 0), a2, voffA);
            PG8_WAIT_V(8); PG8_WAIT_L(0); PG8_BAR; PG8_MMA(1, 0, At, B0); PG8_MMA(1, 1, At, B1); PG8_BAR; PG8_SCHED;
            PG8_LDB(B0, 1, 0); PG8_LDB(B1, 1, 1); PG8_SCHED; PG8_LDA(At, 1, 0); PG8_STAGE(PG8_SA(0, 1), a2 + hstep, voffA);
            PG8_WAIT_V(8); PG8_WAIT_L(0); PG8_BAR; PG8_MMA(0, 0, At, B0); PG8_MMA(0, 1, At, B1); PG8_BAR; PG8_SCHED;
            PG8_LDA(At, 1, 1); PG8_STAGE(PG8_SB(1, 0), b3, voffB); PG8_STAGE(PG8_SB(1, 1), b3 + hstep, voffB); PG8_STAGE(PG8_SA(1, 0), a3, voffA);
            PG8_WAIT_V(8); PG8_WAIT_L(0); PG8_BAR; PG8_MMA(1, 0, At, B0); PG8_MMA(1, 1, At, B1); PG8_BAR; PG8_SCHED;
            } else {
            PG8_LDB(B0, 0, 0); PG8_SCHED; PG8_LDA(At, 0, 0); PG8_STAGE(PG8_SA(1, 1), a1 + hstep, voffA);
            PG8_WAIT_L(8); PG8_BAR; PG8_WAIT_L(0); PG8_MMA(0, 0, At, B0); PG8_BAR; PG8_SCHED;
            PG8_LDB(B1, 0, 1); PG8_STAGE(PG8_SB(0, 0), b2, voffB);
            PG8_BAR; PG8_WAIT_L(0); PG8_MMA(0, 1, At, B1); PG8_BAR;
            PG8_LDA(At, 0, 1); PG8_STAGE(PG8_SA(0, 0), a2, voffA);
            PG8_BAR; PG8_WAIT_L(0); PG8_MMA(1, 0, At, B0); PG8_BAR; PG8_SCHED;
            PG8_STAGE(PG8_SB(0, 1), b2 + hstep, voffB);
            PG8_WAIT_V(6); PG8_BAR; PG8_MMA(1, 1, At, B1); PG8_BAR;
            PG8_LDB(B0, 1, 0); PG8_SCHED; PG8_LDA(At, 1, 0); PG8_STAGE(PG8_SA(0, 1), a2 + hstep, voffA);
            PG8_WAIT_L(8); PG8_BAR; PG8_WAIT_L(0); PG8_MMA(0, 0, At, B0); PG8_BAR; PG8_SCHED;
            PG8_LDB(B1, 1, 1); PG8_STAGE(PG8_SB(1, 0), b3, voffB);
            PG8_BAR; PG8_WAIT_L(0); PG8_MMA(0, 1, At, B1); PG8_BAR;
            PG8_LDA(At, 1, 1); PG8_STAGE(PG8_SA(1, 0), a3, voffA);
            PG8_BAR; PG8_WAIT_L(0); PG8_MMA(1, 0, At, B0); PG8_BAR; PG8_SCHED;
            PG8_STAGE(PG8_SB(1, 1), b3 + hstep, voffB);
            PG8_WAIT_V(6); PG8_BAR; PG8_MMA(1, 1, At, B1); PG8_BAR;
            }
        }
        if constexpr (ALIGN_EPI) { if (wr == 0) PG8_BAR; }
        if constexpr (!Epi::AFTER_DRAIN) { E(acc, cur, wr, wc, fr, fq); S.done(cur); }
        if (!has_next) break;
#pragma unroll
        for (int a = 0; a < 2; ++a)
#pragma unroll
            for (int b = 0; b < 2; ++b)
#pragma unroll
                for (int m = 0; m < 4; ++m)
#pragma unroll
                    for (int n = 0; n < 2; ++n) acc[a][b][m][n] = (f32x4){0.f, 0.f, 0.f, 0.f};
        cur = nxt; cA = nA; cB = nB; ++ui;
        if constexpr (ALIGN_EPI) { if (wr == 1) PG8_BAR; }
    }
    PG8_WAIT_V(0);
    if constexpr (!ALIGN_EPI) { if (wr == 0) PG8_BAR; }
    PG8_BAR;
    if constexpr (Epi::AFTER_DRAIN) { E.fused(acc, cur, wr, wc, fr, fq, lds, wid, lane); S.done(cur); }
#undef PG8_SA
#undef PG8_SB
#undef PG8_STAGE
#undef PG8_LDA
#undef PG8_LDB
#undef PG8_MMA
#undef PG8_WAIT_V
#undef PG8_WAIT_L
#undef PG8_BAR
#undef PG8_SCHED
}

struct EpiInProj {
    static constexpr bool PERM = true, AFTER_DRAIN = false;
    bf16_t *U, *Q, *Kb, *Vb;
    __device__ __forceinline__ void operator()(const f32x4 (&acc)[2][2][4][2], const Unit& u, int wr, int wc, int fr, int fq) const {
        const int row0 = u.pm * BM + wr * 64 + fr;
        if (u.pn < 4) {
            const int col0 = u.pn * BM + wc * 32 + 8 * fq;
#pragma unroll
            for (int ai = 0; ai < 2; ++ai)
#pragma unroll
                for (int m = 0; m < 4; ++m) { const int row = row0 + ai * HALF + m * 16, b = row >> 12, t = row & 4095;
#pragma unroll
                    for (int bj = 0; bj < 2; ++bj) { const int col = col0 + bj * HALF; const f32x4 v0 = acc[ai][bj][m][0], v1 = acc[ai][bj][m][1];
                        u32x4 w; w.x = cvt_pk_bf16(v0[0], v0[1]); w.y = cvt_pk_bf16(v0[2], v0[3]); w.z = cvt_pk_bf16(v1[0], v1[1]); w.w = cvt_pk_bf16(v1[2], v1[3]);
                        *(u32x4*)(U + (((size_t)(b * 64 + (col >> 4)) * 4096 + t) * 16 + (col & 8))) = w; } }
            return;
        }
        bf16_t* base; int ldc, colt;
        if (u.pn < 8) { base = Q; ldc = 1024; colt = (u.pn - 4) * BM; } else if (u.pn == 8) { base = Kb; ldc = 256; colt = 0; } else { base = Vb; ldc = 256; colt = 0; }
        const int col0 = colt + wc * 32 + 8 * fq;
#pragma unroll
        for (int ai = 0; ai < 2; ++ai)
#pragma unroll
            for (int m = 0; m < 4; ++m) { bf16_t* rowp = base + (size_t)(row0 + ai * HALF + m * 16) * ldc + col0;
#pragma unroll
                for (int bj = 0; bj < 2; ++bj) { const f32x4 v0 = acc[ai][bj][m][0], v1 = acc[ai][bj][m][1];
                    u32x4 w; w.x = cvt_pk_bf16(v0[0], v0[1]); w.y = cvt_pk_bf16(v0[2], v0[3]); w.z = cvt_pk_bf16(v1[0], v1[1]); w.w = cvt_pk_bf16(v1[2], v1[3]);
                    *(u32x4*)(rowp + bj * HALF) = w; } }
    }
};
struct EpiBf16Plain {
    static constexpr bool PERM = true, AFTER_DRAIN = false;
    bf16_t* O; int ldc;
    __device__ __forceinline__ void operator()(const f32x4 (&acc)[2][2][4][2], const Unit& u, int wr, int wc, int fr, int fq) const {
        const int row0 = u.pm * BM + wr * 64 + fr, col0 = u.pn * BM + wc * 32 + 8 * fq;
#pragma unroll
        for (int ai = 0; ai < 2; ++ai)
#pragma unroll
            for (int m = 0; m < 4; ++m) { bf16_t* rowp = O + (size_t)(row0 + ai * HALF + m * 16) * ldc + col0;
#pragma unroll
                for (int bj = 0; bj < 2; ++bj) { const f32x4 v0 = acc[ai][bj][m][0], v1 = acc[ai][bj][m][1];
                    u32x4 w; w.x = cvt_pk_bf16(v0[0], v0[1]); w.y = cvt_pk_bf16(v0[2], v0[3]); w.z = cvt_pk_bf16(v1[0], v1[1]); w.w = cvt_pk_bf16(v1[2], v1[3]);
                    *(u32x4*)(rowp + bj * HALF) = w; } }
    }
};
struct EpiGlu {
    static constexpr bool PERM = true, AFTER_DRAIN = false;
    bf16_t* O; int ldo; const bf16_t* Y; int ldy; const float* bias;
    __device__ __forceinline__ void operator()(const f32x4 (&acc)[2][2][4][2], const Unit& u, int wr, int wc, int fr, int fq) const {
        const int row0 = u.pm * BM + wr * 64 + fr, col0 = u.pn * BM + wc * 32 + 8 * fq;
        f32x4 bv[2][2];
#pragma unroll
        for (int bj = 0; bj < 2; ++bj)
#pragma unroll
            for (int n = 0; n < 2; ++n) bv[bj][n] = *(const f32x4*)(bias + col0 + bj * HALF + 4 * n);
#pragma unroll
        for (int ai = 0; ai < 2; ++ai)
#pragma unroll
            for (int m = 0; m < 4; ++m) { const size_t row = (size_t)(row0 + ai * HALF + m * 16);
#pragma unroll
                for (int bj = 0; bj < 2; ++bj) {
                    const u32x4 yw = *(const u32x4*)(Y + row * ldy + col0 + bj * HALF);
                    float o[8];
#pragma unroll
                    for (int e = 0; e < 8; ++e) { const float a = acc[ai][bj][m][e >> 2][e & 3] + bv[bj][e >> 2][e & 3];
                        const unsigned yy = yw[e >> 1]; const float y = __uint_as_float((e & 1) ? (yy & 0xffff0000u) : (yy << 16));
                        o[e] = y / (1.0f + __expf(-a)); }
                    u32x4 w; w.x = cvt_pk_bf16(o[0], o[1]); w.y = cvt_pk_bf16(o[2], o[3]); w.z = cvt_pk_bf16(o[4], o[5]); w.w = cvt_pk_bf16(o[6], o[7]);
                    *(u32x4*)(O + row * ldo + col0 + bj * HALF) = w; } }
    }
};
struct EpiResF32 {
    static constexpr bool PERM = false, AFTER_DRAIN = false;
    float* C; const float* R; int ldc;
    __device__ __forceinline__ void operator()(const f32x4 (&acc)[2][2][4][2], const Unit& u, int wr, int wc, int fr, int fq) const {
        const int row0 = u.pm * BM + wr * 64 + fr, col0 = u.pn * BM + wc * 32 + 4 * fq;
#pragma unroll
        for (int ai = 0; ai < 2; ++ai)
#pragma unroll
            for (int m = 0; m < 4; ++m) { const size_t off = (size_t)(row0 + ai * HALF + m * 16) * ldc + col0;
#pragma unroll
                for (int bj = 0; bj < 2; ++bj)
#pragma unroll
                    for (int n = 0; n < 2; ++n) { f32x4 v = acc[ai][bj][m][n]; if (R) v = v + *(const f32x4*)(R + off + bj * HALF + n * 16); *(f32x4*)(C + off + bj * HALF + n * 16) = v; } }
    }
};
__device__ __forceinline__ float row_rnorm(const float* PS, size_t row) {
    const f32x4* p = (const f32x4*)(PS + row * 32); float s = 0.f;
#pragma unroll
    for (int i = 0; i < 8; ++i) { const f32x4 v = p[i]; s += (v[0] + v[1]) + (v[2] + v[3]); }
    return __builtin_amdgcn_rsqf(s * (1.0f / 2048.0f) + 1e-6f);
}
template <bool RBF16> struct EpiResBf16 {
    static constexpr bool PERM = true, AFTER_DRAIN = false;
    bf16_t* H; const void* R; float* PS;
    __device__ __forceinline__ void operator()(const f32x4 (&acc)[2][2][4][2], const Unit& u, int wr, int wc, int fr, int fq) const {
        const int row0 = u.pm * BM + wr * 64 + fr, col0 = u.pn * BM + wc * 32 + 8 * fq;
#pragma unroll
        for (int ai = 0; ai < 2; ++ai)
#pragma unroll
            for (int m = 0; m < 4; ++m) { const size_t row = (size_t)(row0 + ai * HALF + m * 16), off = row * 2048 + col0; float ss = 0.f;
#pragma unroll
                for (int bj = 0; bj < 2; ++bj) {
                    f32x4 r0, r1;
                    if (RBF16) { const u32x4 rw = *(const u32x4*)((const bf16_t*)R + off + bj * HALF);
                        r0 = (f32x4){__uint_as_float(rw.x << 16), __uint_as_float(rw.x & 0xffff0000u), __uint_as_float(rw.y << 16), __uint_as_float(rw.y & 0xffff0000u)};
                        r1 = (f32x4){__uint_as_float(rw.z << 16), __uint_as_float(rw.z & 0xffff0000u), __uint_as_float(rw.w << 16), __uint_as_float(rw.w & 0xffff0000u)}; }
                    else { r0 = *(const f32x4*)((const float*)R + off + bj * HALF); r1 = *(const f32x4*)((const float*)R + off + bj * HALF + 4); }
                    const f32x4 v0 = acc[ai][bj][m][0] + r0, v1 = acc[ai][bj][m][1] + r1;
                    ss += ((v0[0] * v0[0] + v0[1] * v0[1]) + (v0[2] * v0[2] + v0[3] * v0[3])) + ((v1[0] * v1[0] + v1[1] * v1[1]) + (v1[2] * v1[2] + v1[3] * v1[3]));
                    u32x4 w; w.x = cvt_pk_bf16(v0[0], v0[1]); w.y = cvt_pk_bf16(v0[2], v0[3]); w.z = cvt_pk_bf16(v1[0], v1[1]); w.w = cvt_pk_bf16(v1[2], v1[3]);
                    *(u32x4*)(H + off + bj * HALF) = w; }
                ss += __shfl_xor(ss, 16); ss += __shfl_xor(ss, 32);
                if (fq == 0) PS[row * 32 + u.pn * 4 + wc] = ss; }
    }
};
struct EpiBf16RowScale {
    static constexpr bool PERM = true, AFTER_DRAIN = false;
    bf16_t* O; int ldc; const float* PS;
    __device__ __forceinline__ void operator()(const f32x4 (&acc)[2][2][4][2], const Unit& u, int wr, int wc, int fr, int fq) const {
        const int row0 = u.pm * BM + wr * 64 + fr, col0 = u.pn * BM + wc * 32 + 8 * fq;
#pragma unroll
        for (int ai = 0; ai < 2; ++ai)
#pragma unroll
            for (int m = 0; m < 4; ++m) { const size_t row = (size_t)(row0 + ai * HALF + m * 16); const float r = row_rnorm(PS, row); bf16_t* rowp = O + row * ldc + col0;
#pragma unroll
                for (int bj = 0; bj < 2; ++bj) { const f32x4 v0 = acc[ai][bj][m][0] * r, v1 = acc[ai][bj][m][1] * r;
                    u32x4 w; w.x = cvt_pk_bf16(v0[0], v0[1]); w.y = cvt_pk_bf16(v0[2], v0[3]); w.z = cvt_pk_bf16(v1[0], v1[1]); w.w = cvt_pk_bf16(v1[2], v1[3]);
                    *(u32x4*)(rowp + bj * HALF) = w; } }
    }
};
struct EpiF32RowScale {
    static constexpr bool PERM = true, AFTER_DRAIN = false;
    float* C; int ldc; const float* PS;
    __device__ __forceinline__ void operator()(const f32x4 (&acc)[2][2][4][2], const Unit& u, int wr, int wc, int fr, int fq) const {
        const int row0 = u.pm * BM + wr * 64 + fr, col0 = u.pn * BM + wc * 32 + 8 * fq;
#pragma unroll
        for (int ai = 0; ai < 2; ++ai)
#pragma unroll
            for (int m = 0; m < 4; ++m) { const size_t row = (size_t)(row0 + ai * HALF + m * 16); const float r = row_rnorm(PS, row); const size_t off = row * ldc + col0;
#pragma unroll
                for (int bj = 0; bj < 2; ++bj) { *(f32x4*)(C + off + bj * HALF) = acc[ai][bj][m][0] * r; *(f32x4*)(C + off + bj * HALF + 4) = acc[ai][bj][m][1] * r; } }
    }
};
}

#ifndef PG8_SP2
#define PG8_SP2 false
#endif
#ifndef PG8_ALIGN
#define PG8_ALIGN true
#endif
constexpr int NTOK = 32768, DM = 2048, SEQ = 4096, NB = 8;
constexpr int NWAVES = 8, NTHREADS = 512;
constexpr int LDS_BYTES = 147456;
constexpr float NORM_EPS = 1e-6f;

#define LAS __attribute__((address_space(3)))
typedef unsigned short bf16;
typedef unsigned u32;
typedef short bf16x8 __attribute__((ext_vector_type(8)));
typedef short s16x4 __attribute__((ext_vector_type(4)));
typedef float f32x4 __attribute__((ext_vector_type(4)));
typedef float f32x16 __attribute__((ext_vector_type(16)));
typedef unsigned u32x4 __attribute__((ext_vector_type(4)));
typedef unsigned u32x2 __attribute__((ext_vector_type(2)));

constexpr size_t MiB = 1u << 20;
constexpr size_t WS_CTL = 0, CTL_ZERO_BYTES = 64 * 1024;
constexpr size_t WS_W_IN_T = 1 * MiB, WS_W_GLU_T = 11 * MiB, WS_W_OUT_T = 13 * MiB, WS_W_CQ_T = 21 * MiB, WS_W_CKV_T = 23 * MiB, WS_W_CO_T = 27 * MiB, WS_W_S_T = 29 * MiB;
constexpr size_t WS_S5_WIN = 37 * MiB, WS_S5_WOUT = 41 * MiB, WS_S5_K = 45 * MiB, WS_S5_LAM = 46 * MiB, WS_BIAS_TAB = 46 * MiB + 512 * 1024;
constexpr size_t WS_MEM_N = 47 * MiB, WS_KV_C = 55 * MiB, WS_PS = 59 * MiB;
#ifndef FP6_PACK_INTERLEAVED
#define FP6_PACK_INTERLEAVED 1
#endif
typedef unsigned v6u_t __attribute__((ext_vector_type(6)));
constexpr int PEER_ROW_BYTES = 1536;
constexpr int PEER_SROW = 384;
constexpr size_t PEER_SLICE_BYTES = (size_t)16384 * PEER_SROW;
constexpr size_t WS_PEER_U = 64 * MiB, WS_PEER_V = 96 * MiB;
constexpr size_t WS_PEER_SU = 128 * MiB, WS_PEER_SV = 128 * MiB + 65536;
constexpr size_t WS_HN = 192 * MiB;
constexpr size_t WS_U = 320 * MiB, WS_Q = 384 * MiB, WS_K = 448 * MiB, WS_V = 464 * MiB, WS_YPRE = 480 * MiB, WS_YMIX = 544 * MiB;
constexpr size_t WS_OB = 320 * MiB;
constexpr size_t WS_SCORES = 320 * MiB;
constexpr size_t WS_QC = 672 * MiB, WS_OC = 704 * MiB, WS_TK_IDX = 736 * MiB, WS_TK_G = 752 * MiB, WS_END = 768 * MiB;

__device__ __forceinline__ unsigned f2bf(float f) { unsigned u = __float_as_uint(f); return (u + 0x7fffu + ((u >> 16) & 1u)) >> 16; }
__device__ __forceinline__ unsigned pk2(float lo, float hi) { return pg8::cvt_pk_bf16(lo, hi); }
__device__ __forceinline__ unsigned cvtpk(float lo, float hi) { return pg8::cvt_pk_bf16(lo, hi); }
__device__ __forceinline__ float bflo(unsigned w) { return __uint_as_float(w << 16); }
__device__ __forceinline__ float bfhi(unsigned w) { return __uint_as_float(w & 0xffff0000u); }
__device__ __forceinline__ float wave_sum(float v) {
#pragma unroll
    for (int o = 1; o < 64; o <<= 1) v += __shfl_xor(v, o);
    return v;
}
__device__ __forceinline__ float gelu_tanh(float x) { const float z = 0.7978845608028654f * (x + 0.044715f * x * x * x); return x / (1.0f + __expf(-2.0f * z)); }
#define LDS_WAIT() asm volatile("s_waitcnt lgkmcnt(0)" ::: "memory")
#define MFMA16(a, b, c) __builtin_amdgcn_mfma_f32_16x16x32_bf16((a), (b), (c), 0, 0, 0)
#define MFMA32(a, b, c) __builtin_amdgcn_mfma_f32_32x32x16_bf16((a), (b), (c), 0, 0, 0)

__device__ __forceinline__ void p0_transpose_item(const float* W, int K, int N, bf16* WT, LAS float* scr, int item, int lane, const float* kgain = nullptr) {
    const int nblk = N / 32, kb = item / nblk, nb = item % nblk, k0 = 64 * kb, n0 = 32 * nb;
    f32x4 v[8];
#pragma unroll
    for (int i = 0; i < 8; ++i) v[i] = *(const f32x4*)(W + (size_t)(k0 + 8 * i + (lane >> 3)) * N + n0 + 4 * (lane & 7));
#pragma unroll
    for (int i = 0; i < 8; ++i) { const int kk = 8 * i + (lane >> 3); f32x4 x = v[i]; if (kgain) x = x * kgain[k0 + kk];
#pragma unroll
        for (int c = 0; c < 4; ++c) scr[kk * 33 + 4 * (lane & 7) + c] = x[c]; }
    LDS_WAIT(); asm volatile("" ::: "memory");
    const int c = lane & 7;
#pragma unroll
    for (int j = 0; j < 4; ++j) { const int n = (lane >> 3) + 8 * j; const LAS float* s = scr + (8 * c) * 33 + n;
        u32x4 o; o.x = pk2(s[0 * 33], s[1 * 33]); o.y = pk2(s[2 * 33], s[3 * 33]); o.z = pk2(s[4 * 33], s[5 * 33]); o.w = pk2(s[6 * 33], s[7 * 33]);
        *(u32x4*)(WT + (size_t)(n0 + n) * K + k0 + 8 * c) = o; }
    LDS_WAIT(); asm volatile("" ::: "memory");
}
__device__ __forceinline__ void rms_row_to_bf16(const float* xrow, const float* gain, bf16* orow, int lane) {
    const f32x4* xr = (const f32x4*)xrow + lane; const f32x4* gr = (const f32x4*)gain + lane;
    f32x4 v[8]; float s = 0.f;
#pragma unroll
    for (int j = 0; j < 8; ++j) { v[j] = xr[64 * j]; s += (v[j].x * v[j].x + v[j].y * v[j].y) + (v[j].z * v[j].z + v[j].w * v[j].w); }
    const float r = rsqrtf(wave_sum(s) * (1.f / DM) + NORM_EPS);
    u32x2* o8 = (u32x2*)orow + lane;
#pragma unroll
    for (int j = 0; j < 8; ++j) { const f32x4 g = gr[64 * j]; u32x2 w; w.x = pk2(v[j].x * r * g.x, v[j].y * r * g.y); w.y = pk2(v[j].z * r * g.z, v[j].w * r * g.w); o8[64 * j] = w; }
}

struct Ptrs {
    const float* in[28]; float* out; unsigned char* ws;
};

__device__ __forceinline__ void phase_prologue(const Ptrs& P, LAS unsigned char* lds, int G) {
    const int tid = threadIdx.x, lane = tid & 63, wave = __builtin_amdgcn_readfirstlane(tid >> 6);
    unsigned char* ws = P.ws;
    {
        const float* wq = P.in[23]; const float* sk = P.in[24]; bf16* WsT = (bf16*)(ws + WS_W_S_T);
        LAS float* wq_l = (LAS float*)lds;
        LAS float* sk_l = wq_l + 64 * 129;
        for (int it = blockIdx.x; it < 512; it += G) {
            const int hc = it >> 5, d0 = (it & 31) * 64;
            __syncthreads();
#pragma unroll
            for (int i = 0; i < 4; ++i) { const int e = tid + 512 * i, dl = e >> 5, j4 = (e & 31) * 4; f32x4 v = *(const f32x4*)(wq + (size_t)(d0 + dl) * 2048 + hc * 128 + j4); v = v * P.in[22][d0 + dl];
#pragma unroll
                for (int c = 0; c < 4; ++c) wq_l[dl * 129 + j4 + c] = v[c]; }
#pragma unroll
            for (int i = 0; i < 8; ++i) { const int e = tid + 512 * i, kk = e >> 5, j4 = (e & 31) * 4; const f32x4 v = *(const f32x4*)(sk + ((size_t)hc * 128 + kk) * 128 + j4);
#pragma unroll
                for (int c = 0; c < 4; ++c) sk_l[kk * 129 + j4 + c] = v[c]; }
            __syncthreads();
            const int kb = wave & 3, db = wave >> 2;
            const LAS float* ap = sk_l + (32 * kb + (lane & 31)) * 129 + (lane >> 5); const LAS float* bp = wq_l + (32 * db + (lane & 31)) * 129 + (lane >> 5);
            f32x16 acc;
#pragma unroll
            for (int i = 0; i < 16; ++i) acc[i] = 0.f;
#pragma unroll 16
            for (int st = 0; st < 64; ++st) acc = __builtin_amdgcn_mfma_f32_32x32x2f32(ap[2 * st], bp[2 * st], acc, 0, 0, 0);
#pragma unroll
            for (int r = 0; r < 16; ++r) { const int key = (r & 3) + 8 * (r >> 2) + 4 * (lane >> 5);
                WsT[(size_t)(hc * 128 + 32 * kb + key) * 2048 + d0 + 32 * db + (lane & 31)] = (bf16)f2bf(acc[r]); }
        }
        __syncthreads();
    }
    {
        const float *lam_re = P.in[5], *lam_im = P.in[6], *b_re = P.in[7], *b_im = P.in[8], *c_re = P.in[9], *c_im = P.in[10], *dd = P.in[11], *log_dt = P.in[12];
        LAS float* pwr = (LAS float*)lds;
        LAS float* bbar = pwr + 17 * 64 * 2;
        LAS float* cc = bbar + 64 * 16 * 2;
        for (int gi = blockIdx.x; gi < 256; gi += G) {
            const int g = gi >> 2, qt = gi & 3;
            __syncthreads();
            if (tid < 64) {
                const int p = tid; const float lre = lam_re[g * 64 + p], lim = lam_im[g * 64 + p], dt = expf(log_dt[g]);
                const float er = expf(lre * dt); float sn, cs; sincosf(lim * dt, &sn, &cs);
                const float lbr = er * cs, lbi = er * sn;
                const float nr = lbr - 1.0f, ni = lbi, den = lre * lre + lim * lim;
                const float fr = (nr * lre + ni * lim) / den, fi = (ni * lre - nr * lim) / den;
#pragma unroll
                for (int h = 0; h < 16; ++h) { const float br = b_re[(g * 64 + p) * 16 + h], bi = b_im[(g * 64 + p) * 16 + h];
                    bbar[(p * 16 + h) * 2] = fr * br - fi * bi; bbar[(p * 16 + h) * 2 + 1] = fr * bi + fi * br; }
                float pr = 1.f, pi = 0.f;
                for (int j = 0; j <= 16; ++j) { pwr[(j * 64 + p) * 2] = pr; pwr[(j * 64 + p) * 2 + 1] = pi; const float t = pr * lbr - pi * lbi; pi = pr * lbi + pi * lbr; pr = t; }
            }
            for (int e = tid; e < 1024; e += NTHREADS) { cc[e * 2] = c_re[g * 1024 + e]; cc[e * 2 + 1] = c_im[g * 1024 + e]; }
            __syncthreads();
            bf16* Win = (bf16*)(ws + WS_S5_WIN) + (size_t)g * 32768; bf16* Wout = (bf16*)(ws + WS_S5_WOUT) + (size_t)g * 32768; bf16* Kt = (bf16*)(ws + WS_S5_K) + (size_t)g * 4096;
            for (int e = qt * 8192 + tid; e < (qt + 1) * 8192; e += NTHREADS) {
                const int m = e >> 8, kk = e & 255, p = m & 63, ri = m >> 6, sg = kk >> 4, hp = kk & 15;
                const float ar = pwr[((15 - sg) * 64 + p) * 2], ai = pwr[((15 - sg) * 64 + p) * 2 + 1], xr = bbar[(p * 16 + hp) * 2], xi = bbar[(p * 16 + hp) * 2 + 1];
                Win[e] = (bf16)f2bf(ri ? (ar * xi + ai * xr) : (ar * xr - ai * xi));
            }
            for (int e = qt * 8192 + tid; e < (qt + 1) * 8192; e += NTHREADS) {
                const int mm = e >> 7, m = e & 127, tau = mm >> 4, h = mm & 15, p = m & 63, ri = m >> 6;
                const float ar = pwr[((tau + 1) * 64 + p) * 2], ai = pwr[((tau + 1) * 64 + p) * 2 + 1], cr = cc[(h * 64 + p) * 2], ci = cc[(h * 64 + p) * 2 + 1];
                Wout[e] = (bf16)f2bf(ri ? -(cr * ai + ci * ar) : (cr * ar - ci * ai));
            }
            for (int e = qt * 1024 + tid; e < (qt + 1) * 1024; e += NTHREADS) {
                const int j = e >> 8, h = (e >> 4) & 15, hp = e & 15; float s = 0.f;
                for (int p = 0; p < 64; ++p) { const float ar = pwr[(j * 64 + p) * 2], ai = pwr[(j * 64 + p) * 2 + 1], cr = cc[(h * 64 + p) * 2], ci = cc[(h * 64 + p) * 2 + 1];
                    const float wr = cr * ar - ci * ai, wi = cr * ai + ci * ar; s += wr * bbar[(p * 16 + hp) * 2] - wi * bbar[(p * 16 + hp) * 2 + 1]; }
                if (j == 0 && h == hp) s += dd[g * 16 + h];
                Kt[e] = (bf16)f2bf(s);
            }
            if (tid < 64 && qt == 0) { float* lamq = (float*)(ws + WS_S5_LAM) + g * 128; lamq[2 * tid] = pwr[(16 * 64 + tid) * 2]; lamq[2 * tid + 1] = pwr[(16 * 64 + tid) * 2 + 1]; }
        }
        __syncthreads();
    }
    {
        const float* rel_bias = P.in[2]; float* bt = (float*)(ws + WS_BIAS_TAB);
        for (int e = blockIdx.x * NTHREADS + tid; e < 2048; e += G * NTHREADS) {
            const int hq = e >> 7, dist = e & 127; int bucket = dist;
            if (dist >= 16) { int lg = 16 + (int)(logf((float)dist / 16.0f) / logf(8.0f) * 16.0f); bucket = lg < 31 ? lg : 31; }
            bt[e] = rel_bias[bucket * 16 + hq];
        }
    }
    {
        LAS float* scr = (LAS float*)(lds + wave * 16384);
        const int gw = blockIdx.x * NWAVES + wave, NGW = G * NWAVES;
        constexpr int I0 = 32 * 80, I1 = 16 * 32, I2 = 32 * 64, I3 = 32 * 16, I4 = 32 * 32, I5 = 8 * 64;
        for (int it = gw; it < I0 + I1 + I2 + I3 + I4 + I5; it += NGW) {
            int r = it;
            if (r < I0) { p0_transpose_item(P.in[4], 2048, 2560, (bf16*)(ws + WS_W_IN_T), scr, r, lane); continue; } r -= I0;
            if (r < I1) { p0_transpose_item(P.in[13], 1024, 1024, (bf16*)(ws + WS_W_GLU_T), scr, r, lane); continue; } r -= I1;
            if (r < I2) { p0_transpose_item(P.in[16], 2048, 2048, (bf16*)(ws + WS_W_OUT_T), scr, r, lane); continue; } r -= I2;
            if (r < I3) { p0_transpose_item(P.in[19], 2048, 512, (bf16*)(ws + WS_W_CQ_T), scr, r, lane, P.in[17]); continue; } r -= I3;
            if (r < I4) { p0_transpose_item(P.in[20], 2048, 1024, (bf16*)(ws + WS_W_CKV_T), scr, r, lane); continue; } r -= I4;
            p0_transpose_item(P.in[21], 512, 2048, (bf16*)(ws + WS_W_CO_T), scr, r, lane);
        }
        {
            f32x4 a[8], b[8];
#pragma unroll
            for (int j = 0; j < 8; ++j) { a[j] = ((const f32x4*)(P.in[0] + (size_t)gw * DM))[lane + 64 * j]; b[j] = ((const f32x4*)(P.in[0] + (size_t)(gw + NGW) * DM))[lane + 64 * j]; }
#pragma unroll 1
            for (int m = gw; m < NTOK; m += 2 * NGW) {
                const int mn = (m + 2 * NGW < NTOK) ? m + 2 * NGW : m;
                f32x4 na[8], nb[8];
#pragma unroll
                for (int j = 0; j < 8; ++j) { na[j] = ((const f32x4*)(P.in[0] + (size_t)mn * DM))[lane + 64 * j]; nb[j] = ((const f32x4*)(P.in[0] + (size_t)(mn + NGW) * DM))[lane + 64 * j]; }
                float s0 = 0.f, s1 = 0.f;
#pragma unroll
                for (int j = 0; j < 8; ++j) { s0 += (a[j].x * a[j].x + a[j].y * a[j].y) + (a[j].z * a[j].z + a[j].w * a[j].w); s1 += (b[j].x * b[j].x + b[j].y * b[j].y) + (b[j].z * b[j].z + b[j].w * b[j].w); }
                const float r0 = rsqrtf(wave_sum(s0) * (1.f / DM) + NORM_EPS), r1 = rsqrtf(wave_sum(s1) * (1.f / DM) + NORM_EPS);
                u32x2* o0 = (u32x2*)((bf16*)(ws + WS_HN) + (size_t)m * DM) + lane; u32x2* o1 = (u32x2*)((bf16*)(ws + WS_HN) + (size_t)(m + NGW) * DM) + lane;
#pragma unroll
                for (int j = 0; j < 8; ++j) { const f32x4 g = ((const f32x4*)P.in[3])[lane + 64 * j];
                    u32x2 w0, w1; w0.x = pk2(a[j].x * r0 * g.x, a[j].y * r0 * g.y); w0.y = pk2(a[j].z * r0 * g.z, a[j].w * r0 * g.w); w1.x = pk2(b[j].x * r1 * g.x, b[j].y * r1 * g.y); w1.y = pk2(b[j].z * r1 * g.z, b[j].w * r1 * g.w);
                    o0[64 * j] = w0; o1[64 * j] = w1; }
#pragma unroll
                for (int j = 0; j < 8; ++j) { a[j] = na[j]; b[j] = nb[j]; }
            }
        }
        for (int m = gw; m < 2048; m += NGW) rms_row_to_bf16(P.in[1] + (size_t)m * DM, P.in[18], (bf16*)(ws + WS_MEM_N) + (size_t)m * DM, lane);
    }
}

__device__ __forceinline__ void peer_quant_rows(const Ptrs& P, LAS unsigned char* lds, int wave, int lane, int first, int step, int r_hi) {
    unsigned char* ws = P.ws; (void)lds; (void)wave;
    if (first >= r_hi) return;
    typedef float v16f_t __attribute__((ext_vector_type(16)));
    const int lo4 = 128 * (lane >> 4) + (lane & 15);
#define PQ_SRC(r) (((r) >> 14) ? P.in[26] : P.in[25]) + (size_t)((r) & 16383) * DM
#define PQ_LOAD(V, r) { const f32x4* s4_ = (const f32x4*)(PQ_SRC(r)) + lo4; _Pragma("unroll") for (int q = 0; q < 8; ++q) V[q] = s4_[16 * q]; }
#define PQ_ROW(V, r) { const int t_ = (r) >> 14, e_ = (r) & 16383; float mx = 0.f; \
        if (t_ == 0) { _Pragma("unroll") for (int q = 0; q < 8; ++q) V[q] = V[q] * ((const f32x4*)P.in[22])[lo4 + 16 * q]; } \
        _Pragma("unroll") for (int q = 0; q < 8; ++q) mx = fmaxf(mx, fmaxf(fmaxf(fabsf(V[q].x), fabsf(V[q].y)), fmaxf(fabsf(V[q].z), fabsf(V[q].w)))); \
        _Pragma("unroll") for (int o = 1; o < 64; o <<= 1) mx = fmaxf(mx, __shfl_xor(mx, o)); \
        const float sc = mx > 0.f ? mx * (1.0f / 7.5f) : 1.0f, inv = 1.0f / sc; \
        v16f_t lo16, hi16; \
        _Pragma("unroll") for (int q = 0; q < 8; ++q) { lo16[2 * q] = V[q].x * inv; hi16[2 * q] = V[q].y * inv; lo16[2 * q + 1] = V[q].z * inv; hi16[2 * q + 1] = V[q].w * inv; } \
        const v6u_t wq = __builtin_amdgcn_cvt_scalef32_2xpk16_fp6_f32(lo16, hi16, 1.0f);        \
        unsigned char* dst = ws + (t_ ? WS_PEER_V : WS_PEER_U) + (size_t)(lane >> 4) * PEER_SLICE_BYTES + (size_t)e_ * PEER_SROW; \
          \
        *(u32x4*)(dst + 16 * (lane & 15)) = (u32x4){wq[0], wq[1], wq[2], wq[3]}; *(u32x2*)(dst + 256 + 8 * (lane & 15)) = (u32x2){wq[4], wq[5]}; \
        if (lane == 0) ((float*)(ws + WS_PEER_SU))[2 * e_ + t_] = sc;        }
    f32x4 va[8], vb[8];
    { const int r1 = first + step < r_hi ? first + step : first; PQ_LOAD(va, first) PQ_LOAD(vb, r1) }
#pragma unroll 1
    for (int rr = first; rr < r_hi; rr += 2 * step) {
        const bool two = rr + step < r_hi;
        const int n0 = rr + 2 * step < r_hi ? rr + 2 * step : rr, n1 = rr + 3 * step < r_hi ? rr + 3 * step : n0;
        f32x4 na[8], nb[8];
        PQ_LOAD(na, n0) PQ_LOAD(nb, n1)
        PQ_ROW(va, rr)
        if (two) PQ_ROW(vb, rr + step)
#pragma unroll
        for (int q = 0; q < 8; ++q) { va[q] = na[q]; vb[q] = nb[q]; }
    }
#undef PQ_SRC
#undef PQ_LOAD
#undef PQ_ROW
}

__device__ __forceinline__ void phase_norm(const float* h, const float* gain, bf16* hn, int G) {
    const int lane = threadIdx.x & 63, wave = __builtin_amdgcn_readfirstlane(threadIdx.x >> 6);
    for (int m = blockIdx.x * NWAVES + wave; m < NTOK; m += G * NWAVES) rms_row_to_bf16(h + (size_t)m * DM, gain, hn + (size_t)m * DM, lane);
}

__device__ __forceinline__ void phase_s5(const Ptrs& P, LAS unsigned char* lds, int G) {
    const int tid = threadIdx.x, l = tid & 63, w = __builtin_amdgcn_readfirstlane(tid >> 6);
    unsigned char* ws = P.ws;
    const bf16* U = (const bf16*)(ws + WS_U); bf16* Y = (bf16*)(ws + WS_YPRE);
    LAS unsigned char* U_l = lds;
    LAS float* S_l = (LAS float*)(lds + 33792);
    LAS bf16* Xs_l = (LAS bf16*)(lds + 33792 + 33280);
    LAS float* Eseg = (LAS float*)(lds + 33792 + 33280 + 17408);
    LAS float* Gcar = (LAS float*)(lds + 33792 + 33280 + 17408 + 4096);
    const int l15 = l & 15, l4 = l >> 4;
    const int uoff = l15 * 528 + (l >> 5) * 32 + (l4 & 1) * 16;
    for (int it = blockIdx.x; it < 512; it += G) {
        const int b = it >> 6, g = it & 63;
        const bf16* Win = (const bf16*)(ws + WS_S5_WIN) + (size_t)g * 32768; const bf16* Wout = (const bf16*)(ws + WS_S5_WOUT) + (size_t)g * 32768; const bf16* Kt = (const bf16*)(ws + WS_S5_K) + (size_t)g * 4096;
        const float* lamq = (const float*)(ws + WS_S5_LAM) + g * 128;
        const bf16* Ug = U + (size_t)(b * 64 + g) * 65536;
        const int p = tid & 63, seg = tid >> 6;
        const float lqr = lamq[2 * p], lqi = lamq[2 * p + 1];
        float l8r = lqr, l8i = lqi;
#pragma unroll
        for (int i = 0; i < 3; ++i) { const float t = l8r * l8r - l8i * l8i; l8i = 2.f * l8r * l8i; l8r = t; }
        __syncthreads();
        if (tid < 64) { Gcar[2 * tid] = 0.f; Gcar[2 * tid + 1] = 0.f; }
#pragma unroll 1
        for (int ps = 0; ps < 4; ++ps) {
#pragma unroll
            for (int i = 0; i < 4; ++i) { const int e = tid + 512 * i, t = e >> 1;
                *(LAS u32x4*)(U_l + (t >> 4) * 528 + (t & 15) * 32 + (e & 1) * 16) = *(const u32x4*)(Ug + (size_t)ps * 16384 + e * 8); }
            bf16x8 Aw[8];
#pragma unroll
            for (int ks = 0; ks < 8; ++ks) Aw[ks] = *(const bf16x8*)(Win + (16 * w + l15) * 256 + 32 * ks + 8 * l4);
            __syncthreads();
#pragma unroll
            for (int cb = 0; cb < 4; ++cb) {
                f32x4 acc = (f32x4){0.f, 0.f, 0.f, 0.f};
#pragma unroll
                for (int ks = 0; ks < 8; ++ks) { const bf16x8 Bf = *(const LAS bf16x8*)(U_l + cb * 8448 + uoff + 64 * ks); acc = MFMA16(Aw[ks], Bf, acc); }
#pragma unroll
                for (int r = 0; r < 4; ++r) S_l[(16 * w + 4 * l4 + r) * 65 + cb * 16 + l15] = acc[r];
            }
            __syncthreads();
            {
                float er = 0.f, ei = 0.f; const int c0 = seg * 8;
#pragma unroll
                for (int i = 0; i < 8; ++i) { const int c = c0 + i; const float sr = S_l[p * 65 + c], si = S_l[(64 + p) * 65 + c];
                    const float t = lqr * er - lqi * ei + sr; ei = lqr * ei + lqi * er + si; er = t; S_l[p * 65 + c] = er; S_l[(64 + p) * 65 + c] = ei; }
                Eseg[(seg * 64 + p) * 2] = er; Eseg[(seg * 64 + p) * 2 + 1] = ei;
                __syncthreads();
                float gr = Gcar[((ps & 1) * 64 + p) * 2], gi = Gcar[((ps & 1) * 64 + p) * 2 + 1];
                for (int s = 0; s < seg; ++s) { const float t = l8r * gr - l8i * gi + Eseg[(s * 64 + p) * 2]; gi = l8r * gi + l8i * gr + Eseg[(s * 64 + p) * 2 + 1]; gr = t; }
                if (seg == 7) { Gcar[(((ps + 1) & 1) * 64 + p) * 2] = l8r * gr - l8i * gi + er; Gcar[(((ps + 1) & 1) * 64 + p) * 2 + 1] = l8r * gi + l8i * gr + ei; }
                float pr = 1.f, pi = 0.f;
#pragma unroll
                for (int i = 0; i < 8; ++i) { const int c = c0 + i;
                    float xr = pr * gr - pi * gi, xi = pr * gi + pi * gr;
                    if (i > 0) { xr += S_l[p * 65 + c - 1]; xi += S_l[(64 + p) * 65 + c - 1]; }
                    Xs_l[c * 136 + p] = (bf16)f2bf(xr); Xs_l[c * 136 + 64 + p] = (bf16)f2bf(xi);
                    const float t = pr * lqr - pi * lqi; pi = pr * lqi + pi * lqr; pr = t; }
            }
            __syncthreads();
#pragma unroll 1
            for (int tt = 0; tt < 2; ++tt) {
                const int tau = tt ? 15 - w : w;
                bf16x8 Tf[8], Wo[4];
#pragma unroll
                for (int ks = 0; ks < 8; ++ks) { const int lag = tau - (2 * ks + (l >> 5));
                    bf16x8 z = (bf16x8){0, 0, 0, 0, 0, 0, 0, 0};
                    if (lag >= 0) z = *(const bf16x8*)(Kt + (lag * 16 + l15) * 16 + 8 * (l4 & 1));
                    Tf[ks] = z; }
#pragma unroll
                for (int k2 = 0; k2 < 4; ++k2) Wo[k2] = *(const bf16x8*)(Wout + (tau * 16 + l15) * 128 + 32 * k2 + 8 * l4);
#pragma unroll
                for (int cb = 0; cb < 4; ++cb) {
                    f32x4 acc = (f32x4){0.f, 0.f, 0.f, 0.f};
#pragma unroll
                    for (int ks = 0; ks < 8; ++ks) if (2 * ks <= tau) { const bf16x8 Bf = *(const LAS bf16x8*)(U_l + cb * 8448 + uoff + 64 * ks); acc = MFMA16(Tf[ks], Bf, acc); }
#pragma unroll
                    for (int k2 = 0; k2 < 4; ++k2) { const bf16x8 Bx = *(const LAS bf16x8*)(Xs_l + (cb * 16 + l15) * 136 + 32 * k2 + 8 * l4); acc = MFMA16(Wo[k2], Bx, acc); }
                    u32x2 o; o.x = pk2(gelu_tanh(acc[0]), gelu_tanh(acc[1])); o.y = pk2(gelu_tanh(acc[2]), gelu_tanh(acc[3]));
                    const size_t tok = (size_t)b * SEQ + 16 * (ps * 64 + cb * 16 + l15) + tau;
                    *(u32x2*)(Y + tok * 1024 + 16 * g + 4 * l4) = o;
                }
            }
            __syncthreads();
        }
    }
}

template <int D, int NKB, bool SWA>
__device__ __forceinline__ void attn_task(const bf16* qrow, const LAS unsigned char* Kl, int kstrideB, const LAS unsigned char* Vl, int vstrideB, int kb0,
                                          const LAS float* biasr, int qloc, bool first_blk, float sink, float scale, bf16* orow, int l) {
    const int r32 = l & 31, h = l >> 5;
    bf16x8 qf[D / 16];
#pragma unroll
    for (int s = 0; s < D / 16; ++s) qf[s] = *(const bf16x8*)(qrow + 16 * s + 8 * h);
    f32x16 x[NKB];
#pragma unroll
    for (int kbi = 0; kbi < NKB; ++kbi) {
#pragma unroll
        for (int i = 0; i < 16; ++i) x[kbi][i] = 0.f;
#pragma unroll
        for (int s = 0; s < D / 16; ++s) { const bf16x8 a = *(const LAS bf16x8*)(Kl + ((kb0 + kbi) * 32 + r32) * kstrideB + (16 * s + 8 * h) * 2); x[kbi] = MFMA32(a, qf[s], x[kbi]); }
    }
    float m = -INFINITY;
#pragma unroll
    for (int kbi = 0; kbi < NKB; ++kbi)
#pragma unroll
        for (int i = 0; i < 16; ++i) {
            float s = x[kbi][i] * scale;
            if (SWA) { const int kloc = (kb0 + kbi) * 32 + (i & 3) + 8 * (i >> 2) + 4 * h, dist = qloc - kloc;
                const bool valid = (dist >= 0) && (dist < 128) && (!first_blk || kloc >= 128);
                const int dcl = dist < 0 ? 0 : (dist > 127 ? 127 : dist);
                s = valid ? s + biasr[dcl] : -INFINITY; }
            x[kbi][i] = s; m = fmaxf(m, s);
        }
    m = fmaxf(m, __shfl_xor(m, 32)); if (SWA) m = fmaxf(m, sink);
    float sum = 0.f;
    u32 pk[NKB][8];
#pragma unroll
    for (int kbi = 0; kbi < NKB; ++kbi)
#pragma unroll
        for (int i = 0; i < 16; i += 2) { const float e0 = __expf(x[kbi][i] - m), e1 = __expf(x[kbi][i + 1] - m); sum += e0 + e1; pk[kbi][i >> 1] = cvtpk(e0, e1); }
    sum += __shfl_xor(sum, 32); if (SWA) sum += __expf(sink - m);
    const float inv = 1.0f / sum;
    f32x16 o[D / 32];
#pragma unroll
    for (int db = 0; db < D / 32; ++db)
#pragma unroll
        for (int i = 0; i < 16; ++i) o[db][i] = 0.f;
#pragma unroll
    for (int kbi = 0; kbi < NKB; ++kbi)
#pragma unroll
        for (int s2 = 0; s2 < 2; ++s2) {
            u32x4 pw; pw.x = pk[kbi][4 * s2]; pw.y = pk[kbi][4 * s2 + 1]; pw.z = pk[kbi][4 * s2 + 2]; pw.w = pk[kbi][4 * s2 + 3];
            const bf16x8 pb = __builtin_bit_cast(bf16x8, pw);
#pragma unroll
            for (int db = 0; db < D / 32; ++db) {
                const LAS unsigned char* vp = Vl + (db * 32 + r32) * vstrideB + ((kb0 + kbi) * 32 + 16 * s2 + 4 * h) * 2;
                const s16x4 lo = *(const LAS s16x4*)vp, hi = *(const LAS s16x4*)(vp + 16);
                const bf16x8 a = __builtin_shufflevector(lo, hi, 0, 1, 2, 3, 4, 5, 6, 7);
                o[db] = MFMA32(a, pb, o[db]);
            }
        }
#pragma unroll
    for (int db = 0; db < D / 32; ++db)
#pragma unroll
        for (int g4 = 0; g4 < 4; ++g4) { u32x2 wv; wv.x = cvtpk(o[db][4 * g4] * inv, o[db][4 * g4 + 1] * inv); wv.y = cvtpk(o[db][4 * g4 + 2] * inv, o[db][4 * g4 + 3] * inv);
            *(u32x2*)(orow + db * 32 + 8 * g4 + 4 * h) = wv; }
}

__device__ __forceinline__ void phase_swa(const Ptrs& P, LAS unsigned char* lds, int G) {
    const int tid = threadIdx.x, l = tid & 63, w = __builtin_amdgcn_readfirstlane(tid >> 6);
    unsigned char* ws = P.ws;
    const bf16* Qb = (const bf16*)(ws + WS_Q); const bf16* Kb = (const bf16*)(ws + WS_K); const bf16* Vb = (const bf16*)(ws + WS_V); bf16* Ym = (bf16*)(ws + WS_YMIX);
    const float* bt = (const float*)(ws + WS_BIAS_TAB); const float* sinks = P.in[15];
    LAS unsigned char* Kl = lds;
    LAS unsigned char* Vl = lds + 36864;
    LAS float* bias_l = (LAS float*)(lds + 36864 + 33280);
    for (int it = blockIdx.x; it < 1024; it += G) {
        const int g = it & 3, n = (it >> 2) & 31, b = it >> 7;
        __syncthreads();
#pragma unroll
        for (int i = 0; i < 4; ++i) { const int e = tid + 512 * i, key = e >> 3, part = e & 7; const int kpos = n * 128 - 128 + key;
            u32x4 v = (u32x4){0u, 0u, 0u, 0u};
            if (kpos >= 0) v = *(const u32x4*)(Kb + ((size_t)b * SEQ + kpos) * 256 + g * 64 + part * 8);
            *(LAS u32x4*)(Kl + key * 144 + part * 16) = v; }
#pragma unroll
        for (int i = 0; i < 4; ++i) { const int e = tid + 512 * i, key = e & 255, part = e >> 8; const int kpos = n * 128 - 128 + key;
            u32x4 v = (u32x4){0u, 0u, 0u, 0u};
            if (kpos >= 0) v = *(const u32x4*)(Vb + ((size_t)b * SEQ + kpos) * 256 + g * 64 + part * 8);
#pragma unroll
            for (int jj = 0; jj < 8; ++jj) { const unsigned wv = v[jj >> 1]; *(LAS bf16*)(Vl + (part * 8 + jj) * 520 + key * 2) = (bf16)((jj & 1) ? (wv >> 16) : (wv & 0xffffu)); } }
        bias_l[tid] = bt[(4 * g + (tid >> 7)) * 128 + (tid & 127)];
        __syncthreads();
        const int r = w >> 1, hq = 4 * g + r; const float sink = sinks[hq];
#pragma unroll 1
        for (int t = 0; t < 2; ++t) {
            const int qq = 2 * (w & 1) + t, r32 = l & 31;
            const size_t qtok = (size_t)b * SEQ + n * 128 + 32 * qq + r32;
            attn_task<64, 5, true>(Qb + qtok * 1024 + hq * 64, Kl, 144, Vl, 520, qq, bias_l + r * 128, 128 + 32 * qq + r32, n == 0, sink, 0.125f,
                                   Ym + qtok * 2048 + 1024 + hq * 64, l);
        }
    }
}

__device__ __forceinline__ void phase_cross(const Ptrs& P, LAS unsigned char* lds, int G) {
    const int tid = threadIdx.x, l = tid & 63, w = __builtin_amdgcn_readfirstlane(tid >> 6);
    unsigned char* ws = P.ws;
    const bf16* Qc = (const bf16*)(ws + WS_QC); const bf16* KV = (const bf16*)(ws + WS_KV_C); bf16* Oc = (bf16*)(ws + WS_OC);
    LAS unsigned char* Kl = lds;
    LAS unsigned char* Vl = lds + 69632;
    int prev = -1;
    for (int it = blockIdx.x; it < 512; it += G) {
        const int qb = it & 15, hd = (it >> 4) & 3, b = it >> 6;
        if ((it >> 4) != prev) {
            prev = it >> 4;
            __syncthreads();
#pragma unroll
            for (int i = 0; i < 8; ++i) { const int e = tid + 512 * i, key = e >> 4, part = e & 15;
                *(LAS u32x4*)(Kl + key * 272 + part * 16) = *(const u32x4*)(KV + ((size_t)b * 256 + key) * 1024 + hd * 128 + part * 8); }
#pragma unroll
            for (int i = 0; i < 8; ++i) { const int e = tid + 512 * i, key = e & 255, part = e >> 8;
                const u32x4 v = *(const u32x4*)(KV + ((size_t)b * 256 + key) * 1024 + 512 + hd * 128 + part * 8);
#pragma unroll
                for (int jj = 0; jj < 8; ++jj) { const unsigned wv = v[jj >> 1]; *(LAS bf16*)(Vl + (part * 8 + jj) * 520 + key * 2) = (bf16)((jj & 1) ? (wv >> 16) : (wv & 0xffffu)); } }
            __syncthreads();
        }
        const size_t qtok = (size_t)b * SEQ + qb * 256 + 32 * w + (l & 31);
        attn_task<128, 8, false>(Qc + qtok * 512 + hd * 128, Kl, 272, Vl, 520, 0, (const LAS float*)lds, 0, false, 0.f, 0.08838834764831845f, Oc + qtok * 512 + hd * 128, l);
    }
}
__device__ __forceinline__ void topk_stage1(LAS unsigned char* wb, int l, u32 (&v)[16]) {
    const int j = l >> 1, half = l & 1, sw = 2 * (j & 7);
#pragma unroll
    for (int gq = 0; gq < 4; ++gq) {
        u32 t[16];
#pragma unroll
        for (int i4 = 0; i4 < 4; ++i4) { const int i = 4 * gq + i4, ci = 2 * i + half, phys = ci ^ sw; const f32x4 f = *(const LAS f32x4*)(wb + j * 512 + phys * 16);
#pragma unroll
            for (int e = 0; e < 4; ++e) t[4 * i4 + e] = (f2key(f[e]) & ~0x7Fu) | (u32)(127 - (8 * i + 4 * half + e)); }
        sort16_desc(t);
        if (gq == 0) {
#pragma unroll
            for (int i = 0; i < 16; ++i) v[i] = t[i];
        } else merge_top16_desc(v, t);
    }
    LDS_WAIT(); asm volatile("" ::: "memory");
    {
        u32 o[16];
#pragma unroll
        for (int i = 0; i < 16; ++i) o[i] = (u32)__shfl_xor((int)v[i], 1);
        merge_top16_desc(v, o);
    }
}
__device__ __forceinline__ void topk_stage2(LAS unsigned char* wb, int l, const u32 (&v)[16], int* TI, float* TG, size_t obase, size_t ostride) {
    LAS u32* lut = (LAS u32*)wb;
#pragma unroll
    for (int i = 0; i < 16; ++i) lut[l * 16 + i] = v[i];
    float va[16], vb[16];
    {
        const bool c1 = (l >> 1) & 1;
#pragma unroll
        for (int i = 0; i < 16; ++i) { const u32 o = (u32)__shfl_xor((int)v[i], 2); const u32 a = c1 ? o : v[i], b = c1 ? v[i] : o; va[i] = key2f(a & ~0x7Fu); vb[i] = key2f(b & ~0x7Fu); }
    }
#define CAND(i, q) ((f2key(va[i] + vb[q]) & ~0xFFu) | (u32)(255 - (16 * (i) + (q))))
    u32 c[16];
    {
        u32 t[16];
#pragma unroll
        for (int q = 0; q < 16; ++q) c[q] = CAND(0, q);
        sort16_desc(c);
#pragma unroll
        for (int q = 0; q < 8; ++q) t[q] = CAND(1, q);
#pragma unroll
        for (int q = 0; q < 5; ++q) t[8 + q] = CAND(2, q);
        t[13] = CAND(3, 0); t[14] = CAND(3, 1); t[15] = CAND(3, 2);
        sort16_desc(t); merge_top16_desc(c, t);
        t[0] = CAND(3, 3); t[1] = CAND(4, 0); t[2] = CAND(4, 1); t[3] = CAND(4, 2); t[4] = CAND(5, 0); t[5] = CAND(5, 1); t[6] = CAND(6, 0); t[7] = CAND(6, 1);
        t[8] = CAND(7, 0); t[9] = CAND(7, 1); t[10] = CAND(8, 0); t[11] = CAND(9, 0); t[12] = CAND(10, 0); t[13] = CAND(11, 0); t[14] = CAND(12, 0); t[15] = CAND(13, 0);
        sort16_desc(t); merge_top16_desc(c, t);
        insert_top16_desc(c, CAND(14, 0)); insert_top16_desc(c, CAND(15, 0));
    }
#undef CAND
    LDS_WAIT(); asm volatile("" ::: "memory");
    float best[16]; int eidx[16];
    const int la = (l & ~2) * 16, lb = (l | 2) * 16;
#pragma unroll
    for (int r = 0; r < 16; ++r) { const u32 key = c[r]; const int pos = 255 - (int)(key & 0xFFu); best[r] = key2f(key & ~0xFFu);
        const int k0 = 127 - (int)(lut[la + (pos >> 4)] & 0x7Fu), k1 = 127 - (int)(lut[lb + (pos & 15)] & 0x7Fu); eidx[r] = k0 * 128 + k1; }
    float s = 0.f;
#pragma unroll
    for (int r = 0; r < 16; ++r) { best[r] = __expf(best[r] - key2f(c[0] & ~0xFFu)); s += best[r]; }
    const float inv = 1.0f / s;
    if ((l & 2) == 0) {
        const size_t o = obase + (size_t)(l >> 2) * ostride;
#pragma unroll
        for (int r4 = 0; r4 < 4; ++r4) { *(int4*)(TI + o + 4 * r4) = make_int4(eidx[4 * r4], eidx[4 * r4 + 1], eidx[4 * r4 + 2], eidx[4 * r4 + 3]);
            *(f32x4*)(TG + o + 4 * r4) = (f32x4){best[4 * r4] * inv, best[4 * r4 + 1] * inv, best[4 * r4 + 2] * inv, best[4 * r4 + 3] * inv}; }
    }
    LDS_WAIT(); asm volatile("" ::: "memory");
}
struct EpiTopk {
    static constexpr bool PERM = true, AFTER_DRAIN = true;
    const float* PS; int* TI; float* TG;
    __device__ __forceinline__ void fused(const pg8::f32x4 (&acc)[2][2][4][2], const pg8::Unit& u, int wr, int wc, int fr, int fq, LAS unsigned char* lds, int wid, int lane) const {
        const int cb0 = (8 * wc + 2 * fq) ^ (4 * (fr & 3));
        LAS unsigned char* wq0 = lds + (4 * wr) * 16384 + (2 * fr) * 512 + cb0 * 16;
        LAS unsigned char* wq1 = lds + (4 * wr) * 16384 + (2 * fr + 1) * 512 + (cb0 ^ 2) * 16;
        u32 v0[16];
#pragma unroll
        for (int ai = 0; ai < 2; ++ai) {
#pragma unroll
            for (int m = 0; m < 4; ++m) { const size_t row = (size_t)(u.pm * 256 + ai * 128 + wr * 64 + m * 16 + fr); const float r = pg8::row_rnorm(PS, row);
#pragma unroll
                for (int n = 0; n < 2; ++n) { *(LAS f32x4*)(wq0 + m * 16384 + n * 16) = acc[ai][0][m][n] * r; *(LAS f32x4*)(wq1 + m * 16384 + n * 16) = acc[ai][1][m][n] * r; } }
            __syncthreads();
            if (ai == 0) { topk_stage1(lds + wid * 16384, lane, v0); __syncthreads(); }
            else {
                u32 v1[16];
                topk_stage1(lds + wid * 16384, lane, v1);
#pragma unroll
                for (int i = 0; i < 16; ++i) v1[i] = (lane & 1) ? v1[i] : v0[i];
                LDS_WAIT(); asm volatile("" ::: "memory");
                topk_stage2(lds + wid * 16384, lane, v1, TI, TG, ((size_t)(u.pm * 256 + (lane & 1) * 128 + 16 * wid) * 8 + u.pn) * 16, 128);
                __syncthreads();
            }
        }
    }
};

typedef float f32x2 __attribute__((ext_vector_type(2)));

typedef float v32f_t __attribute__((ext_vector_type(32)));
struct PeerBuf { v6u_t u0, u1, v0, v1; u32x2 sc0, sc1; };
#define PEER_LD6(rs, so) ({ const u32x4 a_ = __builtin_bit_cast(u32x4, __builtin_amdgcn_raw_buffer_load_b128(rs, 16 * l, so, 0)); const u32x2 b_ = __builtin_bit_cast(u32x2, __builtin_amdgcn_raw_buffer_load_b64(rs, 1024 + 8 * l, so, 0)); (v6u_t){a_.x, a_.y, a_.z, a_.w, b_.x, b_.y}; })
template <class RS> __device__ __forceinline__ void peer_issue(PeerBuf& B, const RS& rsU, const RS& rsV, const RS& rsS, int ivA, int ivB, int k0, int l) {
    const int iv = (k0 & 64) ? ivB : ivA;
    const int e0 = __builtin_amdgcn_readlane(iv, (k0 & 63)), e1 = __builtin_amdgcn_readlane(iv, (k0 & 63) + 1);
    B.sc0 = __builtin_bit_cast(u32x2, __builtin_amdgcn_raw_buffer_load_b64(rsS, 0, e0 * 8, 0)); B.sc1 = __builtin_bit_cast(u32x2, __builtin_amdgcn_raw_buffer_load_b64(rsS, 0, e1 * 8, 0));
    B.u0 = PEER_LD6(rsU, e0 * PEER_ROW_BYTES); B.u1 = PEER_LD6(rsU, e1 * PEER_ROW_BYTES); B.v0 = PEER_LD6(rsV, e0 * PEER_ROW_BYTES); B.v1 = PEER_LD6(rsV, e1 * PEER_ROW_BYTES);
}
typedef __bf16 v32bf_t __attribute__((ext_vector_type(32)));
typedef __bf16 bf16x2v __attribute__((ext_vector_type(2)));
__device__ __forceinline__ float peer_dot6(v6u_t w, const u32 (&xp)[16]) { const v32bf_t f = __builtin_amdgcn_cvt_scalef32_pk32_bf16_fp6(w, 1.0f); float s = 0.f;
#define PD2(pp) s = __builtin_amdgcn_fdot2_f32_bf16(__builtin_bit_cast(bf16x2v, xp[pp]), __builtin_shufflevector(f, f, 2 * (pp), 2 * (pp) + 1), s, false);
    PD2(0) PD2(1) PD2(2) PD2(3) PD2(4) PD2(5) PD2(6) PD2(7) PD2(8) PD2(9) PD2(10) PD2(11) PD2(12) PD2(13) PD2(14) PD2(15)
#undef PD2
    return s; }
__device__ __forceinline__ void peer_axpy6(v6u_t w, float c, float (&acc)[32]) { const v32f_t f = __builtin_amdgcn_cvt_scalef32_pk32_f32_fp6(w, 1.0f);
#pragma unroll
    for (int i = 0; i < 32; ++i) acc[i] += c * f[i]; }
__device__ __forceinline__ void peer_axpy6v(v6u_t w, float c, v32f_t& acc) { const v32f_t f = __builtin_amdgcn_cvt_scalef32_pk32_f32_fp6(w, 1.0f); acc = acc + f * c; }
__device__ __forceinline__ void peer_compute(const PeerBuf& B, const u32 (&xr)[16], float (&acc)[32], float rn, int ivA, int ivB, float gvA, float gvB, int k0, int l) {
    const float gv = (k0 & 64) ? gvB : gvA; const int kk = k0 & 63;
    const float d0 = peer_dot6(B.u0, xr); __builtin_amdgcn_sched_barrier(0);
    const float d1 = peer_dot6(B.u1, xr); __builtin_amdgcn_sched_barrier(0);
    const bool o1 = l & 1;
    float t = (o1 ? d1 : d0) + __shfl_xor(o1 ? d0 : d1, 1);
#pragma unroll
    for (int o = 2; o < 64; o <<= 1) t += __shfl_xor(t, o);
    const float g0 = __uint_as_float(__builtin_amdgcn_readlane(__float_as_uint(gv), kk)), g1 = __uint_as_float(__builtin_amdgcn_readlane(__float_as_uint(gv), kk + 1));
    const float su = __uint_as_float(o1 ? B.sc1.x : B.sc0.x), sv = __uint_as_float(o1 ? B.sc1.y : B.sc0.y), gg = o1 ? g1 : g0;
    const float cf = gg * gelu_tanh(t * su * rn) * sv;
    const float c0 = __uint_as_float(__builtin_amdgcn_readlane(__float_as_uint(cf), 0)), c1 = __uint_as_float(__builtin_amdgcn_readlane(__float_as_uint(cf), 1));
    __builtin_amdgcn_sched_barrier(0);
    peer_axpy6(B.v0, c0, acc); __builtin_amdgcn_sched_barrier(0);
    peer_axpy6(B.v1, c1, acc); __builtin_amdgcn_sched_barrier(0);
}
#define XB_TMO      128
#define XB_XCNT(j)  (256  + 64 * (j))
#define XB_XSUB(j)  (1280 + 64 * (j))
#define XB_XGEN(j)  (2304 + 64 * (j))
#define XB_TOP      3328
#define XB_TOPGEN   3392
#define XCD_BAR_WORDS 3456
#define XB_SPIN_CAP (1u << 20)
__device__ __forceinline__ unsigned xb_ld(unsigned* p)              { return __hip_atomic_load(p, __ATOMIC_RELAXED, __HIP_MEMORY_SCOPE_AGENT); }
__device__ __forceinline__ unsigned xb_add(unsigned* p, unsigned v) { return __hip_atomic_fetch_add(p, v, __ATOMIC_RELAXED, __HIP_MEMORY_SCOPE_AGENT); }
__device__ __forceinline__ unsigned xb_xcc_id() { return (unsigned)__builtin_amdgcn_s_getreg((3 << 11) | 20) & 0xFu; }
#define XB_SPIN(cond, bar) do { unsigned _sp = 0; while (cond) { __builtin_amdgcn_s_sleep(1); \
    if ((++_sp & 255u) == 0u) { if (xb_ld(&(bar)[XB_TMO])) break; if (_sp > XB_SPIN_CAP) { atomicAdd(&(bar)[XB_TMO], 1u); break; } } } } while (0)
struct XcdBarrier { unsigned* bar; unsigned x; volatile LAS unsigned* st; };
__device__ __forceinline__ XcdBarrier xcd_barrier_post(unsigned* bar, volatile LAS unsigned* st) {
    XcdBarrier b; b.bar = bar; b.x = xb_xcc_id(); b.st = st;
    if (threadIdx.x == 0) (void)xb_add(&bar[XB_XCNT(b.x)], 1u);
    return b;
}
__device__ __forceinline__ void xcd_barrier_complete(unsigned* bar, unsigned x, unsigned& nloc, unsigned& nx) {
    const unsigned G = gridDim.x * gridDim.y * gridDim.z;
    unsigned sum, cnt, mine, sp = 0u;
    for (;;) {
        sum = 0u; cnt = 0u; mine = 0u;
#pragma unroll
        for (unsigned j = 0; j < 16; ++j) { const unsigned c = xb_ld(&bar[XB_XCNT(j)]); sum += c; cnt += (c > 0u) ? 1u : 0u; mine = (j == x) ? c : mine; }
        if (sum == G) break;
        __builtin_amdgcn_s_sleep(1);
        if ((++sp & 255u) == 0u) { if (xb_ld(&bar[XB_TMO])) break; if (sp > XB_SPIN_CAP) { atomicAdd(&bar[XB_TMO], 1u); break; } }
    }
    nloc = mine > 0u ? mine : 1u; nx = cnt > 0u ? cnt : 1u;
}
__device__ __forceinline__ void xcd_barrier(const XcdBarrier& b) {
    asm volatile("s_waitcnt vmcnt(0)" ::: "memory");
    __syncthreads();
    if (threadIdx.x == 0) {
        unsigned* bar = b.bar;
        __builtin_amdgcn_s_waitcnt(0);
        unsigned nloc = b.st[0], nx = b.st[1];
        if (nloc == 0u) { xcd_barrier_complete(bar, b.x, nloc, nx); b.st[0] = nloc; b.st[1] = nx; }
        const unsigned old = xb_add(&bar[XB_XSUB(b.x)], 1u);
        const unsigned gen = old / nloc;
        if (old + 1u == (gen + 1u) * nloc) {
            __builtin_amdgcn_fence(__ATOMIC_RELEASE, "agent");
            asm volatile("s_waitcnt vmcnt(0)" ::: "memory");
            const unsigned og = xb_add(&bar[XB_TOP], 1u);
            const unsigned tg = og / nx;
            if (og + 1u == (tg + 1u) * nx) xb_add(&bar[XB_TOPGEN], 1u);
            else XB_SPIN(xb_ld(&bar[XB_TOPGEN]) == tg, bar);
            __builtin_amdgcn_fence(__ATOMIC_ACQUIRE, "agent");
            xb_add(&bar[XB_XGEN(b.x)], 1u);
            asm volatile("s_waitcnt vmcnt(0)" ::: "memory");
        } else {
            XB_SPIN(xb_ld(&bar[XB_XGEN(b.x)]) == gen, bar);
            __builtin_amdgcn_fence(__ATOMIC_ACQUIRE, "agent");
            asm volatile("s_waitcnt vmcnt(0)" ::: "memory");
        }
    }
    __syncthreads();
}

template <int CTRL> __device__ __forceinline__ float dpp_f(float v) { return __int_as_float(__builtin_amdgcn_update_dpp(0, __float_as_int(v), CTRL, 0xF, 0xF, true)); }
__device__ __forceinline__ float row16_reduce8(const float (&d)[8], int ch) {
    const bool b0 = ch & 1, b1 = ch & 2;
    float e[4], f[2];
#pragma unroll
    for (int j = 0; j < 4; ++j) { const float keep = b0 ? d[2 * j + 1] : d[2 * j], give = b0 ? d[2 * j] : d[2 * j + 1]; e[j] = keep + dpp_f<0xB1>(give); }
#pragma unroll
    for (int m = 0; m < 2; ++m) { const float keep = b1 ? e[2 * m + 1] : e[2 * m], give = b1 ? e[2 * m] : e[2 * m + 1]; f[m] = keep + dpp_f<0x4E>(give); }
#pragma unroll
    for (int m = 0; m < 2; ++m) { f[m] += dpp_f<0x128>(f[m]); f[m] += dpp_f<0x124>(f[m]); }
    return (ch & 4) ? f[1] : f[0];
}
struct PeerHalf { v6u_t w0, w1, w2, w3, w4, w5, w6, w7; };
__device__ __forceinline__ void peer_q_ids(int (&el)[8], const int* p  ) {
#pragma unroll
    for (int st = 0; st < 8; st += 4) { const int4 t = *(const int4*)(p + st); el[st] = t.x; el[st + 1] = t.y; el[st + 2] = t.z; el[st + 3] = t.w; }
}
template <class RS> __device__ __forceinline__ void peer_q_issue(PeerHalf& B, const RS& rs, const int (&el)[8], int ch) {
#define PH_LD(st) ({ const int vo_ = el[st] * PEER_SROW; \
        const u32x4 a_ = __builtin_bit_cast(u32x4, __builtin_amdgcn_raw_buffer_load_b128(rs, vo_ + 16 * ch, 0, 0)); const u32x2 b_ = __builtin_bit_cast(u32x2, __builtin_amdgcn_raw_buffer_load_b64(rs, vo_ + 256 + 8 * ch, 0, 0)); \
        (v6u_t){a_.x, a_.y, a_.z, a_.w, b_.x, b_.y}; })
    B.w0 = PH_LD(0); B.w1 = PH_LD(1); B.w2 = PH_LD(2); B.w3 = PH_LD(3); B.w4 = PH_LD(4); B.w5 = PH_LD(5); B.w6 = PH_LD(6); B.w7 = PH_LD(7);
#undef PH_LD
}
__device__ __forceinline__ void peer_q_dots(const PeerHalf& B, const u32 (&xs)[16], LAS float* pd  , int ch) {
    float d[8], old[8];
#pragma unroll
    for (int st = 0; st < 8; ++st) old[st] = pd[st];
    d[0] = peer_dot6(B.w0, xs); __builtin_amdgcn_sched_barrier(0); d[1] = peer_dot6(B.w1, xs); __builtin_amdgcn_sched_barrier(0);
    d[2] = peer_dot6(B.w2, xs); __builtin_amdgcn_sched_barrier(0); d[3] = peer_dot6(B.w3, xs); __builtin_amdgcn_sched_barrier(0);
    d[4] = peer_dot6(B.w4, xs); __builtin_amdgcn_sched_barrier(0); d[5] = peer_dot6(B.w5, xs); __builtin_amdgcn_sched_barrier(0);
    d[6] = peer_dot6(B.w6, xs); __builtin_amdgcn_sched_barrier(0); d[7] = peer_dot6(B.w7, xs); __builtin_amdgcn_sched_barrier(0);
#pragma unroll
    for (int o = 1; o < 16; o <<= 1)
#pragma unroll
        for (int st = 0; st < 8; ++st) d[st] += __shfl_xor(d[st], o);
    if (ch == 0) {
#pragma unroll
        for (int st = 0; st < 8; ++st) pd[st] = old[st] + d[st];
    }
}
__device__ __forceinline__ void peer_q_axpy(const PeerHalf& B, const LAS float* pd  , v32f_t& acc) {
    float cf[8];
#pragma unroll
    for (int st = 0; st < 8; ++st) cf[st] = pd[st];
    peer_axpy6v(B.w0, cf[0], acc); __builtin_amdgcn_sched_barrier(0); peer_axpy6v(B.w1, cf[1], acc); __builtin_amdgcn_sched_barrier(0);
    peer_axpy6v(B.w2, cf[2], acc); __builtin_amdgcn_sched_barrier(0); peer_axpy6v(B.w3, cf[3], acc); __builtin_amdgcn_sched_barrier(0);
    peer_axpy6v(B.w4, cf[4], acc); __builtin_amdgcn_sched_barrier(0); peer_axpy6v(B.w5, cf[5], acc); __builtin_amdgcn_sched_barrier(0);
    peer_axpy6v(B.w6, cf[6], acc); __builtin_amdgcn_sched_barrier(0); peer_axpy6v(B.w7, cf[7], acc); __builtin_amdgcn_sched_barrier(0);
}
#define PH_LD1(st) ({ const int vo_ = el[st] * PEER_SROW; \
        const u32x4 a_ = __builtin_bit_cast(u32x4, __builtin_amdgcn_raw_buffer_load_b128(rs, vo_ + 16 * ch, 0, 0)); const u32x2 b_ = __builtin_bit_cast(u32x2, __builtin_amdgcn_raw_buffer_load_b64(rs, vo_ + 256 + 8 * ch, 0, 0)); \
        (v6u_t){a_.x, a_.y, a_.z, a_.w, b_.x, b_.y}; })
template <class RS> __device__ __forceinline__ void peer_q_issue_dots(PeerHalf& N, const RS& rs, const int (&el)[8], const PeerHalf& B, const u32 (&xs)[16], LAS float* pd, int ch) {
    float d[8];
    const float old = pd[ch & 7];
    N.w0 = PH_LD1(0); d[0] = peer_dot6(B.w0, xs); __builtin_amdgcn_sched_barrier(0); N.w1 = PH_LD1(1); d[1] = peer_dot6(B.w1, xs); __builtin_amdgcn_sched_barrier(0);
    N.w2 = PH_LD1(2); d[2] = peer_dot6(B.w2, xs); __builtin_amdgcn_sched_barrier(0); N.w3 = PH_LD1(3); d[3] = peer_dot6(B.w3, xs); __builtin_amdgcn_sched_barrier(0);
    N.w4 = PH_LD1(4); d[4] = peer_dot6(B.w4, xs); __builtin_amdgcn_sched_barrier(0); N.w5 = PH_LD1(5); d[5] = peer_dot6(B.w5, xs); __builtin_amdgcn_sched_barrier(0);
    N.w6 = PH_LD1(6); d[6] = peer_dot6(B.w6, xs); __builtin_amdgcn_sched_barrier(0); N.w7 = PH_LD1(7); d[7] = peer_dot6(B.w7, xs); __builtin_amdgcn_sched_barrier(0);
    const float tot = row16_reduce8(d, ch);
    if (ch < 8) pd[ch] = old + tot;
}
template <class RS> __device__ __forceinline__ void peer_q_issue_axpy(PeerHalf& N, const RS& rs, const int (&el)[8], int ch, const PeerHalf& B, const LAS float* pd, v32f_t& acc) {
    float cf[8];
#pragma unroll
    for (int st = 0; st < 8; ++st) cf[st] = pd[st];
    N.w0 = PH_LD1(0); peer_axpy6v(B.w0, cf[0], acc); __builtin_amdgcn_sched_barrier(0); N.w1 = PH_LD1(1); peer_axpy6v(B.w1, cf[1], acc); __builtin_amdgcn_sched_barrier(0);
    N.w2 = PH_LD1(2); peer_axpy6v(B.w2, cf[2], acc); __builtin_amdgcn_sched_barrier(0); N.w3 = PH_LD1(3); peer_axpy6v(B.w3, cf[3], acc); __builtin_amdgcn_sched_barrier(0);
    N.w4 = PH_LD1(4); peer_axpy6v(B.w4, cf[4], acc); __builtin_amdgcn_sched_barrier(0); N.w5 = PH_LD1(5); peer_axpy6v(B.w5, cf[5], acc); __builtin_amdgcn_sched_barrier(0);
    N.w6 = PH_LD1(6); peer_axpy6v(B.w6, cf[6], acc); __builtin_amdgcn_sched_barrier(0); N.w7 = PH_LD1(7); peer_axpy6v(B.w7, cf[7], acc); __builtin_amdgcn_sched_barrier(0);
}
#undef PH_LD1
__device__ __forceinline__ void phase_peer(const Ptrs& P, LAS unsigned char* lds, int G, const XcdBarrier* bar) {
    const int tid = threadIdx.x, l = tid & 63, w = __builtin_amdgcn_readfirstlane(tid >> 6);
    unsigned char* ws = P.ws;
    const bf16* HN = (const bf16*)(ws + WS_HN); const float* SUV = (const float*)(ws + WS_PEER_SU);
    const int* TI = (const int*)(ws + WS_TK_IDX); const float* TG = (const float*)(ws + WS_TK_G); float* out = P.out; bf16* OB = (bf16*)(ws + WS_OB); const float* gfin = P.in[27]; const float* PS = (const float*)(ws + WS_PS);
    LAS float* PD = (LAS float*)(lds + w * 8192);
    LAS float* SS = (LAS float*)(lds + 65536 + w * 64);
    const int es = l >> 4, ch = l & 15, stride = G * NWAVES, tok0 = blockIdx.x * NWAVES + w;
    (void)bar;
    if (l < 16) SS[l] = 0.f;
#pragma unroll
    for (int q = 0; q < 8; ++q) *(LAS f32x4*)(PD + 4 * l + 256 * q) = (f32x4){0.f, 0.f, 0.f, 0.f};
    {
        int* TIw = (int*)(ws + WS_TK_IDX); float* TGw = (float*)(ws + WS_TK_G);
#pragma unroll 1
        for (int i = 0; i < 16; ++i) {
            const size_t tok = (size_t)(tok0 + i * stride);
            const int e0 = TIw[tok * 128 + l], e1 = TIw[tok * 128 + 64 + l]; const float g0 = TGw[tok * 128 + l], g1 = TGw[tok * 128 + 64 + l];
            const int k0 = (e0 << 7) | l, k1 = (e1 << 7) | (64 + l);
            int r0 = 0, r1 = 0;
#pragma unroll 8
            for (int j = 0; j < 64; ++j) { const int ka = __builtin_amdgcn_readlane(k0, j), kb = __builtin_amdgcn_readlane(k1, j);
                r0 += (ka < k0 ? 1 : 0) + (kb < k0 ? 1 : 0); r1 += (ka < k1 ? 1 : 0) + (kb < k1 ? 1 : 0); }
            TIw[tok * 128 + r0] = e0; TIw[tok * 128 + r1] = e1; TGw[tok * 128 + r0] = g0; TGw[tok * 128 + r1] = g1;
        }
        asm volatile("s_waitcnt vmcnt(0)" ::: "memory");
    }
#pragma unroll 1
    for (int s = 0; s < 4; ++s) {
        const auto rsU = __builtin_amdgcn_make_buffer_rsrc((void*)(ws + WS_PEER_U + (size_t)s * PEER_SLICE_BYTES), 0, (int)PEER_SLICE_BYTES, 0x00020000);
#pragma unroll 1
        for (int p = 0; p < 2; ++p) {
            PeerHalf A, B;
            int elA[8], elB[8];
            u32 xs[16];
#pragma unroll
            for (int q = 0; q < 8; ++q) { const u32x2 a = *(const u32x2*)(HN + (size_t)tok0 * DM + 512 * s + 64 * q + 4 * ch); xs[2 * q] = a.x; xs[2 * q + 1] = a.y; }
            peer_q_ids(elA, TI + (size_t)tok0 * 128 + 64 * p + 8 * es); peer_q_ids(elB, TI + (size_t)tok0 * 128 + 64 * p + 32 + 8 * es);
            peer_q_issue(A, rsU, elA, ch);
#pragma unroll 1
            for (int i = 0; i < 16; ++i) {
                const size_t ntok = (size_t)(tok0 + (i < 15 ? i + 1 : i) * stride);
                u32 nxs[16];
#pragma unroll
                for (int q = 0; q < 8; ++q) { const u32x2 a = *(const u32x2*)(HN + ntok * DM + 512 * s + 64 * q + 4 * ch); nxs[2 * q] = a.x; nxs[2 * q + 1] = a.y; }
                peer_q_ids(elA, TI + ntok * 128 + 64 * p + 8 * es);   __builtin_amdgcn_sched_barrier(0);   peer_q_issue_dots(B, rsU, elB, A, xs, PD + i * 128 + 64 * p + 8 * es, ch);
                peer_q_ids(elB, TI + ntok * 128 + 64 * p + 32 + 8 * es);   __builtin_amdgcn_sched_barrier(0);   peer_q_issue_dots(A, rsU, elA, B, xs, PD + i * 128 + 64 * p + 32 + 8 * es, ch);
#pragma unroll
                for (int q = 0; q < 16; ++q) xs[q] = nxs[q];
            }
        }
    }
#pragma unroll 1
    for (int hb = 0; hb < 2; ++hb) {
        int ce[8][2]; float cg[8][2], cps[8];
#pragma unroll
        for (int j = 0; j < 8; ++j) { const size_t tok = (size_t)(tok0 + (8 * hb + j) * stride);
            cps[j] = l < 32 ? PS[tok * 32 + l] : 0.f;
            ce[j][0] = TI[tok * 128 + l]; ce[j][1] = TI[tok * 128 + 64 + l]; cg[j][0] = TG[tok * 128 + l]; cg[j][1] = TG[tok * 128 + 64 + l]; }
        f32x2 csc[8][2];
#pragma unroll
        for (int j = 0; j < 8; ++j) { csc[j][0] = *(const f32x2*)(SUV + 2 * ce[j][0]); csc[j][1] = *(const f32x2*)(SUV + 2 * ce[j][1]); }
#pragma unroll
        for (int j = 0; j < 8; ++j) { const int i = 8 * hb + j;
            const float rn = __builtin_amdgcn_rsqf(wave_sum(cps[j]) * (1.0f / 2048.0f) + NORM_EPS);
#pragma unroll
            for (int hh = 0; hh < 2; ++hh) { const int k = 64 * hh + l; PD[i * 128 + k] = cg[j][hh] * gelu_tanh(PD[i * 128 + k] * csc[j][hh].x * rn) * csc[j][hh].y; } }
    }
#pragma unroll 1
    for (int s = 0; s < 4; ++s) {
        const auto rsV = __builtin_amdgcn_make_buffer_rsrc((void*)(ws + WS_PEER_V + (size_t)s * PEER_SLICE_BYTES), 0, (int)PEER_SLICE_BYTES, 0x00020000);
#pragma unroll 1
        for (int p = 0; p < 2; ++p) {
            const bf16* RS = p ? (const bf16*)OB : HN;
            asm volatile("s_waitcnt vmcnt(0)" ::: "memory");
            PeerHalf A, B;
            int elA[8], elB[8];
            peer_q_ids(elA, TI + (size_t)tok0 * 128 + 64 * p + 8 * es); peer_q_ids(elB, TI + (size_t)tok0 * 128 + 64 * p + 32 + 8 * es);
            peer_q_issue(A, rsV, elA, ch);
#pragma unroll 1
            for (int i = 0; i < 16; ++i) {
                const size_t tok = (size_t)(tok0 + i * stride), ntok = (size_t)(tok0 + (i < 15 ? i + 1 : i) * stride);
                u32x2 hw[2];
#pragma unroll
                for (int j = 0; j < 2; ++j) hw[j] = *(const u32x2*)(RS + tok * DM + 512 * s + 64 * (2 * es + j) + 4 * ch);
                v32f_t acc;
#pragma unroll
                for (int c = 0; c < 32; ++c) acc[c] = 0.f;
                peer_q_ids(elA, TI + ntok * 128 + 64 * p + 8 * es);   __builtin_amdgcn_sched_barrier(0);   peer_q_issue_axpy(B, rsV, elB, ch, A, PD + i * 128 + 64 * p + 8 * es, acc);
                peer_q_ids(elB, TI + ntok * 128 + 64 * p + 32 + 8 * es);   __builtin_amdgcn_sched_barrier(0);   peer_q_issue_axpy(A, rsV, elA, ch, B, PD + i * 128 + 64 * p + 32 + 8 * es, acc);
                float r1[16], r2[8];
#pragma unroll
                for (int c = 0; c < 16; ++c) { const auto pp = __builtin_amdgcn_permlane32_swap(__float_as_uint(acc[c]), __float_as_uint(acc[c + 16]), false, false); r1[c] = __uint_as_float(pp[0]) + __uint_as_float(pp[1]); }
#pragma unroll
                for (int c = 0; c < 8; ++c) { const auto pp = __builtin_amdgcn_permlane16_swap(__float_as_uint(r1[c]), __float_as_uint(r1[c + 8]), false, false); r2[c] = __uint_as_float(pp[0]) + __uint_as_float(pp[1]); }
                float ss = 0.f;
                {
                    bf16* op = OB + tok * DM + 512 * s + 128 * es + 4 * ch;
#pragma unroll
                    for (int j = 0; j < 2; ++j) {
                        const f32x4 o0 = {r2[4 * j] + bflo(hw[j].x), r2[4 * j + 1] + bfhi(hw[j].x), r2[4 * j + 2] + bflo(hw[j].y), r2[4 * j + 3] + bfhi(hw[j].y)};
                        ss += (o0[0] * o0[0] + o0[1] * o0[1]) + (o0[2] * o0[2] + o0[3] * o0[3]);
                        *(u32x2*)(op + 64 * j) = (u32x2){pk2(o0[0], o0[1]), pk2(o0[2], o0[3])}; }
                }
                if (p == 1) { ss = wave_sum(ss); if (l == 0) SS[i] += ss; }
            }
        }
    }
    asm volatile("s_waitcnt vmcnt(0) lgkmcnt(0)" ::: "memory");
    {
        f32x4 ga[8]; u32x2 cur[8];
#pragma unroll
        for (int j = 0; j < 8; ++j) { ga[j] = ((const f32x4*)gfin)[l + 64 * j]; cur[j] = ((const u32x2*)(OB + (size_t)tok0 * DM))[l + 64 * j]; }
#pragma unroll 1
        for (int i = 0; i < 16; ++i) {
            const size_t tok = (size_t)(tok0 + i * stride), ntok = (size_t)(tok0 + (i < 15 ? i + 1 : i) * stride);
            u32x2 nxt[8];
#pragma unroll
            for (int j = 0; j < 8; ++j) nxt[j] = ((const u32x2*)(OB + ntok * DM))[l + 64 * j];
            const float r = rsqrtf(SS[i] * (1.f / DM) + NORM_EPS);
            f32x4* op = (f32x4*)(out + tok * DM);
#pragma unroll
            for (int j = 0; j < 8; ++j) { const u32x2 o = cur[j]; op[l + 64 * j] = (f32x4){bflo(o.x) * r * ga[j].x, bfhi(o.x) * r * ga[j].y, bflo(o.y) * r * ga[j].z, bfhi(o.y) * r * ga[j].w}; }
#pragma unroll
            for (int j = 0; j < 8; ++j) cur[j] = nxt[j];
        }
    }
}

struct Params { const float* in[28]; float* out; unsigned char* ws; int ph_lo, ph_hi; };
constexpr int N_PHASES = 13;
#ifndef STOP_AFTER
#define STOP_AFTER 12
#endif

__global__ void __launch_bounds__(NTHREADS, 2) mega(Params prm) {
    extern __shared__ __attribute__((aligned(16))) unsigned char lds_raw[];
    LAS unsigned char* lds = (LAS unsigned char*)lds_raw;
    const int G = gridDim.x;
    Ptrs P;
#pragma unroll
    for (int i = 0; i < 28; ++i) P.in[i] = prm.in[i];
    P.out = prm.out; P.ws = prm.ws;
    unsigned char* ws = prm.ws;
    const int lo = prm.ph_lo, hi = prm.ph_hi;
#ifndef PHMASK
#define PHMASK 0x1fff
#endif
#define IN(k) (((PHMASK >> (k)) & 1) && lo <= (k) && (k) < hi)
#if ONE_LAUNCH
    volatile LAS unsigned* bst = (volatile LAS unsigned*)(lds + LDS_BYTES - 64);
    if (threadIdx.x == 0) { bst[0] = 0u; bst[1] = 0u; }
    __syncthreads();
    const XcdBarrier bar = xcd_barrier_post((unsigned*)(ws + WS_CTL), bst);
#define SEAM(k) do { if (IN(k) && IN((k) + 1)) xcd_barrier(bar); } while (0)
#ifndef PEER_SYNC
#define PEER_SYNC 0
#endif
#define PEER_BAR (PEER_SYNC ? &bar : (const XcdBarrier*)nullptr)
#else
#define SEAM(k) do { } while (0)
#define PEER_BAR ((const XcdBarrier*)nullptr)
#endif
    bf16* HN = (bf16*)(ws + WS_HN);
    if (IN(0)) { phase_prologue(P, lds, G); }
    SEAM(0);
    if (IN(1)) {
        __syncthreads();
        { pg8::Gemm g{HN, (const bf16*)(ws + WS_W_IN_T), NTOK, 2560, 2048}; pg8::StaticOrder S; S.init(NTOK, 2560, G, (int)blockIdx.x);
          pg8::EpiInProj E{(bf16*)(ws + WS_U), (bf16*)(ws + WS_Q), (bf16*)(ws + WS_K), (bf16*)(ws + WS_V)};
          pg8::gemm_phase<pg8::EpiInProj, pg8::StaticOrder, PG8_ALIGN, PG8_SP2>(lds, g, S, E); }
        __syncthreads();
        { pg8::Gemm g{(const bf16*)(ws + WS_MEM_N), (const bf16*)(ws + WS_W_CKV_T), 2048, 1024, 2048}; pg8::StaticOrder S; S.init(2048, 1024, G, (int)blockIdx.x);
          pg8::EpiBf16Plain E{(bf16*)(ws + WS_KV_C), 1024};
          pg8::gemm_phase<pg8::EpiBf16Plain, pg8::StaticOrder, PG8_ALIGN, PG8_SP2>(lds, g, S, E); }
        __syncthreads();
        {
            const int wv = __builtin_amdgcn_readfirstlane(threadIdx.x >> 6), ln = threadIdx.x & 63;
            constexpr int R1 = 32768;
            if (blockIdx.x >= 32) peer_quant_rows(P, lds, wv, ln, ((int)blockIdx.x - 32) * NWAVES + wv, (G - 32) * NWAVES, R1);
            else peer_quant_rows(P, lds, wv, ln, R1 + (int)blockIdx.x * NWAVES + wv, 32 * NWAVES, 32768);
        }
    }
    SEAM(1);
    if (IN(2)) {
#ifndef NO_S5
        __syncthreads(); phase_s5(P, lds, G);
#endif
#ifndef NO_SWA
        __syncthreads(); phase_swa(P, lds, G);
#endif
    }
    SEAM(2);
    if (IN(3)) {
        __syncthreads();
        pg8::Gemm g{(const bf16*)(ws + WS_YPRE), (const bf16*)(ws + WS_W_GLU_T), NTOK, 1024, 1024}; pg8::StaticOrder S; S.init(NTOK, 1024, G, (int)blockIdx.x);
        pg8::EpiGlu E{(bf16*)(ws + WS_YMIX), 2048, (const bf16*)(ws + WS_YPRE), 1024, P.in[14]};
        pg8::gemm_phase<pg8::EpiGlu, pg8::StaticOrder, PG8_ALIGN, PG8_SP2>(lds, g, S, E);
    }
    SEAM(3);
    if (IN(4)) {
        __syncthreads();
        pg8::Gemm g{(const bf16*)(ws + WS_YMIX), (const bf16*)(ws + WS_W_OUT_T), NTOK, 2048, 2048}; pg8::StaticOrder S; S.init(NTOK, 2048, G, (int)blockIdx.x);
        pg8::EpiResBf16<false> E{HN, P.in[0], (float*)(ws + WS_PS)};
        pg8::gemm_phase<pg8::EpiResBf16<false>, pg8::StaticOrder, PG8_ALIGN, PG8_SP2>(lds, g, S, E);
    }
    SEAM(4);
    if (IN(6)) {
        __syncthreads();
        pg8::Gemm g{HN, (const bf16*)(ws + WS_W_CQ_T), NTOK, 512, 2048}; pg8::StaticOrder S; S.init(NTOK, 512, G, (int)blockIdx.x);
        pg8::EpiBf16RowScale E{(bf16*)(ws + WS_QC), 512, (const float*)(ws + WS_PS)};
        pg8::gemm_phase<pg8::EpiBf16RowScale, pg8::StaticOrder, PG8_ALIGN, PG8_SP2>(lds, g, S, E);
    }
    SEAM(6);
    if (IN(7)) { __syncthreads(); phase_cross(P, lds, G); }
    SEAM(7);
    if (IN(8)) {
        __syncthreads();
        pg8::Gemm g{(const bf16*)(ws + WS_OC), (const bf16*)(ws + WS_W_CO_T), NTOK, 2048, 512}; pg8::StaticOrder S; S.init(NTOK, 2048, G, (int)blockIdx.x);
        pg8::EpiResBf16<true> E{HN, HN, (float*)(ws + WS_PS)};
        pg8::gemm_phase<pg8::EpiResBf16<true>, pg8::StaticOrder, PG8_ALIGN, PG8_SP2>(lds, g, S, E);
    }
    SEAM(8);
    if (IN(10)) {
        __syncthreads();
        pg8::Gemm g{HN, (const bf16*)(ws + WS_W_S_T), NTOK, 2048, 2048}; pg8::StaticOrder S; S.init(NTOK, 2048, G, (int)blockIdx.x);
        EpiTopk E{(const float*)(ws + WS_PS), (int*)(ws + WS_TK_IDX), (float*)(ws + WS_TK_G)};
        for (int i = 0; ; ++i) { pg8::Unit uu; if (!S.next(i, uu)) break; pg8::OneUnit O1{uu}; pg8::gemm_phase<EpiTopk, pg8::OneUnit, false, false>(lds, g, O1, E); }
    }
    SEAM(11);
    if (IN(12)) { __syncthreads(); phase_peer(P, lds, G, PEER_BAR); }
    if (lo <= 13 && 13 < hi) {
        const int lane = threadIdx.x & 63, wave = threadIdx.x >> 6;
        for (int m = blockIdx.x * NWAVES + wave; m < NTOK; m += G * NWAVES) {
            f32x4* xr = (f32x4*)(P.out + (size_t)m * DM) + lane; const f32x4* gr = (const f32x4*)P.in[27] + lane;
            f32x4 v[8]; float ss = 0.f;
#pragma unroll
            for (int j = 0; j < 8; ++j) { v[j] = xr[64 * j]; ss += (v[j].x * v[j].x + v[j].y * v[j].y) + (v[j].z * v[j].z + v[j].w * v[j].w); }
            const float r = rsqrtf(wave_sum(ss) * (1.f / DM) + NORM_EPS);
#pragma unroll
            for (int j = 0; j < 8; ++j) { const f32x4 g = gr[64 * j]; xr[64 * j] = (f32x4){v[j].x * r * g.x, v[j].y * r * g.y, v[j].z * r * g.z, v[j].w * r * g.w}; }
        }
    }
}

extern "C" void kernel_launch(void* const* d_in, const int* in_sizes, int n_in, void* d_out, int out_size, void* d_ws, size_t ws_size, hipStream_t stream) {
    static int grid = 0;
    if (!grid) {
        int dev = 0, cus = 0, per_cu = 0;
        if (hipGetDevice(&dev) != hipSuccess || hipDeviceGetAttribute(&cus, hipDeviceAttributeMultiprocessorCount, dev) != hipSuccess) { fprintf(stderr, "kernel_launch: device query failed\n"); return; }
        if (hipFuncSetAttribute((const void*)mega, hipFuncAttributeMaxDynamicSharedMemorySize, LDS_BYTES) != hipSuccess) { fprintf(stderr, "kernel_launch: hipFuncSetAttribute failed\n"); return; }
        if (hipOccupancyMaxActiveBlocksPerMultiprocessor(&per_cu, (const void*)mega, NTHREADS, LDS_BYTES) != hipSuccess || per_cu < 1) { fprintf(stderr, "kernel_launch: occupancy query says %d\n", per_cu); per_cu = 1; }
        grid = 256;
        if (cus != 256) fprintf(stderr, "kernel_launch: built for 256 CUs, device reports %d\n", cus);
        if (ws_size < WS_END || n_in != 28) fprintf(stderr, "kernel_launch: unexpected ws_size %zu / n_in %d\n", ws_size, n_in);
    }
    Params p{};
    for (int i = 0; i < 28; ++i) p.in[i] = (const float*)d_in[i];
    p.out = (float*)d_out; p.ws = (unsigned char*)d_ws;
#if ONE_LAUNCH
    p.ph_lo = 0; p.ph_hi = N_PHASES;
    if (hipMemsetAsync((char*)d_ws + WS_CTL, 0, CTL_ZERO_BYTES, stream) != hipSuccess) { fprintf(stderr, "kernel_launch: memset of the barrier words failed\n"); return; }
    hipLaunchKernelGGL(mega, dim3(grid), dim3(NTHREADS), LDS_BYTES, stream, p);
#else
#ifndef REPEAT_MASK
#define REPEAT_MASK 0
#endif
    for (int ph = 0; ph <= STOP_AFTER; ++ph) { p.ph_lo = ph; p.ph_hi = ph + 1;
        for (int rep = 0; rep < (((REPEAT_MASK >> ph) & 1) ? 2 : 1); ++rep) hipLaunchKernelGGL(mega, dim3(grid), dim3(NTHREADS), LDS_BYTES, stream, p); }
    if (STOP_AFTER < 12) { p.ph_lo = 13; p.ph_hi = 14; hipLaunchKernelGGL(mega, dim3(grid), dim3(NTHREADS), LDS_BYTES, stream, p); }
#endif
}
```
